# Optimizing an MI355X kernel written in HIP

```python
import math
import jax, jax.numpy as jnp
from jax import lax
import numpy as np

D_MODEL = 1024
BATCH = 2
SEQ = 8192
DEPTH = 1
DEC_BATCH = 128
DEC_SEQ = 4
PAST_LEN = 8192
PAGE_SIZE = 128

N_HEADS = 8
QK_NOPE = 64
QK_ROPE = 32
QK_HEAD = QK_NOPE + QK_ROPE
V_HEAD = 64
Q_LORA = 384
KV_LORA = 256
ATTN_WIDTH = N_HEADS * V_HEAD
ROPE_THETA = 10000.0
SCALE = QK_HEAD ** -0.5
Q_BLOCK = 128
NEG_INF = -1e30
SSM_WIDTH = 512
GROUP = 16
N_GROUPS = SSM_WIDTH // GROUP
STATE = 64
DT_MIN = 1e-3
DT_MAX = 1e-1
D_FF = 2816
CONV_W = 3
PLE_DIM = 256
EPS = 1e-6
OFF_CKV = Q_LORA
OFF_KR = OFF_CKV + KV_LORA
OFF_U = OFF_KR + QK_ROPE
OFF_GA = OFF_U + SSM_WIDTH
OFF_GS = OFF_GA + D_MODEL
IN_COLS = OFF_GS + D_MODEL
SPLITS = (OFF_CKV, OFF_KR, OFF_U, OFF_GA, OFF_GS)

kernel_name = 'hybrid_mla_s5_convffn_ple_step'


def rmsnorm(x, g):
    xf = x.astype(jnp.float32)
    xf = xf * lax.rsqrt(jnp.mean(xf * xf, axis=-1, keepdims=True) + EPS)
    return (xf * g.astype(jnp.float32)).astype(x.dtype)


def rope_angles(pos):
    inv_freq = jnp.power(ROPE_THETA, -jnp.arange(0, QK_ROPE, 2, dtype=jnp.float32) / QK_ROPE)
    ang = pos.astype(jnp.float32)[:, None] * inv_freq[None, :]
    return jnp.cos(ang)[:, None, :], jnp.sin(ang)[:, None, :]


def apply_rope(x, cos, sin):
    half = QK_ROPE // 2
    x1, x2 = x[..., :half], x[..., half:]
    cos = cos.astype(x.dtype)
    sin = sin.astype(x.dtype)
    return jnp.concatenate([x1 * cos - x2 * sin, x1 * sin + x2 * cos], axis=-1)


def head_queries(cq, w_uq, g_q, cos, sin):
    q = rmsnorm(jnp.einsum('...sc,chd->...shd', cq, w_uq), g_q)
    return jnp.concatenate([q[..., :QK_NOPE], apply_rope(q[..., QK_NOPE:], cos, sin)], axis=-1)


def head_keys(ckv, kr, w_uk, g_k, cos, sin):
    k_nope = jnp.einsum('...sc,chd->...shd', ckv, w_uk)
    k_rope = jnp.broadcast_to(kr[..., None, :], k_nope.shape[:-1] + (QK_ROPE,))
    k = rmsnorm(jnp.concatenate([k_nope, k_rope], axis=-1), g_k)
    return jnp.concatenate([k[..., :QK_NOPE], apply_rope(k[..., QK_NOPE:], cos, sin)], axis=-1)


def mla_prompt(cq, ckv, kr, lw):
    b, s, _ = cq.shape
    cos, sin = rope_angles(jnp.arange(s))
    q = head_queries(cq, lw['w_uq'], lw['g_q'], cos, sin)
    k = head_keys(ckv, kr, lw['w_uk'], lw['g_k'], cos, sin)
    nb = s // Q_BLOCK
    qb = q.reshape(b, nb, Q_BLOCK, N_HEADS, QK_HEAD).transpose(1, 0, 2, 3, 4)
    kpos = jnp.arange(s)

    def block(args):
        q_blk, blk = args
        qpos = blk * Q_BLOCK + jnp.arange(Q_BLOCK)
        sc = jnp.einsum('bqhd,bkhd->bhqk', q_blk, k).astype(jnp.float32) * SCALE
        sc = jnp.where(kpos[None, :] <= qpos[:, None], sc, NEG_INF)
        pr = jax.nn.softmax(sc, axis=-1).astype(ckv.dtype)
        o_lat = jnp.einsum('bhqk,bkc->bhqc', pr, ckv)
        return jnp.einsum('bhqc,chd->bqhd', o_lat, lw['w_uv'])

    o = lax.map(block, (qb, jnp.arange(nb)))
    return o.transpose(1, 0, 2, 3, 4).reshape(b, s, ATTN_WIDTH)


def mla_sample(cq, ckv, kr, cache_ckv, cache_kr, page_table, layer, lw):
    b, t, _ = cq.shape
    cos, sin = rope_angles(PAST_LEN + jnp.arange(t))
    q = head_queries(cq, lw['w_uq'], lw['g_q'], cos, sin)
    k_new = head_keys(ckv, kr, lw['w_uk'], lw['g_k'], cos, sin)
    causal = jnp.arange(t)[None, :] <= jnp.arange(t)[:, None]
    sc = jnp.einsum('bthd,bshd->bhts', q, k_new).astype(jnp.float32) * SCALE
    sc = jnp.where(causal, sc, NEG_INF)
    m0 = sc.max(axis=-1)
    pr = jnp.exp(sc - m0[..., None])
    l0 = pr.sum(axis=-1)
    acc0 = jnp.einsum('bhts,bsc->bhtc', pr, ckv.astype(jnp.float32))

    def page_step(carry, j):
        m, l, acc = carry
        phys = page_table[:, j]
        c = cache_ckv[layer, phys]
        r = cache_kr[layer, phys]
        pc, ps = rope_angles(j * PAGE_SIZE + jnp.arange(PAGE_SIZE))
        kp = head_keys(c, r, lw['w_uk'], lw['g_k'], pc, ps)
        s_p = jnp.einsum('bthd,bphd->bhtp', q, kp).astype(jnp.float32) * SCALE
        m_new = jnp.maximum(m, s_p.max(axis=-1))
        corr = jnp.exp(m - m_new)
        p_p = jnp.exp(s_p - m_new[..., None])
        l = l * corr + p_p.sum(axis=-1)
        acc = acc * corr[..., None] + jnp.einsum('bhtp,bpc->bhtc', p_p, c.astype(jnp.float32))
        return (m_new, l, acc), None

    (m, l, acc), _ = lax.scan(page_step, (m0, l0, acc0), jnp.arange(page_table.shape[1]))
    o_lat = (acc / l[..., None]).astype(cq.dtype)
    return jnp.einsum('bhtc,chd->bthd', o_lat, lw['w_uv']).reshape(b, t, ATTN_WIDTH)


def ssm_discretize(lw):
    a_re = lw['a_re'].astype(jnp.float32)
    a_im = lw['a_im'].astype(jnp.float32)
    dt = jnp.exp(lw['log_dt'].astype(jnp.float32))[:, None]
    mag = jnp.exp(dt * a_re)
    ab_re = mag * jnp.cos(dt * a_im)
    ab_im = mag * jnp.sin(dt * a_im)
    den = a_re * a_re + a_im * a_im
    nr = ab_re - 1.0
    f_re = (nr * a_re + ab_im * a_im) / den
    f_im = (ab_im * a_re - nr * a_im) / den
    b_re = lw['b_re'].astype(jnp.float32)
    b_im = lw['b_im'].astype(jnp.float32)
    bb_re = f_re[..., None] * b_re - f_im[..., None] * b_im
    bb_im = f_re[..., None] * b_im + f_im[..., None] * b_re
    return ab_re, ab_im, bb_re, bb_im


def complex_affine_combine(e1, e2):
    a1r, a1i, b1r, b1i = e1
    a2r, a2i, b2r, b2i = e2
    return (a2r * a1r - a2i * a1i, a2r * a1i + a2i * a1r,
            a2r * b1r - a2i * b1i + b2r, a2r * b1i + a2i * b1r + b2i)


def ssm_scan(u, h0_re, h0_im, lw):
    ab_re, ab_im, bb_re, bb_im = ssm_discretize(lw)
    b, s, _ = u.shape
    ug = u.astype(jnp.float32).reshape(b, s, N_GROUPS, GROUP)
    bu_re = jnp.einsum('bsgi,gpi->bsgp', ug, bb_re)
    bu_im = jnp.einsum('bsgi,gpi->bsgp', ug, bb_im)
    h0_re = h0_re.astype(jnp.float32)
    h0_im = h0_im.astype(jnp.float32)
    bu_re = bu_re.at[:, 0].add(ab_re * h0_re - ab_im * h0_im)
    bu_im = bu_im.at[:, 0].add(ab_re * h0_im + ab_im * h0_re)
    a_re = jnp.broadcast_to(ab_re, bu_re.shape)
    a_im = jnp.broadcast_to(ab_im, bu_im.shape)
    _, _, h_re, h_im = lax.associative_scan(complex_affine_combine, (a_re, a_im, bu_re, bu_im), axis=1)
    c_re = lw['c_re'].astype(jnp.float32)
    c_im = lw['c_im'].astype(jnp.float32)
    y = jnp.einsum('bsgp,gip->bsgi', h_re, c_re) - jnp.einsum('bsgp,gip->bsgi', h_im, c_im)
    y = y + lw['d_skip'].astype(jnp.float32).reshape(N_GROUPS, GROUP) * ug
    return y.reshape(b, s, SSM_WIDTH).astype(u.dtype), h_re[:, -1], h_im[:, -1]


def conv_ffn(x, buf, lw):
    up = rmsnorm(x, lw['g_ffn']) @ lw['w_up']
    s = up.shape[1]
    full = jnp.concatenate([buf.astype(up.dtype), up], axis=1)
    conv = lw['conv_b'] + full[:, 0:s] * lw['conv_w'][0]
    for tap in range(1, CONV_W):
        conv = conv + full[:, tap:tap + s] * lw['conv_w'][tap]
    a, v = jnp.split(conv, 2, axis=-1)
    return (jax.nn.gelu(a) * v) @ lw['w_down'], full[:, s:]


def trunk_layer(x, p, attend, h0_re, h0_im, conv_buf, lw):
    xn = rmsnorm(x, lw['g_mix'])
    cq, ckv, kr, u, ga, gs = jnp.split(xn @ lw['w_in'], SPLITS, axis=-1)
    cq = rmsnorm(cq, lw['g_cq'])
    ckv = rmsnorm(ckv, lw['g_ckv'])
    att = attend(cq, ckv, kr)
    ys, h_re, h_im = ssm_scan(u, h0_re, h0_im, lw)
    gv, gg = jnp.split(jax.nn.gelu(ys) @ lw['w_glu'], 2, axis=-1)
    ys = gv * jax.nn.sigmoid(gg)
    mixed = jax.nn.sigmoid(ga) * (att @ lw['w_oa']) + jax.nn.sigmoid(gs) * (ys @ lw['w_os'])
    x = x + mixed @ lw['w_out']
    f, new_buf = conv_ffn(x, conv_buf, lw)
    x = x + f
    x = x + jax.nn.sigmoid(rmsnorm(x, lw['g_ple']) @ lw['w_ple_gate']) * (p @ lw['w_ple_proj'])
    return x, ckv, kr, h_re, h_im, new_buf


def setup_inputs(seed: int = 0) -> dict:
    key = jax.random.key(seed)
    keys = iter(jax.random.split(key, 64))
    f32 = jnp.float32

    def nrm(shape, scale):
        return jax.random.normal(next(keys), shape, f32) * scale

    def gain(n):
        return 1.0 + nrm((DEPTH, n), 0.02)

    n_pages = PAST_LEN // PAGE_SIZE
    n_used = DEC_BATCH * n_pages
    n_pool = n_used + n_used // 4
    page_table = jax.random.permutation(next(keys), n_pool)[:n_used].reshape(DEC_BATCH, n_pages).astype(jnp.int32)
    a_im = jnp.pi * jnp.arange(STATE, dtype=f32)[None, None, :] + nrm((DEPTH, N_GROUPS, STATE), 0.01)
    log_dt = jax.random.uniform(next(keys), (DEPTH, N_GROUPS), f32, math.log(DT_MIN), math.log(DT_MAX))
    return {
        'x_prompt': nrm((BATCH, SEQ, D_MODEL), 1.0),
        'x_sample': nrm((DEC_BATCH, DEC_SEQ, D_MODEL), 1.0),
        'p_prompt': nrm((DEPTH, BATCH, SEQ, PLE_DIM), 1.0),
        'p_sample': nrm((DEPTH, DEC_BATCH, DEC_SEQ, PLE_DIM), 1.0),
        'cache_ckv': nrm((DEPTH, n_pool, PAGE_SIZE, KV_LORA), 1.0),
        'cache_kr': nrm((DEPTH, n_pool, PAGE_SIZE, QK_ROPE), 1.0),
        'page_table': page_table,
        'state_ssm_re': nrm((DEPTH, DEC_BATCH, N_GROUPS, STATE), 0.5),
        'state_ssm_im': nrm((DEPTH, DEC_BATCH, N_GROUPS, STATE), 0.5),
        'state_conv': nrm((DEPTH, DEC_BATCH, CONV_W - 1, 2 * D_FF), 1.0),
        'g_mix': gain(D_MODEL),
        'w_in': nrm((DEPTH, D_MODEL, IN_COLS), D_MODEL ** -0.5),
        'g_cq': gain(Q_LORA),
        'g_ckv': gain(KV_LORA),
        'w_uq': nrm((DEPTH, Q_LORA, N_HEADS, QK_HEAD), Q_LORA ** -0.5),
        'w_uk': nrm((DEPTH, KV_LORA, N_HEADS, QK_NOPE), KV_LORA ** -0.5),
        'w_uv': nrm((DEPTH, KV_LORA, N_HEADS, V_HEAD), KV_LORA ** -0.5),
        'g_q': gain(QK_HEAD),
        'g_k': gain(QK_HEAD),
        'a_re': -0.5 + nrm((DEPTH, N_GROUPS, STATE), 0.01),
        'a_im': a_im,
        'log_dt': log_dt,
        'b_re': nrm((DEPTH, N_GROUPS, STATE, GROUP), (2 * GROUP) ** -0.5),
        'b_im': nrm((DEPTH, N_GROUPS, STATE, GROUP), (2 * GROUP) ** -0.5),
        'c_re': nrm((DEPTH, N_GROUPS, GROUP, STATE), STATE ** -0.5),
        'c_im': nrm((DEPTH, N_GROUPS, GROUP, STATE), STATE ** -0.5),
        'd_skip': nrm((DEPTH, SSM_WIDTH), 1.0),
        'w_glu': nrm((DEPTH, SSM_WIDTH, 2 * SSM_WIDTH), SSM_WIDTH ** -0.5),
        'w_oa': nrm((DEPTH, ATTN_WIDTH, D_MODEL), ATTN_WIDTH ** -0.5),
        'w_os': nrm((DEPTH, SSM_WIDTH, D_MODEL), SSM_WIDTH ** -0.5),
        'w_out': nrm((DEPTH, D_MODEL, D_MODEL), D_MODEL ** -0.5),
        'g_ffn': gain(D_MODEL),
        'w_up': nrm((DEPTH, D_MODEL, 2 * D_FF), D_MODEL ** -0.5),
        'conv_w': nrm((DEPTH, CONV_W, 2 * D_FF), CONV_W ** -0.5),
        'conv_b': nrm((DEPTH, 2 * D_FF), 0.01),
        'w_down': nrm((DEPTH, D_FF, D_MODEL), D_FF ** -0.5),
        'g_ple': gain(D_MODEL),
        'w_ple_gate': nrm((DEPTH, D_MODEL, D_MODEL), D_MODEL ** -0.5),
        'w_ple_proj': nrm((DEPTH, PLE_DIM, D_MODEL), PLE_DIM ** -0.5),
    }


def reference(x_prompt, x_sample, p_prompt, p_sample, cache_ckv, cache_kr, page_table,
              state_ssm_re, state_ssm_im, state_conv, g_mix, w_in, g_cq, g_ckv, w_uq, w_uk, w_uv,
              g_q, g_k, a_re, a_im, log_dt, b_re, b_im, c_re, c_im, d_skip, w_glu, w_oa, w_os,
              w_out, g_ffn, w_up, conv_w, conv_b, w_down, g_ple, w_ple_gate, w_ple_proj):
    yp, ys = x_prompt, x_sample
    bp = x_prompt.shape[0]
    ckv_p, kr_p, ckv_s, kr_s = [], [], [], []
    sre_p, sim_p, sre_s, sim_s, cv_p, cv_s = [], [], [], [], [], []
    for i in range(DEPTH):
        lw = dict(g_mix=g_mix[i], w_in=w_in[i], g_cq=g_cq[i], g_ckv=g_ckv[i], w_uq=w_uq[i],
                  w_uk=w_uk[i], w_uv=w_uv[i], g_q=g_q[i], g_k=g_k[i], a_re=a_re[i], a_im=a_im[i],
                  log_dt=log_dt[i], b_re=b_re[i], b_im=b_im[i], c_re=c_re[i], c_im=c_im[i],
                  d_skip=d_skip[i], w_glu=w_glu[i], w_oa=w_oa[i], w_os=w_os[i], w_out=w_out[i],
                  g_ffn=g_ffn[i], w_up=w_up[i], conv_w=conv_w[i], conv_b=conv_b[i], w_down=w_down[i],
                  g_ple=g_ple[i], w_ple_gate=w_ple_gate[i], w_ple_proj=w_ple_proj[i])
        zero_h = jnp.zeros((bp, N_GROUPS, STATE), jnp.float32)
        zero_buf = jnp.zeros((bp, CONV_W - 1, 2 * D_FF), yp.dtype)
        yp, ckv, kr, hr, hi, buf = trunk_layer(
            yp, p_prompt[i], lambda cq, c, r: mla_prompt(cq, c, r, lw), zero_h, zero_h, zero_buf, lw)
        ckv_p.append(ckv); kr_p.append(kr); sre_p.append(hr); sim_p.append(hi); cv_p.append(buf)
        ys, ckv, kr, hr, hi, buf = trunk_layer(
            ys, p_sample[i],
            lambda cq, c, r: mla_sample(cq, c, r, cache_ckv, cache_kr, page_table, i, lw),
            state_ssm_re[i], state_ssm_im[i], state_conv[i], lw)
        ckv_s.append(ckv); kr_s.append(kr); sre_s.append(hr); sim_s.append(hi); cv_s.append(buf)
    ckv_prompt = jnp.stack(ckv_p)
    kr_prompt = jnp.stack(kr_p)
    ckv_sample = jnp.stack(ckv_s)
    kr_sample = jnp.stack(kr_s)
    ssm_re_prompt = jnp.stack(sre_p)
    ssm_im_prompt = jnp.stack(sim_p)
    ssm_re_sample = jnp.stack(sre_s)
    ssm_im_sample = jnp.stack(sim_s)
    conv_prompt = jnp.stack(cv_p)
    conv_sample = jnp.stack(cv_s)
    return (yp, ys, ckv_prompt, kr_prompt, ckv_sample, kr_sample, ssm_re_prompt, ssm_im_prompt,
            ssm_re_sample, ssm_im_sample, conv_prompt, conv_sample)
```

```cpp
#include <hip/hip_runtime.h>
#include <cstdio>
#include <cstdint>

#define REP_PA 1
#define REP_SA 1
#define SA_PROBE 0
#define P0A 1
#define P0B 1
#define P0C 1
#define P6A 1
#define P4A 1
#define P4B 1
#define P4C 1
#define P4D 1
#define SA_FIRST_ALL 0
#define SA_ALLREG 1
#define REP_G 0x0
#if REP_G
#define REPLOOP(k) _Pragma("unroll") for (int rep_ = 0; rep_ < 1 + (((REP_G) >> (k)) & 1); ++rep_)
#else
#define REPLOOP(k)
#endif
#ifndef MK_ONE_LAUNCH
#define MK_ONE_LAUNCH 1
#endif

constexpr int D = 1024, SEQ = 8192, NBATCH = 2, MP = NBATCH * SEQ, DECB = 128, DECT = 4, MS = DECB * DECT, M = MP + MS;
constexpr int NH = 8, QKN = 64, QKR = 32, QKH = 96, VH = 64, QL = 384, KVL = 256, ATTW = 512;
constexpr int SSMW = 512, GRP = 16, NG = 32, NST = 64;
constexpr int DFF = 2816, UPW = 2 * DFF, PLE = 256;
constexpr int NPAGES = 64, PAGE = 128, NPOOL = 10240;
constexpr float EPS = 1e-6f;
constexpr int NZ = 3328, ZC_CKV = 0, ZC_CQ = 256, ZC_KR = 640, ZC_U = 768, ZC_GA = 1280, ZC_GS = 2304;
constexpr size_t O_Y = 0, O_CKVP = (size_t)M * D, O_KRP = O_CKVP + (size_t)MP * KVL, O_CKVS = O_KRP + (size_t)MP * QKR, O_KRS = O_CKVS + (size_t)MS * KVL,
                 O_SREP = O_KRS + (size_t)MS * QKR, O_SIMP = O_SREP + NBATCH * NG * NST, O_SRES = O_SIMP + NBATCH * NG * NST, O_SIMS = O_SRES + (size_t)DECB * NG * NST,
                 O_CVP = O_SIMS + (size_t)DECB * NG * NST, O_CVS = O_CVP + (size_t)NBATCH * 2 * UPW, O_END = O_CVS + (size_t)DECB * 2 * UPW;
static_assert(O_END == 24164352, "output size");
constexpr int SL = 32, SCH = MP / SL  , SKU = SL * GRP  , SKA = SKU + 2 * NST  ;

constexpr size_t MiB = 1u << 20;
constexpr size_t WS_CTL = 0, CTL_ZERO_BYTES = 128 * 1024;
constexpr size_t WS_WIN = 2 * MiB;
constexpr size_t WS_WUQ = 10 * MiB;
constexpr size_t WS_WKV = 11 * MiB;
constexpr size_t WS_WGLU = 12 * MiB;
constexpr size_t WS_WOA = 13 * MiB, WS_WOS = 14 * MiB;
constexpr size_t WS_WOUT = 15 * MiB;
constexpr size_t WS_WPG = 17 * MiB;
constexpr size_t WS_WPP = 19 * MiB;
constexpr size_t WS_WUP = 20 * MiB;
constexpr size_t WS_WDN = 32 * MiB;
constexpr size_t WS_ROPE = 38 * MiB;
constexpr size_t WS_SSMT = 40 * MiB;
constexpr size_t WS_MBT = 44 * MiB;
constexpr size_t WS_TYT = 52 * MiB;
constexpr size_t WS_KJ = 72 * MiB;
constexpr size_t WS_XN = 80 * MiB;
constexpr size_t WS_Z = 116 * MiB;
constexpr size_t WS_CQN = 226 * MiB;
constexpr size_t WS_CKVN = 240 * MiB;
constexpr size_t WS_PB = 250 * MiB;
constexpr size_t WS_AY = 260 * MiB;
constexpr size_t WS_QRAW = 300 * MiB;
constexpr size_t WS_KVRAW = 330 * MiB;
constexpr size_t WS_PP = 370 * MiB;
constexpr size_t WS_Q = 410 * MiB;
constexpr size_t WS_K = 440 * MiB;
constexpr size_t WS_ATT = 470 * MiB;
constexpr size_t WS_GY = 490 * MiB;
constexpr size_t WS_YG = 510 * MiB;
constexpr size_t WS_T1 = 530 * MiB;
constexpr size_t WS_MIX = 570 * MiB;
constexpr size_t WS_X1 = 610 * MiB;
constexpr size_t WS_SS1 = 690 * MiB;
constexpr size_t WS_SS2 = 692 * MiB;
constexpr size_t WS_UP = 700 * MiB;
constexpr size_t WS_H = 890 * MiB;
constexpr size_t WS_X2 = 990 * MiB;
constexpr size_t WS_PO = 1080 * MiB;
constexpr size_t WS_PM = 1089 * MiB, WS_PL = 1090 * MiB;
constexpr size_t WS_W8 = 1095 * MiB;
constexpr size_t WS_ROPEB = 1096 * MiB;
constexpr size_t WS_UPF = 1097 * MiB, WS_UPL = 1099 * MiB;
constexpr size_t WS_QABS = 1092 * MiB;
constexpr size_t WS_SST = 1070 * MiB;
constexpr size_t WS_CB = 1100 * MiB;
constexpr size_t WS_KNC = 1650 * MiB;
constexpr size_t WS_END = 2700 * MiB;
constexpr float QSCALE = 0.10206207261596575f * 1.4426950408889634f;

constexpr int CW_BAR = 4096, CW_PAN = 16384, CW_PTMO = 8192;

#define GAS __attribute__((address_space(1)))
#define LAS __attribute__((address_space(3)))
typedef unsigned short bf16;
typedef unsigned v4u __attribute__((ext_vector_type(4)));
typedef unsigned v2u __attribute__((ext_vector_type(2)));
typedef float f32x4 __attribute__((ext_vector_type(4)));
typedef float f32x2 __attribute__((ext_vector_type(2)));
typedef short bf16x8 __attribute__((ext_vector_type(8)));
#define LDS_WAIT() asm volatile("s_waitcnt lgkmcnt(0)" ::: "memory")
#define VM_WAIT() asm volatile("s_waitcnt vmcnt(0)" ::: "memory")
__device__ __forceinline__ unsigned f2bf(float f) { unsigned u = __builtin_bit_cast(unsigned, f); return (u + 0x7fffu + ((u >> 16) & 1u)) >> 16; }
__device__ __forceinline__ unsigned pk2(float lo, float hi) { return f2bf(lo) | (f2bf(hi) << 16); }
__device__ __forceinline__ float bflo(unsigned w) { return __builtin_bit_cast(float, w << 16); }
__device__ __forceinline__ float bfhi(unsigned w) { return __builtin_bit_cast(float, w & 0xffff0000u); }
__device__ __forceinline__ float bf2f(bf16 h) { return __builtin_bit_cast(float, (unsigned)h << 16); }
__device__ __forceinline__ float sigmoidf_(float x) { return __builtin_amdgcn_rcpf(1.0f + __builtin_amdgcn_exp2f(-1.4426950408889634f * x)); }
__device__ __forceinline__ float gelu_tanh(float x) { const float u = 1.5957691216057308f * (x + 0.044715f * x * x * x); return x * sigmoidf_(u); }
__device__ __forceinline__ float wave_sum(float v) {
#pragma unroll
    for (int o = 1; o < 64; o <<= 1) v += __shfl_xor(v, o);
    return v;
}

namespace pg8 {
#define PG8_LAS __attribute__((address_space(3)))
typedef unsigned short bf16_t;
typedef short bf16x8 __attribute__((ext_vector_type(8)));
typedef float f32x4 __attribute__((ext_vector_type(4)));
typedef unsigned u32x4 __attribute__((ext_vector_type(4)));
constexpr int BM = 256, BK = 64, HALF = 128, HTB = HALF * BK * 2, STAGE_BYTES = 8 * HTB, NXCD = 8, WGM = 8;

__host__ __device__ __forceinline__ int lds_byte(int r, int c) { const int st = (r >> 4) * 2 + (c >> 5), rr = r & 15, cc = c & 31, ob = rr * 64 + cc * 2; return st * 1024 + (ob ^ (((ob >> 9) & 1) << 5)); }
__host__ __device__ __forceinline__ void stage_rc(int b, int& R, int& C) { const int st = b / 1024, sb = b % 1024, swz = sb ^ (((sb >> 9) & 1) << 5); R = (st >> 1) * 16 + swz / 64; C = (st & 1) * 32 + (swz % 64) / 2; }
__host__ __device__ __forceinline__ int perm32(int rho) { const int n = rho >> 4, i = rho & 15; return 8 * (i >> 2) + 4 * n + (i & 3); }

struct Unit { int pm, pn, z, q; };
struct Gemm { const bf16_t* A; const bf16_t* Bt; int lda, ldb, K; size_t zA, zB; };

struct Order {
    int nM, nN, n, first, G, pm0, nQ;
    __device__ __forceinline__ void init(int nM_, int nN_, int nZ_, int G_, int c, int base, int pm0_ = 0, int nQ_ = 1) {
        nM = nM_; nN = nN_; n = nM_ * nN_ * nZ_ * nQ_; G = G_; pm0 = pm0_; nQ = nQ_;
        const int i0 = (base > c) ? (base - c + G_ - 1) / G_ : 0;
        first = c + i0 * G_ - base;
    }
    __device__ __forceinline__ bool next(int i, Unit& u) const {
        const long L = (long)first + (long)i * G; if (L >= n) return false;
        int w = (int)L; u.q = -1; if (nQ > 1) { u.q = w % nQ; w /= nQ; }
        const int per = nM * nN; u.z = w / per; int wgid = w % per;
        { const int q = per / NXCD, r = per % NXCD, xcd = wgid % NXCD, off = wgid / NXCD; wgid = (xcd < r ? xcd * (q + 1) : r * (q + 1) + (xcd - r) * q) + off; }
        const int nig = WGM * nN, gid = wgid / nig, fm = gid * WGM, gsz = (nM - fm) < WGM ? (nM - fm) : WGM;
        u.pm = pm0 + fm + ((wgid % nig) % gsz); u.pn = (wgid % nig) / gsz; return true;
    }
};

struct OrderSeq {
    Order a, b; int na;
    __device__ __forceinline__ void init(const Order& a_, const Order& b_, int n1, int G_, int c) { a = a_; b = b_; na = (n1 > c) ? (n1 - c + G_ - 1) / G_ : 0; }
    __device__ __forceinline__ bool next(int i, Unit& u) const { return (i < na) ? a.next(i, u) : b.next(i - na, u); }
};
__device__ __forceinline__ unsigned cvt_pk_bf16(float lo, float hi) { unsigned r; asm volatile("v_cvt_pk_bf16_f32 %0, %1, %2" : "=v"(r) : "v"(lo), "v"(hi)); return r; }

template <class Epi, bool ALIGN_EPI = true, bool SP2 = true, bool QUARTER = false, class Sched = Order>
__device__ __forceinline__ void gemm_phase(PG8_LAS unsigned char* lds, const Gemm g, const Sched& S, const Epi& E) {
    int tid = threadIdx.x; asm volatile("" : "+v"(tid));
    const int wid = __builtin_amdgcn_readfirstlane(tid >> 6), lane = tid & 63, wr = wid >> 2, wc = wid & 3, fr = lane & 15, fq = lane >> 4;
    int K = g.K; asm volatile("" : "+s"(K));
    const int nt = K / BK;
    unsigned voffA[2], voffB[2];
#pragma unroll
    for (int i = 0; i < 2; ++i) { int R, C; stage_rc(tid * 16 + i * 8192, R, C); const int Rb = Epi::PERM ? ((R & ~31) + perm32(R & 31)) : R;
        voffA[i] = (unsigned)(R * g.lda + C) * 2u; voffB[i] = (unsigned)(Rb * g.ldb + C) * 2u; }
    const size_t kstep = (size_t)(BK * 2);
    const size_t hstepA = (size_t)HALF * g.lda * 2, hstepB = (size_t)HALF * g.ldb * 2;
    const size_t tstepA = 2 * hstepA, tstepB = 2 * hstepB;
    const unsigned ldsw = (unsigned)wid * 1024u;
    const int aoff = lds_byte(wr * 64 + fr, fq * 8), boff = lds_byte(wc * 32 + fr, fq * 8);
#define PG8_SA(b, h) (((b) * 2 + (h)) * HTB)
#define PG8_SB(b, h) ((4 + (b) * 2 + (h)) * HTB)
#define PG8_STAGE(bufoff, gbase, voff) do { _Pragma("unroll") for (int _i = 0; _i < 2; ++_i) \
        __builtin_amdgcn_global_load_lds((const unsigned*)((const char*)(gbase) + (voff)[_i]), (PG8_LAS unsigned*)(lds + (bufoff) + ldsw + _i * 8192), 16, 0, 0); } while (0)
#define PG8_LDA(dst, b, h) do { _Pragma("unroll") for (int m = 0; m < 4; ++m) if (!QUARTER || m == cur.q) _Pragma("unroll") for (int k = 0; k < 2; ++k) dst[m][k] = *(const PG8_LAS bf16x8*)(lds + PG8_SA(b, h) + aoff + m * 2048 + k * 1024); } while (0)
#define PG8_LDB(dst, b, h) do { _Pragma("unroll") for (int n = 0; n < 2; ++n) _Pragma("unroll") for (int k = 0; k < 2; ++k) dst[n][k] = *(const PG8_LAS bf16x8*)(lds + PG8_SB(b, h) + boff + n * 2048 + k * 1024); } while (0)
#define PG8_MMA(ai, bj, At, Bt) do { __builtin_amdgcn_s_setprio(1); _Pragma("unroll") for (int m = 0; m < 4; ++m) if (!QUARTER || m == cur.q) _Pragma("unroll") for (int n = 0; n < 2; ++n) _Pragma("unroll") for (int k = 0; k < 2; ++k) \
        acc[ai][bj][m][n] = __builtin_amdgcn_mfma_f32_16x16x32_bf16(Bt[n][k], At[m][k], acc[ai][bj][m][n], 0, 0, 0); __builtin_amdgcn_s_setprio(0); } while (0)
#define PG8_WAIT_V(n) asm volatile("s_waitcnt vmcnt(" #n ")" ::: "memory")
#define PG8_WAIT_L(n) asm volatile("s_waitcnt lgkmcnt(" #n ")" ::: "memory")
#define PG8_BAR __builtin_amdgcn_s_barrier()
#define PG8_SCHED __builtin_amdgcn_sched_barrier(0)
    Unit cur, nxt; int ui = 0;
    if (!S.next(0, cur)) return;
    f32x4 acc[2][2][4][2];
#pragma unroll
    for (int a = 0; a < 2; ++a)
#pragma unroll
        for (int b = 0; b < 2; ++b)
#pragma unroll
            for (int m = 0; m < 4; ++m)
#pragma unroll
                for (int n = 0; n < 2; ++n) acc[a][b][m][n] = (f32x4){0.f, 0.f, 0.f, 0.f};
    bf16x8 At[4][2], B0[2][2], B1[2][2];
    const char* cA = (const char*)(g.A + (size_t)cur.z * g.zA) + (size_t)cur.pm * tstepA; const char* cB = (const char*)(g.Bt + (size_t)cur.z * g.zB) + (size_t)cur.pn * tstepB;
    if constexpr (SP2) {
        PG8_STAGE(PG8_SB(0, 0), cB, voffB); PG8_STAGE(PG8_SB(0, 1), cB + hstepB, voffB); PG8_STAGE(PG8_SA(0, 0), cA, voffA); PG8_STAGE(PG8_SA(0, 1), cA + hstepA, voffA);
        if (wr == 1) PG8_BAR;
        PG8_WAIT_V(2); PG8_BAR;
        PG8_STAGE(PG8_SB(1, 0), cB + kstep, voffB); PG8_STAGE(PG8_SA(1, 0), cA + kstep, voffA); PG8_STAGE(PG8_SB(1, 1), cB + hstepB + kstep, voffB);
        PG8_WAIT_V(6); PG8_BAR;
    } else {
        PG8_STAGE(PG8_SB(0, 0), cB, voffB); PG8_STAGE(PG8_SA(0, 0), cA, voffA); PG8_STAGE(PG8_SB(0, 1), cB + hstepB, voffB); PG8_STAGE(PG8_SA(0, 1), cA + hstepA, voffA);
        if (wr == 1) PG8_BAR;
        PG8_WAIT_V(4); PG8_BAR;
        PG8_STAGE(PG8_SB(1, 0), cB + kstep, voffB); PG8_STAGE(PG8_SA(1, 0), cA + kstep, voffA); PG8_STAGE(PG8_SB(1, 1), cB + hstepB + kstep, voffB);
        PG8_WAIT_V(6); PG8_BAR;
    }
    for (;;) {
        const bool has_next = S.next(ui + 1, nxt);
        const char* nA = has_next ? (const char*)(g.A + (size_t)nxt.z * g.zA) + (size_t)nxt.pm * tstepA : cA; const char* nB = has_next ? (const char*)(g.Bt + (size_t)nxt.z * g.zB) + (size_t)nxt.pn * tstepB : cB;
        for (int t = 0; t < nt; t += 2) {
            const bool last = (t == nt - 2);
            const char* a1 = cA + (size_t)(t + 1) * kstep;
            const char* a2 = last ? nA : cA + (size_t)(t + 2) * kstep; const char* b2 = last ? nB : cB + (size_t)(t + 2) * kstep;
            const char* a3 = a2 + kstep; const char* b3 = b2 + kstep;
            if constexpr (SP2) {
            PG8_LDB(B0, 0, 0); PG8_LDB(B1, 0, 1); PG8_SCHED; PG8_LDA(At, 0, 0); PG8_STAGE(PG8_SA(1, 1), a1 + hstepA, voffA);
            PG8_WAIT_V(8); PG8_WAIT_L(0); PG8_BAR; PG8_MMA(0, 0, At, B0); PG8_MMA(0, 1, At, B1); PG8_BAR; PG8_SCHED;
            PG8_LDA(At, 0, 1); PG8_STAGE(PG8_SB(0, 0), b2, voffB); PG8_STAGE(PG8_SB(0, 1), b2 + hstepB, voffB); PG8_STAGE(PG8_SA(0, 0), a2, voffA);
            PG8_WAIT_V(8); PG8_WAIT_L(0); PG8_BAR; PG8_MMA(1, 0, At, B0); PG8_MMA(1, 1, At, B1); PG8_BAR; PG8_SCHED;
            PG8_LDB(B0, 1, 0); PG8_LDB(B1, 1, 1); PG8_SCHED; PG8_LDA(At, 1, 0); PG8_STAGE(PG8_SA(0, 1), a2 + hstepA, voffA);
            PG8_WAIT_V(8); PG8_WAIT_L(0); PG8_BAR; PG8_MMA(0, 0, At, B0); PG8_MMA(0, 1, At, B1); PG8_BAR; PG8_SCHED;
            PG8_LDA(At, 1, 1); PG8_STAGE(PG8_SB(1, 0), b3, voffB); PG8_STAGE(PG8_SB(1, 1), b3 + hstepB, voffB); PG8_STAGE(PG8_SA(1, 0), a3, voffA);
            PG8_WAIT_V(8); PG8_WAIT_L(0); PG8_BAR; PG8_MMA(1, 0, At, B0); PG8_MMA(1, 1, At, B1); PG8_BAR; PG8_SCHED;
            } else {
            PG8_LDB(B0, 0, 0); PG8_SCHED; PG8_LDA(At, 0, 0); PG8_STAGE(PG8_SA(1, 1), a1 + hstepA, voffA);
            PG8_WAIT_L(8); PG8_BAR; PG8_WAIT_L(0); PG8_MMA(0, 0, At, B0); PG8_BAR; PG8_SCHED;
            PG8_LDB(B1, 0, 1); PG8_STAGE(PG8_SB(0, 0), b2, voffB);
            PG8_BAR; PG8_WAIT_L(0); PG8_MMA(0, 1, At, B1); PG8_BAR;
            PG8_LDA(At, 0, 1); PG8_STAGE(PG8_SA(0, 0), a2, voffA);
            PG8_BAR; PG8_WAIT_L(0); PG8_MMA(1, 0, At, B0); PG8_BAR; PG8_SCHED;
            PG8_STAGE(PG8_SB(0, 1), b2 + hstepB, voffB);
            PG8_WAIT_V(6); PG8_BAR; PG8_MMA(1, 1, At, B1); PG8_BAR;
            PG8_LDB(B0, 1, 0); PG8_SCHED; PG8_LDA(At, 1, 0); PG8_STAGE(PG8_SA(0, 1), a2 + hstepA, voffA);
            PG8_WAIT_L(8); PG8_BAR; PG8_WAIT_L(0); PG8_MMA(0, 0, At, B0); PG8_BAR; PG8_SCHED;
            PG8_LDB(B1, 1, 1); PG8_STAGE(PG8_SB(1, 0), b3, voffB);
            PG8_BAR; PG8_WAIT_L(0); PG8_MMA(0, 1, At, B1); PG8_BAR;
            PG8_LDA(At, 1, 1); PG8_STAGE(PG8_SA(1, 0), a3, voffA);
            PG8_BAR; PG8_WAIT_L(0); PG8_MMA(1, 0, At, B0); PG8_BAR; PG8_SCHED;
            PG8_STAGE(PG8_SB(1, 1), b3 + hstepB, voffB);
            PG8_WAIT_V(6); PG8_BAR; PG8_MMA(1, 1, At, B1); PG8_BAR;
            }
        }
        if constexpr (ALIGN_EPI) { if (wr == 0) PG8_BAR; }
        E(acc, cur, wr, wc, fr, fq);
        if (!has_next) break;
#pragma unroll
        for (int a = 0; a < 2; ++a)
#pragma unroll
            for (int b = 0; b < 2; ++b)
#pragma unroll
                for (int m = 0; m < 4; ++m)
#pragma unroll
                    for (int n = 0; n < 2; ++n) acc[a][b][m][n] = (f32x4){0.f, 0.f, 0.f, 0.f};
        cur = nxt; cA = nA; cB = nB; ++ui;
        if constexpr (ALIGN_EPI) { if (wr == 1) PG8_BAR; }
    }
    PG8_WAIT_V(0);
    if constexpr (!ALIGN_EPI) { if (wr == 0) PG8_BAR; }
    PG8_BAR;
#undef PG8_SA
#undef PG8_SB
#undef PG8_STAGE
#undef PG8_LDA
#undef PG8_LDB
#undef PG8_MMA
#undef PG8_WAIT_V
#undef PG8_WAIT_L
#undef PG8_BAR
#undef PG8_SCHED
}

template <class F> struct EpiRow8 {
    static constexpr bool PERM = true;
    F f;
    __device__ __forceinline__ void operator()(const f32x4 (&acc)[2][2][4][2], const Unit& u, int wr, int wc, int fr, int fq) const {
        const int row0 = u.pm * BM + wr * 64 + fr, col0 = u.pn * BM + wc * 32 + 8 * fq;
#pragma unroll
        for (int ai = 0; ai < 2; ++ai)
#pragma unroll
            for (int m = 0; m < 4; ++m) { if (u.q >= 0 && m != u.q) continue;
#pragma unroll
                for (int bj = 0; bj < 2; ++bj) f(u, row0 + ai * HALF + m * 16, col0 + bj * HALF, acc[ai][bj][m][0], acc[ai][bj][m][1]); }
    }
};
template <class F> struct EpiPair8 {
    static constexpr bool PERM = true;
    F f;
    __device__ __forceinline__ void operator()(const f32x4 (&acc)[2][2][4][2], const Unit& u, int wr, int wc, int fr, int fq) const {
        const int row0 = u.pm * BM + wr * 64 + fr, cp = u.pn * HALF + wc * 32 + 8 * fq;
#pragma unroll
        for (int ai = 0; ai < 2; ++ai)
#pragma unroll
            for (int m = 0; m < 4; ++m) { if (u.q >= 0 && m != u.q) continue; f(u, row0 + ai * HALF + m * 16, cp, acc[ai][0][m][0], acc[ai][0][m][1], acc[ai][1][m][0], acc[ai][1][m][1]); }
    }
};
}
using pg8::cvt_pk_bf16;
__device__ __forceinline__ v4u pack8(f32x4 a, f32x4 b) { v4u w; w.x = cvt_pk_bf16(a[0], a[1]); w.y = cvt_pk_bf16(a[2], a[3]); w.z = cvt_pk_bf16(b[0], b[1]); w.w = cvt_pk_bf16(b[2], b[3]); return w; }

__device__ __forceinline__ void unpack8(v4u w, float (&f)[8]) { f[0] = bflo(w.x); f[1] = bfhi(w.x); f[2] = bflo(w.y); f[3] = bfhi(w.y); f[4] = bflo(w.z); f[5] = bfhi(w.z); f[6] = bflo(w.w); f[7] = bfhi(w.w); }
__device__ __forceinline__ int pg8_opq(int x) { asm volatile("" : "+v"(x)); return x; }
template <bool BASE_BF16> struct EpiResid {
    static constexpr bool PERM = true;
    const float* xp; const float* xs;
    const bf16* xb;
    bf16* XO; float* SS;
    __device__ __forceinline__ void operator()(const pg8::f32x4 (&acc)[2][2][4][2], const pg8::Unit& u, int wr, int wc, int fr_, int fq_) const {
        const int fr = pg8_opq(fr_), fq = pg8_opq(fq_);
        const int row0 = u.pm * 256 + wr * 64 + fr, col0 = u.pn * 256 + wc * 32 + 8 * fq;
#pragma unroll
        for (int ai = 0; ai < 2; ++ai)
#pragma unroll
            for (int m = 0; m < 4; ++m) { if (u.q >= 0 && m != u.q) continue;
                const int row = row0 + ai * 128 + m * 16;
                float ss = 0.f;
#pragma unroll
                for (int bj = 0; bj < 2; ++bj) {
                    const int col = col0 + bj * 128; f32x4 x0, x1;
                    if (BASE_BF16) { float f[8]; unpack8(*(const GAS v4u*)(xb + (size_t)row * D + col), f); x0 = (f32x4){f[0], f[1], f[2], f[3]}; x1 = (f32x4){f[4], f[5], f[6], f[7]}; }
                    else { const float* br = (row < MP) ? xp + (size_t)row * D : xs + (size_t)(row - MP) * D; x0 = *(const GAS f32x4*)(br + col); x1 = *(const GAS f32x4*)(br + col + 4); }
                    x0 += acc[ai][bj][m][0]; x1 += acc[ai][bj][m][1];
                    ss += (x0[0] * x0[0] + x0[1] * x0[1]) + (x0[2] * x0[2] + x0[3] * x0[3]) + (x1[0] * x1[0] + x1[1] * x1[1]) + (x1[2] * x1[2] + x1[3] * x1[3]);
                    *(GAS v4u*)(XO + (size_t)row * D + col) = pack8(x0, x1);
                }
                ss += __shfl_xor(ss, 16); ss += __shfl_xor(ss, 32);
                if (fq == 0) SS[(size_t)row * 16 + u.pn * 4 + wc] = ss;
            }
    }
};
__device__ __forceinline__ float row_rs(const float* SS, int row) {
    const f32x4 a = *(const GAS f32x4*)(SS + (size_t)row * 16), b = *(const GAS f32x4*)(SS + (size_t)row * 16 + 4), c = *(const GAS f32x4*)(SS + (size_t)row * 16 + 8), d = *(const GAS f32x4*)(SS + (size_t)row * 16 + 12);
    const float s = ((a[0] + a[1]) + (a[2] + a[3])) + ((b[0] + b[1]) + (b[2] + b[3])) + ((c[0] + c[1]) + (c[2] + c[3])) + ((d[0] + d[1]) + (d[2] + d[3]));
    return 1.0f / sqrtf(s * (1.f / D) + EPS);
}
struct EpiUp {
    static constexpr bool PERM = true;
    const float* SS; bf16* UPB;
    __device__ __forceinline__ void operator()(const pg8::f32x4 (&acc)[2][2][4][2], const pg8::Unit& u, int wr, int wc, int fr, int fq) const {
        const int row0 = u.pm * 256 + wr * 64 + fr, col0 = u.pn * 256 + wc * 32 + 8 * fq;
#pragma unroll
        for (int ai = 0; ai < 2; ++ai)
#pragma unroll
            for (int m = 0; m < 4; ++m) { if (u.q >= 0 && m != u.q) continue; const int row = row0 + ai * 128 + m * 16; const float rs = row_rs(SS, row);
#pragma unroll
                for (int bj = 0; bj < 2; ++bj) *(GAS v4u*)(UPB + (size_t)row * UPW + col0 + bj * 128) = pack8(acc[ai][bj][m][0] * rs, acc[ai][bj][m][1] * rs); }
    }
};

__device__ __forceinline__ float dpp_ror1(float x) { return __builtin_bit_cast(float, __builtin_amdgcn_update_dpp(0, __builtin_bit_cast(int, x), 0x121, 0xF, 0xF, false)); }
__device__ __forceinline__ float dpp_ror2(float x) { return __builtin_bit_cast(float, __builtin_amdgcn_update_dpp(0, __builtin_bit_cast(int, x), 0x122, 0xF, 0xF, false)); }
struct EpiUpConv {
    static constexpr bool PERM = true;
    const float* SS; bf16* HB; bf16* UPF; bf16* UPL; float* out; const float* conv_w; const float* conv_b; const float* state_conv; LAS unsigned char* scr; unsigned* cnt;
    template <bool SAMPLE> __device__ __forceinline__ void body(const pg8::f32x4 (&acc)[2][2][4][2], const pg8::Unit& u, int wr, int fr, int cl0_, int acol0, LAS float* CW, LAS float* BD, LAS float* RSL) const {
#pragma unroll
        for (int ai = 0; ai < 2; ++ai)
#pragma unroll
            for (int m = 0; m < 4; ++m) {
                const int fro = pg8_opq(fr), cl0 = pg8_opq(cl0_);
                const int rl = ai * 128 + wr * 64 + m * 16 + fro, row = u.pm * 256 + rl; const float rs = RSL[rl];
#pragma unroll
                for (int n = 0; n < 2; ++n) {
                    f32x4 cv2[2];
#pragma unroll
                    for (int bj = 0; bj < 2; ++bj) {
                        const int cl = bj * 128 + cl0 + 4 * n, gcol = bj * DFF + acol0 + cl0 + 4 * n; const f32x4 x = acc[ai][bj][m][n] * rs;
                        f32x4 s1, s2;
#pragma unroll
                        for (int i = 0; i < 4; ++i) { s1[i] = dpp_ror1(x[i]); s2[i] = dpp_ror2(x[i]); }
                        if (SAMPLE) { const int t = fro & 3; const float* sp = state_conv + (size_t)((row - MP) >> 2) * 2 * UPW + gcol;
                            const f32x4 S0 = *(const GAS f32x4*)sp, S1 = *(const GAS f32x4*)(sp + UPW);
#pragma unroll
                            for (int i = 0; i < 4; ++i) { s1[i] = (t >= 1) ? s1[i] : S1[i]; s2[i] = (t >= 2) ? s2[i] : (t == 1 ? S1[i] : S0[i]); }
                            if (t >= 2) *(GAS f32x4*)(out + O_CVS + ((size_t)((row - MP) >> 2) * 2 + (t - 2)) * UPW + gcol) = x;
                        } else if (m > 0) { const f32x4 xp = acc[ai][bj][m > 0 ? m - 1 : 0][n] * RSL[rl - 16];
#pragma unroll
                            for (int i = 0; i < 4; ++i) { s1[i] = dpp_ror1(fro == 15 ? xp[i] : x[i]); s2[i] = dpp_ror2(fro >= 14 ? xp[i] : x[i]); }
                        } else { const int pb = (wr == 1) ? ai * 2 : 1;
                            const int pr0 = (pb >> 1) * 128 + (pb & 1) * 64 + 62;
                            const f32x4 b2 = *(const LAS f32x4*)(BD + (pb * 2 + 0) * 256 + cl) * RSL[pr0], b1 = *(const LAS f32x4*)(BD + (pb * 2 + 1) * 256 + cl) * RSL[pr0 + 1];
#pragma unroll
                            for (int i = 0; i < 4; ++i) { s1[i] = (fro >= 1) ? s1[i] : b1[i]; s2[i] = (fro >= 2) ? s2[i] : (fro == 1 ? b1[i] : b2[i]); }
                        }
                        const f32x4 w0 = *(const LAS f32x4*)(CW + cl), w1 = *(const LAS f32x4*)(CW + 256 + cl), w2 = *(const LAS f32x4*)(CW + 512 + cl), cb = *(const LAS f32x4*)(CW + 768 + cl);
                        cv2[bj] = cb + s2 * w0 + s1 * w1 + x * w2;
                        if (!SAMPLE && ai == 0 && m == 0) { if (rl < 2) { v2u w; w.x = cvt_pk_bf16(x[0], x[1]); w.y = cvt_pk_bf16(x[2], x[3]); *(GAS v2u*)(UPF + ((size_t)u.pm * 2 + rl) * UPW + gcol) = w; } }
                        if (!SAMPLE && ai == 1 && m == 3) { if (rl >= 254) { v2u w; w.x = cvt_pk_bf16(x[0], x[1]); w.y = cvt_pk_bf16(x[2], x[3]); *(GAS v2u*)(UPL + ((size_t)u.pm * 2 + (rl - 254)) * UPW + gcol) = w;
                                if ((u.pm & 31) == 31) *(GAS f32x4*)(out + O_CVP + ((size_t)(u.pm >> 5) * 2 + (rl - 254)) * UPW + gcol) = x; } }
                    }
                    if (SAMPLE || rl >= 2) { v2u w; w.x = cvt_pk_bf16(gelu_tanh(cv2[0][0]) * cv2[1][0], gelu_tanh(cv2[0][1]) * cv2[1][1]); w.y = cvt_pk_bf16(gelu_tanh(cv2[0][2]) * cv2[1][2], gelu_tanh(cv2[0][3]) * cv2[1][3]);
                        if (SAMPLE) asm volatile("global_store_dwordx2 %0, %1, off sc1" :: "v"(HB + (size_t)row * DFF + acol0 + cl0 + 4 * n), "v"(w) : "memory");
                        else *(GAS v2u*)(HB + (size_t)row * DFF + acol0 + cl0 + 4 * n) = w; }
                    asm volatile("" ::: "memory"); __builtin_amdgcn_sched_barrier(0);
                }
            }
    }
    __device__ __forceinline__ void operator()(const pg8::f32x4 (&acc)[2][2][4][2], const pg8::Unit& u, int wr, int wc, int fr_, int fq_) const {
        const int tid = pg8_opq(threadIdx.x), fr = pg8_opq(fr_), fq = pg8_opq(fq_);
        LAS float* CW = (LAS float*)scr;
        LAS float* BD = CW + 1024;
        const int acol0 = u.pn * 128, cl0_ = wc * 32 + 8 * fq;
        for (int e = tid; e < 1024; e += 512) { const int k = e >> 8, cl = e & 255, gcol = (cl >> 7) * DFF + acol0 + (cl & 127); CW[e] = (k < 3) ? conv_w[k * UPW + gcol] : conv_b[gcol]; }
        LAS float* RSL = BD + 2048;
        if (tid < 256) RSL[tid] = row_rs(SS, u.pm * 256 + tid);
        if (fr >= 14) {
#pragma unroll
            for (int ai = 0; ai < 2; ++ai)
#pragma unroll
                for (int bj = 0; bj < 2; ++bj)
#pragma unroll
                    for (int n = 0; n < 2; ++n) *(LAS f32x4*)(BD + ((ai * 2 + wr) * 2 + (fr - 14)) * 256 + bj * 128 + cl0_ + 4 * n) = acc[ai][bj][3][n];
        }
        asm volatile("s_waitcnt vmcnt(0) lgkmcnt(0)" ::: "memory"); __builtin_amdgcn_s_barrier(); asm volatile("" ::: "memory");
        if (u.pm >= MP / 256) { body<true>(acc, u, wr, fr, cl0_, acol0, CW, BD, RSL);
            asm volatile("s_waitcnt vmcnt(0)" ::: "memory"); if ((tid & 63) == 0) __hip_atomic_fetch_add(cnt + 64 * u.pm, 1u, __ATOMIC_RELAXED, __HIP_MEMORY_SCOPE_AGENT); }
        else body<false>(acc, u, wr, fr, cl0_, acol0, CW, BD, RSL);
        asm volatile("s_waitcnt lgkmcnt(0)" ::: "memory"); __builtin_amdgcn_s_barrier(); asm volatile("" ::: "memory");
    }
};
struct EpiPle {
    static constexpr bool PERM = true;
    const float* SS; const bf16* X2B; const bf16* PPB; float* Y;
    __device__ __forceinline__ void operator()(const pg8::f32x4 (&acc)[2][2][4][2], const pg8::Unit& u, int wr, int wc, int fr, int fq) const {
        const int row0 = u.pm * 256 + wr * 64 + fr, col0 = u.pn * 256 + wc * 32 + 8 * fq;
#pragma unroll
        for (int ai = 0; ai < 2; ++ai)
#pragma unroll
            for (int m = 0; m < 4; ++m) { if (u.q >= 0 && m != u.q) continue; const int row = row0 + ai * 128 + m * 16; const float rs = row_rs(SS, row);
#pragma unroll
                for (int bj = 0; bj < 2; ++bj) { const int col = col0 + bj * 128; const size_t o = (size_t)row * D + col;
                    float pw[8], xw[8]; unpack8(*(const GAS v4u*)(PPB + o), pw); unpack8(*(const GAS v4u*)(X2B + o), xw);
                    const f32x4 a = acc[ai][bj][m][0] * rs, b = acc[ai][bj][m][1] * rs; f32x4 y0, y1;
#pragma unroll
                    for (int i = 0; i < 4; ++i) { y0[i] = xw[i] + sigmoidf_(a[i]) * pw[i]; y1[i] = xw[4 + i] + sigmoidf_(b[i]) * pw[4 + i]; }
                    *(GAS f32x4*)(Y + o) = y0; *(GAS f32x4*)(Y + o + 4) = y1; } }
    }
};


struct EpiInproj {
    static constexpr bool PERM = true;
    bf16* Zp; bf16* CQNp; bf16* CKVNp; bf16* AYp; float* out; const float* g_ckv; LAS unsigned char* scr;
    __device__ __forceinline__ void operator()(const pg8::f32x4 (&acc)[2][2][4][2], const pg8::Unit& u, int wr, int wc, int fr, int fq) const {
        const int row0 = u.pm * 256 + wr * 64 + fr, colw = wc * 32 + 8 * fq;
        if (u.pn == 0) {
            LAS float* part = (LAS float*)scr;
#pragma unroll
            for (int ai = 0; ai < 2; ++ai)
#pragma unroll
                for (int m = 0; m < 4; ++m) { float ss = 0.f;
#pragma unroll
                    for (int bj = 0; bj < 2; ++bj)
#pragma unroll
                        for (int n = 0; n < 2; ++n) { const f32x4 v = acc[ai][bj][m][n]; ss += (v[0] * v[0] + v[1] * v[1]) + (v[2] * v[2] + v[3] * v[3]); }
                    ss += __shfl_xor(ss, 16); ss += __shfl_xor(ss, 32);
                    if (fq == 0) part[(ai * 128 + wr * 64 + m * 16 + fr) * 4 + wc] = ss; }
            asm volatile("s_waitcnt lgkmcnt(0)" ::: "memory"); __builtin_amdgcn_s_barrier(); asm volatile("" ::: "memory");
#pragma unroll
            for (int ai = 0; ai < 2; ++ai)
#pragma unroll
                for (int m = 0; m < 4; ++m) { const int rl = ai * 128 + wr * 64 + m * 16 + fr, row = u.pm * 256 + rl; const f32x4 p = *(const LAS f32x4*)(part + rl * 4);
                    const float rs = 1.0f / sqrtf(((p[0] + p[1]) + (p[2] + p[3])) * (1.f / KVL) + EPS);
                    float* dst = (row < MP) ? out + O_CKVP + (size_t)row * KVL : out + O_CKVS + (size_t)(row - MP) * KVL;
#pragma unroll
                    for (int bj = 0; bj < 2; ++bj) { const int col = colw + bj * 128; const f32x4 g0 = *(const GAS f32x4*)(g_ckv + col), g1 = *(const GAS f32x4*)(g_ckv + col + 4);
                        const f32x4 o0 = acc[ai][bj][m][0] * rs * g0, o1 = acc[ai][bj][m][1] * rs * g1;
                        *(GAS f32x4*)(dst + col) = o0; *(GAS f32x4*)(dst + col + 4) = o1; *(GAS v4u*)(CKVNp + (size_t)row * KVL + col) = pack8(o0, o1); } }
            asm volatile("s_waitcnt lgkmcnt(0)" ::: "memory"); __builtin_amdgcn_s_barrier(); asm volatile("" ::: "memory");
            return;
        }
#pragma unroll
        for (int ai = 0; ai < 2; ++ai)
#pragma unroll
            for (int m = 0; m < 4; ++m) { const int row = row0 + ai * 128 + m * 16;
#pragma unroll
                for (int bj = 0; bj < 2; ++bj) { const int col = u.pn * 256 + colw + bj * 128; f32x4 a = acc[ai][bj][m][0], b = acc[ai][bj][m][1];
                    if (u.pn <= 2) {
                        if (col < ZC_KR) *(GAS v4u*)(CQNp + (size_t)row * QL + (col - ZC_CQ)) = pack8(a, b);
                        else if (col < ZC_KR + QKR) { float* dst = ((row < MP) ? out + O_KRP + (size_t)row * QKR : out + O_KRS + (size_t)(row - MP) * QKR) + (col - ZC_KR); *(GAS f32x4*)dst = a; *(GAS f32x4*)(dst + 4) = b; }
                    } else if (u.pn <= 4) {
                        const v4u w = pack8(a, b); const int c = col - ZC_U;
                        if (row < MP) *(GAS v4u*)(AYp + ((size_t)(c >> 4) * SCH + (row >> 5)) * SKA + (row & 31) * GRP + (c & 15)) = w;
                        else *(GAS v4u*)(Zp + (size_t)row * NZ + col) = w;
                    } else {
#pragma unroll
                        for (int i = 0; i < 4; ++i) { a[i] = sigmoidf_(a[i]); b[i] = sigmoidf_(b[i]); }
                        *(GAS v4u*)(Zp + (size_t)row * NZ + col) = pack8(a, b);
                    } } }
    }
};

#define XB_TMO      128
#define XB_XCNT(j)  (256  + 64 * (j))
#define XB_XSUB(j)  (1280 + 64 * (j))
#define XB_XGEN(j)  (2304 + 64 * (j))
#define XB_TOP      3328
#define XB_TOPGEN   3392
#define XCD_BAR_WORDS 3456
#define XB_SPIN_CAP (1u << 18)
__device__ __forceinline__ unsigned xb_ld(unsigned* p)              { return __hip_atomic_load(p, __ATOMIC_RELAXED, __HIP_MEMORY_SCOPE_AGENT); }
__device__ __forceinline__ unsigned xb_add(unsigned* p, unsigned v) { return __hip_atomic_fetch_add(p, v, __ATOMIC_RELAXED, __HIP_MEMORY_SCOPE_AGENT); }
__device__ __forceinline__ unsigned xb_xcc_id() { return (unsigned)__builtin_amdgcn_s_getreg((3 << 11) | 20) & 0xFu; }
#define XB_SPIN(cond, bar) do { unsigned _sp = 0; while (cond) { __builtin_amdgcn_s_sleep(1); \
    if ((++_sp & 255u) == 0u) { if (xb_ld(&(bar)[XB_TMO])) break; if (_sp > XB_SPIN_CAP) { atomicAdd(&(bar)[XB_TMO], 1u); break; } } } } while (0)
struct XcdBarrier { unsigned* bar; unsigned x; volatile LAS unsigned* st; };
__device__ __forceinline__ XcdBarrier xcd_barrier_post(unsigned* bar, volatile LAS unsigned* st) {
    XcdBarrier b; b.bar = bar; b.x = xb_xcc_id(); b.st = st;
    if (threadIdx.x == 0) (void)xb_add(&bar[XB_XCNT(b.x)], 1u);
    return b;
}
__device__ __forceinline__ void xcd_barrier_complete(unsigned* bar, unsigned x, unsigned& nloc, unsigned& nx) {
    const unsigned G = gridDim.x * gridDim.y * gridDim.z;
    unsigned sum, cnt, mine, sp = 0u;
    for (;;) {
        sum = 0u; cnt = 0u; mine = 0u;
#pragma unroll
        for (unsigned j = 0; j < 16; ++j) { const unsigned c = xb_ld(&bar[XB_XCNT(j)]); sum += c; cnt += (c > 0u) ? 1u : 0u; mine = (j == x) ? c : mine; }
        if (sum == G) break;
        __builtin_amdgcn_s_sleep(1);
        if ((++sp & 255u) == 0u) { if (xb_ld(&bar[XB_TMO])) break; if (sp > XB_SPIN_CAP) { atomicAdd(&bar[XB_TMO], 1u); break; } }
    }
    nloc = mine > 0u ? mine : 1u; nx = cnt > 0u ? cnt : 1u;
}
__device__ __forceinline__ void xcd_barrier(const XcdBarrier& b) {
    asm volatile("s_waitcnt vmcnt(0)" ::: "memory");
    __syncthreads();
    if (threadIdx.x == 0) {
        unsigned* bar = b.bar;
        __builtin_amdgcn_s_waitcnt(0);
        unsigned nloc = b.st[0], nx = b.st[1];
        if (nloc == 0u) { xcd_barrier_complete(bar, b.x, nloc, nx); b.st[0] = nloc; b.st[1] = nx; }
        const unsigned old = xb_add(&bar[XB_XSUB(b.x)], 1u);
        const unsigned gen = old / nloc;
        if (old + 1u == (gen + 1u) * nloc) {
            __builtin_amdgcn_fence(__ATOMIC_RELEASE, "agent");
            asm volatile("s_waitcnt vmcnt(0)" ::: "memory");
            const unsigned og = xb_add(&bar[XB_TOP], 1u);
            const unsigned tg = og / nx;
            if (og + 1u == (tg + 1u) * nx) xb_add(&bar[XB_TOPGEN], 1u);
            else XB_SPIN(xb_ld(&bar[XB_TOPGEN]) == tg, bar);
            __builtin_amdgcn_fence(__ATOMIC_ACQUIRE, "agent");
            xb_add(&bar[XB_XGEN(b.x)], 1u);
            asm volatile("s_waitcnt vmcnt(0)" ::: "memory");
        } else {
            XB_SPIN(xb_ld(&bar[XB_XGEN(b.x)]) == gen, bar);
            __builtin_amdgcn_fence(__ATOMIC_ACQUIRE, "agent");
            asm volatile("s_waitcnt vmcnt(0)" ::: "memory");
        }
    }
    __syncthreads();
}

constexpr int NWAVES = 8;
constexpr int RING_OFF = 0, RING_BYTES = 159744;
constexpr int LDSCTL_OFF = RING_BYTES, MISC_OFF = LDSCTL_OFF + 320;
constexpr int LDS_BYTES = 163840;

struct Args { const void* in[39]; float* out; unsigned char* ws; int ph_lo, ph_hi; };
static_assert(sizeof(Args) == 39 * 8 + 8 + 8 + 8, "Args has no padding");

__device__ __forceinline__ void tr_item(const float* W, int ldw, int k0, int n0s, bf16* WT, int ldt, int n0d, LAS float* scr, int lane, const float* kg = nullptr) {
    if (W) {
        f32x4 v[8];
#pragma unroll
        for (int i = 0; i < 8; ++i) v[i] = *(const GAS f32x4*)(W + (size_t)(k0 + (lane >> 3) + 8 * i) * ldw + n0s + (lane & 7) * 4);
#pragma unroll
        for (int i = 0; i < 8; ++i) { LAS float* d = scr + ((lane >> 3) + 8 * i) * 33 + (lane & 7) * 4; const float gk = kg ? kg[k0 + (lane >> 3) + 8 * i] : 1.0f; d[0] = v[i].x * gk; d[1] = v[i].y * gk; d[2] = v[i].z * gk; d[3] = v[i].w * gk; }
    } else {
#pragma unroll 8
        for (int i = 0; i < 32; ++i) { const int kk = 2 * i + (lane >> 5); scr[kk * 33 + (lane & 31)] = 0.f; }
    }
    LDS_WAIT(); asm volatile("" ::: "memory");
    const int c = lane & 7;
#pragma unroll
    for (int j = 0; j < 4; ++j) { const int n = (lane >> 3) + 8 * j; const LAS float* s = scr + (8 * c) * 33 + n;
        v4u o; o.x = pk2(s[0 * 33], s[1 * 33]); o.y = pk2(s[2 * 33], s[3 * 33]); o.z = pk2(s[4 * 33], s[5 * 33]); o.w = pk2(s[6 * 33], s[7 * 33]);
        *(GAS v4u*)(WT + (size_t)(n0d + n) * ldt + k0 + 8 * c) = o; }
    LDS_WAIT(); asm volatile("" ::: "memory");
}
__device__ __forceinline__ void tr_plain(const float* W, int K, int N, bf16* WT, int it, LAS float* scr, int lane, const float* kg = nullptr) {
    const int nblk = N / 32, kb = it / nblk, nb = it % nblk;
    tr_item(W, N, 64 * kb, 32 * nb, WT, K, 32 * nb, scr, lane, kg);
}

__device__ __forceinline__ void glds16(const void* gsrc, unsigned lds_dst) { unsigned keep;
    asm volatile("s_mov_b32 %0, m0\n\ts_mov_b32 m0, %2\n\ts_nop 0\n\tglobal_load_lds_dwordx4 %1, off\n\ts_mov_b32 m0, %0" : "=&s"(keep) : "v"(gsrc), "s"(lds_dst) : "memory"); }
__device__ __forceinline__ int opq(int x) { asm volatile("" : "+v"(x)); return x; }
namespace pa {
typedef float f32x16 __attribute__((ext_vector_type(16)));
typedef short s16x4 __attribute__((ext_vector_type(4)));
constexpr int KSLOT = 12288, VSLOT = 8192, SLOT = KSLOT + VSLOT;
__device__ __forceinline__ int crow(int r, int hi) { return (r & 3) + 8 * (r >> 2) + 4 * hi; }
__device__ __forceinline__ s16x4 vtr(const LAS unsigned char* p) { return __builtin_bit_cast(s16x4, __builtin_amdgcn_ds_read_tr16_b64_v4i16((LAS s16x4*)p)); }
__device__ __forceinline__ float swap_max(float v) { auto rr = __builtin_amdgcn_permlane32_swap(__float_as_uint(v), __float_as_uint(v), false, false); return fmaxf(__uint_as_float(rr[0]), __uint_as_float(rr[1])); }
__device__ __forceinline__ float swap_sum(float v) { auto rr = __builtin_amdgcn_permlane32_swap(__float_as_uint(v), __float_as_uint(v), false, false); return __uint_as_float(rr[0]) + __uint_as_float(rr[1]); }

__device__ __forceinline__ void issue_tile(const bf16* Kg, const bf16* Vg, LAS unsigned char* slot, int kv0, int wave, int lane) {
    const unsigned s0 = (unsigned)(uintptr_t)slot;
    { const bf16* src = Kg + (size_t)(kv0 + lane) * 768 + wave * 8;
      glds16(src, (unsigned)__builtin_amdgcn_readfirstlane(s0 + wave * 1024));
      if (wave < 4) glds16(src + 64, (unsigned)__builtin_amdgcn_readfirstlane(s0 + (8 + wave) * 1024)); }
    { const bf16* src = Vg + (size_t)(kv0 + 16 * (wave & 3) + (lane >> 2)) * 1024 + (wave >> 2) * 32 + (lane & 3) * 8;
      glds16(src, (unsigned)__builtin_amdgcn_readfirstlane(s0 + KSLOT + wave * 1024)); }
}

__device__ __forceinline__ void attn_unit(const bf16* Q, const bf16* K, const bf16* V, bf16* O, int b, int h, int qb, float sref, LAS unsigned char* lds, int wave, int lane_) {
    const int lane = opq(lane_), r32 = lane & 31, hi = lane >> 5;
    const size_t rowbase = (size_t)b * SEQ; const int q0 = qb * 256, qw = q0 + wave * 32;
    const bf16* Kg = K + rowbase * 768 + h * QKH; const bf16* Vg = V + rowbase * 1024 + h * VH;
    const int NT = (q0 + 256) / 64;
    bf16x8 qf[6];
    { const bf16* qp = Q + (rowbase + qw + r32) * 768 + h * QKH + hi * 8;
#pragma unroll
      for (int s = 0; s < 6; ++s) qf[s] = *(const GAS bf16x8*)(qp + 16 * s); }
    asm volatile("s_waitcnt vmcnt(0)" ::: "memory");
#pragma unroll
    for (int s = 0; s < 6; ++s) asm volatile("" : "+v"(qf[s]));
    issue_tile(Kg, Vg, lds, 0, wave, lane); issue_tile(Kg, Vg, lds + SLOT, 64, wave, lane);
    f32x16 o0 = {}, o1 = {};
    float l = 0.f;
    const int qrow = qw + r32;
    const int vaddr = ((lane >> 4) & 1) * 32 + (lane & 3) * 8 + (4 * hi + ((lane & 15) >> 2)) * 64;
    const int tmax = (qw + 31) >> 6;
#define PA_S(P0, P1, t_, slot_) do { const LAS unsigned char* ks = lds + (slot_) * SLOT; const int kv0 = (t_) * 64; \
        _Pragma("unroll") for (int r = 0; r < 16; ++r) { P0[r] = -sref; P1[r] = -sref; } \
        _Pragma("unroll") for (int s_ = 0; s_ < 6; ++s_) { \
            const bf16x8 a0 = *(const LAS bf16x8*)(ks + (2 * s_ + hi) * 1024 + r32 * 16), a1 = *(const LAS bf16x8*)(ks + (2 * s_ + hi) * 1024 + 512 + r32 * 16); \
            P0 = __builtin_amdgcn_mfma_f32_32x32x16_bf16(a0, qf[s_], P0, 0, 0, 0); P1 = __builtin_amdgcn_mfma_f32_32x32x16_bf16(a1, qf[s_], P1, 0, 0, 0); } \
        if (kv0 + 63 > qw) { _Pragma("unroll") for (int r = 0; r < 16; ++r) { const int kv = kv0 + crow(r, hi); if (kv > qrow) P0[r] = -1e30f; if (kv + 32 > qrow) P1[r] = -1e30f; } } } while (0)
#define PA_PV(P0, P1, slot_) do { const LAS unsigned char* vs = lds + (slot_) * SLOT + KSLOT; float rs = 0.f; \
        _Pragma("unroll") for (int r = 0; r < 16; ++r) { P0[r] = __builtin_amdgcn_exp2f(P0[r]); P1[r] = __builtin_amdgcn_exp2f(P1[r]); rs += P0[r] + P1[r]; } \
        l += rs; \
        _Pragma("unroll") for (int kstep = 0; kstep < 4; ++kstep) { v4u pw; const int rb = 8 * (kstep & 1); \
            if (kstep < 2) { pw.x = cvt_pk_bf16(P0[rb], P0[rb + 1]); pw.y = cvt_pk_bf16(P0[rb + 2], P0[rb + 3]); pw.z = cvt_pk_bf16(P0[rb + 4], P0[rb + 5]); pw.w = cvt_pk_bf16(P0[rb + 6], P0[rb + 7]); } \
            else { pw.x = cvt_pk_bf16(P1[rb], P1[rb + 1]); pw.y = cvt_pk_bf16(P1[rb + 2], P1[rb + 3]); pw.z = cvt_pk_bf16(P1[rb + 4], P1[rb + 5]); pw.w = cvt_pk_bf16(P1[rb + 6], P1[rb + 7]); } \
            const bf16x8 pb = __builtin_bit_cast(bf16x8, pw); \
            _Pragma("unroll") for (int d0 = 0; d0 < 2; ++d0) { \
                const s16x4 lo = vtr(vs + vaddr + d0 * 4096 + kstep * 1024), hh = vtr(vs + vaddr + d0 * 4096 + kstep * 1024 + 512); \
                const bf16x8 va = (bf16x8){lo[0], lo[1], lo[2], lo[3], hh[0], hh[1], hh[2], hh[3]}; \
                if (d0 == 0) o0 = __builtin_amdgcn_mfma_f32_32x32x16_bf16(va, pb, o0, 0, 0, 0); else o1 = __builtin_amdgcn_mfma_f32_32x32x16_bf16(va, pb, o1, 0, 0, 0); } } } while (0)
#define PA_BAR() do { asm volatile("s_waitcnt lgkmcnt(0)" ::: "memory"); __builtin_amdgcn_s_barrier(); asm volatile("" ::: "memory"); } while (0)
#define PA_SB() __builtin_amdgcn_sched_barrier(0)
#define PA_KRD(s_, o_) (*(const LAS bf16x8*)(ks + (2 * (s_) + hi) * 1024 + (o_) + r32 * 16))
#define PA_SX(PN0, PN1, t_, slot_, PC0, PC1) do { const LAS unsigned char* ks = lds + (slot_) * SLOT; const int kv0 = (t_) * 64; float rs = 0.f; \
        _Pragma("unroll") for (int r = 0; r < 16; ++r) { PN0[r] = -sref; PN1[r] = -sref; } \
        bf16x8 a0 = PA_KRD(0, 0), a1 = PA_KRD(0, 512); \
        _Pragma("unroll") for (int s_ = 0; s_ < 6; ++s_) { bf16x8 b0 = a0, b1 = a1; const int r0 = s_ < 4 ? 3 * s_ : 12 + 2 * (s_ - 4), r1 = r0 + (s_ < 4 ? 3 : 2); \
            if (s_ < 5) { b0 = PA_KRD(s_ + 1, 0); b1 = PA_KRD(s_ + 1, 512); } \
            PN0 = __builtin_amdgcn_mfma_f32_32x32x16_bf16(a0, qf[s_], PN0, 0, 0, 0); asm volatile("" : "+v"(PN0)); PA_SB(); \
            _Pragma("unroll") for (int r = r0; r < r1; ++r) PC0[r] = __builtin_amdgcn_exp2f(PC0[r]); asm volatile("" : "+v"(PC0)); \
            _Pragma("unroll") for (int r = r0; r < r1; ++r) rs += PC0[r]; asm volatile("" : "+v"(rs)); PA_SB(); \
            PN1 = __builtin_amdgcn_mfma_f32_32x32x16_bf16(a1, qf[s_], PN1, 0, 0, 0); asm volatile("" : "+v"(PN1)); PA_SB(); \
            _Pragma("unroll") for (int r = r0; r < r1; ++r) PC1[r] = __builtin_amdgcn_exp2f(PC1[r]); asm volatile("" : "+v"(PC1)); \
            _Pragma("unroll") for (int r = r0; r < r1; ++r) rs += PC1[r]; asm volatile("" : "+v"(rs)); PA_SB(); \
            a0 = b0; a1 = b1; } \
        l += rs; \
        if (kv0 + 63 > qw) { _Pragma("unroll") for (int r = 0; r < 16; ++r) { const int kv = kv0 + crow(r, hi); if (kv > qrow) PN0[r] = -1e30f; if (kv + 32 > qrow) PN1[r] = -1e30f; } } } while (0)
#define PA_PVN(P0, P1, slot_) do { const LAS unsigned char* vs = lds + (slot_) * SLOT + KSLOT + vaddr; s16x4 lo[4][2], hh[4][2]; \
        _Pragma("unroll") for (int d0 = 0; d0 < 2; ++d0) { lo[0][d0] = vtr(vs + d0 * 4096); hh[0][d0] = vtr(vs + d0 * 4096 + 512); } \
        _Pragma("unroll") for (int kstep = 0; kstep < 4; ++kstep) { v4u pw; const int rb = 8 * (kstep & 1); \
            if (kstep < 3) { _Pragma("unroll") for (int d0 = 0; d0 < 2; ++d0) { lo[kstep + 1][d0] = vtr(vs + d0 * 4096 + (kstep + 1) * 1024); hh[kstep + 1][d0] = vtr(vs + d0 * 4096 + (kstep + 1) * 1024 + 512); } }     \
            if (kstep < 2) { pw.x = cvt_pk_bf16(P0[rb], P0[rb + 1]); pw.y = cvt_pk_bf16(P0[rb + 2], P0[rb + 3]); pw.z = cvt_pk_bf16(P0[rb + 4], P0[rb + 5]); pw.w = cvt_pk_bf16(P0[rb + 6], P0[rb + 7]); } \
            else { pw.x = cvt_pk_bf16(P1[rb], P1[rb + 1]); pw.y = cvt_pk_bf16(P1[rb + 2], P1[rb + 3]); pw.z = cvt_pk_bf16(P1[rb + 4], P1[rb + 5]); pw.w = cvt_pk_bf16(P1[rb + 6], P1[rb + 7]); } \
            const bf16x8 pb = __builtin_bit_cast(bf16x8, pw); PA_SB(); \
            { const bf16x8 va = (bf16x8){lo[kstep][0][0], lo[kstep][0][1], lo[kstep][0][2], lo[kstep][0][3], hh[kstep][0][0], hh[kstep][0][1], hh[kstep][0][2], hh[kstep][0][3]}; o0 = __builtin_amdgcn_mfma_f32_32x32x16_bf16(va, pb, o0, 0, 0, 0); } \
            { const bf16x8 va = (bf16x8){lo[kstep][1][0], lo[kstep][1][1], lo[kstep][1][2], lo[kstep][1][3], hh[kstep][1][0], hh[kstep][1][1], hh[kstep][1][2], hh[kstep][1][3]}; o1 = __builtin_amdgcn_mfma_f32_32x32x16_bf16(va, pb, o1, 0, 0, 0); } \
            PA_SB(); } } while (0)
    f32x16 pA0, pA1, pB0, pB1;
    if (wave < 4) asm volatile("s_waitcnt vmcnt(3)" ::: "memory"); else asm volatile("s_waitcnt vmcnt(2)" ::: "memory");
    PA_BAR();
    PA_S(pA0, pA1, 0, 0);
    int sl = 0, s1 = 1;
    for (int t = 0; ; t += 2) {
        const int s2 = (s1 == 2) ? 0 : s1 + 1;
        asm volatile("s_waitcnt vmcnt(0)" ::: "memory"); PA_BAR();
        if (t + 2 < NT) issue_tile(Kg, Vg, lds + s2 * SLOT, (t + 2) * 64, wave, lane);
        PA_SX(pB0, pB1, t + 1, s1, pA0, pA1); PA_PVN(pA0, pA1, sl);
        asm volatile("s_waitcnt vmcnt(0)" ::: "memory"); PA_BAR();
        if (t + 2 >= NT) break;
        if (t + 3 < NT) issue_tile(Kg, Vg, lds + sl * SLOT, (t + 3) * 64, wave, lane);
        PA_SX(pA0, pA1, t + 2, s2, pB0, pB1); PA_PVN(pB0, pB1, s1);
        sl = s2; s1 = (s2 == 2) ? 0 : s2 + 1;
    }
    PA_PV(pB0, pB1, s1);
#undef PA_S
#undef PA_PV
#undef PA_BAR
#undef PA_SB
#undef PA_KRD
#undef PA_SX
#undef PA_PVN
    const float il = 1.0f / swap_sum(l);
    bf16* op = O + (rowbase + qw + r32) * ATTW + h * VH + 4 * hi;
#pragma unroll
    for (int g = 0; g < 4; ++g) {
        v2u w0, w1; w0.x = cvt_pk_bf16(o0[4 * g] * il, o0[4 * g + 1] * il); w0.y = cvt_pk_bf16(o0[4 * g + 2] * il, o0[4 * g + 3] * il);
        w1.x = cvt_pk_bf16(o1[4 * g] * il, o1[4 * g + 1] * il); w1.y = cvt_pk_bf16(o1[4 * g + 2] * il, o1[4 * g + 3] * il);
        *(GAS v2u*)(op + 8 * g) = w0; *(GAS v2u*)(op + 32 + 8 * g) = w1;
    }
    asm volatile("s_waitcnt vmcnt(0) lgkmcnt(0)" ::: "memory");
    __syncthreads();
}
}

namespace sa {
using pa::f32x16; using pa::s16x4; using pa::crow; using pa::vtr; using pa::swap_max; using pa::swap_sum;
constexpr int HK = 64;
constexpr int CHS = (HK + 1) * 16;
constexpr int CSB = 36 * CHS;
constexpr int C8S = (HK + 1) * 32, C8B = 8 * C8S;
constexpr int OFF_CS = 0, OFF_C8 = 2 * CSB;
constexpr int OFF_QA = OFF_C8 + 2 * C8B;
constexpr int PSTR = 144, OFF_P = OFF_QA + 18432;
constexpr int OFF_RS = OFF_P + 32 * PSTR;
constexpr int OFF_KSS = OFF_RS + 2048;
constexpr int OFF_PSUM = OFF_KSS + 512, OFF_PHYS = OFF_PSUM + 512, OFF_GK = OFF_PHYS + 128, SA_LDS = OFF_GK + 128;
static_assert(SA_LDS <= RING_BYTES, "sample attention LDS");
constexpr int PO_STRIDE = 32 * 256;
#define SA_BAR() do { asm volatile("s_waitcnt lgkmcnt(0)" ::: "memory"); __builtin_amdgcn_s_barrier(); asm volatile("" ::: "memory"); } while (0)

__device__ __forceinline__ void gld16(f32x4& d, const void* p) { asm volatile("global_load_dwordx4 %0, %1, off" : "=v"(d) : "v"(p) : "memory"); }
__device__ __forceinline__ void gld8(v2u& d, const void* p) { asm volatile("global_load_dwordx2 %0, %1, off" : "=v"(d) : "v"(p) : "memory"); }
template <int MODE> __device__ __forceinline__ void item(const void* const* in, const bf16* QABS, const unsigned char* W8, const bf16* ROPEB, float* PO, float* PL, float sref, int b, int half, LAS unsigned char* lds, int tid_, int wave, int lane_) {
    const int tid = opq(tid_), lane = tid & 63;
    (void)lane_;
    const float* cache_ckv = (const float*)in[4]; const float* cache_kr = (const float*)in[5]; const int* page_table = (const int*)in[6]; const float* g_k = (const float*)in[18];
    const int r32 = lane & 31, hi = lane >> 5;
    typedef int v8i __attribute__((ext_vector_type(8)));
    for (int e = tid; e < 36 * 32; e += 512) *(LAS v4u*)(lds + OFF_QA + e * 16) = *(const GAS v4u*)(QABS + ((size_t)b * 36 * 32 + e) * 8);
    if (tid < NPAGES / 2) *(LAS int*)(lds + OFF_PHYS + tid * 4) = page_table[b * NPAGES + half * (NPAGES / 2) + tid];
    v8i wf[4][2];
#pragma unroll
    for (int s = 0; s < 4; ++s)
#pragma unroll
        for (int nb = 0; nb < 2; ++nb) { const GAS v4u* wp = (const GAS v4u*)(W8 + (size_t)(wave * QKN + 32 * nb + r32) * KVL + 64 * s + 32 * hi); const v4u a = wp[0], bq = wp[1];
            wf[s][nb] = (v8i){(int)a.x, (int)a.y, (int)a.z, (int)a.w, (int)bq.x, (int)bq.y, (int)bq.z, (int)bq.w}; }
    if (tid < 32) *(LAS float*)(lds + OFF_GK + tid * 4) = g_k[64 + tid];
    asm volatile("s_waitcnt vmcnt(0) lgkmcnt(0)" ::: "memory");
#pragma unroll
    for (int s = 0; s < 4; ++s) asm volatile("" : "+v"(wf[s][0]), "+v"(wf[s][1]));
    __builtin_amdgcn_s_barrier(); asm volatile("" ::: "memory");
    f32x16 o = {};
    float l_run = 0.f;
    const int kq = wave >> 1;
    constexpr int NHP = NPAGES;
#define SA_IDS() const int tq = opq(tid), lq = tq & 63, r32 = lq & 31, hi = lq >> 5, kkey = tq >> 2, qd = tq & 3, cs_col = 16 * (wave & 1) + (lq & 15), quad = lq >> 4; (void)r32; (void)hi; (void)kkey; (void)qd; (void)cs_col; (void)quad
    f32x4 va[4], vb[4], x1 = {}, x2 = {}; v2u cw = {}, sw = {};
#define SA_SRC(hp_) const int sub_ = (hp_) & 1; const int phys_ = *(const LAS int*)(lds + OFF_PHYS + ((hp_) >> 1) * 4); const float* src_ = cache_ckv + ((size_t)phys_ * PAGE + sub_ * HK + 2 * wave) * KVL + lq * 4
#define SA_LD(i_) do { gld16(va[i_], src_ + (size_t)(i_) * 16 * KVL); gld16(vb[i_], src_ + (size_t)(i_) * 16 * KVL + KVL); } while (0)
#define SA_LDK(hp_) do { if (wave < 4) { const float* krp_ = cache_kr + ((size_t)phys_ * PAGE + sub_ * HK + kkey) * QKR; gld16(x1, krp_ + 4 * qd); gld16(x2, krp_ + 16 + 4 * qd); \
            const bf16* rp_ = ROPEB + ((size_t)(half * (NPAGES / 2) + ((hp_) >> 1)) * PAGE + sub_ * HK + kkey) * 32; gld8(cw, rp_ + 4 * qd); gld8(sw, rp_ + 16 + 4 * qd); } } while (0)
#define SA_AKR(CSW, KSSW) do { \
            const f32x4 rc_ = {bflo(cw.x), bfhi(cw.x), bflo(cw.y), bfhi(cw.y)}, rs_ = {bflo(sw.x), bfhi(sw.x), bflo(sw.y), bfhi(sw.y)}; \
            float ss = (x1[0] * x1[0] + x1[1] * x1[1]) + (x1[2] * x1[2] + x1[3] * x1[3]) + (x2[0] * x2[0] + x2[1] * x2[1]) + (x2[2] * x2[2] + x2[3] * x2[3]); \
            ss += __shfl_xor(ss, 1); ss += __shfl_xor(ss, 2); \
            const f32x4 ga = *(const LAS f32x4*)(lds + OFF_GK + qd * 16), gb = *(const LAS f32x4*)(lds + OFF_GK + 64 + qd * 16); \
            const f32x4 a = x1 * ga, bb = x2 * gb; const f32x4 y1 = a * rc_ - bb * rs_, y2 = a * rs_ + bb * rc_; \
            v2u w1, w2; w1.x = cvt_pk_bf16(y1[0], y1[1]); w1.y = cvt_pk_bf16(y1[2], y1[3]); w2.x = cvt_pk_bf16(y2[0], y2[1]); w2.y = cvt_pk_bf16(y2[2], y2[3]); \
            const int c1 = 32 + (qd >> 1), c2 = 34 + (qd >> 1); \
            *(LAS v2u*)((CSW) + c1 * CHS + kkey * 16 + 8 * (qd & 1)) = w1; *(LAS v2u*)((CSW) + c2 * CHS + kkey * 16 + 8 * (qd & 1)) = w2; \
            if (qd == 0) *(LAS float*)(lds + (KSSW) + kkey * 4) = ss; } while (0)
#define SA_R(CF, kb, s2) do { const LAS v4u* cp = (const LAS v4u*)(c8 + (2 * (s2) + hi) * C8S + (32 * (kb) + r32) * 32); const v4u a = cp[0], bq = cp[1]; \
            CF = (v8i){(int)a.x, (int)a.y, (int)a.z, (int)a.w, (int)bq.x, (int)bq.y, (int)bq.z, (int)bq.w}; } while (0)
#define SA_M(ACC, s2, nb, CF) do { ACC = __builtin_amdgcn_mfma_scale_f32_32x32x64_f8f6f4(wf[s2][nb], CF, ACC, 0, 0, 0, 127, 0, 127); asm volatile("" : "+v"(ACC)); } while (0)
#define SA_PA(i, kk, CSW) do { const int key_ = 2 * wave + (kk) + 16 * (i), ch8 = lq >> 1, hf = lq & 1; const f32x4 v = (kk) ? vb[i] : va[i]; \
            v2u w; w.x = cvt_pk_bf16(v[0], v[1]); w.y = cvt_pk_bf16(v[2], v[3]); *(LAS v2u*)((CSW) + ch8 * CHS + key_ * 16 + hf * 8) = w; } while (0)
#define SA_PB(i, kk, C8W) do { const int key_ = 2 * wave + (kk) + 16 * (i), ch8 = lq >> 1, hf = lq & 1; const f32x4 v = (kk) ? vb[i] : va[i]; \
            int w8 = 0; w8 = __builtin_amdgcn_cvt_pk_fp8_f32(v[0], v[1], w8, false); w8 = __builtin_amdgcn_cvt_pk_fp8_f32(v[2], v[3], w8, true); \
            *(LAS int*)((C8W) + (ch8 >> 2) * C8S + key_ * 32 + (ch8 & 3) * 8 + hf * 4) = w8; } while (0)
#define SA_SEG(T0, T1, s2a, i, HOOK, RN0, RN1) do { \
            SA_M(T0, s2a, 0, cfa); SA_SB(); HOOK; SA_PA(i, 0, csn); SA_SB(); \
            SA_M(T1, s2a, 1, cfa); SA_SB(); SA_PB(i, 0, c8n); RN0; SA_SB(); \
            SA_M(T0, (s2a) + 1, 0, cfb); SA_SB(); SA_PA(i, 1, csn); SA_SB(); \
            SA_M(T1, (s2a) + 1, 1, cfb); SA_SB(); SA_PB(i, 1, c8n); RN1; SA_SB(); } while (0)
#define SA_BRED(T0, T1, kb, KSSR) do { const int key_ = 32 * (kb) + r32; const f32x16 sq = T0 * T0 + T1 * T1; \
            const f32x4 s4 = (f32x4){sq[0], sq[1], sq[2], sq[3]} + (f32x4){sq[4], sq[5], sq[6], sq[7]} + ((f32x4){sq[8], sq[9], sq[10], sq[11]} + (f32x4){sq[12], sq[13], sq[14], sq[15]}); \
            float ss = (s4[0] + s4[1]) + (s4[2] + s4[3]); \
            ss = swap_sum(ss) * (1.0f / 4096.0f) + *(const LAS float*)(lds + (KSSR) + key_ * 4); \
            if (hi == 0) *(LAS float*)(lds + OFF_RS + (key_ * 8 + wave) * 4) = __builtin_amdgcn_rsqf(ss * (1.f / QKH) + EPS); } while (0)
#define SA_SB() __builtin_amdgcn_sched_barrier(0)
    { SA_IDS(); { SA_SRC(0); SA_LD(0); SA_LD(1); SA_LD(2); SA_LD(3); SA_LDK(0); }
      asm volatile("s_waitcnt vmcnt(0)" ::: "memory");
      asm volatile("" : "+v"(va[0]), "+v"(va[1]), "+v"(va[2]), "+v"(va[3]), "+v"(vb[0]), "+v"(vb[1]), "+v"(vb[2]), "+v"(vb[3]));
      asm volatile("" : "+v"(x1), "+v"(x2), "+v"(cw), "+v"(sw));
      LAS unsigned char* cs0 = lds + OFF_CS; LAS unsigned char* c80 = lds + OFF_C8; SA_SRC(1);
      _Pragma("unroll") for (int i = 0; i < 4; ++i) { SA_PA(i, 0, cs0); SA_PB(i, 0, c80); SA_PA(i, 1, cs0); SA_PB(i, 1, c80); SA_SB(); SA_LD(i); SA_SB(); }
      if (tid < 256) SA_AKR(cs0, OFF_KSS);
      SA_SB(); SA_LDK(1);
      SA_BAR(); }
#pragma unroll 1
    for (int hp = 0; hp < NHP; ++hp) { SA_IDS();
        const int par = hp & 1;
        LAS unsigned char* cs = lds + OFF_CS + par * CSB; LAS unsigned char* c8 = lds + OFF_C8 + par * C8B;
        LAS unsigned char* csn = lds + OFF_CS + (par ^ 1) * CSB; LAS unsigned char* c8n = lds + OFF_C8 + (par ^ 1) * C8B;
        const int kssr = OFF_KSS + par * 256, kssw = OFF_KSS + (par ^ 1) * 256;
        const bool more = hp + 2 < NHP; const int hn = more ? hp + 2 : hp; SA_SRC(hn);
        asm volatile("s_waitcnt vmcnt(0)" ::: "memory");
        asm volatile("" : "+v"(va[0]), "+v"(va[1]), "+v"(va[2]), "+v"(va[3]), "+v"(vb[0]), "+v"(vb[1]), "+v"(vb[2]), "+v"(vb[3]));
        asm volatile("" : "+v"(x1), "+v"(x2), "+v"(cw), "+v"(sw));
        { f32x16 t0 = {}, t1 = {}, t2 = {}, t3 = {}; v8i cfa, cfb;
          SA_R(cfa, 0, 0); SA_R(cfb, 0, 1); SA_SB();
          SA_SEG(t0, t1, 0, 0, (void)0, SA_R(cfa, 0, 2), SA_R(cfb, 0, 3)); if (more) SA_LD(0); SA_SB();
          SA_SEG(t0, t1, 2, 1, (void)0, SA_R(cfa, 1, 0), SA_R(cfb, 1, 1)); if (more) SA_LD(1); SA_SB();
          if (tid < 256) SA_AKR(csn, kssw);
          SA_SB(); if (more) SA_LDK(hn); SA_SB();
          SA_SEG(t2, t3, 0, 2, SA_BRED(t0, t1, 0, kssr); SA_SB(), SA_R(cfa, 1, 2), SA_R(cfb, 1, 3)); if (more) SA_LD(2); SA_SB();
          SA_SEG(t2, t3, 2, 3, (void)0, (void)0, (void)0); if (more) SA_LD(3); SA_SB();
          SA_BRED(t2, t3, 1, kssr); }
        SA_BAR();
        { f32x4 p4 = {0.f, 0.f, 0.f, 0.f}, p5 = {0.f, 0.f, 0.f, 0.f}; const int key = 16 * kq + (lq & 15);
          bf16x8 cf[9], qf[9];
          { LAS unsigned char* cb = cs + quad * CHS + key * 16; LAS unsigned char* qb = lds + OFF_QA + quad * 512 + cs_col * 16;
#pragma unroll
            for (int s2 = 0; s2 < 9; ++s2) { cf[s2] = *(const LAS bf16x8*)(cb + s2 * 4 * CHS); qf[s2] = *(const LAS bf16x8*)(qb + s2 * 2048); } }
#pragma unroll
          for (int s2 = 0; s2 < 9; ++s2) { if (s2 & 1) p5 = __builtin_amdgcn_mfma_f32_16x16x32_bf16(cf[s2], qf[s2], p5, 0, 0, 0); else p4 = __builtin_amdgcn_mfma_f32_16x16x32_bf16(cf[s2], qf[s2], p4, 0, 0, 0); }
          p4 += p5;
          float rsum = 0.f;
#pragma unroll
          for (int r = 0; r < 4; ++r) { p4[r] = __builtin_amdgcn_exp2f(p4[r] * *(const LAS float*)(lds + OFF_RS + ((16 * kq + 4 * quad + r) * 8 + (cs_col & 7)) * 4) - sref); rsum += p4[r]; }
          rsum += __shfl_xor(rsum, 16); rsum += __shfl_xor(rsum, 32);
          if (lq < 16) *(LAS float*)(lds + OFF_PSUM + (kq * 32 + cs_col) * 4) = rsum;
          v2u w; w.x = cvt_pk_bf16(p4[0], p4[1]); w.y = cvt_pk_bf16(p4[2], p4[3]);
          *(LAS v2u*)(lds + OFF_P + cs_col * PSTR + (16 * kq + 4 * quad) * 2) = w; }
        SA_BAR();
        l_run += ((*(const LAS float*)(lds + OFF_PSUM + r32 * 4) + *(const LAS float*)(lds + OFF_PSUM + (32 + r32) * 4)) + (*(const LAS float*)(lds + OFF_PSUM + (64 + r32) * 4) + *(const LAS float*)(lds + OFF_PSUM + (96 + r32) * 4)));
        { const int dim = 32 * wave + 16 * ((lq >> 4) & 1) + 4 * (lq & 3), ch = dim >> 3, k0 = 8 * hi + ((lq & 15) >> 2);
          s16x4 lo[4], hh[4]; bf16x8 pb[4];
          { LAS unsigned char* tb = cs + ch * CHS + k0 * 16 + 8 * (lq & 1); LAS unsigned char* pp = lds + OFF_P + r32 * PSTR + 16 * hi;
#pragma unroll
            for (int ks = 0; ks < 4; ++ks) { lo[ks] = vtr(tb + ks * 256); hh[ks] = vtr(tb + ks * 256 + 64); pb[ks] = *(const LAS bf16x8*)(pp + ks * 32); } }
#pragma unroll
          for (int ks = 0; ks < 4; ++ks) { const bf16x8 ca = (bf16x8){lo[ks][0], lo[ks][1], lo[ks][2], lo[ks][3], hh[ks][0], hh[ks][1], hh[ks][2], hh[ks][3]};
              o = __builtin_amdgcn_mfma_f32_32x32x16_bf16(ca, pb[ks], o, 0, 0, 0); } }
        SA_BAR();
    }
#undef SA_R
#undef SA_M
#undef SA_PA
#undef SA_PB
#undef SA_SEG
#undef SA_AKR
#undef SA_BRED
#undef SA_SB
#undef SA_IDS
#undef SA_SRC
#undef SA_LD
#undef SA_LDK
    asm volatile("s_waitcnt vmcnt(0)" ::: "memory");
    float* po = PO + (size_t)(b * 2 + half) * PO_STRIDE + (size_t)r32 * 256 + 32 * wave + 4 * hi;
#pragma unroll
    for (int g = 0; g < 4; ++g) *(GAS f32x4*)(po + 8 * g) = (f32x4){o[4 * g], o[4 * g + 1], o[4 * g + 2], o[4 * g + 3]};
    if (wave == 0 && hi == 0) PL[(b * 2 + half) * 32 + r32] = l_run;
    asm volatile("s_waitcnt vmcnt(0) lgkmcnt(0)" ::: "memory"); __syncthreads();
}

__device__ __forceinline__ void combine_item(const void* const* in, const bf16* Q, const bf16* K, const bf16* CKVN, const float* PO, const float* PL, float sref, bf16* ATT, int h, int rc, LAS unsigned char* lds, int tid, int wave, int lane) {
    const float* w_uv = (const float*)in[16];
    LAS float* WU = (LAS float*)lds;
    LAS float* OL = WU + 256 * 64;
    f32x4 wreg[8];
#pragma unroll
    for (int i = 0; i < 8; ++i) { const int e4 = tid + 512 * i, c = e4 >> 4, d4 = (e4 & 15) * 4; wreg[i] = *(const GAS f32x4*)(w_uv + (size_t)c * 512 + h * VH + d4); }
    { f32x4 v0[2], v1[2]; float pl0[2], pl1[2]; v4u qc[2], kc[2][4]; v2u cw_[2][4];
#pragma unroll
      for (int rr = 0; rr < 2; ++rr) { const int r = rc * 16 + 2 * wave + rr, b = r >> 2, t = r & 3, col = t * 8 + h; const size_t row = (size_t)MP + r;
          pl0[rr] = PL[(b * 2) * 32 + col]; pl1[rr] = PL[(b * 2 + 1) * 32 + col];
          v0[rr] = *(const GAS f32x4*)(PO + (size_t)(b * 2) * PO_STRIDE + (size_t)col * 256 + 4 * lane); v1[rr] = *(const GAS f32x4*)(PO + (size_t)(b * 2 + 1) * PO_STRIDE + (size_t)col * 256 + 4 * lane);
          const int c = lane < 12 ? lane : 0;
          qc[rr] = *(const GAS v4u*)(Q + row * 768 + h * QKH + 8 * c);
#pragma unroll
          for (int s2 = 0; s2 < 4; ++s2) { const size_t kr_ = (size_t)MP + b * DECT + s2; kc[rr][s2] = *(const GAS v4u*)(K + kr_ * 768 + h * QKH + 8 * c); cw_[rr][s2] = *(const GAS v2u*)(CKVN + kr_ * KVL + 4 * lane); } }
#pragma unroll
      for (int rr = 0; rr < 2; ++rr) { const int rl = 2 * wave + rr, r = rc * 16 + rl, t = r & 3;
          float l = pl0[rr] + pl1[rr]; float acc[4];
#pragma unroll
          for (int i = 0; i < 4; ++i) acc[i] = v0[rr][i] + v1[rr][i];
          float qf[8]; unpack8(qc[rr], qf);
#pragma unroll
          for (int s2 = 0; s2 < 4; ++s2) { float f[8]; unpack8(kc[rr][s2], f); float sc = 0.f;
#pragma unroll
              for (int i = 0; i < 8; ++i) sc += qf[i] * f[i];
              sc = wave_sum(lane < 12 ? sc : 0.f);
              const float pr = (s2 <= t) ? __builtin_amdgcn_exp2f(sc - sref) : 0.f;
              l += pr; const v2u w = cw_[rr][s2];
              acc[0] += pr * bflo(w.x); acc[1] += pr * bfhi(w.x); acc[2] += pr * bflo(w.y); acc[3] += pr * bfhi(w.y); }
          const float il = 1.0f / l;
          *(LAS f32x4*)(OL + rl * 256 + 4 * lane) = (f32x4){acc[0] * il, acc[1] * il, acc[2] * il, acc[3] * il}; } }
#pragma unroll
    for (int i = 0; i < 8; ++i) { const int e4 = tid + 512 * i, c = e4 >> 4, d4 = (e4 & 15) * 4; *(LAS f32x4*)(WU + c * 64 + d4) = wreg[i]; }
    LDS_WAIT(); __syncthreads();
    { const int rl = tid >> 5, dp = tid & 31; float o0 = 0.f, o1 = 0.f;
#pragma unroll 8
      for (int c = 0; c < KVL; ++c) { const float ov = OL[rl * 256 + c]; const f32x2 w = *(const LAS f32x2*)(WU + c * 64 + 2 * dp); o0 += ov * w.x; o1 += ov * w.y; }
      *(GAS unsigned*)(ATT + ((size_t)MP + rc * 16 + rl) * ATTW + h * VH + 2 * dp) = pk2(o0, o1); }
    LDS_WAIT(); __syncthreads();
}
}


__device__ __forceinline__ void qabs_item(const void* const* in, const bf16* QRAW, const bf16* WKV, const float* ROPE, bf16* QABS, int h, int rg, LAS unsigned char* lds, int tid) {
    const float* g_q = (const float*)in[17]; const float* g_k = (const float*)in[18];
    LAS unsigned char* WH = lds;
    LAS float* QG = (LAS float*)(lds + 32768);
#pragma unroll
    for (int i = 0; i < 4; ++i) *(LAS v4u*)(WH + (tid + 512 * i) * 16) = *(const GAS v4u*)(WKV + (size_t)(h * QKN) * KVL + (size_t)(tid + 512 * i) * 8);
    { const int rl = tid >> 3, sub = tid & 7, sr = rg * 64 + rl, pos = SEQ + (sr & 3);
      const bf16* qr = QRAW + ((size_t)MP + sr) * 768 + h * QKH; float n[8]; unpack8(*(const GAS v4u*)(qr + 8 * sub), n);
      const unsigned wa = *(const GAS unsigned*)(qr + 64 + 2 * sub), wb = *(const GAS unsigned*)(qr + 80 + 2 * sub);
      float a0 = bflo(wa), a1 = bfhi(wa), b0 = bflo(wb), b1 = bfhi(wb);
      float ss = (a0 * a0 + a1 * a1) + (b0 * b0 + b1 * b1);
#pragma unroll
      for (int i = 0; i < 8; ++i) ss += n[i] * n[i];
      ss += __shfl_xor(ss, 1); ss += __shfl_xor(ss, 2); ss += __shfl_xor(ss, 4);
      const float rs = QSCALE / sqrtf(ss * (1.f / QKH) + EPS);
      const float* rp = ROPE + (size_t)pos * 32; const f32x2 cs = *(const GAS f32x2*)(rp + 2 * sub), sn = *(const GAS f32x2*)(rp + 16 + 2 * sub);
#pragma unroll
      for (int i = 0; i < 8; ++i) QG[rl * 64 + 8 * sub + i] = bf2f((bf16)f2bf(n[i] * rs * g_q[8 * sub + i])) * g_k[8 * sub + i];
      a0 *= rs * g_q[64 + 2 * sub]; a1 *= rs * g_q[65 + 2 * sub]; b0 *= rs * g_q[80 + 2 * sub]; b1 *= rs * g_q[81 + 2 * sub];
      const unsigned r1 = pk2(a0 * cs.x - b0 * sn.x, a1 * cs.y - b1 * sn.y), r2 = pk2(a0 * sn.x + b0 * cs.x, a1 * sn.y + b1 * cs.y);
      bf16* qab = QABS + (size_t)(sr >> 2) * 36 * 32 * 8 + ((sr & 3) * 8 + h) * 8;
      *(GAS unsigned*)(qab + (32 + (sub >> 2)) * 256 + 2 * (sub & 3)) = r1; *(GAS unsigned*)(qab + (34 + (sub >> 2)) * 256 + 2 * (sub & 3)) = r2; }
    LDS_WAIT(); __syncthreads();
    { const int r4 = tid >> 5, ch = tid & 31; float acc[4][8];
#pragma unroll
      for (int r = 0; r < 4; ++r)
#pragma unroll
          for (int i = 0; i < 8; ++i) acc[r][i] = 0.f;
#pragma unroll 4
      for (int d = 0; d < QKN; ++d) { float w[8]; unpack8(*(const LAS v4u*)(WH + d * 512 + ch * 16), w);
#pragma unroll
          for (int r = 0; r < 4; ++r) { const float qg = QG[(r4 * 4 + r) * 64 + d];
#pragma unroll
              for (int i = 0; i < 8; ++i) acc[r][i] += qg * w[i]; } }
#pragma unroll
      for (int r = 0; r < 4; ++r) { const int sr = rg * 64 + r4 * 4 + r; v4u o; o.x = pk2(acc[r][0], acc[r][1]); o.y = pk2(acc[r][2], acc[r][3]); o.z = pk2(acc[r][4], acc[r][5]); o.w = pk2(acc[r][6], acc[r][7]);
          *(GAS v4u*)(QABS + (size_t)(sr >> 2) * 36 * 32 * 8 + ch * 256 + ((sr & 3) * 8 + h) * 8) = o; } }
    LDS_WAIT(); __syncthreads();
}

__device__ __forceinline__ void ssm_tables_item(const void* const* in, int g, int dq, LAS unsigned char* lds, bf16* MBT, bf16* TYT, float* A32, int tid) {
    const float* a_re = (const float*)in[19]; const float* a_im = (const float*)in[20]; const float* log_dt = (const float*)in[21];
    const float* b_re = (const float*)in[22]; const float* b_im = (const float*)in[23]; const float* c_re = (const float*)in[24]; const float* c_im = (const float*)in[25]; const float* d_skip = (const float*)in[26];
    LAS float* ap = (LAS float*)lds;
    LAS float* bb = ap + 64 * 33 * 2;
    LAS float* cc = bb + 2048;
    LAS float* kj = cc + 2048;
    if (tid < 64) { const int p = tid;
        const double dt = exp((double)log_dt[g]); const double are = a_re[g * NST + p], aim = a_im[g * NST + p];
        const double mag = exp(dt * are), abr = mag * cos(dt * aim), abi = mag * sin(dt * aim), den = are * are + aim * aim, nr = abr - 1.0;
        const double fre = (nr * are + abi * aim) / den, fim = (abi * are - nr * aim) / den;
        double pr = 1.0, pi = 0.0;
        for (int j = 0; j <= 32; ++j) { ap[(p * 33 + j) * 2] = (float)pr; ap[(p * 33 + j) * 2 + 1] = (float)pi; const double t = pr * abr - pi * abi; pi = pr * abi + pi * abr; pr = t; }
        for (int i = 0; i < 16; ++i) { const double br = b_re[(g * NST + p) * GRP + i], bi = b_im[(g * NST + p) * GRP + i]; bb[(p * 16 + i) * 2] = (float)(fre * br - fim * bi); bb[(p * 16 + i) * 2 + 1] = (float)(fre * bi + fim * br); }
        if (dq == 0) { A32[(g * NST + p) * 2] = ap[(p * 33 + 32) * 2]; A32[(g * NST + p) * 2 + 1] = ap[(p * 33 + 32) * 2 + 1];
            A32[4096 + (g * NST + p) * 2] = (float)abr; A32[4096 + (g * NST + p) * 2 + 1] = (float)abi;
            for (int i = 0; i < 16; ++i) { A32[8192 + ((g * NST + p) * 16 + i) * 2] = bb[(p * 16 + i) * 2]; A32[8192 + ((g * NST + p) * 16 + i) * 2 + 1] = bb[(p * 16 + i) * 2 + 1]; } }
    }
    for (int e = tid; e < 1024; e += 512) { const int i = e >> 6, p = e & 63; cc[e * 2] = c_re[(g * GRP + i) * NST + p]; cc[e * 2 + 1] = c_im[(g * GRP + i) * NST + p]; }
    LDS_WAIT(); __syncthreads();
    for (int e = tid; e < 1024; e += 512) { const int dd = e >> 8, i = (e >> 4) & 15, j = e & 15, d = 4 * dq + dd; float acc = 0.f;
        for (int p = 0; p < 64; ++p) { const float cr = cc[(i * 64 + p) * 2], ci = cc[(i * 64 + p) * 2 + 1], ar = ap[(p * 33 + d) * 2], ai = ap[(p * 33 + d) * 2 + 1], br = bb[(p * 16 + j) * 2], bi = bb[(p * 16 + j) * 2 + 1];
            const float tr = cr * ar - ci * ai, ti = cr * ai + ci * ar; acc += tr * br - ti * bi; }
        if (d == 0 && i == j) acc += d_skip[g * GRP + i];
        kj[e] = acc; }
    LDS_WAIT(); __syncthreads();
    for (int e = tid; e < 4 * 32 * 16; e += 512) { const int dd = e >> 9, t = (e >> 4) & 31, i = e & 15, d = 4 * dq + dd; bf16* rowp = TYT + ((size_t)g * 512 + t * 16 + i) * SKA;
        if (t >= d) { const LAS float* kp = kj + dd * 256 + i * 16; v4u w0, w1; w0.x = pk2(kp[0], kp[1]); w0.y = pk2(kp[2], kp[3]); w0.z = pk2(kp[4], kp[5]); w0.w = pk2(kp[6], kp[7]);
            w1.x = pk2(kp[8], kp[9]); w1.y = pk2(kp[10], kp[11]); w1.z = pk2(kp[12], kp[13]); w1.w = pk2(kp[14], kp[15]);
            *(GAS v4u*)(rowp + (t - d) * 16) = w0; *(GAS v4u*)(rowp + (t - d) * 16 + 8) = w1; }
        if (d >= 1 && t + d <= 31) { const v4u z = {0u, 0u, 0u, 0u}; *(GAS v4u*)(rowp + (t + d) * 16) = z; *(GAS v4u*)(rowp + (t + d) * 16 + 8) = z; } }
    for (int e = tid; e < 4 * 16 * 64; e += 512) { const int tt = e >> 10, i = (e >> 6) & 15, p = e & 63, t = 4 * dq + tt;
        const float cr = cc[(i * 64 + p) * 2], ci = cc[(i * 64 + p) * 2 + 1], ar = ap[(p * 33 + t + 1) * 2], ai = ap[(p * 33 + t + 1) * 2 + 1];
        bf16* rowp = TYT + ((size_t)g * 512 + t * 16 + i) * SKA; rowp[512 + p] = (bf16)f2bf(cr * ar - ci * ai); rowp[576 + p] = (bf16)f2bf(-(cr * ai + ci * ar)); }
    for (int e = tid; e < 64 * 4 * 16; e += 512) { const int p = e >> 6, tt = (e >> 4) & 3, i = e & 15, t = 4 * dq + tt;
        const float ar = ap[(p * 33 + 31 - t) * 2], ai = ap[(p * 33 + 31 - t) * 2 + 1], br = bb[(p * 16 + i) * 2], bi = bb[(p * 16 + i) * 2 + 1];
        MBT[((size_t)g * 256 + p) * SKU + t * 16 + i] = (bf16)f2bf(ar * br - ai * bi); MBT[((size_t)g * 256 + 64 + p) * SKU + t * 16 + i] = (bf16)f2bf(ar * bi + ai * br); }
    for (int e = tid; e < 128 * 8; e += 512) { const int r = e >> 3, c8 = e & 7; const v4u z = {0u, 0u, 0u, 0u}; *(GAS v4u*)(MBT + ((size_t)g * 256 + 128 + r) * SKU + 64 * dq + 8 * c8) = z; }
    LDS_WAIT(); __syncthreads();
}

__device__ __forceinline__ float reduce16(float (&v)[16], int lane) {
#pragma unroll
    for (int st = 0; st < 4; ++st) { const int half = 8 >> st, bit = 1 << st; const bool hi = (lane & bit) != 0;
#pragma unroll
        for (int j = 0; j < half; ++j) { const float send = hi ? v[j] : v[j + half], keep = hi ? v[j + half] : v[j]; v[j] = keep + __shfl_xor(send, bit); } }
    float r = v[0]; r += __shfl_xor(r, 16); r += __shfl_xor(r, 32); return r;
}
__device__ __forceinline__ void ssm_sample(const void* const* in, const float* TAB, const bf16* Z, bf16* GY, float* out, int g, int b0, int bstride, LAS float* scr, int lane) {
    const float* c_re = (const float*)in[24]; const float* c_im = (const float*)in[25]; const float* d_skip = (const float*)in[26];
    const int p = lane;
    const float abr = TAB[4096 + (g * NST + p) * 2], abi = TAB[4096 + (g * NST + p) * 2 + 1];
    float bbr[16], bbi[16], cr[16], ci[16], dsk[16];
    { const GAS f32x4* bp = (const GAS f32x4*)(TAB + 8192 + (size_t)(g * NST + p) * 32);
#pragma unroll
      for (int i = 0; i < 8; ++i) { const f32x4 v = bp[i]; bbr[2 * i] = v[0]; bbi[2 * i] = v[1]; bbr[2 * i + 1] = v[2]; bbi[2 * i + 1] = v[3]; } }
#pragma unroll
    for (int i = 0; i < 16; ++i) { cr[i] = c_re[(g * GRP + i) * NST + p]; ci[i] = c_im[(g * GRP + i) * NST + p]; dsk[i] = (p == 0) ? d_skip[g * GRP + i] : 0.f; }
    for (int b = b0; b < DECB; b += bstride) {
    const int row0 = MP + b * DECT;
    float hr = ((const float*)in[7])[(b * NG + g) * NST + p], hi = ((const float*)in[8])[(b * NG + g) * NST + p];
    v4u uw[DECT][2];
#pragma unroll
    for (int t = 0; t < DECT; ++t) { const bf16* zr = Z + (size_t)(row0 + t) * NZ + ZC_U + GRP * g; uw[t][0] = *(const GAS v4u*)zr; uw[t][1] = *(const GAS v4u*)(zr + 8); }
#pragma unroll
    for (int t = 0; t < DECT; ++t) {
        float u[16]; { float a[8], b[8]; unpack8(uw[t][0], a); unpack8(uw[t][1], b);
#pragma unroll
            for (int i = 0; i < 8; ++i) { u[i] = a[i]; u[8 + i] = b[i]; } }
        float bur = 0.f, bui = 0.f;
#pragma unroll
        for (int i = 0; i < 16; ++i) { bur += bbr[i] * u[i]; bui += bbi[i] * u[i]; }
        const float nhr = abr * hr - abi * hi + bur, nhi = abr * hi + abi * hr + bui; hr = nhr; hi = nhi;
        float z[16];
#pragma unroll
        for (int i = 0; i < 16; ++i) z[i] = cr[i] * hr - ci[i] * hi + dsk[i] * u[i];
#pragma unroll
        for (int i = 0; i < 16; ++i) scr[lane * 17 + i] = z[i];
        LDS_WAIT(); asm volatile("" ::: "memory");
        float y = 0.f;
#pragma unroll
        for (int k = 0; k < 16; ++k) y += scr[((lane >> 4) * 16 + k) * 17 + (lane & 15)];
        y += __shfl_xor(y, 16); y += __shfl_xor(y, 32);
        LDS_WAIT(); asm volatile("" ::: "memory");
        if (lane < 16) GY[(size_t)(row0 + t) * SSMW + GRP * g + lane] = (bf16)f2bf(gelu_tanh(y));
    }
    out[O_SRES + (size_t)(b * NG + g) * NST + p] = hr; out[O_SIMS + (size_t)(b * NG + g) * NST + p] = hi;
    }
}
__device__ __forceinline__ void ssm_carry_item(const float* TAB, const float* SST, bf16* AY, float* out, int b, int g, int ph, LAS unsigned char* lds, int tid) {
    const int pl = tid & 31, sup = tid >> 5, p = 32 * ph + pl;
    const float ar = TAB[(g * NST + p) * 2], ai = TAB[(g * NST + p) * 2 + 1];
    float sr[16], si[16];
#pragma unroll
    for (int i = 0; i < 16; ++i) { const int ch = b * 256 + sup * 16 + i; const float* sp = SST + ((size_t)ch * NG + g) * 128; sr[i] = sp[p]; si[i] = sp[64 + p]; }
    float hr = 0.f, hi = 0.f;
#pragma unroll
    for (int i = 0; i < 16; ++i) { const float nr = ar * hr - ai * hi + sr[i], ni = ar * hi + ai * hr + si[i]; hr = nr; hi = ni; sr[i] = hr; si[i] = hi; }
    LAS float* tot = (LAS float*)lds;
    LAS float* car = tot + 1024;
    tot[(sup * 32 + pl) * 2] = hr; tot[(sup * 32 + pl) * 2 + 1] = hi;
    LDS_WAIT(); __syncthreads();
    if (sup == 0) { float br = ar, bi = ai;
#pragma unroll
        for (int k = 0; k < 4; ++k) { const float t = br * br - bi * bi; bi = 2.f * br * bi; br = t; }
        float cr = 0.f, ci = 0.f;
        for (int s2 = 0; s2 < 16; ++s2) { car[(s2 * 32 + pl) * 2] = cr; car[(s2 * 32 + pl) * 2 + 1] = ci; const float tr = tot[(s2 * 32 + pl) * 2], ti = tot[(s2 * 32 + pl) * 2 + 1];
            const float nr = br * cr - bi * ci + tr, ni = br * ci + bi * cr + ti; cr = nr; ci = ni; }
        out[O_SREP + (b * NG + g) * NST + p] = cr; out[O_SIMP + (b * NG + g) * NST + p] = ci; }
    LDS_WAIT(); __syncthreads();
    float er = car[(sup * 32 + pl) * 2], ei = car[(sup * 32 + pl) * 2 + 1], lr = 0.f, li = 0.f;
#pragma unroll
    for (int i = 0; i < 16; ++i) { const int ch = b * 256 + sup * 16 + i; bf16* ay = AY + ((size_t)g * SCH + ch) * SKA;
        ay[512 + p] = (bf16)f2bf(er + lr); ay[576 + p] = (bf16)f2bf(ei + li);
        const float nr = ar * er - ai * ei, ni = ar * ei + ai * er; er = nr; ei = ni; lr = sr[i]; li = si[i]; }
    LDS_WAIT(); __syncthreads();
}

#define TAIL_FILL(nbusy, NIT, ...) do { const int ntail_ = ((nbusy) < G) ? (nbusy) : 0; LAS float* scr = (LAS float*)(lds + RING_OFF + wave * 16384); \
        if (ntail_ == 0) { for (int r = gw; r < (NIT); r += NGW) { __VA_ARGS__; } } \
        else if (bx >= ntail_) { for (int r = (bx - ntail_) * NWAVES + wave; r < (NIT); r += (G - ntail_) * NWAVES) { __VA_ARGS__; } } } while (0)

__device__ __forceinline__ float softmax_ref(const float* g_q, const float* g_k, int lane) {
    float a = fmaxf(fabsf(g_q[lane]), fabsf(g_q[64 + (lane & 31)])), b = fmaxf(fabsf(g_k[lane]), fabsf(g_k[64 + (lane & 31)]));
#pragma unroll
    for (int o = 1; o < 64; o <<= 1) { a = fmaxf(a, __shfl_xor(a, o)); b = fmaxf(b, __shfl_xor(b, o)); }
    return QSCALE * 96.0f * a * b * 1.015f + 0.25f;
}

__device__ __forceinline__ void wait_panel(unsigned* cnt, int pm, unsigned target, unsigned* tmo) {
    if (threadIdx.x < 64) {
        unsigned sp = 0;
        while (__hip_atomic_load(cnt + 64 * pm, __ATOMIC_RELAXED, __HIP_MEMORY_SCOPE_AGENT) < target) {
            __builtin_amdgcn_s_sleep(2);
            if ((++sp & 1023u) == 0u && sp > (1u << 22)) { if (threadIdx.x == 0) __hip_atomic_store(tmo, 1u, __ATOMIC_RELAXED, __HIP_MEMORY_SCOPE_AGENT); break; }
        }
        __builtin_amdgcn_fence(__ATOMIC_ACQUIRE, "agent");
        asm volatile("s_waitcnt vmcnt(0)" ::: "memory");
    }
    __syncthreads();
}
#define GEMM_PS(g, nN_, base_p, base_s, E) do { \
      { pg8::Order S_; S_.init(MP / 256, (nN_), 1, G, bx, (base_p)); pg8::gemm_phase<decltype(E), true, true, false>(lds + RING_OFF, g, S_, E); } \
      { pg8::Order S_; S_.init(MS / 256, (nN_), 1, G, bx, (base_s), MP / 256, 4); pg8::gemm_phase<decltype(E), true, true, true>(lds + RING_OFF, g, S_, E); } } while (0)
#define GEMM_P(g, nN_, base_p, E) do { pg8::Order S_; S_.init(MP / 256, (nN_), 1, G, bx, (base_p)); pg8::gemm_phase<decltype(E), true, true, false>(lds + RING_OFF, g, S_, E); } while (0)
#define GEMM_S(g, nN_, base_s, E) do { pg8::Order S_; S_.init(MS / 256, (nN_), 1, G, bx, (base_s), MP / 256, 4); pg8::gemm_phase<decltype(E), true, true, true>(lds + RING_OFF, g, S_, E); } while (0)

__device__ __forceinline__ unsigned char* opqp(unsigned char* p) { asm volatile("" : "+s"(p)); return p; }
#define WIN ((bf16*)(ws + WS_WIN))
#define WUQ ((bf16*)(ws + WS_WUQ))
#define WKV ((bf16*)(ws + WS_WKV))
#define WGLU ((bf16*)(ws + WS_WGLU))
#define WOA ((bf16*)(ws + WS_WOA))
#define WOS ((bf16*)(ws + WS_WOS))
#define WOUT ((bf16*)(ws + WS_WOUT))
#define WPG ((bf16*)(ws + WS_WPG))
#define WPP ((bf16*)(ws + WS_WPP))
#define WUP ((bf16*)(ws + WS_WUP))
#define WDN ((bf16*)(ws + WS_WDN))
#define XN ((bf16*)(ws + WS_XN))
#define Z ((bf16*)(ws + WS_Z))
#define CQN ((bf16*)(ws + WS_CQN))
#define CKVN ((bf16*)(ws + WS_CKVN))
#define PB ((bf16*)(ws + WS_PB))
#define AY ((bf16*)(ws + WS_AY))
#define RT ((float*)(ws + WS_ROPE))
#define RB ((bf16*)(ws + WS_ROPEB))
#define QRAW ((bf16*)(ws + WS_QRAW))
#define KVRAW ((bf16*)(ws + WS_KVRAW))
#define PP ((bf16*)(ws + WS_PP))
#define Q ((bf16*)(ws + WS_Q))
#define K ((bf16*)(ws + WS_K))
#define ATT ((bf16*)(ws + WS_ATT))
#define GY ((bf16*)(ws + WS_GY))
#define YG ((bf16*)(ws + WS_YG))
#define T1 ((bf16*)(ws + WS_T1))
#define MIX ((bf16*)(ws + WS_MIX))
#define SS1 ((float*)(ws + WS_SS1))
#define SS2 ((float*)(ws + WS_SS2))
#define UPB ((bf16*)(ws + WS_UP))
#define HB ((bf16*)(ws + WS_H))
#define X2B ((bf16*)(ws + WS_X2))
#define CB ((bf16*)(ws + WS_CB))
#define KNC ((bf16*)(ws + WS_KNC))
#define ROPE ((float*)(ws + WS_ROPE))
#define SST ((float*)(ws + WS_SST))
__global__ void __launch_bounds__(NWAVES * 64, 2) mk_fwd(Args args) {
    extern __shared__ __attribute__((aligned(16))) unsigned char lds_raw[];
    LAS unsigned char* lds = (LAS unsigned char*)lds_raw;
    volatile LAS unsigned* MISC = (volatile LAS unsigned*)(lds + MISC_OFF);
    const int tid0 = threadIdx.x;
    const int G = gridDim.x, bx = blockIdx.x;
    const int vcu = (G % 8 == 0) ? (bx % 8) * (G / 8) + bx / 8 : bx;
    const int NGW = G * NWAVES;
    unsigned char* ws0 = args.ws;
    unsigned* ctl = (unsigned*)(ws0 + WS_CTL);
    float* out = args.out;
    for (int u = opq(tid0); u < (LDS_BYTES - LDSCTL_OFF) / 4; u += NWAVES * 64) ((LAS unsigned*)(lds + LDSCTL_OFF))[u] = 0u;
    __syncthreads();
    XcdBarrier bar; bar.bar = ctl + CW_BAR; bar.x = 0; bar.st = nullptr;
#if MK_ONE_LAUNCH
    bar = xcd_barrier_post(ctl + CW_BAR, MISC + 8);
#define GRID_BAR() xcd_barrier(bar)
#else
#define GRID_BAR() do {} while (0)
#endif
    const int lo = args.ph_lo, hi = args.ph_hi;
#ifndef PHMASK
#define PHMASK 0xFFFFFFFFu
#endif
#define IN(k) ((((PHMASK) >> (k)) & 1u) && lo <= (k) && (k) < hi)
#define BOTH(k) (IN(k) && IN((k) + 1))

    const float* x_prompt = (const float*)args.in[0]; const float* x_sample = (const float*)args.in[1];
    const float* p_prompt = (const float*)args.in[2]; const float* p_sample = (const float*)args.in[3];
    if (IN(0)) REPLOOP(0) { unsigned char* ws = opqp(ws0); const int tid = opq(tid0), lane = tid & 63, wave = __builtin_amdgcn_readfirstlane(tid >> 6), gw = vcu * NWAVES + wave; (void)lane; (void)gw;
        _Pragma("unroll") for (int rq_ = 0; rq_ < P0A; ++rq_)
        for (int it = bx; it < NG * 8; it += G) ssm_tables_item(args.in, it >> 3, it & 7, lds + RING_OFF, (bf16*)(ws + WS_MBT), (bf16*)(ws + WS_TYT), (float*)(ws + WS_SSMT), tid);
        LAS float* scr = (LAS float*)(lds + RING_OFF + wave * 16384);
        constexpr int I_WIN = 16 * (NZ / 32);
        _Pragma("unroll") for (int rq_ = 0; rq_ < P0B; ++rq_)
        for (int r = gw; r < I_WIN; r += NGW) { const int nblk = NZ / 32, kb = r / nblk, nb = r % nblk, nd = 32 * nb; int ns; bool pad = false;
                if (nd < 256) ns = 384 + nd; else if (nd < 640) ns = nd - 256; else if (nd < 672) ns = nd; else if (nd < 768) { ns = 0; pad = true; }
                else if (nd < 1280) ns = 672 + (nd - 768); else if (nd < 2304) ns = 1184 + (nd - 1280); else ns = 2208 + (nd - 2304);
                tr_item(pad ? nullptr : (const float*)args.in[11], 3232, 64 * kb, ns, WIN, 1024, nd, scr, lane); }
        const float* gmix = (const float*)args.in[10];
        f32x4 gm[4];
#pragma unroll
        for (int j = 0; j < 4; ++j) gm[j] = ((const GAS f32x4*)gmix)[lane + 64 * j];
        for (int m0 = gw; m0 < M; m0 += 2 * NGW) { const int m1 = m0 + NGW; const bool two = m1 < M;
            f32x4 v[2][4], pv[2];
#pragma unroll
            for (int r = 0; r < 2; ++r) { const int m = (r == 0 || two) ? (r == 0 ? m0 : m1) : m0;
                const float* xrow = (m < MP) ? x_prompt + (size_t)m * D : x_sample + (size_t)(m - MP) * D; const GAS f32x4* xr = (const GAS f32x4*)xrow + lane;
#pragma unroll
                for (int j = 0; j < 4; ++j) v[r][j] = xr[64 * j];
                const float* prow = (m < MP) ? p_prompt + (size_t)m * PLE : p_sample + (size_t)(m - MP) * PLE; pv[r] = ((const GAS f32x4*)prow)[lane]; }
#pragma unroll
            for (int r = 0; r < 2; ++r) { if (r == 1 && !two) break; const int m = r == 0 ? m0 : m1; float sq = 0.f;
#pragma unroll
                for (int j = 0; j < 4; ++j) sq += (v[r][j].x * v[r][j].x + v[r][j].y * v[r][j].y) + (v[r][j].z * v[r][j].z + v[r][j].w * v[r][j].w);
                const float rs = 1.0f / sqrtf(wave_sum(sq) * (1.f / D) + EPS);
                GAS v2u* o8 = (GAS v2u*)(XN + (size_t)m * D) + lane;
#pragma unroll
                for (int j = 0; j < 4; ++j) { v2u w; w.x = pk2(v[r][j].x * rs * gm[j].x, v[r][j].y * rs * gm[j].y); w.y = pk2(v[r][j].z * rs * gm[j].z, v[r][j].w * rs * gm[j].w); o8[64 * j] = w; }
                v2u w; w.x = pk2(pv[r].x, pv[r].y); w.y = pk2(pv[r].z, pv[r].w); ((GAS v2u*)(PB + (size_t)m * PLE))[lane] = w; }
        }
        if (BOTH(0)) GRID_BAR();
    }

    if (IN(1)) REPLOOP(1) { unsigned char* ws = opqp(ws0); const int tid = opq(tid0), lane = tid & 63, wave = __builtin_amdgcn_readfirstlane(tid >> 6), gw = vcu * NWAVES + wave; (void)lane; (void)gw;
        pg8::Gemm g{XN, WIN, D, D, D, 0, 0}; pg8::Order S; S.init(M / 256, NZ / 256, 1, G, bx, 0);
        EpiInproj E{Z, CQN, CKVN, AY, out, (const float*)args.in[13], lds + 131072};
        pg8::gemm_phase(lds + RING_OFF, g, S, E);
        { constexpr int I_WUQ = 6 * 24, I_WUK = 4 * 16, I_WUV = 4 * 16, I_WGLU = 8 * 32, I_WOA = 8 * 32, I_WOS = 8 * 32, I_WOUT = 16 * 32, I_WPP = 4 * 32;
          constexpr int NIT1 = I_WUQ + I_WUK + I_WUV + I_WGLU + I_WOA + I_WOS + I_WOUT + I_WPP;
          TAIL_FILL(((M / 256) * (NZ / 256)) % G, NIT1, { int q = r;
            if (q < I_WUQ) { tr_plain((const float*)args.in[14], 384, 768, WUQ, q, scr, lane, (const float*)args.in[12]); continue; } q -= I_WUQ;
            if (q < I_WUK) { tr_plain((const float*)args.in[15], 256, 512, WKV, q, scr, lane); continue; } q -= I_WUK;
            if (q < I_WUV) { tr_plain((const float*)args.in[16], 256, 512, WKV + 512 * 256, q, scr, lane); continue; } q -= I_WUV;
            if (q < I_WGLU) { const int kb = q / 32, nb = q % 32, nd = 32 * nb; const int pn = nd >> 8, bj = (nd >> 7) & 1, c = nd & 127; const int ns = bj * 512 + 128 * pn + c;
                tr_item((const float*)args.in[27], 1024, 64 * kb, ns, WGLU, 512, nd, scr, lane); continue; } q -= I_WGLU;
            if (q < I_WOA) { tr_plain((const float*)args.in[28], 512, 1024, WOA, q, scr, lane); continue; } q -= I_WOA;
            if (q < I_WOS) { tr_plain((const float*)args.in[29], 512, 1024, WOS, q, scr, lane); continue; } q -= I_WOS;
            if (q < I_WOUT) { tr_plain((const float*)args.in[30], 1024, 1024, WOUT, q, scr, lane); continue; } q -= I_WOUT;
            tr_plain((const float*)args.in[38], 256, 1024, WPP, q, scr, lane); });
          TAIL_FILL(((M / 256) * (NZ / 256)) % G, 16 * 176, { const int kb_ = r / 176, nd_ = 32 * (r % 176), ns_ = ((nd_ >> 7) & 1) * DFF + 128 * (nd_ >> 8) + (nd_ & 127);     \
            tr_item((const float*)args.in[32], UPW, 64 * kb_, ns_, WUP, 1024, nd_, scr, lane, (const float*)args.in[31]); });
          const int nb1 = ((M / 256) * (NZ / 256)) % G, b0_ = (nb1 && bx >= nb1) ? bx - nb1 : (nb1 ? -1 : bx), gs_ = nb1 ? G - nb1 : G;
          if (b0_ >= 0) {
        { for (int i = b0_ * 512 + tid; i < (SEQ + DECT) * 16; i += gs_ * 512) { const int pos = i >> 4, k = i & 15;
              const float inv = (float)exp(-(double)k * (1.0 / 16.0) * 9.210340371976184); const float ang = (float)pos * inv; const float c = cosf(ang), sn = sinf(ang);
              RT[pos * 32 + k] = c; RT[pos * 32 + 16 + k] = sn; RB[pos * 32 + k] = (bf16)f2bf(c); RB[pos * 32 + 16 + k] = (bf16)f2bf(sn); } }
        { unsigned* W8 = (unsigned*)(ws + WS_W8); const float* w_uk = (const float*)args.in[15];
          for (int i = b0_ * 512 + tid; i < 512 * 64; i += gs_ * 512) { const int row = i & 511, k4 = (i >> 9) * 4; int w = 0;
              w = __builtin_amdgcn_cvt_pk_fp8_f32(64.f * w_uk[(size_t)k4 * 512 + row], 64.f * w_uk[(size_t)(k4 + 1) * 512 + row], w, false);
              w = __builtin_amdgcn_cvt_pk_fp8_f32(64.f * w_uk[(size_t)(k4 + 2) * 512 + row], 64.f * w_uk[(size_t)(k4 + 3) * 512 + row], w, true);
              W8[row * 64 + (k4 >> 2)] = (unsigned)w; } }
          } }
        if (BOTH(1)) GRID_BAR();
    }

    constexpr int NMT = M / 256;

    if (IN(3)) REPLOOP(3) { unsigned char* ws = opqp(ws0); const int tid = opq(tid0), lane = tid & 63, wave = __builtin_amdgcn_readfirstlane(tid >> 6), gw = vcu * NWAVES + wave; (void)lane; (void)gw;
        {
          constexpr int NPR = MP / 256;
          pg8::Gemm gq{CQN, WUQ, QL, QL, QL, 0, 0}; auto fq_ = [=](const pg8::Unit& u, int row, int col, f32x4 a, f32x4 b) { *(GAS v4u*)(QRAW + (size_t)row * 768 + col) = pack8(a, b); }; pg8::EpiRow8<decltype(fq_)> Eq{fq_};
          pg8::Gemm gk{CKVN, WKV, KVL, KVL, KVL, 0, 0}; auto fk_ = [=](const pg8::Unit& u, int row, int col, f32x4 a, f32x4 b) { *(GAS v4u*)(KVRAW + (size_t)row * 1024 + col) = pack8(a, b); }; pg8::EpiRow8<decltype(fk_)> Ek{fk_};
          GEMM_P(gq, 3, 0, Eq); GEMM_P(gk, 4, NPR * 3, Ek);
          { pg8::Gemm g{AY, (const bf16*)(ws + WS_MBT), SKA, SKU, SKU, (size_t)SCH * SKA, (size_t)256 * SKU}; pg8::Order S; S.init(SCH / 256, 1, NG, G, bx, NPR * 7);
            auto f = [=](const pg8::Unit& u, int row, int col, f32x4 a, f32x4 b) { if (col < 128) { float* d = SST + ((size_t)row * NG + u.z) * 128 + col; *(GAS f32x4*)d = a; *(GAS f32x4*)(d + 4) = b; } };
            pg8::EpiRow8<decltype(f)> E{f}; pg8::gemm_phase(lds + RING_OFF, g, S, E); }
          constexpr int B2 = NPR * 7 + 64;
          GEMM_S(gq, 3, B2, Eq); GEMM_S(gk, 4, B2 + 24, Ek); }
        if (BOTH(3)) GRID_BAR();
    }

    if (IN(4)) REPLOOP(4) { unsigned char* ws = opqp(ws0); const int tid = opq(tid0), lane = tid & 63, wave = __builtin_amdgcn_readfirstlane(tid >> 6), gw = vcu * NWAVES + wave; (void)lane; (void)gw;
        _Pragma("unroll") for (int rpc_ = 0; rpc_ < P4C; ++rpc_)
        for (int it = bx; it < NBATCH * NG * 2; it += G) ssm_carry_item((const float*)(ws + WS_SSMT), (const float*)(ws + WS_SST), AY, out, it >> 6, (it >> 1) & 31, it & 1, lds + RING_OFF, tid);
        _Pragma("unroll") for (int rpd_ = 0; rpd_ < P4D; ++rpd_)
        for (int it = G - 1 - bx; it < NH * (MS / 64); it += G) qabs_item(args.in, QRAW, WKV, ROPE, (bf16*)(ws + WS_QABS), it & 7, it >> 3, lds + RING_OFF, tid);
        const float* g_q = (const float*)args.in[17]; const float* g_k = (const float*)args.in[18];
        const int h = lane >> 3, sub = lane & 7;
        float gq[12], gk[12];
#pragma unroll
        for (int i = 0; i < 8; ++i) { gq[i] = g_q[8 * sub + i]; gk[i] = g_k[8 * sub + i]; }
        gq[8] = g_q[64 + 2 * sub]; gq[9] = g_q[65 + 2 * sub]; gq[10] = g_q[80 + 2 * sub]; gq[11] = g_q[81 + 2 * sub];
        gk[8] = g_k[64 + 2 * sub]; gk[9] = g_k[65 + 2 * sub]; gk[10] = g_k[80 + 2 * sub]; gk[11] = g_k[81 + 2 * sub];
        _Pragma("unroll") for (int rpa_ = 0; rpa_ < P4A; ++rpa_)
        for (int m0 = gw; m0 < M; m0 += 2 * NGW) {
            const int m1 = m0 + NGW; const bool two = m1 < M;
            f32x2 cs[2], sn[2]; v4u qn8[2], kn8[2]; unsigned qa[2], qb[2]; f32x2 xa[2], xb[2];
#pragma unroll
            for (int j = 0; j < 2; ++j) { const int m = (j == 0 || two) ? (j == 0 ? m0 : m1) : m0;
                const int pos = (m < MP) ? (m & (SEQ - 1)) : SEQ + ((m - MP) & 3);
                const float* rp = ROPE + (size_t)pos * 32; cs[j] = *(const GAS f32x2*)(rp + 2 * sub); sn[j] = *(const GAS f32x2*)(rp + 16 + 2 * sub);
                const bf16* qr = QRAW + (size_t)m * 768 + h * QKH; qn8[j] = *(const GAS v4u*)(qr + 8 * sub); qa[j] = *(const GAS unsigned*)(qr + 64 + 2 * sub); qb[j] = *(const GAS unsigned*)(qr + 80 + 2 * sub);
                kn8[j] = *(const GAS v4u*)(KVRAW + (size_t)m * 1024 + h * QKN + 8 * sub);
                const float* krp = (m < MP) ? out + O_KRP + (size_t)m * QKR : out + O_KRS + (size_t)(m - MP) * QKR; xa[j] = *(const GAS f32x2*)(krp + 2 * sub); xb[j] = *(const GAS f32x2*)(krp + 16 + 2 * sub); }
#pragma unroll
            for (int j = 0; j < 2; ++j) { if (j == 1 && !two) break; const int m = j == 0 ? m0 : m1;
            { float n[8]; unpack8(qn8[j], n);
              float a0 = bflo(qa[j]), a1 = bfhi(qa[j]), b0 = bflo(qb[j]), b1 = bfhi(qb[j]);
              float ss = (a0 * a0 + a1 * a1) + (b0 * b0 + b1 * b1);
#pragma unroll
              for (int i = 0; i < 8; ++i) ss += n[i] * n[i];
              ss += __shfl_xor(ss, 1); ss += __shfl_xor(ss, 2); ss += __shfl_xor(ss, 4);
              const float rs = QSCALE / sqrtf(ss * (1.f / QKH) + EPS);
#pragma unroll
              for (int i = 0; i < 8; ++i) n[i] *= rs * gq[i];
              a0 *= rs * gq[8]; a1 *= rs * gq[9]; b0 *= rs * gq[10]; b1 *= rs * gq[11];
              bf16* qo = Q + (size_t)m * 768 + h * QKH;
              v4u w; w.x = pk2(n[0], n[1]); w.y = pk2(n[2], n[3]); w.z = pk2(n[4], n[5]); w.w = pk2(n[6], n[7]); *(GAS v4u*)(qo + 8 * sub) = w;
              *(GAS unsigned*)(qo + 64 + 2 * sub) = pk2(a0 * cs[j].x - b0 * sn[j].x, a1 * cs[j].y - b1 * sn[j].y); *(GAS unsigned*)(qo + 80 + 2 * sub) = pk2(a0 * sn[j].x + b0 * cs[j].x, a1 * sn[j].y + b1 * cs[j].y); }
            { float n[8]; unpack8(kn8[j], n);
              float a0 = xa[j].x, a1 = xa[j].y, b0 = xb[j].x, b1 = xb[j].y;
              float ss = (a0 * a0 + a1 * a1) + (b0 * b0 + b1 * b1);
#pragma unroll
              for (int i = 0; i < 8; ++i) ss += n[i] * n[i];
              ss += __shfl_xor(ss, 1); ss += __shfl_xor(ss, 2); ss += __shfl_xor(ss, 4);
              const float rs = 1.0f / sqrtf(ss * (1.f / QKH) + EPS);
#pragma unroll
              for (int i = 0; i < 8; ++i) n[i] *= rs * gk[i];
              a0 *= rs * gk[8]; a1 *= rs * gk[9]; b0 *= rs * gk[10]; b1 *= rs * gk[11];
              bf16* ko = K + (size_t)m * 768 + h * QKH;
              v4u w; w.x = pk2(n[0], n[1]); w.y = pk2(n[2], n[3]); w.z = pk2(n[4], n[5]); w.w = pk2(n[6], n[7]); *(GAS v4u*)(ko + 8 * sub) = w;
              *(GAS unsigned*)(ko + 64 + 2 * sub) = pk2(a0 * cs[j].x - b0 * sn[j].x, a1 * cs[j].y - b1 * sn[j].y);
              *(GAS unsigned*)(ko + 80 + 2 * sub) = pk2(a0 * sn[j].x + b0 * cs[j].x, a1 * sn[j].y + b1 * cs[j].y); } }
        }
        _Pragma("unroll") for (int rpb_ = 0; rpb_ < P4B; ++rpb_)
        if (NGW % NG == 0) ssm_sample(args.in, (const float*)(ws + WS_SSMT), Z, GY, out, gw % NG, gw / NG, NGW / NG, (LAS float*)(lds + RING_OFF + wave * 16384), lane);
        else for (int it = gw; it < DECB * NG; it += NGW) ssm_sample(args.in, (const float*)(ws + WS_SSMT), Z, GY, out, it % NG, it / NG, DECB, (LAS float*)(lds + RING_OFF + wave * 16384), lane);
        if (BOTH(4)) GRID_BAR();
    }

    if (IN(5)) REPLOOP(5) { unsigned char* ws = opqp(ws0); const int tid = opq(tid0), lane = tid & 63, wave = __builtin_amdgcn_readfirstlane(tid >> 6), gw = vcu * NWAVES + wave; (void)lane; (void)gw;
        const bool sa_first = SA_FIRST_ALL ? true : ((vcu & 1) != 0);
        const float sref = softmax_ref((const float*)args.in[17], (const float*)args.in[18], lane);
        if (sa_first)
            for (int it = bx; it < DECB * 2; it += G)
                sa::item<0>(args.in, (const bf16*)(ws + WS_QABS), (const unsigned char*)(ws + WS_W8), (const bf16*)(ws + WS_ROPEB), (float*)(ws + WS_PO), (float*)(ws + WS_PL), sref, it >> 1, it & 1, lds + RING_OFF, tid, wave, lane);
        for (int pi = vcu; pi < 256; pi += G) { const int bh = pi >> 4, s_ = pi & 15;
            pa::attn_unit(Q, K, KVRAW + 512, ATT, bh >> 3, bh & 7, s_, sref, lds + RING_OFF, wave, lane);
            pa::attn_unit(Q, K, KVRAW + 512, ATT, bh >> 3, bh & 7, 31 - s_, sref, lds + RING_OFF, wave, lane); }
        if (!sa_first)
            for (int it = bx; it < DECB * 2; it += G)
                sa::item<0>(args.in, (const bf16*)(ws + WS_QABS), (const unsigned char*)(ws + WS_W8), (const bf16*)(ws + WS_ROPEB), (float*)(ws + WS_PO), (float*)(ws + WS_PL), sref, it >> 1, it & 1, lds + RING_OFF, tid, wave, lane);
        if (BOTH(5)) GRID_BAR();
    }

    if (IN(6)) REPLOOP(6) { unsigned char* ws = opqp(ws0); const int tid = opq(tid0), lane = tid & 63, wave = __builtin_amdgcn_readfirstlane(tid >> 6), gw = vcu * NWAVES + wave; (void)lane; (void)gw;
        const float sref6 = softmax_ref((const float*)args.in[17], (const float*)args.in[18], lane);
        const int GH = G / 2;
        _Pragma("unroll") for (int rq_ = 0; rq_ < P6A; ++rq_)
        if (bx >= GH) for (int it = bx - GH; it < NH * (MS / 16); it += G - GH)
            sa::combine_item(args.in, Q, K, CKVN, (const float*)(ws + WS_PO), (const float*)(ws + WS_PL), sref6, ATT, it & 7, it >> 3, lds + RING_OFF, tid, wave, lane);
        { pg8::Gemm g{AY, (const bf16*)(ws + WS_TYT), SKA, SKA, SKA, (size_t)SCH * SKA, (size_t)512 * SKA}; pg8::Order S; S.init(SCH / 256, 2, NG, GH, bx, 0);
          auto f = [=](const pg8::Unit& u, int row, int col, f32x4 a, f32x4 b) {
#pragma unroll
              for (int i = 0; i < 4; ++i) { a[i] = gelu_tanh(a[i]); b[i] = gelu_tanh(b[i]); }
              *(GAS v4u*)(GY + ((size_t)row * SL + (col >> 4)) * SSMW + u.z * GRP + (col & 15)) = pack8(a, b); };
          pg8::EpiRow8<decltype(f)> E{f}; if (bx < GH) pg8::gemm_phase(lds + RING_OFF, g, S, E); }
        if (BOTH(6)) GRID_BAR();
    }

    if (IN(7)) REPLOOP(7) { unsigned char* ws = opqp(ws0); const int tid = opq(tid0), lane = tid & 63, wave = __builtin_amdgcn_readfirstlane(tid >> 6), gw = vcu * NWAVES + wave; (void)lane; (void)gw;
        { pg8::Gemm gg{GY, WGLU, SSMW, SSMW, SSMW, 0, 0};
          auto fg_ = [=](const pg8::Unit& u, int row, int cp, f32x4 a0, f32x4 a1, f32x4 b0, f32x4 b1) {
#pragma unroll
              for (int i = 0; i < 4; ++i) { a0[i] *= sigmoidf_(b0[i]); a1[i] *= sigmoidf_(b1[i]); }
              *(GAS v4u*)(YG + (size_t)row * SSMW + cp) = pack8(a0, a1); };
          pg8::EpiPair8<decltype(fg_)> Eg{fg_};
          pg8::Gemm ga_{ATT, WOA, ATTW, ATTW, ATTW, 0, 0};
          auto fa_ = [=](const pg8::Unit& u, int row, int col, f32x4 a, f32x4 b) { float gt[8]; unpack8(*(const GAS v4u*)(Z + (size_t)row * NZ + ZC_GA + col), gt);
#pragma unroll
              for (int i = 0; i < 4; ++i) { a[i] *= gt[i]; b[i] *= gt[4 + i]; }
              *(GAS v4u*)(T1 + (size_t)row * D + col) = pack8(a, b); };
          pg8::EpiRow8<decltype(fa_)> Ea{fa_};
          GEMM_P(gg, 4, 0, Eg); GEMM_P(ga_, 4, 256, Ea); GEMM_S(gg, 4, 512, Eg); GEMM_S(ga_, 4, 544, Ea); }
        if (BOTH(7)) GRID_BAR();
    }

    if (IN(8)) REPLOOP(8) { unsigned char* ws = opqp(ws0); const int tid = opq(tid0), lane = tid & 63, wave = __builtin_amdgcn_readfirstlane(tid >> 6), gw = vcu * NWAVES + wave; (void)lane; (void)gw;
        pg8::Gemm g{YG, WOS, SSMW, SSMW, SSMW, 0, 0};
        auto f = [=](const pg8::Unit& u, int row, int col, f32x4 a, f32x4 b) { float gt[8], t1[8]; unpack8(*(const GAS v4u*)(Z + (size_t)row * NZ + ZC_GS + col), gt); unpack8(*(const GAS v4u*)(T1 + (size_t)row * D + col), t1);
#pragma unroll
            for (int i = 0; i < 4; ++i) { a[i] = t1[i] + a[i] * gt[i]; b[i] = t1[4 + i] + b[i] * gt[4 + i]; }
            *(GAS v4u*)(MIX + (size_t)row * D + col) = pack8(a, b); };
        pg8::EpiRow8<decltype(f)> E{f}; GEMM_PS(g, 4, 0, 256, E);
        TAIL_FILL(32, 44 * 32, tr_plain((const float*)args.in[35], DFF, 1024, WDN, r, scr, lane));
        if (BOTH(8)) GRID_BAR();
    }

    if (IN(9)) REPLOOP(9) { unsigned char* ws = opqp(ws0); const int tid = opq(tid0), lane = tid & 63, wave = __builtin_amdgcn_readfirstlane(tid >> 6), gw = vcu * NWAVES + wave; (void)lane; (void)gw;
        pg8::Gemm g{MIX, WOUT, D, D, D, 0, 0};
        EpiResid<false> E{x_prompt, x_sample, nullptr, XN, SS1};
        GEMM_PS(g, 4, 0, 256, E);
        TAIL_FILL(32, 16 * 32, tr_plain((const float*)args.in[37], 1024, 1024, WPG, r, scr, lane, (const float*)args.in[36]));
        if (BOTH(9)) GRID_BAR();
    }

    if (IN(10)) REPLOOP(10) { unsigned char* ws = opqp(ws0); const int tid = opq(tid0), lane = tid & 63, wave = __builtin_amdgcn_readfirstlane(tid >> 6), gw = vcu * NWAVES + wave; (void)lane; (void)gw;
        pg8::Gemm g{XN, WUP, D, D, D, 0, 0};
        EpiUpConv E{SS1, HB, (bf16*)(ws + WS_UPF), (bf16*)(ws + WS_UPL), out, (const float*)args.in[33], (const float*)args.in[34], (const float*)args.in[9], lds + 131072, ctl + CW_PAN};
        constexpr int NUS = (MS / 256) * (UPW / 256), NUP = (MP / 256) * (UPW / 256);
        { pg8::Order Sa, Sb; Sa.init(MS / 256, UPW / 256, 1, G, bx, 0, MP / 256, 1); Sb.init(MP / 256, UPW / 256, 1, G, bx, NUS); pg8::OrderSeq S; S.init(Sa, Sb, NUS, G, bx);
          pg8::gemm_phase<EpiUpConv, true, true, false, pg8::OrderSeq>(lds + RING_OFF, g, S, E); }
        {
          pg8::Gemm gp{PB, WPP, PLE, PLE, PLE, 0, 0}; auto fp_ = [=](const pg8::Unit& u, int row, int col, f32x4 a, f32x4 b) { *(GAS v4u*)(PP + (size_t)row * 1024 + col) = pack8(a, b); }; pg8::EpiRow8<decltype(fp_)> Ep{fp_};
          const int nb_ = (NUS + NUP) % G; const int nidle = nb_ ? G - nb_ : G, ci = nb_ ? bx - nb_ : bx;
          const int nd_ = (nidle > 64) ? 32 : 0;
          if (ci >= 0 && ci < nd_) { pg8::Gemm gd{HB, WDN, DFF, DFF, DFF, 0, 0}; EpiResid<true> Ed{nullptr, nullptr, XN, X2B, SS2};
              pg8::Order Sd; Sd.init(MS / 256, 4, 1, nd_, ci, 0, MP / 256, 4); pg8::Unit uo;
              for (int i = 0; Sd.next(i, uo); ++i) wait_panel(ctl + CW_PAN, uo.pm, (unsigned)(UPW / 256) * 8u, ctl + CW_PTMO);
              pg8::gemm_phase<EpiResid<true>, true, true, true>(lds + RING_OFF, gd, Sd, Ed); }
          else if (ci >= nd_) { pg8::Order So; So.init(NMT, 4, 1, nidle - nd_, ci - nd_, 0); pg8::gemm_phase(lds + RING_OFF, gp, So, Ep); } }
        if (BOTH(10)) GRID_BAR();
    }


    if (IN(12)) REPLOOP(12) { unsigned char* ws = opqp(ws0); const int tid = opq(tid0), lane = tid & 63, wave = __builtin_amdgcn_readfirstlane(tid >> 6), gw = vcu * NWAVES + wave; (void)lane; (void)gw;
        { const float* conv_w = (const float*)args.in[33]; const float* conv_b = (const float*)args.in[34]; const bf16* UPF = (const bf16*)(ws + WS_UPF); const bf16* UPL = (const bf16*)(ws + WS_UPL);
          constexpr int NCG = DFF / 8; pg8::Order So; So.init(MP / 256, 4, 1, G, bx, 0); pg8::Unit uo;
          for (int ui = 0; So.next(ui, uo); ++ui) { const int pm = uo.pm;
          for (int it = tid; it < 2 * NCG; it += 512) {
            const int cg = it % NCG, rr = it / NCG, c0 = 8 * cg; const bool first = (pm & 31) == 0;
            float cur[16], p1[16], p2[16];
            unpack8(*(const GAS v4u*)(UPF + ((size_t)pm * 2 + rr) * UPW + c0), *(float(*)[8])&cur[0]); unpack8(*(const GAS v4u*)(UPF + ((size_t)pm * 2 + rr) * UPW + DFF + c0), *(float(*)[8])&cur[8]);
#pragma unroll
            for (int i = 0; i < 16; ++i) { p1[i] = 0.f; p2[i] = 0.f; }
            if (rr == 1) { unpack8(*(const GAS v4u*)(UPF + ((size_t)pm * 2) * UPW + c0), *(float(*)[8])&p1[0]); unpack8(*(const GAS v4u*)(UPF + ((size_t)pm * 2) * UPW + DFF + c0), *(float(*)[8])&p1[8]); }
            if (!first) {
                if (rr == 0) { unpack8(*(const GAS v4u*)(UPL + ((size_t)(pm - 1) * 2 + 1) * UPW + c0), *(float(*)[8])&p1[0]); unpack8(*(const GAS v4u*)(UPL + ((size_t)(pm - 1) * 2 + 1) * UPW + DFF + c0), *(float(*)[8])&p1[8]);
                               unpack8(*(const GAS v4u*)(UPL + ((size_t)(pm - 1) * 2) * UPW + c0), *(float(*)[8])&p2[0]); unpack8(*(const GAS v4u*)(UPL + ((size_t)(pm - 1) * 2) * UPW + DFF + c0), *(float(*)[8])&p2[8]); }
                else { unpack8(*(const GAS v4u*)(UPL + ((size_t)(pm - 1) * 2 + 1) * UPW + c0), *(float(*)[8])&p2[0]); unpack8(*(const GAS v4u*)(UPL + ((size_t)(pm - 1) * 2 + 1) * UPW + DFF + c0), *(float(*)[8])&p2[8]); }
            }
            float hh[8];
#pragma unroll
            for (int i = 0; i < 8; ++i) { const float ca = conv_b[c0 + i] + p2[i] * conv_w[c0 + i] + p1[i] * conv_w[UPW + c0 + i] + cur[i] * conv_w[2 * UPW + c0 + i];
                const float cv = conv_b[DFF + c0 + i] + p2[8 + i] * conv_w[DFF + c0 + i] + p1[8 + i] * conv_w[UPW + DFF + c0 + i] + cur[8 + i] * conv_w[2 * UPW + DFF + c0 + i]; hh[i] = gelu_tanh(ca) * cv; }
            v4u o; o.x = pk2(hh[0], hh[1]); o.y = pk2(hh[2], hh[3]); o.z = pk2(hh[4], hh[5]); o.w = pk2(hh[6], hh[7]);
            *(GAS v4u*)(HB + ((size_t)pm * 256 + rr) * DFF + c0) = o;
        }
          }
          asm volatile("s_waitcnt vmcnt(0)" ::: "memory"); __syncthreads(); }
        pg8::Gemm g{HB, WDN, DFF, DFF, DFF, 0, 0};
        EpiResid<true> E{nullptr, nullptr, XN, X2B, SS2};
        { constexpr int NU10 = (M / 256) * (UPW / 256); const int nb_ = NU10 % G, nidle = nb_ ? G - nb_ : G;
          if (nidle > 64) GEMM_P(g, 4, 0, E); else GEMM_PS(g, 4, 0, 256, E); }
        if (BOTH(12)) GRID_BAR();
    }

    if (IN(13)) REPLOOP(13) { unsigned char* ws = opqp(ws0); const int tid = opq(tid0), lane = tid & 63, wave = __builtin_amdgcn_readfirstlane(tid >> 6), gw = vcu * NWAVES + wave; (void)lane; (void)gw;
        pg8::Gemm g{X2B, WPG, D, D, D, 0, 0};
        EpiPle E{SS2, X2B, PP, out + O_Y};
        GEMM_PS(g, 4, 0, 256, E);
    }
#undef IN
#undef BOTH
}

#undef WIN
#undef WUQ
#undef WKV
#undef WGLU
#undef WOA
#undef WOS
#undef WOUT
#undef WPG
#undef WPP
#undef WUP
#undef WDN
#undef XN
#undef Z
#undef CQN
#undef CKVN
#undef PB
#undef AY
#undef RT
#undef RB
#undef QRAW
#undef KVRAW
#undef PP
#undef Q
#undef K
#undef ATT
#undef GY
#undef YG
#undef T1
#undef MIX
#undef SS1
#undef SS2
#undef UPB
#undef HB
#undef X2B
#undef CB
#undef KNC
#undef ROPE
#undef SST
constexpr int N_PHASES = 14;
extern "C" void kernel_launch(void* const* d_in, const int* in_sizes, int n_in, void* d_out, int out_size, void* d_ws, size_t ws_size, hipStream_t stream) {
    static int grid = 0;
    if (grid == 0) {
        if (n_in != 39 || (size_t)out_size != O_END || ws_size < WS_END) { fprintf(stderr, "kernel_launch: unexpected sizes n_in %d out %d ws %zu\n", n_in, out_size, ws_size); grid = -1; return; }
        int dev = 0, cus = 0, per_cu = 0;
        if (hipGetDevice(&dev) != hipSuccess || hipDeviceGetAttribute(&cus, hipDeviceAttributeMultiprocessorCount, dev) != hipSuccess) { grid = -1; return; }
        if (hipFuncSetAttribute((const void*)mk_fwd, hipFuncAttributeMaxDynamicSharedMemorySize, LDS_BYTES) != hipSuccess) { fprintf(stderr, "kernel_launch: hipFuncSetAttribute failed\n"); grid = -1; return; }
        if (hipOccupancyMaxActiveBlocksPerMultiprocessor(&per_cu, (const void*)mk_fwd, NWAVES * 64, LDS_BYTES) != hipSuccess || per_cu < 1)
            fprintf(stderr, "kernel_launch: occupancy query reports %d\n", per_cu);
        (void)hipGetLastError();
        grid = cus;
    }
    if (grid < 0) return;
    if (hipMemsetAsync((char*)d_ws + WS_CTL, 0, CTL_ZERO_BYTES, stream) != hipSuccess) return;
    Args a{};
    for (int i = 0; i < 39; ++i) a.in[i] = d_in[i];
    a.out = (float*)d_out; a.ws = (unsigned char*)d_ws;
#if MK_ONE_LAUNCH
    a.ph_lo = 0; a.ph_hi = N_PHASES;
    hipLaunchKernelGGL(mk_fwd, dim3(grid), dim3(NWAVES * 64), LDS_BYTES, stream, a);
#else
    for (int p = 0; p < N_PHASES; ++p) { a.ph_lo = p; a.ph_hi = p + 1;
        hipLaunchKernelGGL(mk_fwd, dim3(grid), dim3(NWAVES * 64), LDS_BYTES, stream, a); }
#endif
}
```

```cpp
#include <hip/hip_runtime.h>
#include <cstdio>
#include <cstdint>

#define REP_PA 1
#define REP_SA 1
#define SA_PROBE 0
#define P0A 1
#define P0B 1
#define P0C 1
#define P6A 1
#define P4A 1
#define P4B 1
#define P4C 1
#define P4D 1
#define SA_FIRST_ALL 0
#define SA_ALLREG 1
#define REP_G 0x0
#if REP_G
#define REPLOOP(k) _Pragma("unroll") for (int rep_ = 0; rep_ < 1 + (((REP_G) >> (k)) & 1); ++rep_)
#else
#define REPLOOP(k)
#endif
#ifndef MK_ONE_LAUNCH
#define MK_ONE_LAUNCH 1
#endif

constexpr int D = 1024, SEQ = 8192, NBATCH = 2, MP = NBATCH * SEQ, DECB = 128, DECT = 4, MS = DECB * DECT, M = MP + MS;
constexpr int NH = 8, QKN = 64, QKR = 32, QKH = 96, VH = 64, QL = 384, KVL = 256, ATTW = 512;
constexpr int SSMW = 512, GRP = 16, NG = 32, NST = 64;
constexpr int DFF = 2816, UPW = 2 * DFF, PLE = 256;
constexpr int NPAGES = 64, PAGE = 128, NPOOL = 10240;
constexpr float EPS = 1e-6f;
constexpr int NZ = 3328, ZC_CKV = 0, ZC_CQ = 256, ZC_KR = 640, ZC_U = 768, ZC_GA = 1280, ZC_GS = 2304;
constexpr size_t O_Y = 0, O_CKVP = (size_t)M * D, O_KRP = O_CKVP + (size_t)MP * KVL, O_CKVS = O_KRP + (size_t)MP * QKR, O_KRS = O_CKVS + (size_t)MS * KVL,
                 O_SREP = O_KRS + (size_t)MS * QKR, O_SIMP = O_SREP + NBATCH * NG * NST, O_SRES = O_SIMP + NBATCH * NG * NST, O_SIMS = O_SRES + (size_t)DECB * NG * NST,
                 O_CVP = O_SIMS + (size_t)DECB * NG * NST, O_CVS = O_CVP + (size_t)NBATCH * 2 * UPW, O_END = O_CVS + (size_t)DECB * 2 * UPW;
static_assert(O_END == 24164352, "output size");
constexpr int SL = 32, SCH = MP / SL  , SKU = SL * GRP  , SKA = SKU + 2 * NST  ;

constexpr size_t MiB = 1u << 20;
constexpr size_t WS_CTL = 0, CTL_ZERO_BYTES = 1 * MiB;
constexpr size_t WS_WIN = 2 * MiB;
constexpr size_t WS_WUQ = 10 * MiB;
constexpr size_t WS_WKV = 11 * MiB;
constexpr size_t WS_WGLU = 12 * MiB;
constexpr size_t WS_WOA = 13 * MiB, WS_WOS = 14 * MiB;
constexpr size_t WS_WOUT = 15 * MiB;
constexpr size_t WS_WPG = 17 * MiB;
constexpr size_t WS_WPP = 19 * MiB;
constexpr size_t WS_WUP = 20 * MiB;
constexpr size_t WS_WDN = 32 * MiB;
constexpr size_t WS_ROPE = 38 * MiB;
constexpr size_t WS_SSMT = 40 * MiB;
constexpr size_t WS_MBT = 44 * MiB;
constexpr size_t WS_TYT = 52 * MiB;
constexpr size_t WS_KJ = 72 * MiB;
constexpr size_t WS_XN = 80 * MiB;
constexpr size_t WS_Z = 116 * MiB;
constexpr size_t WS_CQN = 226 * MiB;
constexpr size_t WS_CKVN = 240 * MiB;
constexpr size_t WS_PB = 250 * MiB;
constexpr size_t WS_AY = 260 * MiB;
constexpr size_t WS_QRAW = 300 * MiB;
constexpr size_t WS_KVRAW = 330 * MiB;
constexpr size_t WS_PP = 370 * MiB;
constexpr size_t WS_Q = 410 * MiB;
constexpr size_t WS_K = 440 * MiB;
constexpr size_t WS_ATT = 470 * MiB;
constexpr size_t WS_GY = 490 * MiB;
constexpr size_t WS_YG = 510 * MiB;
constexpr size_t WS_T1 = 530 * MiB;
constexpr size_t WS_MIX = 570 * MiB;
constexpr size_t WS_X1 = 610 * MiB;
constexpr size_t WS_SS1 = 690 * MiB;
constexpr size_t WS_SS2 = 692 * MiB;
constexpr size_t WS_UP = 700 * MiB;
constexpr size_t WS_H = 890 * MiB;
constexpr size_t WS_X2 = 990 * MiB;
constexpr size_t WS_PO = 1080 * MiB;
constexpr size_t WS_PM = 1089 * MiB, WS_PL = 1090 * MiB;
constexpr size_t WS_W8 = 1095 * MiB;
constexpr size_t WS_ROPEB = 1096 * MiB;
constexpr size_t WS_UPF = 1097 * MiB, WS_UPL = 1099 * MiB;
constexpr size_t WS_QABS = 1092 * MiB;
constexpr size_t WS_SST = 1070 * MiB;
constexpr size_t WS_CB = 1100 * MiB;
constexpr size_t WS_KNC = 1650 * MiB;
constexpr size_t WS_END = 2700 * MiB;
constexpr float QSCALE = 0.10206207261596575f * 1.4426950408889634f;

constexpr int CW_BAR = 4096, CW_PAN = 16384, CW_PTMO = 8192;

#define GAS __attribute__((address_space(1)))
#define LAS __attribute__((address_space(3)))
typedef unsigned short bf16;
typedef unsigned v4u __attribute__((ext_vector_type(4)));
typedef unsigned v2u __attribute__((ext_vector_type(2)));
typedef float f32x4 __attribute__((ext_vector_type(4)));
typedef float f32x2 __attribute__((ext_vector_type(2)));
typedef short bf16x8 __attribute__((ext_vector_type(8)));
#define LDS_WAIT() asm volatile("s_waitcnt lgkmcnt(0)" ::: "memory")
#define VM_WAIT() asm volatile("s_waitcnt vmcnt(0)" ::: "memory")
__device__ __forceinline__ unsigned f2bf(float f) { unsigned u = __builtin_bit_cast(unsigned, f); return (u + 0x7fffu + ((u >> 16) & 1u)) >> 16; }
__device__ __forceinline__ unsigned pk2(float lo, float hi) { return f2bf(lo) | (f2bf(hi) << 16); }
__device__ __forceinline__ float bflo(unsigned w) { return __builtin_bit_cast(float, w << 16); }
__device__ __forceinline__ float bfhi(unsigned w) { return __builtin_bit_cast(float, w & 0xffff0000u); }
__device__ __forceinline__ float bf2f(bf16 h) { return __builtin_bit_cast(float, (unsigned)h << 16); }
__device__ __forceinline__ float sigmoidf_(float x) { return __builtin_amdgcn_rcpf(1.0f + __builtin_amdgcn_exp2f(-1.4426950408889634f * x)); }
__device__ __forceinline__ float gelu_tanh(float x) { const float u = 1.5957691216057308f * (x + 0.044715f * x * x * x); return x * sigmoidf_(u); }
__device__ __forceinline__ float wave_sum(float v) {
#pragma unroll
    for (int o = 1; o < 64; o <<= 1) v += __shfl_xor(v, o);
    return v;
}

namespace pg8 {
#define PG8_LAS __attribute__((address_space(3)))
typedef unsigned short bf16_t;
typedef short bf16x8 __attribute__((ext_vector_type(8)));
typedef float f32x4 __attribute__((ext_vector_type(4)));
typedef unsigned u32x4 __attribute__((ext_vector_type(4)));
constexpr int BM = 256, BK = 64, HALF = 128, HTB = HALF * BK * 2, STAGE_BYTES = 8 * HTB, NXCD = 8, WGM = 8;

__host__ __device__ __forceinline__ int lds_byte(int r, int c) { const int st = (r >> 4) * 2 + (c >> 5), rr = r & 15, cc = c & 31, ob = rr * 64 + cc * 2; return st * 1024 + (ob ^ (((ob >> 9) & 1) << 5)); }
__host__ __device__ __forceinline__ void stage_rc(int b, int& R, int& C) { const int st = b / 1024, sb = b % 1024, swz = sb ^ (((sb >> 9) & 1) << 5); R = (st >> 1) * 16 + swz / 64; C = (st & 1) * 32 + (swz % 64) / 2; }
__host__ __device__ __forceinline__ int perm32(int rho) { const int n = rho >> 4, i = rho & 15; return 8 * (i >> 2) + 4 * n + (i & 3); }

struct Unit { int pm, pn, z, q; };
struct Gemm { const bf16_t* A; const bf16_t* Bt; int lda, ldb, K; size_t zA, zB; };

struct Order {
    int nM, nN, n, first, G, pm0, nQ;
    __device__ __forceinline__ void init(int nM_, int nN_, int nZ_, int G_, int c, int base, int pm0_ = 0, int nQ_ = 1) {
        nM = nM_; nN = nN_; n = nM_ * nN_ * nZ_ * nQ_; G = G_; pm0 = pm0_; nQ = nQ_;
        const int i0 = (base > c) ? (base - c + G_ - 1) / G_ : 0;
        first = c + i0 * G_ - base;
    }
    __device__ __forceinline__ bool next(int i, Unit& u) const {
        const long L = (long)first + (long)i * G; if (L >= n) return false;
        int w = (int)L; u.q = -1; if (nQ > 1) { u.q = w % nQ; w /= nQ; }
        const int per = nM * nN; u.z = w / per; int wgid = w % per;
        { const int q = per / NXCD, r = per % NXCD, xcd = wgid % NXCD, off = wgid / NXCD; wgid = (xcd < r ? xcd * (q + 1) : r * (q + 1) + (xcd - r) * q) + off; }
        const int nig = WGM * nN, gid = wgid / nig, fm = gid * WGM, gsz = (nM - fm) < WGM ? (nM - fm) : WGM;
        u.pm = pm0 + fm + ((wgid % nig) % gsz); u.pn = (wgid % nig) / gsz; return true;
    }
};

struct OrderSeq {
    Order a, b; int na;
    __device__ __forceinline__ void init(const Order& a_, const Order& b_, int n1, int G_, int c) { a = a_; b = b_; na = (n1 > c) ? (n1 - c + G_ - 1) / G_ : 0; }
    __device__ __forceinline__ bool next(int i, Unit& u) const { return (i < na) ? a.next(i, u) : b.next(i - na, u); }
};
__device__ __forceinline__ unsigned cvt_pk_bf16(float lo, float hi) { unsigned r; asm volatile("v_cvt_pk_bf16_f32 %0, %1, %2" : "=v"(r) : "v"(lo), "v"(hi)); return r; }

template <class Epi, bool ALIGN_EPI = true, bool SP2 = true, bool QUARTER = false, class Sched = Order>
__device__ __forceinline__ void gemm_phase(PG8_LAS unsigned char* lds, const Gemm g, const Sched& S, const Epi& E) {
    int tid = threadIdx.x; asm volatile("" : "+v"(tid));
    const int wid = __builtin_amdgcn_readfirstlane(tid >> 6), lane = tid & 63, wr = wid >> 2, wc = wid & 3, fr = lane & 15, fq = lane >> 4;
    int K = g.K; asm volatile("" : "+s"(K));
    const int nt = K / BK;
    unsigned voffA[2], voffB[2];
#pragma unroll
    for (int i = 0; i < 2; ++i) { int R, C; stage_rc(tid * 16 + i * 8192, R, C); const int Rb = Epi::PERM ? ((R & ~31) + perm32(R & 31)) : R;
        voffA[i] = (unsigned)(R * g.lda + C) * 2u; voffB[i] = (unsigned)(Rb * g.ldb + C) * 2u; }
    const size_t kstep = (size_t)(BK * 2);
    const size_t hstepA = (size_t)HALF * g.lda * 2, hstepB = (size_t)HALF * g.ldb * 2;
    const size_t tstepA = 2 * hstepA, tstepB = 2 * hstepB;
    const unsigned ldsw = (unsigned)wid * 1024u;
    const int aoff = lds_byte(wr * 64 + fr, fq * 8), boff = lds_byte(wc * 32 + fr, fq * 8);
#define PG8_SA(b, h) (((b) * 2 + (h)) * HTB)
#define PG8_SB(b, h) ((4 + (b) * 2 + (h)) * HTB)
#define PG8_STAGE(bufoff, gbase, voff) do { _Pragma("unroll") for (int _i = 0; _i < 2; ++_i) \
        __builtin_amdgcn_global_load_lds((const unsigned*)((const char*)(gbase) + (voff)[_i]), (PG8_LAS unsigned*)(lds + (bufoff) + ldsw + _i * 8192), 16, 0, 0); } while (0)
#define PG8_LDA(dst, b, h) do { _Pragma("unroll") for (int m = 0; m < 4; ++m) if (!QUARTER || m == cur.q) _Pragma("unroll") for (int k = 0; k < 2; ++k) dst[m][k] = *(const PG8_LAS bf16x8*)(lds + PG8_SA(b, h) + aoff + m * 2048 + k * 1024); } while (0)
#define PG8_LDB(dst, b, h) do { _Pragma("unroll") for (int n = 0; n < 2; ++n) _Pragma("unroll") for (int k = 0; k < 2; ++k) dst[n][k] = *(const PG8_LAS bf16x8*)(lds + PG8_SB(b, h) + boff + n * 2048 + k * 1024); } while (0)
#define PG8_MMA(ai, bj, At, Bt) do { __builtin_amdgcn_s_setprio(1); _Pragma("unroll") for (int m = 0; m < 4; ++m) if (!QUARTER || m == cur.q) _Pragma("unroll") for (int n = 0; n < 2; ++n) _Pragma("unroll") for (int k = 0; k < 2; ++k) \
        acc[ai][bj][m][n] = __builtin_amdgcn_mfma_f32_16x16x32_bf16(Bt[n][k], At[m][k], acc[ai][bj][m][n], 0, 0, 0); __builtin_amdgcn_s_setprio(0); } while (0)
#define PG8_WAIT_V(n) asm volatile("s_waitcnt vmcnt(" #n ")" ::: "memory")
#define PG8_WAIT_L(n) asm volatile("s_waitcnt lgkmcnt(" #n ")" ::: "memory")
#define PG8_BAR __builtin_amdgcn_s_barrier()
#define PG8_SCHED __builtin_amdgcn_sched_barrier(0)
    Unit cur, nxt; int ui = 0;
    if (!S.next(0, cur)) return;
    f32x4 acc[2][2][4][2];
#pragma unroll
    for (int a = 0; a < 2; ++a)
#pragma unroll
        for (int b = 0; b < 2; ++b)
#pragma unroll
            for (int m = 0; m < 4; ++m)
#pragma unroll
                for (int n = 0; n < 2; ++n) acc[a][b][m][n] = (f32x4){0.f, 0.f, 0.f, 0.f};
    bf16x8 At[4][2], B0[2][2], B1[2][2];
    const char* cA = (const char*)(g.A + (size_t)cur.z * g.zA) + (size_t)cur.pm * tstepA; const char* cB = (const char*)(g.Bt + (size_t)cur.z * g.zB) + (size_t)cur.pn * tstepB;
    if constexpr (SP2) {
        PG8_STAGE(PG8_SB(0, 0), cB, voffB); PG8_STAGE(PG8_SB(0, 1), cB + hstepB, voffB); PG8_STAGE(PG8_SA(0, 0), cA, voffA); PG8_STAGE(PG8_SA(0, 1), cA + hstepA, voffA);
        if (wr == 1) PG8_BAR;
        PG8_WAIT_V(2); PG8_BAR;
        PG8_STAGE(PG8_SB(1, 0), cB + kstep, voffB); PG8_STAGE(PG8_SA(1, 0), cA + kstep, voffA); PG8_STAGE(PG8_SB(1, 1), cB + hstepB + kstep, voffB);
        PG8_WAIT_V(6); PG8_BAR;
    } else {
        PG8_STAGE(PG8_SB(0, 0), cB, voffB); PG8_STAGE(PG8_SA(0, 0), cA, voffA); PG8_STAGE(PG8_SB(0, 1), cB + hstepB, voffB); PG8_STAGE(PG8_SA(0, 1), cA + hstepA, voffA);
        if (wr == 1) PG8_BAR;
        PG8_WAIT_V(4); PG8_BAR;
        PG8_STAGE(PG8_SB(1, 0), cB + kstep, voffB); PG8_STAGE(PG8_SA(1, 0), cA + kstep, voffA); PG8_STAGE(PG8_SB(1, 1), cB + hstepB + kstep, voffB);
        PG8_WAIT_V(6); PG8_BAR;
    }
    for (;;) {
        const bool has_next = S.next(ui + 1, nxt);
        const char* nA = has_next ? (const char*)(g.A + (size_t)nxt.z * g.zA) + (size_t)nxt.pm * tstepA : cA; const char* nB = has_next ? (const char*)(g.Bt + (size_t)nxt.z * g.zB) + (size_t)nxt.pn * tstepB : cB;
        for (int t = 0; t < nt; t += 2) {
            const bool last = (t == nt - 2);
            const char* a1 = cA + (size_t)(t + 1) * kstep;
            const char* a2 = last ? nA : cA + (size_t)(t + 2) * kstep; const char* b2 = last ? nB : cB + (size_t)(t + 2) * kstep;
            const char* a3 = a2 + kstep; const char* b3 = b2 + kstep;
            if constexpr (SP2) {
            PG8_LDB(B0, 0, 0); PG8_LDB(B1, 0, 1); PG8_SCHED; PG8_LDA(At, 0, 0); PG8_STAGE(PG8_SA(1, 1), a1 + hstepA, voffA);
            PG8_WAIT_V(8); PG8_WAIT_L(0); PG8_BAR; PG8_MMA(0, 0, At, B0); PG8_MMA(0, 1, At, B1); PG8_BAR; PG8_SCHED;
            PG8_LDA(At, 0, 1); PG8_STAGE(PG8_SB(0, 0), b2, voffB); PG8_STAGE(PG8_SB(0, 1), b2 + hstepB, voffB); PG8_STAGE(PG8_SA(0, 0), a2, voffA);
            PG8_WAIT_V(8); PG8_WAIT_L(0); PG8_BAR; PG8_MMA(1, 0, At, B0); PG8_MMA(1, 1, At, B1); PG8_BAR; PG8_SCHED;
            PG8_LDB(B0, 1, 0); PG8_LDB(B1, 1, 1); PG8_SCHED; PG8_LDA(At, 1, 0); PG8_STAGE(PG8_SA(0, 1), a2 + hstepA, voffA);
            PG8_WAIT_V(8); PG8_WAIT_L(0); PG8_BAR; PG8_MMA(0, 0, At, B0); PG8_MMA(0, 1, At, B1); PG8_BAR; PG8_SCHED;
            PG8_LDA(At, 1, 1); PG8_STAGE(PG8_SB(1, 0), b3, voffB); PG8_STAGE(PG8_SB(1, 1), b3 + hstepB, voffB); PG8_STAGE(PG8_SA(1, 0), a3, voffA);
            PG8_WAIT_V(8); PG8_WAIT_L(0); PG8_BAR; PG8_MMA(1, 0, At, B0); PG8_MMA(1, 1, At, B1); PG8_BAR; PG8_SCHED;
            } else {
            PG8_LDB(B0, 0, 0); PG8_SCHED; PG8_LDA(At, 0, 0); PG8_STAGE(PG8_SA(1, 1), a1 + hstepA, voffA);
            PG8_WAIT_L(8); PG8_BAR; PG8_WAIT_L(0); PG8_MMA(0, 0, At, B0); PG8_BAR; PG8_SCHED;
            PG8_LDB(B1, 0, 1); PG8_STAGE(PG8_SB(0, 0), b2, voffB);
            PG8_BAR; PG8_WAIT_L(0); PG8_MMA(0, 1, At, B1); PG8_BAR;
            PG8_LDA(At, 0, 1); PG8_STAGE(PG8_SA(0, 0), a2, voffA);
            PG8_BAR; PG8_WAIT_L(0); PG8_MMA(1, 0, At, B0); PG8_BAR; PG8_SCHED;
            PG8_STAGE(PG8_SB(0, 1), b2 + hstepB, voffB);
            PG8_WAIT_V(6); PG8_BAR; PG8_MMA(1, 1, At, B1); PG8_BAR;
            PG8_LDB(B0, 1, 0); PG8_SCHED; PG8_LDA(At, 1, 0); PG8_STAGE(PG8_SA(0, 1), a2 + hstepA, voffA);
            PG8_WAIT_L(8); PG8_BAR; PG8_WAIT_L(0); PG8_MMA(0, 0, At, B0); PG8_BAR; PG8_SCHED;
            PG8_LDB(B1, 1, 1); PG8_STAGE(PG8_SB(1, 0), b3, voffB);
            PG8_BAR; PG8_WAIT_L(0); PG8_MMA(0, 1, At, B1); PG8_BAR;
            PG8_LDA(At, 1, 1); PG8_STAGE(PG8_SA(1, 0), a3, voffA);
            PG8_BAR; PG8_WAIT_L(0); PG8_MMA(1, 0, At, B0); PG8_BAR; PG8_SCHED;
            PG8_STAGE(PG8_SB(1, 1), b3 + hstepB, voffB);
            PG8_WAIT_V(6); PG8_BAR; PG8_MMA(1, 1, At, B1); PG8_BAR;
            }
        }
        if constexpr (ALIGN_EPI) { if (wr == 0) PG8_BAR; }
        E(acc, cur, wr, wc, fr, fq);
        if (!has_next) break;
#pragma unroll
        for (int a = 0; a < 2; ++a)
#pragma unroll
            for (int b = 0; b < 2; ++b)
#pragma unroll
                for (int m = 0; m < 4; ++m)
#pragma unroll
                    for (int n = 0; n < 2; ++n) acc[a][b][m][n] = (f32x4){0.f, 0.f, 0.f, 0.f};
        cur = nxt; cA = nA; cB = nB; ++ui;
        if constexpr (ALIGN_EPI) { if (wr == 1) PG8_BAR; }
    }
    PG8_WAIT_V(0);
    if constexpr (!ALIGN_EPI) { if (wr == 0) PG8_BAR; }
    PG8_BAR;
#undef PG8_SA
#undef PG8_SB
#undef PG8_STAGE
#undef PG8_LDA
#undef PG8_LDB
#undef PG8_MMA
#undef PG8_WAIT_V
#undef PG8_WAIT_L
#undef PG8_BAR
#undef PG8_SCHED
}

template <class F> struct EpiRow8 {
    static constexpr bool PERM = true;
    F f;
    __device__ __forceinline__ void operator()(const f32x4 (&acc)[2][2][4][2], const Unit& u, int wr, int wc, int fr, int fq) const {
        const int row0 = u.pm * BM + wr * 64 + fr, col0 = u.pn * BM + wc * 32 + 8 * fq;
#pragma unroll
        for (int ai = 0; ai < 2; ++ai)
#pragma unroll
            for (int m = 0; m < 4; ++m) { if (u.q >= 0 && m != u.q) continue;
#pragma unroll
                for (int bj = 0; bj < 2; ++bj) f(u, row0 + ai * HALF + m * 16, col0 + bj * HALF, acc[ai][bj][m][0], acc[ai][bj][m][1]); }
    }
};
template <class F> struct EpiPair8 {
    static constexpr bool PERM = true;
    F f;
    __device__ __forceinline__ void operator()(const f32x4 (&acc)[2][2][4][2], const Unit& u, int wr, int wc, int fr, int fq) const {
        const int row0 = u.pm * BM + wr * 64 + fr, cp = u.pn * HALF + wc * 32 + 8 * fq;
#pragma unroll
        for (int ai = 0; ai < 2; ++ai)
#pragma unroll
            for (int m = 0; m < 4; ++m) { if (u.q >= 0 && m != u.q) continue; f(u, row0 + ai * HALF + m * 16, cp, acc[ai][0][m][0], acc[ai][0][m][1], acc[ai][1][m][0], acc[ai][1][m][1]); }
    }
};
}
using pg8::cvt_pk_bf16;
__device__ __forceinline__ v4u pack8(f32x4 a, f32x4 b) { v4u w; w.x = cvt_pk_bf16(a[0], a[1]); w.y = cvt_pk_bf16(a[2], a[3]); w.z = cvt_pk_bf16(b[0], b[1]); w.w = cvt_pk_bf16(b[2], b[3]); return w; }

__device__ __forceinline__ void unpack8(v4u w, float (&f)[8]) { f[0] = bflo(w.x); f[1] = bfhi(w.x); f[2] = bflo(w.y); f[3] = bfhi(w.y); f[4] = bflo(w.z); f[5] = bfhi(w.z); f[6] = bflo(w.w); f[7] = bfhi(w.w); }
__device__ __forceinline__ int pg8_opq(int x) { asm volatile("" : "+v"(x)); return x; }
template <bool BASE_BF16> struct EpiResid {
    static constexpr bool PERM = true;
    const float* xp; const float* xs;
    const bf16* xb;
    bf16* XO; float* SS;
    __device__ __forceinline__ void operator()(const pg8::f32x4 (&acc)[2][2][4][2], const pg8::Unit& u, int wr, int wc, int fr_, int fq_) const {
        const int fr = pg8_opq(fr_), fq = pg8_opq(fq_);
        const int row0 = u.pm * 256 + wr * 64 + fr, col0 = u.pn * 256 + wc * 32 + 8 * fq;
#pragma unroll
        for (int ai = 0; ai < 2; ++ai)
#pragma unroll
            for (int m = 0; m < 4; ++m) { if (u.q >= 0 && m != u.q) continue;
                const int row = row0 + ai * 128 + m * 16;
                float ss = 0.f;
#pragma unroll
                for (int bj = 0; bj < 2; ++bj) {
                    const int col = col0 + bj * 128; f32x4 x0, x1;
                    if (BASE_BF16) { float f[8]; unpack8(*(const GAS v4u*)(xb + (size_t)row * D + col), f); x0 = (f32x4){f[0], f[1], f[2], f[3]}; x1 = (f32x4){f[4], f[5], f[6], f[7]}; }
                    else { const float* br = (row < MP) ? xp + (size_t)row * D : xs + (size_t)(row - MP) * D; x0 = *(const GAS f32x4*)(br + col); x1 = *(const GAS f32x4*)(br + col + 4); }
                    x0 += acc[ai][bj][m][0]; x1 += acc[ai][bj][m][1];
                    ss += (x0[0] * x0[0] + x0[1] * x0[1]) + (x0[2] * x0[2] + x0[3] * x0[3]) + (x1[0] * x1[0] + x1[1] * x1[1]) + (x1[2] * x1[2] + x1[3] * x1[3]);
                    *(GAS v4u*)(XO + (size_t)row * D + col) = pack8(x0, x1);
                }
                ss += __shfl_xor(ss, 16); ss += __shfl_xor(ss, 32);
                if (fq == 0) SS[(size_t)row * 16 + u.pn * 4 + wc] = ss;
            }
    }
};
__device__ __forceinline__ float row_rs(const float* SS, int row) {
    const f32x4 a = *(const GAS f32x4*)(SS + (size_t)row * 16), b = *(const GAS f32x4*)(SS + (size_t)row * 16 + 4), c = *(const GAS f32x4*)(SS + (size_t)row * 16 + 8), d = *(const GAS f32x4*)(SS + (size_t)row * 16 + 12);
    const float s = ((a[0] + a[1]) + (a[2] + a[3])) + ((b[0] + b[1]) + (b[2] + b[3])) + ((c[0] + c[1]) + (c[2] + c[3])) + ((d[0] + d[1]) + (d[2] + d[3]));
    return 1.0f / sqrtf(s * (1.f / D) + EPS);
}
struct EpiUp {
    static constexpr bool PERM = true;
    const float* SS; bf16* UPB;
    __device__ __forceinline__ void operator()(const pg8::f32x4 (&acc)[2][2][4][2], const pg8::Unit& u, int wr, int wc, int fr, int fq) const {
        const int row0 = u.pm * 256 + wr * 64 + fr, col0 = u.pn * 256 + wc * 32 + 8 * fq;
#pragma unroll
        for (int ai = 0; ai < 2; ++ai)
#pragma unroll
            for (int m = 0; m < 4; ++m) { if (u.q >= 0 && m != u.q) continue; const int row = row0 + ai * 128 + m * 16; const float rs = row_rs(SS, row);
#pragma unroll
                for (int bj = 0; bj < 2; ++bj) *(GAS v4u*)(UPB + (size_t)row * UPW + col0 + bj * 128) = pack8(acc[ai][bj][m][0] * rs, acc[ai][bj][m][1] * rs); }
    }
};

__device__ __forceinline__ float dpp_ror1(float x) { return __builtin_bit_cast(float, __builtin_amdgcn_update_dpp(0, __builtin_bit_cast(int, x), 0x121, 0xF, 0xF, false)); }
__device__ __forceinline__ float dpp_ror2(float x) { return __builtin_bit_cast(float, __builtin_amdgcn_update_dpp(0, __builtin_bit_cast(int, x), 0x122, 0xF, 0xF, false)); }
struct EpiUpConv {
    static constexpr bool PERM = true;
    const float* SS; bf16* HB; bf16* UPF; bf16* UPL; float* out; const float* conv_w; const float* conv_b; const float* state_conv; LAS unsigned char* scr; unsigned* cnt;
    template <bool SAMPLE> __device__ __forceinline__ void body(const pg8::f32x4 (&acc)[2][2][4][2], const pg8::Unit& u, int wr, int fr, int cl0_, int acol0, LAS float* CW, LAS float* BD, LAS float* RSL) const {
#pragma unroll
        for (int ai = 0; ai < 2; ++ai)
#pragma unroll
            for (int m = 0; m < 4; ++m) {
                const int fro = pg8_opq(fr), cl0 = pg8_opq(cl0_);
                const int rl = ai * 128 + wr * 64 + m * 16 + fro, row = u.pm * 256 + rl; const float rs = RSL[rl];
#pragma unroll
                for (int n = 0; n < 2; ++n) {
                    f32x4 cv2[2];
#pragma unroll
                    for (int bj = 0; bj < 2; ++bj) {
                        const int cl = bj * 128 + cl0 + 4 * n, gcol = bj * DFF + acol0 + cl0 + 4 * n; const f32x4 x = acc[ai][bj][m][n] * rs;
                        f32x4 s1, s2;
#pragma unroll
                        for (int i = 0; i < 4; ++i) { s1[i] = dpp_ror1(x[i]); s2[i] = dpp_ror2(x[i]); }
                        if (SAMPLE) { const int t = fro & 3; const float* sp = state_conv + (size_t)((row - MP) >> 2) * 2 * UPW + gcol;
                            const f32x4 S0 = *(const GAS f32x4*)sp, S1 = *(const GAS f32x4*)(sp + UPW);
#pragma unroll
                            for (int i = 0; i < 4; ++i) { s1[i] = (t >= 1) ? s1[i] : S1[i]; s2[i] = (t >= 2) ? s2[i] : (t == 1 ? S1[i] : S0[i]); }
                            if (t >= 2) *(GAS f32x4*)(out + O_CVS + ((size_t)((row - MP) >> 2) * 2 + (t - 2)) * UPW + gcol) = x;
                        } else if (m > 0) { const f32x4 xp = acc[ai][bj][m > 0 ? m - 1 : 0][n] * RSL[rl - 16];
#pragma unroll
                            for (int i = 0; i < 4; ++i) { s1[i] = dpp_ror1(fro == 15 ? xp[i] : x[i]); s2[i] = dpp_ror2(fro >= 14 ? xp[i] : x[i]); }
                        } else { const int pb = (wr == 1) ? ai * 2 : 1;
                            const int pr0 = (pb >> 1) * 128 + (pb & 1) * 64 + 62;
                            const f32x4 b2 = *(const LAS f32x4*)(BD + (pb * 2 + 0) * 256 + cl) * RSL[pr0], b1 = *(const LAS f32x4*)(BD + (pb * 2 + 1) * 256 + cl) * RSL[pr0 + 1];
#pragma unroll
                            for (int i = 0; i < 4; ++i) { s1[i] = (fro >= 1) ? s1[i] : b1[i]; s2[i] = (fro >= 2) ? s2[i] : (fro == 1 ? b1[i] : b2[i]); }
                        }
                        const f32x4 w0 = *(const LAS f32x4*)(CW + cl), w1 = *(const LAS f32x4*)(CW + 256 + cl), w2 = *(const LAS f32x4*)(CW + 512 + cl), cb = *(const LAS f32x4*)(CW + 768 + cl);
                        cv2[bj] = cb + s2 * w0 + s1 * w1 + x * w2;
                        if (!SAMPLE && ai == 0 && m == 0) { if (rl < 2) { v2u w; w.x = cvt_pk_bf16(x[0], x[1]); w.y = cvt_pk_bf16(x[2], x[3]); *(GAS v2u*)(UPF + ((size_t)u.pm * 2 + rl) * UPW + gcol) = w; } }
                        if (!SAMPLE && ai == 1 && m == 3) { if (rl >= 254) { v2u w; w.x = cvt_pk_bf16(x[0], x[1]); w.y = cvt_pk_bf16(x[2], x[3]); *(GAS v2u*)(UPL + ((size_t)u.pm * 2 + (rl - 254)) * UPW + gcol) = w;
                                if ((u.pm & 31) == 31) *(GAS f32x4*)(out + O_CVP + ((size_t)(u.pm >> 5) * 2 + (rl - 254)) * UPW + gcol) = x; } }
                    }
                    if (SAMPLE || rl >= 2) { v2u w; w.x = cvt_pk_bf16(gelu_tanh(cv2[0][0]) * cv2[1][0], gelu_tanh(cv2[0][1]) * cv2[1][1]); w.y = cvt_pk_bf16(gelu_tanh(cv2[0][2]) * cv2[1][2], gelu_tanh(cv2[0][3]) * cv2[1][3]);
                        if (SAMPLE) asm volatile("global_store_dwordx2 %0, %1, off sc1" :: "v"(HB + (size_t)row * DFF + acol0 + cl0 + 4 * n), "v"(w) : "memory");
                        else *(GAS v2u*)(HB + (size_t)row * DFF + acol0 + cl0 + 4 * n) = w; }
                    asm volatile("" ::: "memory"); __builtin_amdgcn_sched_barrier(0);
                }
            }
    }
    __device__ __forceinline__ void operator()(const pg8::f32x4 (&acc)[2][2][4][2], const pg8::Unit& u, int wr, int wc, int fr_, int fq_) const {
        const int tid = pg8_opq(threadIdx.x), fr = pg8_opq(fr_), fq = pg8_opq(fq_);
        LAS float* CW = (LAS float*)scr;
        LAS float* BD = CW + 1024;
        const int acol0 = u.pn * 128, cl0_ = wc * 32 + 8 * fq;
        for (int e = tid; e < 1024; e += 512) { const int k = e >> 8, cl = e & 255, gcol = (cl >> 7) * DFF + acol0 + (cl & 127); CW[e] = (k < 3) ? conv_w[k * UPW + gcol] : conv_b[gcol]; }
        LAS float* RSL = BD + 2048;
        if (tid < 256) RSL[tid] = row_rs(SS, u.pm * 256 + tid);
        if (fr >= 14) {
#pragma unroll
            for (int ai = 0; ai < 2; ++ai)
#pragma unroll
                for (int bj = 0; bj < 2; ++bj)
#pragma unroll
                    for (int n = 0; n < 2; ++n) *(LAS f32x4*)(BD + ((ai * 2 + wr) * 2 + (fr - 14)) * 256 + bj * 128 + cl0_ + 4 * n) = acc[ai][bj][3][n];
        }
        asm volatile("s_waitcnt vmcnt(0) lgkmcnt(0)" ::: "memory"); __builtin_amdgcn_s_barrier(); asm volatile("" ::: "memory");
        if (u.pm >= MP / 256) { body<true>(acc, u, wr, fr, cl0_, acol0, CW, BD, RSL);
            asm volatile("s_waitcnt vmcnt(0)" ::: "memory"); if ((tid & 63) == 0) __hip_atomic_fetch_add(cnt + 64 * u.pm, 1u, __ATOMIC_RELAXED, __HIP_MEMORY_SCOPE_AGENT); }
        else body<false>(acc, u, wr, fr, cl0_, acol0, CW, BD, RSL);
        asm volatile("s_waitcnt lgkmcnt(0)" ::: "memory"); __builtin_amdgcn_s_barrier(); asm volatile("" ::: "memory");
    }
};
struct EpiPle {
    static constexpr bool PERM = true;
    const float* SS; const bf16* X2B; const bf16* PPB; float* Y;
    __device__ __forceinline__ void operator()(const pg8::f32x4 (&acc)[2][2][4][2], const pg8::Unit& u, int wr, int wc, int fr, int fq) const {
        const int row0 = u.pm * 256 + wr * 64 + fr, col0 = u.pn * 256 + wc * 32 + 8 * fq;
#pragma unroll
        for (int ai = 0; ai < 2; ++ai)
#pragma unroll
            for (int m = 0; m < 4; ++m) { if (u.q >= 0 && m != u.q) continue; const int row = row0 + ai * 128 + m * 16; const float rs = row_rs(SS, row);
#pragma unroll
                for (int bj = 0; bj < 2; ++bj) { const int col = col0 + bj * 128; const size_t o = (size_t)row * D + col;
                    float pw[8], xw[8]; unpack8(*(const GAS v4u*)(PPB + o), pw); unpack8(*(const GAS v4u*)(X2B + o), xw);
                    const f32x4 a = acc[ai][bj][m][0] * rs, b = acc[ai][bj][m][1] * rs; f32x4 y0, y1;
#pragma unroll
                    for (int i = 0; i < 4; ++i) { y0[i] = xw[i] + sigmoidf_(a[i]) * pw[i]; y1[i] = xw[4 + i] + sigmoidf_(b[i]) * pw[4 + i]; }
                    *(GAS f32x4*)(Y + o) = y0; *(GAS f32x4*)(Y + o + 4) = y1; } }
    }
};


struct EpiInproj {
    static constexpr bool PERM = true;
    bf16* Zp; bf16* CQNp; bf16* CKVNp; bf16* AYp; float* out; const float* g_ckv; LAS unsigned char* scr;
    __device__ __forceinline__ void operator()(const pg8::f32x4 (&acc)[2][2][4][2], const pg8::Unit& u, int wr, int wc, int fr, int fq) const {
        const int row0 = u.pm * 256 + wr * 64 + fr, colw = wc * 32 + 8 * fq;
        if (u.pn == 0) {
            LAS float* part = (LAS float*)scr;
#pragma unroll
            for (int ai = 0; ai < 2; ++ai)
#pragma unroll
                for (int m = 0; m < 4; ++m) { float ss = 0.f;
#pragma unroll
                    for (int bj = 0; bj < 2; ++bj)
#pragma unroll
                        for (int n = 0; n < 2; ++n) { const f32x4 v = acc[ai][bj][m][n]; ss += (v[0] * v[0] + v[1] * v[1]) + (v[2] * v[2] + v[3] * v[3]); }
                    ss += __shfl_xor(ss, 16); ss += __shfl_xor(ss, 32);
                    if (fq == 0) part[(ai * 128 + wr * 64 + m * 16 + fr) * 4 + wc] = ss; }
            asm volatile("s_waitcnt lgkmcnt(0)" ::: "memory"); __builtin_amdgcn_s_barrier(); asm volatile("" ::: "memory");
#pragma unroll
            for (int ai = 0; ai < 2; ++ai)
#pragma unroll
                for (int m = 0; m < 4; ++m) { const int rl = ai * 128 + wr * 64 + m * 16 + fr, row = u.pm * 256 + rl; const f32x4 p = *(const LAS f32x4*)(part + rl * 4);
                    const float rs = 1.0f / sqrtf(((p[0] + p[1]) + (p[2] + p[3])) * (1.f / KVL) + EPS);
                    float* dst = (row < MP) ? out + O_CKVP + (size_t)row * KVL : out + O_CKVS + (size_t)(row - MP) * KVL;
#pragma unroll
                    for (int bj = 0; bj < 2; ++bj) { const int col = colw + bj * 128; const f32x4 g0 = *(const GAS f32x4*)(g_ckv + col), g1 = *(const GAS f32x4*)(g_ckv + col + 4);
                        const f32x4 o0 = acc[ai][bj][m][0] * rs * g0, o1 = acc[ai][bj][m][1] * rs * g1;
                        *(GAS f32x4*)(dst + col) = o0; *(GAS f32x4*)(dst + col + 4) = o1; *(GAS v4u*)(CKVNp + (size_t)row * KVL + col) = pack8(o0, o1); } }
            asm volatile("s_waitcnt lgkmcnt(0)" ::: "memory"); __builtin_amdgcn_s_barrier(); asm volatile("" ::: "memory");
            return;
        }
#pragma unroll
        for (int ai = 0; ai < 2; ++ai)
#pragma unroll
            for (int m = 0; m < 4; ++m) { const int row = row0 + ai * 128 + m * 16;
#pragma unroll
                for (int bj = 0; bj < 2; ++bj) { const int col = u.pn * 256 + colw + bj * 128; f32x4 a = acc[ai][bj][m][0], b = acc[ai][bj][m][1];
                    if (u.pn <= 2) {
                        if (col < ZC_KR) *(GAS v4u*)(CQNp + (size_t)row * QL + (col - ZC_CQ)) = pack8(a, b);
                        else if (col < ZC_KR + QKR) { float* dst = ((row < MP) ? out + O_KRP + (size_t)row * QKR : out + O_KRS + (size_t)(row - MP) * QKR) + (col - ZC_KR); *(GAS f32x4*)dst = a; *(GAS f32x4*)(dst + 4) = b; }
                    } else if (u.pn <= 4) {
                        const v4u w = pack8(a, b); const int c = col - ZC_U;
                        if (row < MP) *(GAS v4u*)(AYp + ((size_t)(c >> 4) * SCH + (row >> 5)) * SKA + (row & 31) * GRP + (c & 15)) = w;
                        else *(GAS v4u*)(Zp + (size_t)row * NZ + col) = w;
                    } else {
#pragma unroll
                        for (int i = 0; i < 4; ++i) { a[i] = sigmoidf_(a[i]); b[i] = sigmoidf_(b[i]); }
                        *(GAS v4u*)(Zp + (size_t)row * NZ + col) = pack8(a, b);
                    } } }
    }
};

#define XB_TMO      128
#define XB_XCNT(j)  (256  + 64 * (j))
#define XB_XSUB(j)  (1280 + 64 * (j))
#define XB_XGEN(j)  (2304 + 64 * (j))
#define XB_TOP      3328
#define XB_TOPGEN   3392
#define XCD_BAR_WORDS 3456
#define XB_SPIN_CAP (1u << 18)
__device__ __forceinline__ unsigned xb_ld(unsigned* p)              { return __hip_atomic_load(p, __ATOMIC_RELAXED, __HIP_MEMORY_SCOPE_AGENT); }
__device__ __forceinline__ unsigned xb_add(unsigned* p, unsigned v) { return __hip_atomic_fetch_add(p, v, __ATOMIC_RELAXED, __HIP_MEMORY_SCOPE_AGENT); }
__device__ __forceinline__ unsigned xb_xcc_id() { return (unsigned)__builtin_amdgcn_s_getreg((3 << 11) | 20) & 0xFu; }
#define XB_SPIN(cond, bar) do { unsigned _sp = 0; while (cond) { __builtin_amdgcn_s_sleep(1); \
    if ((++_sp & 255u) == 0u) { if (xb_ld(&(bar)[XB_TMO])) break; if (_sp > XB_SPIN_CAP) { atomicAdd(&(bar)[XB_TMO], 1u); break; } } } } while (0)
struct XcdBarrier { unsigned* bar; unsigned x; volatile LAS unsigned* st; };
__device__ __forceinline__ XcdBarrier xcd_barrier_post(unsigned* bar, volatile LAS unsigned* st) {
    XcdBarrier b; b.bar = bar; b.x = xb_xcc_id(); b.st = st;
    if (threadIdx.x == 0) (void)xb_add(&bar[XB_XCNT(b.x)], 1u);
    return b;
}
__device__ __forceinline__ void xcd_barrier_complete(unsigned* bar, unsigned x, unsigned& nloc, unsigned& nx) {
    const unsigned G = gridDim.x * gridDim.y * gridDim.z;
    unsigned sum, cnt, mine, sp = 0u;
    for (;;) {
        sum = 0u; cnt = 0u; mine = 0u;
#pragma unroll
        for (unsigned j = 0; j < 16; ++j) { const unsigned c = xb_ld(&bar[XB_XCNT(j)]); sum += c; cnt += (c > 0u) ? 1u : 0u; mine = (j == x) ? c : mine; }
        if (sum == G) break;
        __builtin_amdgcn_s_sleep(1);
        if ((++sp & 255u) == 0u) { if (xb_ld(&bar[XB_TMO])) break; if (sp > XB_SPIN_CAP) { atomicAdd(&bar[XB_TMO], 1u); break; } }
    }
    nloc = mine > 0u ? mine : 1u; nx = cnt > 0u ? cnt : 1u;
}
__device__ __forceinline__ void xcd_barrier(const XcdBarrier& b) {
    asm volatile("s_waitcnt vmcnt(0)" ::: "memory");
    __syncthreads();
    if (threadIdx.x == 0) {
        unsigned* bar = b.bar;
        __builtin_amdgcn_s_waitcnt(0);
        unsigned nloc = b.st[0], nx = b.st[1];
        if (nloc == 0u) { xcd_barrier_complete(bar, b.x, nloc, nx); b.st[0] = nloc; b.st[1] = nx; }
        const unsigned old = xb_add(&bar[XB_XSUB(b.x)], 1u);
        const unsigned gen = old / nloc;
        if (old + 1u == (gen + 1u) * nloc) {
            __builtin_amdgcn_fence(__ATOMIC_RELEASE, "agent");
            asm volatile("s_waitcnt vmcnt(0)" ::: "memory");
            const unsigned og = xb_add(&bar[XB_TOP], 1u);
            const unsigned tg = og / nx;
            if (og + 1u == (tg + 1u) * nx) xb_add(&bar[XB_TOPGEN], 1u);
            else XB_SPIN(xb_ld(&bar[XB_TOPGEN]) == tg, bar);
            __builtin_amdgcn_fence(__ATOMIC_ACQUIRE, "agent");
            xb_add(&bar[XB_XGEN(b.x)], 1u);
            asm volatile("s_waitcnt vmcnt(0)" ::: "memory");
        } else {
            XB_SPIN(xb_ld(&bar[XB_XGEN(b.x)]) == gen, bar);
            __builtin_amdgcn_fence(__ATOMIC_ACQUIRE, "agent");
            asm volatile("s_waitcnt vmcnt(0)" ::: "memory");
        }
    }
    __syncthreads();
}

constexpr int NWAVES = 8;
constexpr int RING_OFF = 0, RING_BYTES = 159744;
constexpr int LDSCTL_OFF = RING_BYTES, MISC_OFF = LDSCTL_OFF + 320;
constexpr int LDS_BYTES = 163840;

struct Args { const void* in[39]; float* out; unsigned char* ws; int ph_lo, ph_hi; };
static_assert(sizeof(Args) == 39 * 8 + 8 + 8 + 8, "Args has no padding");

__device__ __forceinline__ void tr_item(const float* W, int ldw, int k0, int n0s, bf16* WT, int ldt, int n0d, LAS float* scr, int lane, const float* kg = nullptr) {
    if (W) {
        f32x4 v[8];
#pragma unroll
        for (int i = 0; i < 8; ++i) v[i] = *(const GAS f32x4*)(W + (size_t)(k0 + (lane >> 3) + 8 * i) * ldw + n0s + (lane & 7) * 4);
#pragma unroll
        for (int i = 0; i < 8; ++i) { LAS float* d = scr + ((lane >> 3) + 8 * i) * 33 + (lane & 7) * 4; const float gk = kg ? kg[k0 + (lane >> 3) + 8 * i] : 1.0f; d[0] = v[i].x * gk; d[1] = v[i].y * gk; d[2] = v[i].z * gk; d[3] = v[i].w * gk; }
    } else {
#pragma unroll 8
        for (int i = 0; i < 32; ++i) { const int kk = 2 * i + (lane >> 5); scr[kk * 33 + (lane & 31)] = 0.f; }
    }
    LDS_WAIT(); asm volatile("" ::: "memory");
    const int c = lane & 7;
#pragma unroll
    for (int j = 0; j < 4; ++j) { const int n = (lane >> 3) + 8 * j; const LAS float* s = scr + (8 * c) * 33 + n;
        v4u o; o.x = pk2(s[0 * 33], s[1 * 33]); o.y = pk2(s[2 * 33], s[3 * 33]); o.z = pk2(s[4 * 33], s[5 * 33]); o.w = pk2(s[6 * 33], s[7 * 33]);
        *(GAS v4u*)(WT + (size_t)(n0d + n) * ldt + k0 + 8 * c) = o; }
    LDS_WAIT(); asm volatile("" ::: "memory");
}
__device__ __forceinline__ void tr_plain(const float* W, int K, int N, bf16* WT, int it, LAS float* scr, int lane, const float* kg = nullptr) {
    const int nblk = N / 32, kb = it / nblk, nb = it % nblk;
    tr_item(W, N, 64 * kb, 32 * nb, WT, K, 32 * nb, scr, lane, kg);
}

__device__ __forceinline__ void glds16(const void* gsrc, unsigned lds_dst) { unsigned keep;
    asm volatile("s_mov_b32 %0, m0\n\ts_mov_b32 m0, %2\n\ts_nop 0\n\tglobal_load_lds_dwordx4 %1, off\n\ts_mov_b32 m0, %0" : "=&s"(keep) : "v"(gsrc), "s"(lds_dst) : "memory"); }
__device__ __forceinline__ int opq(int x) { asm volatile("" : "+v"(x)); return x; }
namespace pa {
typedef float f32x16 __attribute__((ext_vector_type(16)));
typedef short s16x4 __attribute__((ext_vector_type(4)));
constexpr int KSLOT = 12288, VSLOT = 8192, SLOT = KSLOT + VSLOT;
__device__ __forceinline__ int crow(int r, int hi) { return (r & 3) + 8 * (r >> 2) + 4 * hi; }
__device__ __forceinline__ s16x4 vtr(const LAS unsigned char* p) { return __builtin_bit_cast(s16x4, __builtin_amdgcn_ds_read_tr16_b64_v4i16((LAS s16x4*)p)); }
__device__ __forceinline__ float swap_max(float v) { auto rr = __builtin_amdgcn_permlane32_swap(__float_as_uint(v), __float_as_uint(v), false, false); return fmaxf(__uint_as_float(rr[0]), __uint_as_float(rr[1])); }
__device__ __forceinline__ float swap_sum(float v) { auto rr = __builtin_amdgcn_permlane32_swap(__float_as_uint(v), __float_as_uint(v), false, false); return __uint_as_float(rr[0]) + __uint_as_float(rr[1]); }

__device__ __forceinline__ void issue_tile(const bf16* Kg, const bf16* Vg, LAS unsigned char* slot, int kv0, int wave, int lane) {
    const unsigned s0 = (unsigned)(uintptr_t)slot;
    { const bf16* src = Kg + (size_t)(kv0 + lane) * 768 + wave * 8;
      glds16(src, (unsigned)__builtin_amdgcn_readfirstlane(s0 + wave * 1024));
      if (wave < 4) glds16(src + 64, (unsigned)__builtin_amdgcn_readfirstlane(s0 + (8 + wave) * 1024)); }
    { const bf16* src = Vg + (size_t)(kv0 + 16 * (wave & 3) + (lane >> 2)) * 1024 + (wave >> 2) * 32 + (lane & 3) * 8;
      glds16(src, (unsigned)__builtin_amdgcn_readfirstlane(s0 + KSLOT + wave * 1024)); }
}

__device__ __forceinline__ void attn_unit(const bf16* Q, const bf16* K, const bf16* V, bf16* O, int b, int h, int qb, float sref, LAS unsigned char* lds, int wave, int lane_) {
    const int lane = opq(lane_), r32 = lane & 31, hi = lane >> 5;
    const size_t rowbase = (size_t)b * SEQ; const int q0 = qb * 256, qw = q0 + wave * 32;
    const bf16* Kg = K + rowbase * 768 + h * QKH; const bf16* Vg = V + rowbase * 1024 + h * VH;
    const int NT = (q0 + 256) / 64;
    bf16x8 qf[6];
    { const bf16* qp = Q + (rowbase + qw + r32) * 768 + h * QKH + hi * 8;
#pragma unroll
      for (int s = 0; s < 6; ++s) qf[s] = *(const GAS bf16x8*)(qp + 16 * s); }
    asm volatile("s_waitcnt vmcnt(0)" ::: "memory");
#pragma unroll
    for (int s = 0; s < 6; ++s) asm volatile("" : "+v"(qf[s]));
    issue_tile(Kg, Vg, lds, 0, wave, lane); issue_tile(Kg, Vg, lds + SLOT, 64, wave, lane);
    f32x16 o0 = {}, o1 = {};
    float l = 0.f;
    const int qrow = qw + r32;
    const int vaddr = ((lane >> 4) & 1) * 32 + (lane & 3) * 8 + (4 * hi + ((lane & 15) >> 2)) * 64;
    const int tmax = (qw + 31) >> 6;
#define PA_S(P0, P1, t_, slot_) do { const LAS unsigned char* ks = lds + (slot_) * SLOT; const int kv0 = (t_) * 64; \
        _Pragma("unroll") for (int r = 0; r < 16; ++r) { P0[r] = -sref; P1[r] = -sref; } \
        _Pragma("unroll") for (int s_ = 0; s_ < 6; ++s_) { \
            const bf16x8 a0 = *(const LAS bf16x8*)(ks + (2 * s_ + hi) * 1024 + r32 * 16), a1 = *(const LAS bf16x8*)(ks + (2 * s_ + hi) * 1024 + 512 + r32 * 16); \
            P0 = __builtin_amdgcn_mfma_f32_32x32x16_bf16(a0, qf[s_], P0, 0, 0, 0); P1 = __builtin_amdgcn_mfma_f32_32x32x16_bf16(a1, qf[s_], P1, 0, 0, 0); } \
        if (kv0 + 63 > qw) { _Pragma("unroll") for (int r = 0; r < 16; ++r) { const int kv = kv0 + crow(r, hi); if (kv > qrow) P0[r] = -1e30f; if (kv + 32 > qrow) P1[r] = -1e30f; } } } while (0)
#define PA_PV(P0, P1, slot_) do { const LAS unsigned char* vs = lds + (slot_) * SLOT + KSLOT; float rs = 0.f; \
        _Pragma("unroll") for (int r = 0; r < 16; ++r) { P0[r] = __builtin_amdgcn_exp2f(P0[r]); P1[r] = __builtin_amdgcn_exp2f(P1[r]); rs += P0[r] + P1[r]; } \
        l += rs; \
        _Pragma("unroll") for (int kstep = 0; kstep < 4; ++kstep) { v4u pw; const int rb = 8 * (kstep & 1); \
            if (kstep < 2) { pw.x = cvt_pk_bf16(P0[rb], P0[rb + 1]); pw.y = cvt_pk_bf16(P0[rb + 2], P0[rb + 3]); pw.z = cvt_pk_bf16(P0[rb + 4], P0[rb + 5]); pw.w = cvt_pk_bf16(P0[rb + 6], P0[rb + 7]); } \
            else { pw.x = cvt_pk_bf16(P1[rb], P1[rb + 1]); pw.y = cvt_pk_bf16(P1[rb + 2], P1[rb + 3]); pw.z = cvt_pk_bf16(P1[rb + 4], P1[rb + 5]); pw.w = cvt_pk_bf16(P1[rb + 6], P1[rb + 7]); } \
            const bf16x8 pb = __builtin_bit_cast(bf16x8, pw); \
            _Pragma("unroll") for (int d0 = 0; d0 < 2; ++d0) { \
                const s16x4 lo = vtr(vs + vaddr + d0 * 4096 + kstep * 1024), hh = vtr(vs + vaddr + d0 * 4096 + kstep * 1024 + 512); \
                const bf16x8 va = (bf16x8){lo[0], lo[1], lo[2], lo[3], hh[0], hh[1], hh[2], hh[3]}; \
                if (d0 == 0) o0 = __builtin_amdgcn_mfma_f32_32x32x16_bf16(va, pb, o0, 0, 0, 0); else o1 = __builtin_amdgcn_mfma_f32_32x32x16_bf16(va, pb, o1, 0, 0, 0); } } } while (0)
#define PA_BAR() do { asm volatile("s_waitcnt lgkmcnt(0)" ::: "memory"); __builtin_amdgcn_s_barrier(); asm volatile("" ::: "memory"); } while (0)
#define PA_SB() __builtin_amdgcn_sched_barrier(0)
#define PA_KRD(s_, o_) (*(const LAS bf16x8*)(ks + (2 * (s_) + hi) * 1024 + (o_) + r32 * 16))
#define PA_SX(PN0, PN1, t_, slot_, PC0, PC1, vslot_) do { const LAS unsigned char* ks = lds + (slot_) * SLOT; const LAS unsigned char* vs0 = lds + (vslot_) * SLOT + KSLOT + vaddr; const int kv0 = (t_) * 64; float rs = 0.f; \
        bf16x8 a0 = PA_KRD(0, 0), a1 = PA_KRD(0, 512); \
        _Pragma("unroll") for (int s_ = 0; s_ < 6; ++s_) { bf16x8 b0 = a0, b1 = a1; const int r0 = s_ < 4 ? 3 * s_ : 12 + 2 * (s_ - 4), r1 = r0 + (s_ < 4 ? 3 : 2); \
            if (s_ < 5) { b0 = PA_KRD(s_ + 1, 0); b1 = PA_KRD(s_ + 1, 512); } else { vl[0] = vtr(vs0); vh[0] = vtr(vs0 + 512); vl[1] = vtr(vs0 + 4096); vh[1] = vtr(vs0 + 4096 + 512); }     \
            PN0 = __builtin_amdgcn_mfma_f32_32x32x16_bf16(a0, qf[s_], s_ == 0 ? nref : PN0, 0, 0, 0); asm volatile("" : "+v"(PN0)); PA_SB(); \
            _Pragma("unroll") for (int r = r0; r < r1; ++r) PC0[r] = __builtin_amdgcn_exp2f(PC0[r]); asm volatile("" : "+v"(PC0)); \
            _Pragma("unroll") for (int r = r0; r < r1; ++r) rs += PC0[r]; asm volatile("" : "+v"(rs)); PA_SB(); \
            PN1 = __builtin_amdgcn_mfma_f32_32x32x16_bf16(a1, qf[s_], s_ == 0 ? nref : PN1, 0, 0, 0); asm volatile("" : "+v"(PN1)); PA_SB(); \
            _Pragma("unroll") for (int r = r0; r < r1; ++r) PC1[r] = __builtin_amdgcn_exp2f(PC1[r]); asm volatile("" : "+v"(PC1)); \
            _Pragma("unroll") for (int r = r0; r < r1; ++r) rs += PC1[r]; asm volatile("" : "+v"(rs)); PA_SB(); \
            a0 = b0; a1 = b1; } \
        l += rs; \
        if (kv0 + 63 > qw) { _Pragma("unroll") for (int r = 0; r < 16; ++r) { const int kv = kv0 + crow(r, hi); if (kv > qrow) PN0[r] = -1e30f; if (kv + 32 > qrow) PN1[r] = -1e30f; } } } while (0)
#define PA_PVN(P0, P1, slot_) do { const LAS unsigned char* vs = lds + (slot_) * SLOT + KSLOT + vaddr; s16x4 lo[4][2], hh[4][2]; \
        _Pragma("unroll") for (int d0 = 0; d0 < 2; ++d0) { lo[0][d0] = vl[d0]; hh[0][d0] = vh[d0]; } \
        _Pragma("unroll") for (int kstep = 0; kstep < 4; ++kstep) { v4u pw; const int rb = 8 * (kstep & 1); \
            if (kstep < 3) { _Pragma("unroll") for (int d0 = 0; d0 < 2; ++d0) { lo[kstep + 1][d0] = vtr(vs + d0 * 4096 + (kstep + 1) * 1024); hh[kstep + 1][d0] = vtr(vs + d0 * 4096 + (kstep + 1) * 1024 + 512); } }     \
            if (kstep < 2) { pw.x = cvt_pk_bf16(P0[rb], P0[rb + 1]); pw.y = cvt_pk_bf16(P0[rb + 2], P0[rb + 3]); pw.z = cvt_pk_bf16(P0[rb + 4], P0[rb + 5]); pw.w = cvt_pk_bf16(P0[rb + 6], P0[rb + 7]); } \
            else { pw.x = cvt_pk_bf16(P1[rb], P1[rb + 1]); pw.y = cvt_pk_bf16(P1[rb + 2], P1[rb + 3]); pw.z = cvt_pk_bf16(P1[rb + 4], P1[rb + 5]); pw.w = cvt_pk_bf16(P1[rb + 6], P1[rb + 7]); } \
            const bf16x8 pb = __builtin_bit_cast(bf16x8, pw); PA_SB(); \
            { const bf16x8 va = (bf16x8){lo[kstep][0][0], lo[kstep][0][1], lo[kstep][0][2], lo[kstep][0][3], hh[kstep][0][0], hh[kstep][0][1], hh[kstep][0][2], hh[kstep][0][3]}; o0 = __builtin_amdgcn_mfma_f32_32x32x16_bf16(va, pb, o0, 0, 0, 0); } \
            { const bf16x8 va = (bf16x8){lo[kstep][1][0], lo[kstep][1][1], lo[kstep][1][2], lo[kstep][1][3], hh[kstep][1][0], hh[kstep][1][1], hh[kstep][1][2], hh[kstep][1][3]}; o1 = __builtin_amdgcn_mfma_f32_32x32x16_bf16(va, pb, o1, 0, 0, 0); } \
            PA_SB(); } } while (0)
    f32x16 pA0, pA1, pB0, pB1, nref; s16x4 vl[2], vh[2];
#pragma unroll
    for (int r = 0; r < 16; ++r) nref[r] = -sref;
    asm volatile("" : "+v"(nref));
    if (wave < 4) asm volatile("s_waitcnt vmcnt(3)" ::: "memory"); else asm volatile("s_waitcnt vmcnt(2)" ::: "memory");
    PA_BAR();
    PA_S(pA0, pA1, 0, 0);
    int sl = 0, s1 = 1;
    for (int t = 0; ; t += 2) {
        const int s2 = (s1 == 2) ? 0 : s1 + 1;
        asm volatile("s_waitcnt vmcnt(0)" ::: "memory"); PA_BAR();
        if (t + 2 < NT) issue_tile(Kg, Vg, lds + s2 * SLOT, (t + 2) * 64, wave, lane);
        PA_SX(pB0, pB1, t + 1, s1, pA0, pA1, sl); PA_PVN(pA0, pA1, sl);
        asm volatile("s_waitcnt vmcnt(0)" ::: "memory"); PA_BAR();
        if (t + 2 >= NT) break;
        if (t + 3 < NT) issue_tile(Kg, Vg, lds + sl * SLOT, (t + 3) * 64, wave, lane);
        PA_SX(pA0, pA1, t + 2, s2, pB0, pB1, s1); PA_PVN(pB0, pB1, s1);
        sl = s2; s1 = (s2 == 2) ? 0 : s2 + 1;
    }
    PA_PV(pB0, pB1, s1);
#undef PA_S
#undef PA_PV
#undef PA_BAR
#undef PA_SB
#undef PA_KRD
#undef PA_SX
#undef PA_PVN
    const float il = 1.0f / swap_sum(l);
    bf16* op = O + (rowbase + qw + r32) * ATTW + h * VH + 4 * hi;
#pragma unroll
    for (int g = 0; g < 4; ++g) {
        v2u w0, w1; w0.x = cvt_pk_bf16(o0[4 * g] * il, o0[4 * g + 1] * il); w0.y = cvt_pk_bf16(o0[4 * g + 2] * il, o0[4 * g + 3] * il);
        w1.x = cvt_pk_bf16(o1[4 * g] * il, o1[4 * g + 1] * il); w1.y = cvt_pk_bf16(o1[4 * g + 2] * il, o1[4 * g + 3] * il);
        *(GAS v2u*)(op + 8 * g) = w0; *(GAS v2u*)(op + 32 + 8 * g) = w1;
    }
    asm volatile("s_waitcnt vmcnt(0) lgkmcnt(0)" ::: "memory");
    __syncthreads();
}
}

namespace sa {
using pa::f32x16; using pa::s16x4; using pa::crow; using pa::vtr; using pa::swap_max; using pa::swap_sum;
constexpr int HK = 64;
constexpr int CHS = (HK + 1) * 16;
constexpr int CSB = 36 * CHS;
constexpr int C8S = (HK + 1) * 32, C8B = 8 * C8S;
constexpr int OFF_CS = 0, OFF_C8 = 2 * CSB;
constexpr int OFF_QA = OFF_C8 + 2 * C8B;
constexpr int PSTR = 144, OFF_P = OFF_QA + 18432;
constexpr int OFF_RS = OFF_P + 32 * PSTR;
constexpr int OFF_KSS = OFF_RS + 2048;
constexpr int OFF_PSUM = OFF_KSS + 512, OFF_PHYS = OFF_PSUM + 512, OFF_GK = OFF_PHYS + 128, SA_LDS = OFF_GK + 128;
static_assert(SA_LDS <= RING_BYTES, "sample attention LDS");
constexpr int PO_STRIDE = 32 * 256;
#define SA_BAR() do { asm volatile("s_waitcnt lgkmcnt(0)" ::: "memory"); __builtin_amdgcn_s_barrier(); asm volatile("" ::: "memory"); } while (0)

__device__ __forceinline__ void gld16(f32x4& d, const void* p) { asm volatile("global_load_dwordx4 %0, %1, off" : "=v"(d) : "v"(p) : "memory"); }
__device__ __forceinline__ void gld8(v2u& d, const void* p) { asm volatile("global_load_dwordx2 %0, %1, off" : "=v"(d) : "v"(p) : "memory"); }
template <int MODE> __device__ __forceinline__ void item(const void* const* in, const bf16* QABS, const unsigned char* W8, const bf16* ROPEB, float* PO, float* PL, float sref, int b, int half, LAS unsigned char* lds, int tid_, int wave, int lane_) {
    const int tid = opq(tid_), lane = tid & 63;
    (void)lane_;
    const float* cache_ckv = (const float*)in[4]; const float* cache_kr = (const float*)in[5]; const int* page_table = (const int*)in[6]; const float* g_k = (const float*)in[18];
    const int r32 = lane & 31, hi = lane >> 5;
    typedef int v8i __attribute__((ext_vector_type(8)));
    for (int e = tid; e < 36 * 32; e += 512) *(LAS v4u*)(lds + OFF_QA + e * 16) = *(const GAS v4u*)(QABS + ((size_t)b * 36 * 32 + e) * 8);
    if (tid < NPAGES / 2) *(LAS int*)(lds + OFF_PHYS + tid * 4) = page_table[b * NPAGES + half * (NPAGES / 2) + tid];
    v8i wf[4][2];
#pragma unroll
    for (int s = 0; s < 4; ++s)
#pragma unroll
        for (int nb = 0; nb < 2; ++nb) { const GAS v4u* wp = (const GAS v4u*)(W8 + (size_t)(wave * QKN + 32 * nb + r32) * KVL + 64 * s + 32 * hi); const v4u a = wp[0], bq = wp[1];
            wf[s][nb] = (v8i){(int)a.x, (int)a.y, (int)a.z, (int)a.w, (int)bq.x, (int)bq.y, (int)bq.z, (int)bq.w}; }
    if (tid < 32) *(LAS float*)(lds + OFF_GK + tid * 4) = g_k[64 + tid];
    asm volatile("s_waitcnt vmcnt(0) lgkmcnt(0)" ::: "memory");
#pragma unroll
    for (int s = 0; s < 4; ++s) asm volatile("" : "+v"(wf[s][0]), "+v"(wf[s][1]));
    __builtin_amdgcn_s_barrier(); asm volatile("" ::: "memory");
    f32x16 o = {};
    float l_run = 0.f;
    const int kq = wave >> 1;
    constexpr int NHP = NPAGES;
#define SA_IDS() const int tq = opq(tid), lq = tq & 63, r32 = lq & 31, hi = lq >> 5, kkey = tq >> 2, qd = tq & 3, cs_col = 16 * (wave & 1) + (lq & 15), quad = lq >> 4; (void)r32; (void)hi; (void)kkey; (void)qd; (void)cs_col; (void)quad
    f32x4 va[4], vb[4], x1 = {}, x2 = {}; v2u cw = {}, sw = {};
#define SA_SRC(hp_) const int sub_ = (hp_) & 1; const int phys_ = *(const LAS int*)(lds + OFF_PHYS + ((hp_) >> 1) * 4); const float* src_ = cache_ckv + ((size_t)phys_ * PAGE + sub_ * HK + 2 * wave) * KVL + lq * 4
#define SA_LD(i_) do { gld16(va[i_], src_ + (size_t)(i_) * 16 * KVL); gld16(vb[i_], src_ + (size_t)(i_) * 16 * KVL + KVL); } while (0)
#define SA_LDK(hp_) do { if (wave < 4) { const float* krp_ = cache_kr + ((size_t)phys_ * PAGE + sub_ * HK + kkey) * QKR; gld16(x1, krp_ + 4 * qd); gld16(x2, krp_ + 16 + 4 * qd); \
            const bf16* rp_ = ROPEB + ((size_t)(half * (NPAGES / 2) + ((hp_) >> 1)) * PAGE + sub_ * HK + kkey) * 32; gld8(cw, rp_ + 4 * qd); gld8(sw, rp_ + 16 + 4 * qd); } } while (0)
#define SA_AKR(CSW, KSSW) do { \
            const f32x4 rc_ = {bflo(cw.x), bfhi(cw.x), bflo(cw.y), bfhi(cw.y)}, rs_ = {bflo(sw.x), bfhi(sw.x), bflo(sw.y), bfhi(sw.y)}; \
            float ss = (x1[0] * x1[0] + x1[1] * x1[1]) + (x1[2] * x1[2] + x1[3] * x1[3]) + (x2[0] * x2[0] + x2[1] * x2[1]) + (x2[2] * x2[2] + x2[3] * x2[3]); \
            ss += __shfl_xor(ss, 1); ss += __shfl_xor(ss, 2); \
            const f32x4 ga = *(const LAS f32x4*)(lds + OFF_GK + qd * 16), gb = *(const LAS f32x4*)(lds + OFF_GK + 64 + qd * 16); \
            const f32x4 a = x1 * ga, bb = x2 * gb; const f32x4 y1 = a * rc_ - bb * rs_, y2 = a * rs_ + bb * rc_; \
            v2u w1, w2; w1.x = cvt_pk_bf16(y1[0], y1[1]); w1.y = cvt_pk_bf16(y1[2], y1[3]); w2.x = cvt_pk_bf16(y2[0], y2[1]); w2.y = cvt_pk_bf16(y2[2], y2[3]); \
            const int c1 = 32 + (qd >> 1), c2 = 34 + (qd >> 1); \
            *(LAS v2u*)((CSW) + c1 * CHS + kkey * 16 + 8 * (qd & 1)) = w1; *(LAS v2u*)((CSW) + c2 * CHS + kkey * 16 + 8 * (qd & 1)) = w2; \
            if (qd == 0) *(LAS float*)(lds + (KSSW) + kkey * 4) = ss; } while (0)
#define SA_R(CF, kb, s2) do { const LAS v4u* cp = (const LAS v4u*)(c8 + (2 * (s2) + hi) * C8S + (32 * (kb) + r32) * 32); const v4u a = cp[0], bq = cp[1]; \
            CF = (v8i){(int)a.x, (int)a.y, (int)a.z, (int)a.w, (int)bq.x, (int)bq.y, (int)bq.z, (int)bq.w}; } while (0)
#define SA_M(ACC, s2, nb, CF) do { ACC = __builtin_amdgcn_mfma_scale_f32_32x32x64_f8f6f4(wf[s2][nb], CF, ACC, 0, 0, 0, 127, 0, 127); asm volatile("" : "+v"(ACC)); } while (0)
#define SA_PA(i, kk, CSW) do { const int key_ = 2 * wave + (kk) + 16 * (i), ch8 = lq >> 1, hf = lq & 1; const f32x4 v = (kk) ? vb[i] : va[i]; \
            v2u w; w.x = cvt_pk_bf16(v[0], v[1]); w.y = cvt_pk_bf16(v[2], v[3]); *(LAS v2u*)((CSW) + ch8 * CHS + key_ * 16 + hf * 8) = w; } while (0)
#define SA_PB(i, kk, C8W) do { const int key_ = 2 * wave + (kk) + 16 * (i), ch8 = lq >> 1, hf = lq & 1; const f32x4 v = (kk) ? vb[i] : va[i]; \
            int w8 = 0; w8 = __builtin_amdgcn_cvt_pk_fp8_f32(v[0], v[1], w8, false); w8 = __builtin_amdgcn_cvt_pk_fp8_f32(v[2], v[3], w8, true); \
            *(LAS int*)((C8W) + (ch8 >> 2) * C8S + key_ * 32 + (ch8 & 3) * 8 + hf * 4) = w8; } while (0)
#define SA_SEG(T0, T1, s2a, i, HOOK, RN0, RN1) do { \
            SA_M(T0, s2a, 0, cfa); SA_SB(); HOOK; SA_PA(i, 0, csn); SA_SB(); \
            SA_M(T1, s2a, 1, cfa); SA_SB(); SA_PB(i, 0, c8n); RN0; SA_SB(); \
            SA_M(T0, (s2a) + 1, 0, cfb); SA_SB(); SA_PA(i, 1, csn); SA_SB(); \
            SA_M(T1, (s2a) + 1, 1, cfb); SA_SB(); SA_PB(i, 1, c8n); RN1; SA_SB(); } while (0)
#define SA_BRED(T0, T1, kb, KSSR) do { const int key_ = 32 * (kb) + r32; const f32x16 sq = T0 * T0 + T1 * T1; \
            const f32x4 s4 = (f32x4){sq[0], sq[1], sq[2], sq[3]} + (f32x4){sq[4], sq[5], sq[6], sq[7]} + ((f32x4){sq[8], sq[9], sq[10], sq[11]} + (f32x4){sq[12], sq[13], sq[14], sq[15]}); \
            float ss = (s4[0] + s4[1]) + (s4[2] + s4[3]); \
            ss = swap_sum(ss) * (1.0f / 4096.0f) + *(const LAS float*)(lds + (KSSR) + key_ * 4); \
            if (hi == 0) *(LAS float*)(lds + OFF_RS + (key_ * 8 + wave) * 4) = __builtin_amdgcn_rsqf(ss * (1.f / QKH) + EPS); } while (0)
#define SA_SB() __builtin_amdgcn_sched_barrier(0)
    { SA_IDS(); { SA_SRC(0); SA_LD(0); SA_LD(1); SA_LD(2); SA_LD(3); SA_LDK(0); }
      asm volatile("s_waitcnt vmcnt(0)" ::: "memory");
      asm volatile("" : "+v"(va[0]), "+v"(va[1]), "+v"(va[2]), "+v"(va[3]), "+v"(vb[0]), "+v"(vb[1]), "+v"(vb[2]), "+v"(vb[3]));
      asm volatile("" : "+v"(x1), "+v"(x2), "+v"(cw), "+v"(sw));
      LAS unsigned char* cs0 = lds + OFF_CS; LAS unsigned char* c80 = lds + OFF_C8; SA_SRC(1);
      _Pragma("unroll") for (int i = 0; i < 4; ++i) { SA_PA(i, 0, cs0); SA_PB(i, 0, c80); SA_PA(i, 1, cs0); SA_PB(i, 1, c80); SA_SB(); SA_LD(i); SA_SB(); }
      if (tid < 256) SA_AKR(cs0, OFF_KSS);
      SA_SB(); SA_LDK(1);
      SA_BAR(); }
#pragma unroll 1
    for (int hp = 0; hp < NHP; ++hp) { SA_IDS();
        const int par = hp & 1;
        LAS unsigned char* cs = lds + OFF_CS + par * CSB; LAS unsigned char* c8 = lds + OFF_C8 + par * C8B;
        LAS unsigned char* csn = lds + OFF_CS + (par ^ 1) * CSB; LAS unsigned char* c8n = lds + OFF_C8 + (par ^ 1) * C8B;
        const int kssr = OFF_KSS + par * 256, kssw = OFF_KSS + (par ^ 1) * 256;
        const bool more = hp + 2 < NHP; const int hn = more ? hp + 2 : hp; SA_SRC(hn);
        asm volatile("s_waitcnt vmcnt(0)" ::: "memory");
        asm volatile("" : "+v"(va[0]), "+v"(va[1]), "+v"(va[2]), "+v"(va[3]), "+v"(vb[0]), "+v"(vb[1]), "+v"(vb[2]), "+v"(vb[3]));
        asm volatile("" : "+v"(x1), "+v"(x2), "+v"(cw), "+v"(sw));
        { f32x16 t0 = {}, t1 = {}, t2 = {}, t3 = {}; v8i cfa, cfb;
          SA_R(cfa, 0, 0); SA_R(cfb, 0, 1); SA_SB();
          SA_SEG(t0, t1, 0, 0, (void)0, SA_R(cfa, 0, 2), SA_R(cfb, 0, 3)); if (more) SA_LD(0); SA_SB();
          SA_SEG(t0, t1, 2, 1, (void)0, SA_R(cfa, 1, 0), SA_R(cfb, 1, 1)); if (more) SA_LD(1); SA_SB();
          if (tid < 256) SA_AKR(csn, kssw);
          SA_SB(); if (more) SA_LDK(hn); SA_SB();
          SA_SEG(t2, t3, 0, 2, SA_BRED(t0, t1, 0, kssr); SA_SB(), SA_R(cfa, 1, 2), SA_R(cfb, 1, 3)); if (more) SA_LD(2); SA_SB();
          SA_SEG(t2, t3, 2, 3, (void)0, (void)0, (void)0); if (more) SA_LD(3); SA_SB();
          SA_BRED(t2, t3, 1, kssr); }
        SA_BAR();
        { f32x4 p4 = {0.f, 0.f, 0.f, 0.f}, p5 = {0.f, 0.f, 0.f, 0.f}; const int key = 16 * kq + (lq & 15);
          bf16x8 cf[9], qf[9];
          { LAS unsigned char* cb = cs + quad * CHS + key * 16; LAS unsigned char* qb = lds + OFF_QA + quad * 512 + cs_col * 16;
#pragma unroll
            for (int s2 = 0; s2 < 9; ++s2) { cf[s2] = *(const LAS bf16x8*)(cb + s2 * 4 * CHS); qf[s2] = *(const LAS bf16x8*)(qb + s2 * 2048); } }
#pragma unroll
          for (int s2 = 0; s2 < 9; ++s2) { if (s2 & 1) p5 = __builtin_amdgcn_mfma_f32_16x16x32_bf16(cf[s2], qf[s2], p5, 0, 0, 0); else p4 = __builtin_amdgcn_mfma_f32_16x16x32_bf16(cf[s2], qf[s2], p4, 0, 0, 0); }
          p4 += p5;
          float rsum = 0.f;
#pragma unroll
          for (int r = 0; r < 4; ++r) { p4[r] = __builtin_amdgcn_exp2f(p4[r] * *(const LAS float*)(lds + OFF_RS + ((16 * kq + 4 * quad + r) * 8 + (cs_col & 7)) * 4) - sref); rsum += p4[r]; }
          rsum += __shfl_xor(rsum, 16); rsum += __shfl_xor(rsum, 32);
          if (lq < 16) *(LAS float*)(lds + OFF_PSUM + (kq * 32 + cs_col) * 4) = rsum;
          v2u w; w.x = cvt_pk_bf16(p4[0], p4[1]); w.y = cvt_pk_bf16(p4[2], p4[3]);
          *(LAS v2u*)(lds + OFF_P + cs_col * PSTR + (16 * kq + 4 * quad) * 2) = w; }
        SA_BAR();
        l_run += ((*(const LAS float*)(lds + OFF_PSUM + r32 * 4) + *(const LAS float*)(lds + OFF_PSUM + (32 + r32) * 4)) + (*(const LAS float*)(lds + OFF_PSUM + (64 + r32) * 4) + *(const LAS float*)(lds + OFF_PSUM + (96 + r32) * 4)));
        { const int dim = 32 * wave + 16 * ((lq >> 4) & 1) + 4 * (lq & 3), ch = dim >> 3, k0 = 8 * hi + ((lq & 15) >> 2);
          s16x4 lo[4], hh[4]; bf16x8 pb[4];
          { LAS unsigned char* tb = cs + ch * CHS + k0 * 16 + 8 * (lq & 1); LAS unsigned char* pp = lds + OFF_P + r32 * PSTR + 16 * hi;
#pragma unroll
            for (int ks = 0; ks < 4; ++ks) { lo[ks] = vtr(tb + ks * 256); hh[ks] = vtr(tb + ks * 256 + 64); pb[ks] = *(const LAS bf16x8*)(pp + ks * 32); } }
#pragma unroll
          for (int ks = 0; ks < 4; ++ks) { const bf16x8 ca = (bf16x8){lo[ks][0], lo[ks][1], lo[ks][2], lo[ks][3], hh[ks][0], hh[ks][1], hh[ks][2], hh[ks][3]};
              o = __builtin_amdgcn_mfma_f32_32x32x16_bf16(ca, pb[ks], o, 0, 0, 0); } }
        SA_BAR();
    }
#undef SA_R
#undef SA_M
#undef SA_PA
#undef SA_PB
#undef SA_SEG
#undef SA_AKR
#undef SA_BRED
#undef SA_SB
#undef SA_IDS
#undef SA_SRC
#undef SA_LD
#undef SA_LDK
    asm volatile("s_waitcnt vmcnt(0)" ::: "memory");
    float* po = PO + (size_t)(b * 2 + half) * PO_STRIDE + (size_t)r32 * 256 + 32 * wave + 4 * hi;
#pragma unroll
    for (int g = 0; g < 4; ++g) *(GAS f32x4*)(po + 8 * g) = (f32x4){o[4 * g], o[4 * g + 1], o[4 * g + 2], o[4 * g + 3]};
    if (wave == 0 && hi == 0) PL[(b * 2 + half) * 32 + r32] = l_run;
    asm volatile("s_waitcnt vmcnt(0) lgkmcnt(0)" ::: "memory"); __syncthreads();
}

__device__ __forceinline__ void combine_item(const void* const* in, const bf16* Q, const bf16* K, const bf16* CKVN, const float* PO, const float* PL, float sref, bf16* ATT, int h, int rc, LAS unsigned char* lds, int tid, int wave, int lane) {
    const float* w_uv = (const float*)in[16];
    LAS float* WU = (LAS float*)lds;
    LAS float* OL = WU + 256 * 64;
    f32x4 wreg[8];
#pragma unroll
    for (int i = 0; i < 8; ++i) { const int e4 = tid + 512 * i, c = e4 >> 4, d4 = (e4 & 15) * 4; wreg[i] = *(const GAS f32x4*)(w_uv + (size_t)c * 512 + h * VH + d4); }
    { f32x4 v0[2], v1[2]; float pl0[2], pl1[2]; v4u qc[2], kc[2][4]; v2u cw_[2][4];
#pragma unroll
      for (int rr = 0; rr < 2; ++rr) { const int r = rc * 16 + 2 * wave + rr, b = r >> 2, t = r & 3, col = t * 8 + h; const size_t row = (size_t)MP + r;
          pl0[rr] = PL[(b * 2) * 32 + col]; pl1[rr] = PL[(b * 2 + 1) * 32 + col];
          v0[rr] = *(const GAS f32x4*)(PO + (size_t)(b * 2) * PO_STRIDE + (size_t)col * 256 + 4 * lane); v1[rr] = *(const GAS f32x4*)(PO + (size_t)(b * 2 + 1) * PO_STRIDE + (size_t)col * 256 + 4 * lane);
          const int c = lane < 12 ? lane : 0;
          qc[rr] = *(const GAS v4u*)(Q + row * 768 + h * QKH + 8 * c);
#pragma unroll
          for (int s2 = 0; s2 < 4; ++s2) { const size_t kr_ = (size_t)MP + b * DECT + s2; kc[rr][s2] = *(const GAS v4u*)(K + kr_ * 768 + h * QKH + 8 * c); cw_[rr][s2] = *(const GAS v2u*)(CKVN + kr_ * KVL + 4 * lane); } }
#pragma unroll
      for (int rr = 0; rr < 2; ++rr) { const int rl = 2 * wave + rr, r = rc * 16 + rl, t = r & 3;
          float l = pl0[rr] + pl1[rr]; float acc[4];
#pragma unroll
          for (int i = 0; i < 4; ++i) acc[i] = v0[rr][i] + v1[rr][i];
          float qf[8]; unpack8(qc[rr], qf);
#pragma unroll
          for (int s2 = 0; s2 < 4; ++s2) { float f[8]; unpack8(kc[rr][s2], f); float sc = 0.f;
#pragma unroll
              for (int i = 0; i < 8; ++i) sc += qf[i] * f[i];
              sc = wave_sum(lane < 12 ? sc : 0.f);
              const float pr = (s2 <= t) ? __builtin_amdgcn_exp2f(sc - sref) : 0.f;
              l += pr; const v2u w = cw_[rr][s2];
              acc[0] += pr * bflo(w.x); acc[1] += pr * bfhi(w.x); acc[2] += pr * bflo(w.y); acc[3] += pr * bfhi(w.y); }
          const float il = 1.0f / l;
          *(LAS f32x4*)(OL + rl * 256 + 4 * lane) = (f32x4){acc[0] * il, acc[1] * il, acc[2] * il, acc[3] * il}; } }
#pragma unroll
    for (int i = 0; i < 8; ++i) { const int e4 = tid + 512 * i, c = e4 >> 4, d4 = (e4 & 15) * 4; *(LAS f32x4*)(WU + c * 64 + d4) = wreg[i]; }
    LDS_WAIT(); __syncthreads();
    { const int rl = tid >> 5, dp = tid & 31; float o0 = 0.f, o1 = 0.f;
#pragma unroll 8
      for (int c = 0; c < KVL; ++c) { const float ov = OL[rl * 256 + c]; const f32x2 w = *(const LAS f32x2*)(WU + c * 64 + 2 * dp); o0 += ov * w.x; o1 += ov * w.y; }
      *(GAS unsigned*)(ATT + ((size_t)MP + rc * 16 + rl) * ATTW + h * VH + 2 * dp) = pk2(o0, o1); }
    LDS_WAIT(); __syncthreads();
}
}


__device__ __forceinline__ void qabs_item(const void* const* in, const bf16* QRAW, const bf16* WKV, const float* ROPE, bf16* QABS, int h, int rg, LAS unsigned char* lds, int tid) {
    const float* g_q = (const float*)in[17]; const float* g_k = (const float*)in[18];
    LAS unsigned char* WH = lds;
    LAS float* QG = (LAS float*)(lds + 32768);
#pragma unroll
    for (int i = 0; i < 4; ++i) *(LAS v4u*)(WH + (tid + 512 * i) * 16) = *(const GAS v4u*)(WKV + (size_t)(h * QKN) * KVL + (size_t)(tid + 512 * i) * 8);
    { const int rl = tid >> 3, sub = tid & 7, sr = rg * 64 + rl, pos = SEQ + (sr & 3);
      const bf16* qr = QRAW + ((size_t)MP + sr) * 768 + h * QKH; float n[8]; unpack8(*(const GAS v4u*)(qr + 8 * sub), n);
      const unsigned wa = *(const GAS unsigned*)(qr + 64 + 2 * sub), wb = *(const GAS unsigned*)(qr + 80 + 2 * sub);
      float a0 = bflo(wa), a1 = bfhi(wa), b0 = bflo(wb), b1 = bfhi(wb);
      float ss = (a0 * a0 + a1 * a1) + (b0 * b0 + b1 * b1);
#pragma unroll
      for (int i = 0; i < 8; ++i) ss += n[i] * n[i];
      ss += __shfl_xor(ss, 1); ss += __shfl_xor(ss, 2); ss += __shfl_xor(ss, 4);
      const float rs = QSCALE / sqrtf(ss * (1.f / QKH) + EPS);
      const float* rp = ROPE + (size_t)pos * 32; const f32x2 cs = *(const GAS f32x2*)(rp + 2 * sub), sn = *(const GAS f32x2*)(rp + 16 + 2 * sub);
#pragma unroll
      for (int i = 0; i < 8; ++i) QG[rl * 64 + 8 * sub + i] = bf2f((bf16)f2bf(n[i] * rs * g_q[8 * sub + i])) * g_k[8 * sub + i];
      a0 *= rs * g_q[64 + 2 * sub]; a1 *= rs * g_q[65 + 2 * sub]; b0 *= rs * g_q[80 + 2 * sub]; b1 *= rs * g_q[81 + 2 * sub];
      const unsigned r1 = pk2(a0 * cs.x - b0 * sn.x, a1 * cs.y - b1 * sn.y), r2 = pk2(a0 * sn.x + b0 * cs.x, a1 * sn.y + b1 * cs.y);
      bf16* qab = QABS + (size_t)(sr >> 2) * 36 * 32 * 8 + ((sr & 3) * 8 + h) * 8;
      *(GAS unsigned*)(qab + (32 + (sub >> 2)) * 256 + 2 * (sub & 3)) = r1; *(GAS unsigned*)(qab + (34 + (sub >> 2)) * 256 + 2 * (sub & 3)) = r2; }
    LDS_WAIT(); __syncthreads();
    { const int r4 = tid >> 5, ch = tid & 31; float acc[4][8];
#pragma unroll
      for (int r = 0; r < 4; ++r)
#pragma unroll
          for (int i = 0; i < 8; ++i) acc[r][i] = 0.f;
#pragma unroll 4
      for (int d = 0; d < QKN; ++d) { float w[8]; unpack8(*(const LAS v4u*)(WH + d * 512 + ch * 16), w);
#pragma unroll
          for (int r = 0; r < 4; ++r) { const float qg = QG[(r4 * 4 + r) * 64 + d];
#pragma unroll
              for (int i = 0; i < 8; ++i) acc[r][i] += qg * w[i]; } }
#pragma unroll
      for (int r = 0; r < 4; ++r) { const int sr = rg * 64 + r4 * 4 + r; v4u o; o.x = pk2(acc[r][0], acc[r][1]); o.y = pk2(acc[r][2], acc[r][3]); o.z = pk2(acc[r][4], acc[r][5]); o.w = pk2(acc[r][6], acc[r][7]);
          *(GAS v4u*)(QABS + (size_t)(sr >> 2) * 36 * 32 * 8 + ch * 256 + ((sr & 3) * 8 + h) * 8) = o; } }
    LDS_WAIT(); __syncthreads();
}

__device__ __forceinline__ void ssm_tables_item(const void* const* in, int g, int dq, LAS unsigned char* lds, bf16* MBT, bf16* TYT, float* A32, int tid) {
    const float* a_re = (const float*)in[19]; const float* a_im = (const float*)in[20]; const float* log_dt = (const float*)in[21];
    const float* b_re = (const float*)in[22]; const float* b_im = (const float*)in[23]; const float* c_re = (const float*)in[24]; const float* c_im = (const float*)in[25]; const float* d_skip = (const float*)in[26];
    LAS float* ap = (LAS float*)lds;
    LAS float* bb = ap + 64 * 33 * 2;
    LAS float* cc = bb + 2048;
    LAS float* kj = cc + 2048;
    if (tid < 64) { const int p = tid;
        const double dt = exp((double)log_dt[g]); const double are = a_re[g * NST + p], aim = a_im[g * NST + p];
        const double mag = exp(dt * are), abr = mag * cos(dt * aim), abi = mag * sin(dt * aim), den = are * are + aim * aim, nr = abr - 1.0;
        const double fre = (nr * are + abi * aim) / den, fim = (abi * are - nr * aim) / den;
        double pr = 1.0, pi = 0.0;
        for (int j = 0; j <= 32; ++j) { ap[(p * 33 + j) * 2] = (float)pr; ap[(p * 33 + j) * 2 + 1] = (float)pi; const double t = pr * abr - pi * abi; pi = pr * abi + pi * abr; pr = t; }
        for (int i = 0; i < 16; ++i) { const double br = b_re[(g * NST + p) * GRP + i], bi = b_im[(g * NST + p) * GRP + i]; bb[(p * 16 + i) * 2] = (float)(fre * br - fim * bi); bb[(p * 16 + i) * 2 + 1] = (float)(fre * bi + fim * br); }
        if (dq == 0) { A32[(g * NST + p) * 2] = ap[(p * 33 + 32) * 2]; A32[(g * NST + p) * 2 + 1] = ap[(p * 33 + 32) * 2 + 1];
            A32[4096 + (g * NST + p) * 2] = (float)abr; A32[4096 + (g * NST + p) * 2 + 1] = (float)abi;
            for (int i = 0; i < 16; ++i) { A32[8192 + ((g * NST + p) * 16 + i) * 2] = bb[(p * 16 + i) * 2]; A32[8192 + ((g * NST + p) * 16 + i) * 2 + 1] = bb[(p * 16 + i) * 2 + 1]; } }
    }
    for (int e = tid; e < 1024; e += 512) { const int i = e >> 6, p = e & 63; cc[e * 2] = c_re[(g * GRP + i) * NST + p]; cc[e * 2 + 1] = c_im[(g * GRP + i) * NST + p]; }
    LDS_WAIT(); __syncthreads();
    for (int e = tid; e < 1024; e += 512) { const int dd = e >> 8, i = (e >> 4) & 15, j = e & 15, d = 4 * dq + dd; float acc = 0.f;
        for (int p = 0; p < 64; ++p) { const float cr = cc[(i * 64 + p) * 2], ci = cc[(i * 64 + p) * 2 + 1], ar = ap[(p * 33 + d) * 2], ai = ap[(p * 33 + d) * 2 + 1], br = bb[(p * 16 + j) * 2], bi = bb[(p * 16 + j) * 2 + 1];
            const float tr = cr * ar - ci * ai, ti = cr * ai + ci * ar; acc += tr * br - ti * bi; }
        if (d == 0 && i == j) acc += d_skip[g * GRP + i];
        kj[e] = acc; }
    LDS_WAIT(); __syncthreads();
    for (int e = tid; e < 4 * 32 * 16; e += 512) { const int dd = e >> 9, t = (e >> 4) & 31, i = e & 15, d = 4 * dq + dd; bf16* rowp = TYT + ((size_t)g * 512 + t * 16 + i) * SKA;
        if (t >= d) { const LAS float* kp = kj + dd * 256 + i * 16; v4u w0, w1; w0.x = pk2(kp[0], kp[1]); w0.y = pk2(kp[2], kp[3]); w0.z = pk2(kp[4], kp[5]); w0.w = pk2(kp[6], kp[7]);
            w1.x = pk2(kp[8], kp[9]); w1.y = pk2(kp[10], kp[11]); w1.z = pk2(kp[12], kp[13]); w1.w = pk2(kp[14], kp[15]);
            *(GAS v4u*)(rowp + (t - d) * 16) = w0; *(GAS v4u*)(rowp + (t - d) * 16 + 8) = w1; }
        if (d >= 1 && t + d <= 31) { const v4u z = {0u, 0u, 0u, 0u}; *(GAS v4u*)(rowp + (t + d) * 16) = z; *(GAS v4u*)(rowp + (t + d) * 16 + 8) = z; } }
    for (int e = tid; e < 4 * 16 * 64; e += 512) { const int tt = e >> 10, i = (e >> 6) & 15, p = e & 63, t = 4 * dq + tt;
        const float cr = cc[(i * 64 + p) * 2], ci = cc[(i * 64 + p) * 2 + 1], ar = ap[(p * 33 + t + 1) * 2], ai = ap[(p * 33 + t + 1) * 2 + 1];
        bf16* rowp = TYT + ((size_t)g * 512 + t * 16 + i) * SKA; rowp[512 + p] = (bf16)f2bf(cr * ar - ci * ai); rowp[576 + p] = (bf16)f2bf(-(cr * ai + ci * ar)); }
    for (int e = tid; e < 64 * 4 * 16; e += 512) { const int p = e >> 6, tt = (e >> 4) & 3, i = e & 15, t = 4 * dq + tt;
        const float ar = ap[(p * 33 + 31 - t) * 2], ai = ap[(p * 33 + 31 - t) * 2 + 1], br = bb[(p * 16 + i) * 2], bi = bb[(p * 16 + i) * 2 + 1];
        MBT[((size_t)g * 256 + p) * SKU + t * 16 + i] = (bf16)f2bf(ar * br - ai * bi); MBT[((size_t)g * 256 + 64 + p) * SKU + t * 16 + i] = (bf16)f2bf(ar * bi + ai * br); }
    for (int e = tid; e < 128 * 8; e += 512) { const int r = e >> 3, c8 = e & 7; const v4u z = {0u, 0u, 0u, 0u}; *(GAS v4u*)(MBT + ((size_t)g * 256 + 128 + r) * SKU + 64 * dq + 8 * c8) = z; }
    LDS_WAIT(); __syncthreads();
}

__device__ __forceinline__ float reduce16(float (&v)[16], int lane) {
#pragma unroll
    for (int st = 0; st < 4; ++st) { const int half = 8 >> st, bit = 1 << st; const bool hi = (lane & bit) != 0;
#pragma unroll
        for (int j = 0; j < half; ++j) { const float send = hi ? v[j] : v[j + half], keep = hi ? v[j + half] : v[j]; v[j] = keep + __shfl_xor(send, bit); } }
    float r = v[0]; r += __shfl_xor(r, 16); r += __shfl_xor(r, 32); return r;
}
__device__ __forceinline__ void ssm_sample(const void* const* in, const float* TAB, const bf16* Z, bf16* GY, float* out, int g, int b0, int bstride, LAS float* scr, int lane) {
    const float* c_re = (const float*)in[24]; const float* c_im = (const float*)in[25]; const float* d_skip = (const float*)in[26];
    const int p = lane;
    const float abr = TAB[4096 + (g * NST + p) * 2], abi = TAB[4096 + (g * NST + p) * 2 + 1];
    float bbr[16], bbi[16], cr[16], ci[16], dsk[16];
    { const GAS f32x4* bp = (const GAS f32x4*)(TAB + 8192 + (size_t)(g * NST + p) * 32);
#pragma unroll
      for (int i = 0; i < 8; ++i) { const f32x4 v = bp[i]; bbr[2 * i] = v[0]; bbi[2 * i] = v[1]; bbr[2 * i + 1] = v[2]; bbi[2 * i + 1] = v[3]; } }
#pragma unroll
    for (int i = 0; i < 16; ++i) { cr[i] = c_re[(g * GRP + i) * NST + p]; ci[i] = c_im[(g * GRP + i) * NST + p]; dsk[i] = (p == 0) ? d_skip[g * GRP + i] : 0.f; }
    for (int b = b0; b < DECB; b += bstride) {
    const int row0 = MP + b * DECT;
    float hr = ((const float*)in[7])[(b * NG + g) * NST + p], hi = ((const float*)in[8])[(b * NG + g) * NST + p];
    v4u uw[DECT][2];
#pragma unroll
    for (int t = 0; t < DECT; ++t) { const bf16* zr = Z + (size_t)(row0 + t) * NZ + ZC_U + GRP * g; uw[t][0] = *(const GAS v4u*)zr; uw[t][1] = *(const GAS v4u*)(zr + 8); }
#pragma unroll
    for (int t = 0; t < DECT; ++t) {
        float u[16]; { float a[8], b[8]; unpack8(uw[t][0], a); unpack8(uw[t][1], b);
#pragma unroll
            for (int i = 0; i < 8; ++i) { u[i] = a[i]; u[8 + i] = b[i]; } }
        float bur = 0.f, bui = 0.f;
#pragma unroll
        for (int i = 0; i < 16; ++i) { bur += bbr[i] * u[i]; bui += bbi[i] * u[i]; }
        const float nhr = abr * hr - abi * hi + bur, nhi = abr * hi + abi * hr + bui; hr = nhr; hi = nhi;
        float z[16];
#pragma unroll
        for (int i = 0; i < 16; ++i) z[i] = cr[i] * hr - ci[i] * hi + dsk[i] * u[i];
#pragma unroll
        for (int i = 0; i < 16; ++i) scr[lane * 17 + i] = z[i];
        LDS_WAIT(); asm volatile("" ::: "memory");
        float y = 0.f;
#pragma unroll
        for (int k = 0; k < 16; ++k) y += scr[((lane >> 4) * 16 + k) * 17 + (lane & 15)];
        y += __shfl_xor(y, 16); y += __shfl_xor(y, 32);
        LDS_WAIT(); asm volatile("" ::: "memory");
        if (lane < 16) GY[(size_t)(row0 + t) * SSMW + GRP * g + lane] = (bf16)f2bf(gelu_tanh(y));
    }
    out[O_SRES + (size_t)(b * NG + g) * NST + p] = hr; out[O_SIMS + (size_t)(b * NG + g) * NST + p] = hi;
    }
}
__device__ __forceinline__ void ssm_carry_item(const float* TAB, const float* SST, bf16* AY, float* out, int b, int g, int ph, LAS unsigned char* lds, int tid) {
    const int pl = tid & 31, sup = tid >> 5, p = 32 * ph + pl;
    const float ar = TAB[(g * NST + p) * 2], ai = TAB[(g * NST + p) * 2 + 1];
    float sr[16], si[16];
#pragma unroll
    for (int i = 0; i < 16; ++i) { const int ch = b * 256 + sup * 16 + i; const float* sp = SST + ((size_t)ch * NG + g) * 128; sr[i] = sp[p]; si[i] = sp[64 + p]; }
    float hr = 0.f, hi = 0.f;
#pragma unroll
    for (int i = 0; i < 16; ++i) { const float nr = ar * hr - ai * hi + sr[i], ni = ar * hi + ai * hr + si[i]; hr = nr; hi = ni; sr[i] = hr; si[i] = hi; }
    LAS float* tot = (LAS float*)lds;
    LAS float* car = tot + 1024;
    tot[(sup * 32 + pl) * 2] = hr; tot[(sup * 32 + pl) * 2 + 1] = hi;
    LDS_WAIT(); __syncthreads();
    if (sup == 0) { float br = ar, bi = ai;
#pragma unroll
        for (int k = 0; k < 4; ++k) { const float t = br * br - bi * bi; bi = 2.f * br * bi; br = t; }
        float cr = 0.f, ci = 0.f;
        for (int s2 = 0; s2 < 16; ++s2) { car[(s2 * 32 + pl) * 2] = cr; car[(s2 * 32 + pl) * 2 + 1] = ci; const float tr = tot[(s2 * 32 + pl) * 2], ti = tot[(s2 * 32 + pl) * 2 + 1];
            const float nr = br * cr - bi * ci + tr, ni = br * ci + bi * cr + ti; cr = nr; ci = ni; }
        out[O_SREP + (b * NG + g) * NST + p] = cr; out[O_SIMP + (b * NG + g) * NST + p] = ci; }
    LDS_WAIT(); __syncthreads();
    float er = car[(sup * 32 + pl) * 2], ei = car[(sup * 32 + pl) * 2 + 1], lr = 0.f, li = 0.f;
#pragma unroll
    for (int i = 0; i < 16; ++i) { const int ch = b * 256 + sup * 16 + i; bf16* ay = AY + ((size_t)g * SCH + ch) * SKA;
        ay[512 + p] = (bf16)f2bf(er + lr); ay[576 + p] = (bf16)f2bf(ei + li);
        const float nr = ar * er - ai * ei, ni = ar * ei + ai * er; er = nr; ei = ni; lr = sr[i]; li = si[i]; }
    LDS_WAIT(); __syncthreads();
}

#define TAIL_FILL(nbusy, NIT, ...) do { const int ntail_ = ((nbusy) < G) ? (nbusy) : 0; LAS float* scr = (LAS float*)(lds + RING_OFF + wave * 16384); \
        if (ntail_ == 0) { for (int r = gw; r < (NIT); r += NGW) { __VA_ARGS__; } } \
        else if (bx >= ntail_) { for (int r = (bx - ntail_) * NWAVES + wave; r < (NIT); r += (G - ntail_) * NWAVES) { __VA_ARGS__; } } } while (0)

__device__ __forceinline__ float softmax_ref(const float* g_q, const float* g_k, int lane) {
    float a = fmaxf(fabsf(g_q[lane]), fabsf(g_q[64 + (lane & 31)])), b = fmaxf(fabsf(g_k[lane]), fabsf(g_k[64 + (lane & 31)]));
#pragma unroll
    for (int o = 1; o < 64; o <<= 1) { a = fmaxf(a, __shfl_xor(a, o)); b = fmaxf(b, __shfl_xor(b, o)); }
    return QSCALE * 96.0f * a * b * 1.015f + 0.25f;
}

__device__ __forceinline__ void wait_panel(unsigned* cnt, int pm, unsigned target, unsigned* tmo) {
    if (threadIdx.x < 64) {
        unsigned sp = 0;
        while (__hip_atomic_load(cnt + 64 * pm, __ATOMIC_RELAXED, __HIP_MEMORY_SCOPE_AGENT) < target) {
            __builtin_amdgcn_s_sleep(2);
            if ((++sp & 1023u) == 0u && sp > (1u << 22)) { if (threadIdx.x == 0) __hip_atomic_store(tmo, 1u, __ATOMIC_RELAXED, __HIP_MEMORY_SCOPE_AGENT); break; }
        }
        __builtin_amdgcn_fence(__ATOMIC_ACQUIRE, "agent");
        asm volatile("s_waitcnt vmcnt(0)" ::: "memory");
    }
    __syncthreads();
}
#define GEMM_PS(g, nN_, base_p, base_s, E) do { \
      { pg8::Order S_; S_.init(MP / 256, (nN_), 1, G, bx, (base_p)); pg8::gemm_phase<decltype(E), true, true, false>(lds + RING_OFF, g, S_, E); } \
      { pg8::Order S_; S_.init(MS / 256, (nN_), 1, G, bx, (base_s), MP / 256, 4); pg8::gemm_phase<decltype(E), true, true, true>(lds + RING_OFF, g, S_, E); } } while (0)
#define GEMM_P(g, nN_, base_p, E) do { pg8::Order S_; S_.init(MP / 256, (nN_), 1, G, bx, (base_p)); pg8::gemm_phase<decltype(E), true, true, false>(lds + RING_OFF, g, S_, E); } while (0)
#define GEMM_S(g, nN_, base_s, E) do { pg8::Order S_; S_.init(MS / 256, (nN_), 1, G, bx, (base_s), MP / 256, 4); pg8::gemm_phase<decltype(E), true, true, true>(lds + RING_OFF, g, S_, E); } while (0)

__device__ __forceinline__ unsigned char* opqp(unsigned char* p) { asm volatile("" : "+s"(p)); return p; }
#define WIN ((bf16*)(ws + WS_WIN))
#define WUQ ((bf16*)(ws + WS_WUQ))
#define WKV ((bf16*)(ws + WS_WKV))
#define WGLU ((bf16*)(ws + WS_WGLU))
#define WOA ((bf16*)(ws + WS_WOA))
#define WOS ((bf16*)(ws + WS_WOS))
#define WOUT ((bf16*)(ws + WS_WOUT))
#define WPG ((bf16*)(ws + WS_WPG))
#define WPP ((bf16*)(ws + WS_WPP))
#define WUP ((bf16*)(ws + WS_WUP))
#define WDN ((bf16*)(ws + WS_WDN))
#define XN ((bf16*)(ws + WS_XN))
#define Z ((bf16*)(ws + WS_Z))
#define CQN ((bf16*)(ws + WS_CQN))
#define CKVN ((bf16*)(ws + WS_CKVN))
#define PB ((bf16*)(ws + WS_PB))
#define AY ((bf16*)(ws + WS_AY))
#define RT ((float*)(ws + WS_ROPE))
#define RB ((bf16*)(ws + WS_ROPEB))
#define QRAW ((bf16*)(ws + WS_QRAW))
#define KVRAW ((bf16*)(ws + WS_KVRAW))
#define PP ((bf16*)(ws + WS_PP))
#define Q ((bf16*)(ws + WS_Q))
#define K ((bf16*)(ws + WS_K))
#define ATT ((bf16*)(ws + WS_ATT))
#define GY ((bf16*)(ws + WS_GY))
#define YG ((bf16*)(ws + WS_YG))
#define T1 ((bf16*)(ws + WS_T1))
#define MIX ((bf16*)(ws + WS_MIX))
#define SS1 ((float*)(ws + WS_SS1))
#define SS2 ((float*)(ws + WS_SS2))
#define UPB ((bf16*)(ws + WS_UP))
#define HB ((bf16*)(ws + WS_H))
#define X2B ((bf16*)(ws + WS_X2))
#define CB ((bf16*)(ws + WS_CB))
#define KNC ((bf16*)(ws + WS_KNC))
#define ROPE ((float*)(ws + WS_ROPE))
#define SST ((float*)(ws + WS_SST))
__global__ void __launch_bounds__(NWAVES * 64, 2) mk_fwd(Args args) {
    extern __shared__ __attribute__((aligned(16))) unsigned char lds_raw[];
    LAS unsigned char* lds = (LAS unsigned char*)lds_raw;
    volatile LAS unsigned* MISC = (volatile LAS unsigned*)(lds + MISC_OFF);
    const int tid0 = threadIdx.x;
    const int G = gridDim.x, bx = blockIdx.x;
    const int vcu = (G % 8 == 0) ? (bx % 8) * (G / 8) + bx / 8 : bx;
    const int NGW = G * NWAVES;
    unsigned char* ws0 = args.ws;
    unsigned* ctl = (unsigned*)(ws0 + WS_CTL);
    float* out = args.out;
    for (int u = opq(tid0); u < (LDS_BYTES - LDSCTL_OFF) / 4; u += NWAVES * 64) ((LAS unsigned*)(lds + LDSCTL_OFF))[u] = 0u;
    __syncthreads();
    XcdBarrier bar; bar.bar = ctl + CW_BAR; bar.x = 0; bar.st = nullptr;
#if MK_ONE_LAUNCH
    bar = xcd_barrier_post(ctl + CW_BAR, MISC + 8);
#define GRID_BAR() xcd_barrier(bar)
#else
#define GRID_BAR() do {} while (0)
#endif
    const int lo = args.ph_lo, hi = args.ph_hi;
#ifndef PHMASK
#define PHMASK 0xFFFFFFFFu
#endif
#define IN(k) ((((PHMASK) >> (k)) & 1u) && lo <= (k) && (k) < hi)
#define BOTH(k) (IN(k) && IN((k) + 1))

    const float* x_prompt = (const float*)args.in[0]; const float* x_sample = (const float*)args.in[1];
    const float* p_prompt = (const float*)args.in[2]; const float* p_sample = (const float*)args.in[3];
    if (IN(0)) REPLOOP(0) { unsigned char* ws = opqp(ws0); const int tid = opq(tid0), lane = tid & 63, wave = __builtin_amdgcn_readfirstlane(tid >> 6), gw = vcu * NWAVES + wave; (void)lane; (void)gw;
        _Pragma("unroll") for (int rq_ = 0; rq_ < P0A; ++rq_)
        for (int it = bx; it < NG * 8; it += G) ssm_tables_item(args.in, it >> 3, it & 7, lds + RING_OFF, (bf16*)(ws + WS_MBT), (bf16*)(ws + WS_TYT), (float*)(ws + WS_SSMT), tid);
        LAS float* scr = (LAS float*)(lds + RING_OFF + wave * 16384);
        constexpr int I_WIN = 16 * (NZ / 32);
        _Pragma("unroll") for (int rq_ = 0; rq_ < P0B; ++rq_)
        for (int r = gw; r < I_WIN; r += NGW) { const int nblk = NZ / 32, kb = r / nblk, nb = r % nblk, nd = 32 * nb; int ns; bool pad = false;
                if (nd < 256) ns = 384 + nd; else if (nd < 640) ns = nd - 256; else if (nd < 672) ns = nd; else if (nd < 768) { ns = 0; pad = true; }
                else if (nd < 1280) ns = 672 + (nd - 768); else if (nd < 2304) ns = 1184 + (nd - 1280); else ns = 2208 + (nd - 2304);
                tr_item(pad ? nullptr : (const float*)args.in[11], 3232, 64 * kb, ns, WIN, 1024, nd, scr, lane); }
        const float* gmix = (const float*)args.in[10];
        f32x4 gm[4];
#pragma unroll
        for (int j = 0; j < 4; ++j) gm[j] = ((const GAS f32x4*)gmix)[lane + 64 * j];
        for (int m0 = gw; m0 < M; m0 += 2 * NGW) { const int m1 = m0 + NGW; const bool two = m1 < M;
            f32x4 v[2][4], pv[2];
#pragma unroll
            for (int r = 0; r < 2; ++r) { const int m = (r == 0 || two) ? (r == 0 ? m0 : m1) : m0;
                const float* xrow = (m < MP) ? x_prompt + (size_t)m * D : x_sample + (size_t)(m - MP) * D; const GAS f32x4* xr = (const GAS f32x4*)xrow + lane;
#pragma unroll
                for (int j = 0; j < 4; ++j) v[r][j] = xr[64 * j];
                const float* prow = (m < MP) ? p_prompt + (size_t)m * PLE : p_sample + (size_t)(m - MP) * PLE; pv[r] = ((const GAS f32x4*)prow)[lane]; }
#pragma unroll
            for (int r = 0; r < 2; ++r) { if (r == 1 && !two) break; const int m = r == 0 ? m0 : m1; float sq = 0.f;
#pragma unroll
                for (int j = 0; j < 4; ++j) sq += (v[r][j].x * v[r][j].x + v[r][j].y * v[r][j].y) + (v[r][j].z * v[r][j].z + v[r][j].w * v[r][j].w);
                const float rs = 1.0f / sqrtf(wave_sum(sq) * (1.f / D) + EPS);
                GAS v2u* o8 = (GAS v2u*)(XN + (size_t)m * D) + lane;
#pragma unroll
                for (int j = 0; j < 4; ++j) { v2u w; w.x = pk2(v[r][j].x * rs * gm[j].x, v[r][j].y * rs * gm[j].y); w.y = pk2(v[r][j].z * rs * gm[j].z, v[r][j].w * rs * gm[j].w); o8[64 * j] = w; }
                v2u w; w.x = pk2(pv[r].x, pv[r].y); w.y = pk2(pv[r].z, pv[r].w); ((GAS v2u*)(PB + (size_t)m * PLE))[lane] = w; }
        }
        if (BOTH(0)) GRID_BAR();
    }

    if (IN(1)) REPLOOP(1) { unsigned char* ws = opqp(ws0); const int tid = opq(tid0), lane = tid & 63, wave = __builtin_amdgcn_readfirstlane(tid >> 6), gw = vcu * NWAVES + wave; (void)lane; (void)gw;
        pg8::Gemm g{XN, WIN, D, D, D, 0, 0}; pg8::Order S; S.init(M / 256, NZ / 256, 1, G, bx, 0);
        EpiInproj E{Z, CQN, CKVN, AY, out, (const float*)args.in[13], lds + 131072};
        pg8::gemm_phase(lds + RING_OFF, g, S, E);
        { constexpr int I_WUQ = 6 * 24, I_WUK = 4 * 16, I_WUV = 4 * 16, I_WGLU = 8 * 32, I_WOA = 8 * 32, I_WOS = 8 * 32, I_WOUT = 16 * 32, I_WPP = 4 * 32;
          constexpr int NIT1 = I_WUQ + I_WUK + I_WUV + I_WGLU + I_WOA + I_WOS + I_WOUT + I_WPP;
          TAIL_FILL(((M / 256) * (NZ / 256)) % G, NIT1, { int q = r;
            if (q < I_WUQ) { tr_plain((const float*)args.in[14], 384, 768, WUQ, q, scr, lane, (const float*)args.in[12]); continue; } q -= I_WUQ;
            if (q < I_WUK) { tr_plain((const float*)args.in[15], 256, 512, WKV, q, scr, lane); continue; } q -= I_WUK;
            if (q < I_WUV) { tr_plain((const float*)args.in[16], 256, 512, WKV + 512 * 256, q, scr, lane); continue; } q -= I_WUV;
            if (q < I_WGLU) { const int kb = q / 32, nb = q % 32, nd = 32 * nb; const int pn = nd >> 8, bj = (nd >> 7) & 1, c = nd & 127; const int ns = bj * 512 + 128 * pn + c;
                tr_item((const float*)args.in[27], 1024, 64 * kb, ns, WGLU, 512, nd, scr, lane); continue; } q -= I_WGLU;
            if (q < I_WOA) { tr_plain((const float*)args.in[28], 512, 1024, WOA, q, scr, lane); continue; } q -= I_WOA;
            if (q < I_WOS) { tr_plain((const float*)args.in[29], 512, 1024, WOS, q, scr, lane); continue; } q -= I_WOS;
            if (q < I_WOUT) { tr_plain((const float*)args.in[30], 1024, 1024, WOUT, q, scr, lane); continue; } q -= I_WOUT;
            tr_plain((const float*)args.in[38], 256, 1024, WPP, q, scr, lane); });
          TAIL_FILL(((M / 256) * (NZ / 256)) % G, 16 * 176, { const int kb_ = r / 176, nd_ = 32 * (r % 176), ns_ = ((nd_ >> 7) & 1) * DFF + 128 * (nd_ >> 8) + (nd_ & 127);     \
            tr_item((const float*)args.in[32], UPW, 64 * kb_, ns_, WUP, 1024, nd_, scr, lane, (const float*)args.in[31]); });
          const int nb1 = ((M / 256) * (NZ / 256)) % G, b0_ = (nb1 && bx >= nb1) ? bx - nb1 : (nb1 ? -1 : bx), gs_ = nb1 ? G - nb1 : G;
          if (b0_ >= 0) {
        { for (int i = b0_ * 512 + tid; i < (SEQ + DECT) * 16; i += gs_ * 512) { const int pos = i >> 4, k = i & 15;
              const float inv = (float)exp(-(double)k * (1.0 / 16.0) * 9.210340371976184); const float ang = (float)pos * inv; const float c = cosf(ang), sn = sinf(ang);
              RT[pos * 32 + k] = c; RT[pos * 32 + 16 + k] = sn; RB[pos * 32 + k] = (bf16)f2bf(c); RB[pos * 32 + 16 + k] = (bf16)f2bf(sn); } }
        { unsigned* W8 = (unsigned*)(ws + WS_W8); const float* w_uk = (const float*)args.in[15];
          for (int i = b0_ * 512 + tid; i < 512 * 64; i += gs_ * 512) { const int row = i & 511, k4 = (i >> 9) * 4; int w = 0;
              w = __builtin_amdgcn_cvt_pk_fp8_f32(64.f * w_uk[(size_t)k4 * 512 + row], 64.f * w_uk[(size_t)(k4 + 1) * 512 + row], w, false);
              w = __builtin_amdgcn_cvt_pk_fp8_f32(64.f * w_uk[(size_t)(k4 + 2) * 512 + row], 64.f * w_uk[(size_t)(k4 + 3) * 512 + row], w, true);
              W8[row * 64 + (k4 >> 2)] = (unsigned)w; } }
          } }
        if (BOTH(1)) GRID_BAR();
    }

    constexpr int NMT = M / 256;

    if (IN(3)) REPLOOP(3) { unsigned char* ws = opqp(ws0); const int tid = opq(tid0), lane = tid & 63, wave = __builtin_amdgcn_readfirstlane(tid >> 6), gw = vcu * NWAVES + wave; (void)lane; (void)gw;
        {
          constexpr int NPR = MP / 256;
          pg8::Gemm gq{CQN, WUQ, QL, QL, QL, 0, 0}; auto fq_ = [=](const pg8::Unit& u, int row, int col, f32x4 a, f32x4 b) { *(GAS v4u*)(QRAW + (size_t)row * 768 + col) = pack8(a, b); }; pg8::EpiRow8<decltype(fq_)> Eq{fq_};
          pg8::Gemm gk{CKVN, WKV, KVL, KVL, KVL, 0, 0}; auto fk_ = [=](const pg8::Unit& u, int row, int col, f32x4 a, f32x4 b) { *(GAS v4u*)(KVRAW + (size_t)row * 1024 + col) = pack8(a, b); }; pg8::EpiRow8<decltype(fk_)> Ek{fk_};
          GEMM_P(gq, 3, 0, Eq); GEMM_P(gk, 4, NPR * 3, Ek);
          { pg8::Gemm g{AY, (const bf16*)(ws + WS_MBT), SKA, SKU, SKU, (size_t)SCH * SKA, (size_t)256 * SKU}; pg8::Order S; S.init(SCH / 256, 1, NG, G, bx, NPR * 7);
            auto f = [=](const pg8::Unit& u, int row, int col, f32x4 a, f32x4 b) { if (col < 128) { float* d = SST + ((size_t)row * NG + u.z) * 128 + col; *(GAS f32x4*)d = a; *(GAS f32x4*)(d + 4) = b; } };
            pg8::EpiRow8<decltype(f)> E{f}; pg8::gemm_phase(lds + RING_OFF, g, S, E); }
          constexpr int B2 = NPR * 7 + 64;
          GEMM_S(gq, 3, B2, Eq); GEMM_S(gk, 4, B2 + 24, Ek); }
        if (BOTH(3)) GRID_BAR();
    }

    if (IN(4)) REPLOOP(4) { unsigned char* ws = opqp(ws0); const int tid = opq(tid0), lane = tid & 63, wave = __builtin_amdgcn_readfirstlane(tid >> 6), gw = vcu * NWAVES + wave; (void)lane; (void)gw;
        _Pragma("unroll") for (int rpc_ = 0; rpc_ < P4C; ++rpc_)
        for (int it = bx; it < NBATCH * NG * 2; it += G) ssm_carry_item((const float*)(ws + WS_SSMT), (const float*)(ws + WS_SST), AY, out, it >> 6, (it >> 1) & 31, it & 1, lds + RING_OFF, tid);
        _Pragma("unroll") for (int rpd_ = 0; rpd_ < P4D; ++rpd_)
        for (int it = G - 1 - bx; it < NH * (MS / 64); it += G) qabs_item(args.in, QRAW, WKV, ROPE, (bf16*)(ws + WS_QABS), it & 7, it >> 3, lds + RING_OFF, tid);
        const float* g_q = (const float*)args.in[17]; const float* g_k = (const float*)args.in[18];
        const int h = lane >> 3, sub = lane & 7;
        float gq[12], gk[12];
#pragma unroll
        for (int i = 0; i < 8; ++i) { gq[i] = g_q[8 * sub + i]; gk[i] = g_k[8 * sub + i]; }
        gq[8] = g_q[64 + 2 * sub]; gq[9] = g_q[65 + 2 * sub]; gq[10] = g_q[80 + 2 * sub]; gq[11] = g_q[81 + 2 * sub];
        gk[8] = g_k[64 + 2 * sub]; gk[9] = g_k[65 + 2 * sub]; gk[10] = g_k[80 + 2 * sub]; gk[11] = g_k[81 + 2 * sub];
        _Pragma("unroll") for (int rpa_ = 0; rpa_ < P4A; ++rpa_)
        for (int m0 = gw; m0 < M; m0 += 2 * NGW) {
            const int m1 = m0 + NGW; const bool two = m1 < M;
            f32x2 cs[2], sn[2]; v4u qn8[2], kn8[2]; unsigned qa[2], qb[2]; f32x2 xa[2], xb[2];
#pragma unroll
            for (int j = 0; j < 2; ++j) { const int m = (j == 0 || two) ? (j == 0 ? m0 : m1) : m0;
                const int pos = (m < MP) ? (m & (SEQ - 1)) : SEQ + ((m - MP) & 3);
                const float* rp = ROPE + (size_t)pos * 32; cs[j] = *(const GAS f32x2*)(rp + 2 * sub); sn[j] = *(const GAS f32x2*)(rp + 16 + 2 * sub);
                const bf16* qr = QRAW + (size_t)m * 768 + h * QKH; qn8[j] = *(const GAS v4u*)(qr + 8 * sub); qa[j] = *(const GAS unsigned*)(qr + 64 + 2 * sub); qb[j] = *(const GAS unsigned*)(qr + 80 + 2 * sub);
                kn8[j] = *(const GAS v4u*)(KVRAW + (size_t)m * 1024 + h * QKN + 8 * sub);
                const float* krp = (m < MP) ? out + O_KRP + (size_t)m * QKR : out + O_KRS + (size_t)(m - MP) * QKR; xa[j] = *(const GAS f32x2*)(krp + 2 * sub); xb[j] = *(const GAS f32x2*)(krp + 16 + 2 * sub); }
#pragma unroll
            for (int j = 0; j < 2; ++j) { if (j == 1 && !two) break; const int m = j == 0 ? m0 : m1;
            { float n[8]; unpack8(qn8[j], n);
              float a0 = bflo(qa[j]), a1 = bfhi(qa[j]), b0 = bflo(qb[j]), b1 = bfhi(qb[j]);
              float ss = (a0 * a0 + a1 * a1) + (b0 * b0 + b1 * b1);
#pragma unroll
              for (int i = 0; i < 8; ++i) ss += n[i] * n[i];
              ss += __shfl_xor(ss, 1); ss += __shfl_xor(ss, 2); ss += __shfl_xor(ss, 4);
              const float rs = QSCALE / sqrtf(ss * (1.f / QKH) + EPS);
#pragma unroll
              for (int i = 0; i < 8; ++i) n[i] *= rs * gq[i];
              a0 *= rs * gq[8]; a1 *= rs * gq[9]; b0 *= rs * gq[10]; b1 *= rs * gq[11];
              bf16* qo = Q + (size_t)m * 768 + h * QKH;
              v4u w; w.x = pk2(n[0], n[1]); w.y = pk2(n[2], n[3]); w.z = pk2(n[4], n[5]); w.w = pk2(n[6], n[7]); *(GAS v4u*)(qo + 8 * sub) = w;
              *(GAS unsigned*)(qo + 64 + 2 * sub) = pk2(a0 * cs[j].x - b0 * sn[j].x, a1 * cs[j].y - b1 * sn[j].y); *(GAS unsigned*)(qo + 80 + 2 * sub) = pk2(a0 * sn[j].x + b0 * cs[j].x, a1 * sn[j].y + b1 * cs[j].y); }
            { float n[8]; unpack8(kn8[j], n);
              float a0 = xa[j].x, a1 = xa[j].y, b0 = xb[j].x, b1 = xb[j].y;
              float ss = (a0 * a0 + a1 * a1) + (b0 * b0 + b1 * b1);
#pragma unroll
              for (int i = 0; i < 8; ++i) ss += n[i] * n[i];
              ss += __shfl_xor(ss, 1); ss += __shfl_xor(ss, 2); ss += __shfl_xor(ss, 4);
              const float rs = 1.0f / sqrtf(ss * (1.f / QKH) + EPS);
#pragma unroll
              for (int i = 0; i < 8; ++i) n[i] *= rs * gk[i];
              a0 *= rs * gk[8]; a1 *= rs * gk[9]; b0 *= rs * gk[10]; b1 *= rs * gk[11];
              bf16* ko = K + (size_t)m * 768 + h * QKH;
              v4u w; w.x = pk2(n[0], n[1]); w.y = pk2(n[2], n[3]); w.z = pk2(n[4], n[5]); w.w = pk2(n[6], n[7]); *(GAS v4u*)(ko + 8 * sub) = w;
              *(GAS unsigned*)(ko + 64 + 2 * sub) = pk2(a0 * cs[j].x - b0 * sn[j].x, a1 * cs[j].y - b1 * sn[j].y);
              *(GAS unsigned*)(ko + 80 + 2 * sub) = pk2(a0 * sn[j].x + b0 * cs[j].x, a1 * sn[j].y + b1 * cs[j].y); } }
        }
        _Pragma("unroll") for (int rpb_ = 0; rpb_ < P4B; ++rpb_)
        if (NGW % NG == 0) ssm_sample(args.in, (const float*)(ws + WS_SSMT), Z, GY, out, gw % NG, gw / NG, NGW / NG, (LAS float*)(lds + RING_OFF + wave * 16384), lane);
        else for (int it = gw; it < DECB * NG; it += NGW) ssm_sample(args.in, (const float*)(ws + WS_SSMT), Z, GY, out, it % NG, it / NG, DECB, (LAS float*)(lds + RING_OFF + wave * 16384), lane);
        if (BOTH(4)) GRID_BAR();
    }

    if (IN(5)) REPLOOP(5) { unsigned char* ws = opqp(ws0); const int tid = opq(tid0), lane = tid & 63, wave = __builtin_amdgcn_readfirstlane(tid >> 6), gw = vcu * NWAVES + wave; (void)lane; (void)gw;
        const bool sa_first = SA_FIRST_ALL ? true : ((vcu & 1) != 0);
        const float sref = softmax_ref((const float*)args.in[17], (const float*)args.in[18], lane);
        if (sa_first)
            for (int it = bx; it < DECB * 2; it += G)
                sa::item<0>(args.in, (const bf16*)(ws + WS_QABS), (const unsigned char*)(ws + WS_W8), (const bf16*)(ws + WS_ROPEB), (float*)(ws + WS_PO), (float*)(ws + WS_PL), sref, it >> 1, it & 1, lds + RING_OFF, tid, wave, lane);
        for (int pi = vcu; pi < 256; pi += G) { const int bh = pi >> 4, s_ = pi & 15;
            pa::attn_unit(Q, K, KVRAW + 512, ATT, bh >> 3, bh & 7, s_, sref, lds + RING_OFF, wave, lane);
            pa::attn_unit(Q, K, KVRAW + 512, ATT, bh >> 3, bh & 7, 31 - s_, sref, lds + RING_OFF, wave, lane); }
        if (!sa_first)
            for (int it = bx; it < DECB * 2; it += G)
                sa::item<0>(args.in, (const bf16*)(ws + WS_QABS), (const unsigned char*)(ws + WS_W8), (const bf16*)(ws + WS_ROPEB), (float*)(ws + WS_PO), (float*)(ws + WS_PL), sref, it >> 1, it & 1, lds + RING_OFF, tid, wave, lane);
        if (BOTH(5)) GRID_BAR();
    }

    if (IN(6)) REPLOOP(6) { unsigned char* ws = opqp(ws0); const int tid = opq(tid0), lane = tid & 63, wave = __builtin_amdgcn_readfirstlane(tid >> 6), gw = vcu * NWAVES + wave; (void)lane; (void)gw;
        const float sref6 = softmax_ref((const float*)args.in[17], (const float*)args.in[18], lane);
        const int GH = G / 2;
        _Pragma("unroll") for (int rq_ = 0; rq_ < P6A; ++rq_)
        if (bx >= GH) for (int it = bx - GH; it < NH * (MS / 16); it += G - GH)
            sa::combine_item(args.in, Q, K, CKVN, (const float*)(ws + WS_PO), (const float*)(ws + WS_PL), sref6, ATT, it & 7, it >> 3, lds + RING_OFF, tid, wave, lane);
        { pg8::Gemm g{AY, (const bf16*)(ws + WS_TYT), SKA, SKA, SKA, (size_t)SCH * SKA, (size_t)512 * SKA}; pg8::Order S; S.init(SCH / 256, 2, NG, GH, bx, 0);
          auto f = [=](const pg8::Unit& u, int row, int col, f32x4 a, f32x4 b) {
#pragma unroll
              for (int i = 0; i < 4; ++i) { a[i] = gelu_tanh(a[i]); b[i] = gelu_tanh(b[i]); }
              *(GAS v4u*)(GY + ((size_t)row * SL + (col >> 4)) * SSMW + u.z * GRP + (col & 15)) = pack8(a, b); };
          pg8::EpiRow8<decltype(f)> E{f}; if (bx < GH) pg8::gemm_phase(lds + RING_OFF, g, S, E); }
        if (BOTH(6)) GRID_BAR();
    }

    if (IN(7)) REPLOOP(7) { unsigned char* ws = opqp(ws0); const int tid = opq(tid0), lane = tid & 63, wave = __builtin_amdgcn_readfirstlane(tid >> 6), gw = vcu * NWAVES + wave; (void)lane; (void)gw;
        { pg8::Gemm gg{GY, WGLU, SSMW, SSMW, SSMW, 0, 0};
          auto fg_ = [=](const pg8::Unit& u, int row, int cp, f32x4 a0, f32x4 a1, f32x4 b0, f32x4 b1) {
#pragma unroll
              for (int i = 0; i < 4; ++i) { a0[i] *= sigmoidf_(b0[i]); a1[i] *= sigmoidf_(b1[i]); }
              *(GAS v4u*)(YG + (size_t)row * SSMW + cp) = pack8(a0, a1); };
          pg8::EpiPair8<decltype(fg_)> Eg{fg_};
          pg8::Gemm ga_{ATT, WOA, ATTW, ATTW, ATTW, 0, 0};
          auto fa_ = [=](const pg8::Unit& u, int row, int col, f32x4 a, f32x4 b) { float gt[8]; unpack8(*(const GAS v4u*)(Z + (size_t)row * NZ + ZC_GA + col), gt);
#pragma unroll
              for (int i = 0; i < 4; ++i) { a[i] *= gt[i]; b[i] *= gt[4 + i]; }
              *(GAS v4u*)(T1 + (size_t)row * D + col) = pack8(a, b); };
          pg8::EpiRow8<decltype(fa_)> Ea{fa_};
          GEMM_P(gg, 4, 0, Eg); GEMM_P(ga_, 4, 256, Ea); GEMM_S(gg, 4, 512, Eg); GEMM_S(ga_, 4, 544, Ea); }
        if (BOTH(7)) GRID_BAR();
    }

    if (IN(8)) REPLOOP(8) { unsigned char* ws = opqp(ws0); const int tid = opq(tid0), lane = tid & 63, wave = __builtin_amdgcn_readfirstlane(tid >> 6), gw = vcu * NWAVES + wave; (void)lane; (void)gw;
        pg8::Gemm g{YG, WOS, SSMW, SSMW, SSMW, 0, 0};
        auto f = [=](const pg8::Unit& u, int row, int col, f32x4 a, f32x4 b) { float gt[8], t1[8]; unpack8(*(const GAS v4u*)(Z + (size_t)row * NZ + ZC_GS + col), gt); unpack8(*(const GAS v4u*)(T1 + (size_t)row * D + col), t1);
#pragma unroll
            for (int i = 0; i < 4; ++i) { a[i] = t1[i] + a[i] * gt[i]; b[i] = t1[4 + i] + b[i] * gt[4 + i]; }
            *(GAS v4u*)(MIX + (size_t)row * D + col) = pack8(a, b); };
        pg8::EpiRow8<decltype(f)> E{f}; GEMM_PS(g, 4, 0, 256, E);
        TAIL_FILL(32, 44 * 32, tr_plain((const float*)args.in[35], DFF, 1024, WDN, r, scr, lane));
        if (BOTH(8)) GRID_BAR();
    }

    if (IN(9)) REPLOOP(9) { unsigned char* ws = opqp(ws0); const int tid = opq(tid0), lane = tid & 63, wave = __builtin_amdgcn_readfirstlane(tid >> 6), gw = vcu * NWAVES + wave; (void)lane; (void)gw;
        pg8::Gemm g{MIX, WOUT, D, D, D, 0, 0};
        EpiResid<false> E{x_prompt, x_sample, nullptr, XN, SS1};
        GEMM_PS(g, 4, 0, 256, E);
        TAIL_FILL(32, 16 * 32, tr_plain((const float*)args.in[37], 1024, 1024, WPG, r, scr, lane, (const float*)args.in[36]));
        if (BOTH(9)) GRID_BAR();
    }

    if (IN(10)) REPLOOP(10) { unsigned char* ws = opqp(ws0); const int tid = opq(tid0), lane = tid & 63, wave = __builtin_amdgcn_readfirstlane(tid >> 6), gw = vcu * NWAVES + wave; (void)lane; (void)gw;
        pg8::Gemm g{XN, WUP, D, D, D, 0, 0};
        EpiUpConv E{SS1, HB, (bf16*)(ws + WS_UPF), (bf16*)(ws + WS_UPL), out, (const float*)args.in[33], (const float*)args.in[34], (const float*)args.in[9], lds + 131072, ctl + CW_PAN};
        constexpr int NUS = (MS / 256) * (UPW / 256), NUP = (MP / 256) * (UPW / 256);
        { pg8::Order Sa, Sb; Sa.init(MS / 256, UPW / 256, 1, G, bx, 0, MP / 256, 1); Sb.init(MP / 256, UPW / 256, 1, G, bx, NUS); pg8::OrderSeq S; S.init(Sa, Sb, NUS, G, bx);
          pg8::gemm_phase<EpiUpConv, true, true, false, pg8::OrderSeq>(lds + RING_OFF, g, S, E); }
        {
          pg8::Gemm gp{PB, WPP, PLE, PLE, PLE, 0, 0}; auto fp_ = [=](const pg8::Unit& u, int row, int col, f32x4 a, f32x4 b) { *(GAS v4u*)(PP + (size_t)row * 1024 + col) = pack8(a, b); }; pg8::EpiRow8<decltype(fp_)> Ep{fp_};
          const int nb_ = (NUS + NUP) % G; const int nidle = nb_ ? G - nb_ : G, ci = nb_ ? bx - nb_ : bx;
          const int nd_ = (nidle > 64) ? 32 : 0;
          if (ci >= 0 && ci < nd_) { pg8::Gemm gd{HB, WDN, DFF, DFF, DFF, 0, 0}; EpiResid<true> Ed{nullptr, nullptr, XN, X2B, SS2};
              pg8::Order Sd; Sd.init(MS / 256, 4, 1, nd_, ci, 0, MP / 256, 4); pg8::Unit uo;
              for (int i = 0; Sd.next(i, uo); ++i) wait_panel(ctl + CW_PAN, uo.pm, (unsigned)(UPW / 256) * 8u, ctl + CW_PTMO);
              pg8::gemm_phase<EpiResid<true>, true, true, true>(lds + RING_OFF, gd, Sd, Ed); }
          else if (ci >= nd_) { pg8::Order So; So.init(NMT, 4, 1, nidle - nd_, ci - nd_, 0); pg8::gemm_phase(lds + RING_OFF, gp, So, Ep); } }
        if (BOTH(10)) GRID_BAR();
    }


    if (IN(12)) REPLOOP(12) { unsigned char* ws = opqp(ws0); const int tid = opq(tid0), lane = tid & 63, wave = __builtin_amdgcn_readfirstlane(tid >> 6), gw = vcu * NWAVES + wave; (void)lane; (void)gw;
        { const float* conv_w = (const float*)args.in[33]; const float* conv_b = (const float*)args.in[34]; const bf16* UPF = (const bf16*)(ws + WS_UPF); const bf16* UPL = (const bf16*)(ws + WS_UPL);
          constexpr int NCG = DFF / 8; pg8::Order So; So.init(MP / 256, 4, 1, G, bx, 0); pg8::Unit uo;
          for (int ui = 0; So.next(ui, uo); ++ui) { const int pm = uo.pm;
          for (int it = tid; it < 2 * NCG; it += 512) {
            const int cg = it % NCG, rr = it / NCG, c0 = 8 * cg; const bool first = (pm & 31) == 0;
            float cur[16], p1[16], p2[16];
            unpack8(*(const GAS v4u*)(UPF + ((size_t)pm * 2 + rr) * UPW + c0), *(float(*)[8])&cur[0]); unpack8(*(const GAS v4u*)(UPF + ((size_t)pm * 2 + rr) * UPW + DFF + c0), *(float(*)[8])&cur[8]);
#pragma unroll
            for (int i = 0; i < 16; ++i) { p1[i] = 0.f; p2[i] = 0.f; }
            if (rr == 1) { unpack8(*(const GAS v4u*)(UPF + ((size_t)pm * 2) * UPW + c0), *(float(*)[8])&p1[0]); unpack8(*(const GAS v4u*)(UPF + ((size_t)pm * 2) * UPW + DFF + c0), *(float(*)[8])&p1[8]); }
            if (!first) {
                if (rr == 0) { unpack8(*(const GAS v4u*)(UPL + ((size_t)(pm - 1) * 2 + 1) * UPW + c0), *(float(*)[8])&p1[0]); unpack8(*(const GAS v4u*)(UPL + ((size_t)(pm - 1) * 2 + 1) * UPW + DFF + c0), *(float(*)[8])&p1[8]);
                               unpack8(*(const GAS v4u*)(UPL + ((size_t)(pm - 1) * 2) * UPW + c0), *(float(*)[8])&p2[0]); unpack8(*(const GAS v4u*)(UPL + ((size_t)(pm - 1) * 2) * UPW + DFF + c0), *(float(*)[8])&p2[8]); }
                else { unpack8(*(const GAS v4u*)(UPL + ((size_t)(pm - 1) * 2 + 1) * UPW + c0), *(float(*)[8])&p2[0]); unpack8(*(const GAS v4u*)(UPL + ((size_t)(pm - 1) * 2 + 1) * UPW + DFF + c0), *(float(*)[8])&p2[8]); }
            }
            float hh[8];
#pragma unroll
            for (int i = 0; i < 8; ++i) { const float ca = conv_b[c0 + i] + p2[i] * conv_w[c0 + i] + p1[i] * conv_w[UPW + c0 + i] + cur[i] * conv_w[2 * UPW + c0 + i];
                const float cv = conv_b[DFF + c0 + i] + p2[8 + i] * conv_w[DFF + c0 + i] + p1[8 + i] * conv_w[UPW + DFF + c0 + i] + cur[8 + i] * conv_w[2 * UPW + DFF + c0 + i]; hh[i] = gelu_tanh(ca) * cv; }
            v4u o; o.x = pk2(hh[0], hh[1]); o.y = pk2(hh[2], hh[3]); o.z = pk2(hh[4], hh[5]); o.w = pk2(hh[6], hh[7]);
            *(GAS v4u*)(HB + ((size_t)pm * 256 + rr) * DFF + c0) = o;
        }
          }
          asm volatile("s_waitcnt vmcnt(0)" ::: "memory"); __syncthreads(); }
        pg8::Gemm g{HB, WDN, DFF, DFF, DFF, 0, 0};
        EpiResid<true> E{nullptr, nullptr, XN, X2B, SS2};
        { constexpr int NU10 = (M / 256) * (UPW / 256); const int nb_ = NU10 % G, nidle = nb_ ? G - nb_ : G;
          if (nidle > 64) GEMM_P(g, 4, 0, E); else GEMM_PS(g, 4, 0, 256, E); }
        if (BOTH(12)) GRID_BAR();
    }

    if (IN(13)) REPLOOP(13) { unsigned char* ws = opqp(ws0); const int tid = opq(tid0), lane = tid & 63, wave = __builtin_amdgcn_readfirstlane(tid >> 6), gw = vcu * NWAVES + wave; (void)lane; (void)gw;
        pg8::Gemm g{X2B, WPG, D, D, D, 0, 0};
        EpiPle E{SS2, X2B, PP, out + O_Y};
        GEMM_PS(g, 4, 0, 256, E);
    }
#undef IN
#undef BOTH
}

#undef WIN
#undef WUQ
#undef WKV
#undef WGLU
#undef WOA
#undef WOS
#undef WOUT
#undef WPG
#undef WPP
#undef WUP
#undef WDN
#undef XN
#undef Z
#undef CQN
#undef CKVN
#undef PB
#undef AY
#undef RT
#undef RB
#undef QRAW
#undef KVRAW
#undef PP
#undef Q
#undef K
#undef ATT
#undef GY
#undef YG
#undef T1
#undef MIX
#undef SS1
#undef SS2
#undef UPB
#undef HB
#undef X2B
#undef CB
#undef KNC
#undef ROPE
#undef SST
constexpr int N_PHASES = 14;
extern "C" void kernel_launch(void* const* d_in, const int* in_sizes, int n_in, void* d_out, int out_size, void* d_ws, size_t ws_size, hipStream_t stream) {
    static int grid = 0;
    if (grid == 0) {
        if (n_in != 39 || (size_t)out_size != O_END || ws_size < WS_END) { fprintf(stderr, "kernel_launch: unexpected sizes n_in %d out %d ws %zu\n", n_in, out_size, ws_size); grid = -1; return; }
        int dev = 0, cus = 0, per_cu = 0;
        if (hipGetDevice(&dev) != hipSuccess || hipDeviceGetAttribute(&cus, hipDeviceAttributeMultiprocessorCount, dev) != hipSuccess) { grid = -1; return; }
        if (hipFuncSetAttribute((const void*)mk_fwd, hipFuncAttributeMaxDynamicSharedMemorySize, LDS_BYTES) != hipSuccess) { fprintf(stderr, "kernel_launch: hipFuncSetAttribute failed\n"); grid = -1; return; }
        if (hipOccupancyMaxActiveBlocksPerMultiprocessor(&per_cu, (const void*)mk_fwd, NWAVES * 64, LDS_BYTES) != hipSuccess || per_cu < 1)
            fprintf(stderr, "kernel_launch: occupancy query reports %d\n", per_cu);
        (void)hipGetLastError();
        grid = cus;
    }
    if (grid < 0) return;
    if (hipMemsetAsync((char*)d_ws + WS_CTL, 0, CTL_ZERO_BYTES, stream) != hipSuccess) return;
    Args a{};
    for (int i = 0; i < 39; ++i) a.in[i] = d_in[i];
    a.out = (float*)d_out; a.ws = (unsigned char*)d_ws;
#if MK_ONE_LAUNCH
    a.ph_lo = 0; a.ph_hi = N_PHASES;
    hipLaunchKernelGGL(mk_fwd, dim3(grid), dim3(NWAVES * 64), LDS_BYTES, stream, a);
#else
    for (int p = 0; p < N_PHASES; ++p) { a.ph_lo = p; a.ph_hi = p + 1;
        hipLaunchKernelGGL(mk_fwd, dim3(grid), dim3(NWAVES * 64), LDS_BYTES, stream, a); }
#endif
}
```

```cpp
#include <hip/hip_runtime.h>
#include <cstdio>
#include <cstdint>

#define REP_PA 1
#define REP_SA 1
#define SA_PROBE 0
#define P0A 1
#define P0B 1
#define P0C 1
#define P6A 1
#define P4A 1
#define P4B 1
#define P4C 1
#define P4D 1
#define SA_FIRST_ALL 0
#define SA_ALLREG 1
#define REP_G 0x0
#if REP_G
#define REPLOOP(k) _Pragma("unroll") for (int rep_ = 0; rep_ < 1 + (((REP_G) >> (k)) & 1); ++rep_)
#else
#define REPLOOP(k)
#endif
#ifndef MK_ONE_LAUNCH
#define MK_ONE_LAUNCH 1
#endif

constexpr int D = 1024, SEQ = 8192, NBATCH = 2, MP = NBATCH * SEQ, DECB = 128, DECT = 4, MS = DECB * DECT, M = MP + MS;
constexpr int NH = 8, QKN = 64, QKR = 32, QKH = 96, VH = 64, QL = 384, KVL = 256, ATTW = 512;
constexpr int SSMW = 512, GRP = 16, NG = 32, NST = 64;
constexpr int DFF = 2816, UPW = 2 * DFF, PLE = 256;
constexpr int NPAGES = 64, PAGE = 128, NPOOL = 10240;
constexpr float EPS = 1e-6f;
constexpr int NZ = 3328, ZC_CKV = 0, ZC_CQ = 256, ZC_KR = 640, ZC_U = 768, ZC_GA = 1280, ZC_GS = 2304;
constexpr size_t O_Y = 0, O_CKVP = (size_t)M * D, O_KRP = O_CKVP + (size_t)MP * KVL, O_CKVS = O_KRP + (size_t)MP * QKR, O_KRS = O_CKVS + (size_t)MS * KVL,
                 O_SREP = O_KRS + (size_t)MS * QKR, O_SIMP = O_SREP + NBATCH * NG * NST, O_SRES = O_SIMP + NBATCH * NG * NST, O_SIMS = O_SRES + (size_t)DECB * NG * NST,
                 O_CVP = O_SIMS + (size_t)DECB * NG * NST, O_CVS = O_CVP + (size_t)NBATCH * 2 * UPW, O_END = O_CVS + (size_t)DECB * 2 * UPW;
static_assert(O_END == 24164352, "output size");
constexpr int SL = 32, SCH = MP / SL  , SKU = SL * GRP  , SKA = SKU + 2 * NST  ;

constexpr size_t MiB = 1u << 20;
constexpr size_t WS_CTL = 0, CTL_ZERO_BYTES = 1 * MiB;
constexpr size_t WS_WIN = 2 * MiB;
constexpr size_t WS_WUQ = 10 * MiB;
constexpr size_t WS_WKV = 11 * MiB;
constexpr size_t WS_WGLU = 12 * MiB;
constexpr size_t WS_WOA = 13 * MiB, WS_WOS = 14 * MiB;
constexpr size_t WS_WOUT = 15 * MiB;
constexpr size_t WS_WPG = 17 * MiB;
constexpr size_t WS_WPP = 19 * MiB;
constexpr size_t WS_WUP = 20 * MiB;
constexpr size_t WS_WDN = 32 * MiB;
constexpr size_t WS_ROPE = 38 * MiB;
constexpr size_t WS_SSMT = 40 * MiB;
constexpr size_t WS_MBT = 44 * MiB;
constexpr size_t WS_TYT = 52 * MiB;
constexpr size_t WS_KJ = 72 * MiB;
constexpr size_t WS_XN = 80 * MiB;
constexpr size_t WS_Z = 116 * MiB;
constexpr size_t WS_CQN = 226 * MiB;
constexpr size_t WS_CKVN = 240 * MiB;
constexpr size_t WS_PB = 250 * MiB;
constexpr size_t WS_AY = 260 * MiB;
constexpr size_t WS_QRAW = 300 * MiB;
constexpr size_t WS_KVRAW = 330 * MiB;
constexpr size_t WS_PP = 370 * MiB;
constexpr size_t WS_Q = 410 * MiB;
constexpr size_t WS_K = 440 * MiB;
constexpr size_t WS_ATT = 470 * MiB;
constexpr size_t WS_GY = 490 * MiB;
constexpr size_t WS_YG = 510 * MiB;
constexpr size_t WS_T1 = 530 * MiB;
constexpr size_t WS_MIX = 570 * MiB;
constexpr size_t WS_X1 = 610 * MiB;
constexpr size_t WS_SS1 = 690 * MiB;
constexpr size_t WS_SS2 = 692 * MiB;
constexpr size_t WS_UP = 700 * MiB;
constexpr size_t WS_H = 890 * MiB;
constexpr size_t WS_X2 = 990 * MiB;
constexpr size_t WS_PO = 1080 * MiB;
constexpr size_t WS_PM = 1089 * MiB, WS_PL = 1090 * MiB;
constexpr size_t WS_W8 = 1095 * MiB;
constexpr size_t WS_ROPEB = 1096 * MiB;
constexpr size_t WS_UPF = 1097 * MiB, WS_UPL = 1099 * MiB;
constexpr size_t WS_QABS = 1092 * MiB;
constexpr size_t WS_SST = 1070 * MiB;
constexpr size_t WS_CB = 1100 * MiB;
constexpr size_t WS_KNC = 1650 * MiB;
constexpr size_t WS_END = 2700 * MiB;
constexpr float QSCALE = 0.10206207261596575f * 1.4426950408889634f;

constexpr int CW_BAR = 4096, CW_PAN = 16384, CW_PTMO = 8192;

#define GAS __attribute__((address_space(1)))
#define LAS __attribute__((address_space(3)))
typedef unsigned short bf16;
typedef unsigned v4u __attribute__((ext_vector_type(4)));
typedef unsigned v2u __attribute__((ext_vector_type(2)));
typedef float f32x4 __attribute__((ext_vector_type(4)));
typedef float f32x2 __attribute__((ext_vector_type(2)));
typedef short bf16x8 __attribute__((ext_vector_type(8)));
#define LDS_WAIT() asm volatile("s_waitcnt lgkmcnt(0)" ::: "memory")
#define VM_WAIT() asm volatile("s_waitcnt vmcnt(0)" ::: "memory")
__device__ __forceinline__ unsigned f2bf(float f) { unsigned u = __builtin_bit_cast(unsigned, f); return (u + 0x7fffu + ((u >> 16) & 1u)) >> 16; }
__device__ __forceinline__ unsigned pk2(float lo, float hi) { return f2bf(lo) | (f2bf(hi) << 16); }
__device__ __forceinline__ float bflo(unsigned w) { return __builtin_bit_cast(float, w << 16); }
__device__ __forceinline__ float bfhi(unsigned w) { return __builtin_bit_cast(float, w & 0xffff0000u); }
__device__ __forceinline__ float bf2f(bf16 h) { return __builtin_bit_cast(float, (unsigned)h << 16); }
__device__ __forceinline__ float sigmoidf_(float x) { return __builtin_amdgcn_rcpf(1.0f + __builtin_amdgcn_exp2f(-1.4426950408889634f * x)); }
__device__ __forceinline__ float gelu_tanh(float x) { const float u = 1.5957691216057308f * (x + 0.044715f * x * x * x); return x * sigmoidf_(u); }
#define DPPF(x, ctrl) __builtin_bit_cast(float, __builtin_amdgcn_update_dpp(0, __builtin_bit_cast(int, (x)), (ctrl), 0xF, 0xF, false))
__device__ __forceinline__ float sum4(float v) { v += DPPF(v, 0xB1); v += DPPF(v, 0x4E); return v; }
__device__ __forceinline__ float sum8(float v) { v = sum4(v); v += DPPF(v, 0x141); return v; }
__device__ __forceinline__ float sum16(float v) { v = sum8(v); v += DPPF(v, 0x140); return v; }
__device__ __forceinline__ float rows_sum(float v) {
    auto r1 = __builtin_amdgcn_permlane16_swap(__float_as_uint(v), __float_as_uint(v), false, false); v = __uint_as_float(r1[0]) + __uint_as_float(r1[1]);
    auto r2 = __builtin_amdgcn_permlane32_swap(__float_as_uint(v), __float_as_uint(v), false, false); return __uint_as_float(r2[0]) + __uint_as_float(r2[1]); }
__device__ __forceinline__ float wave_sum(float v) { return rows_sum(sum16(v)); }

namespace pg8 {
#define PG8_LAS __attribute__((address_space(3)))
typedef unsigned short bf16_t;
typedef short bf16x8 __attribute__((ext_vector_type(8)));
typedef float f32x4 __attribute__((ext_vector_type(4)));
typedef unsigned u32x4 __attribute__((ext_vector_type(4)));
constexpr int BM = 256, BK = 64, HALF = 128, HTB = HALF * BK * 2, STAGE_BYTES = 8 * HTB, NXCD = 8, WGM = 8;

__host__ __device__ __forceinline__ int lds_byte(int r, int c) { const int st = (r >> 4) * 2 + (c >> 5), rr = r & 15, cc = c & 31, ob = rr * 64 + cc * 2; return st * 1024 + (ob ^ (((ob >> 9) & 1) << 5)); }
__host__ __device__ __forceinline__ void stage_rc(int b, int& R, int& C) { const int st = b / 1024, sb = b % 1024, swz = sb ^ (((sb >> 9) & 1) << 5); R = (st >> 1) * 16 + swz / 64; C = (st & 1) * 32 + (swz % 64) / 2; }
__host__ __device__ __forceinline__ int perm32(int rho) { const int n = rho >> 4, i = rho & 15; return 8 * (i >> 2) + 4 * n + (i & 3); }

struct Unit { int pm, pn, z, q; };
struct Gemm { const bf16_t* A; const bf16_t* Bt; int lda, ldb, K; size_t zA, zB; };

struct Order {
    int nM, nN, n, first, G, pm0, nQ;
    __device__ __forceinline__ void init(int nM_, int nN_, int nZ_, int G_, int c, int base, int pm0_ = 0, int nQ_ = 1) {
        nM = nM_; nN = nN_; n = nM_ * nN_ * nZ_ * nQ_; G = G_; pm0 = pm0_; nQ = nQ_;
        const int i0 = (base > c) ? (base - c + G_ - 1) / G_ : 0;
        first = c + i0 * G_ - base;
    }
    __device__ __forceinline__ bool next(int i, Unit& u) const {
        const long L = (long)first + (long)i * G; if (L >= n) return false;
        int w = (int)L; u.q = -1; if (nQ > 1) { u.q = w % nQ; w /= nQ; }
        const int per = nM * nN; u.z = w / per; int wgid = w % per;
        { const int q = per / NXCD, r = per % NXCD, xcd = wgid % NXCD, off = wgid / NXCD; wgid = (xcd < r ? xcd * (q + 1) : r * (q + 1) + (xcd - r) * q) + off; }
        const int nig = WGM * nN, gid = wgid / nig, fm = gid * WGM, gsz = (nM - fm) < WGM ? (nM - fm) : WGM;
        u.pm = pm0 + fm + ((wgid % nig) % gsz); u.pn = (wgid % nig) / gsz; return true;
    }
};

struct OrderSeq {
    Order a, b; int na;
    __device__ __forceinline__ void init(const Order& a_, const Order& b_, int n1, int G_, int c) { a = a_; b = b_; na = (n1 > c) ? (n1 - c + G_ - 1) / G_ : 0; }
    __device__ __forceinline__ bool next(int i, Unit& u) const { return (i < na) ? a.next(i, u) : b.next(i - na, u); }
};
__device__ __forceinline__ unsigned cvt_pk_bf16(float lo, float hi) { unsigned r; asm volatile("v_cvt_pk_bf16_f32 %0, %1, %2" : "=v"(r) : "v"(lo), "v"(hi)); return r; }

template <class Epi, bool ALIGN_EPI = true, bool SP2 = true, bool QUARTER = false, class Sched = Order>
__device__ __forceinline__ void gemm_phase(PG8_LAS unsigned char* lds, const Gemm g, const Sched& S, const Epi& E) {
    int tid = threadIdx.x; asm volatile("" : "+v"(tid));
    const int wid = __builtin_amdgcn_readfirstlane(tid >> 6), lane = tid & 63, wr = wid >> 2, wc = wid & 3, fr = lane & 15, fq = lane >> 4;
    int K = g.K; asm volatile("" : "+s"(K));
    const int nt = K / BK;
    unsigned voffA[2], voffB[2];
#pragma unroll
    for (int i = 0; i < 2; ++i) { int R, C; stage_rc(tid * 16 + i * 8192, R, C); const int Rb = Epi::PERM ? ((R & ~31) + perm32(R & 31)) : R;
        voffA[i] = (unsigned)(R * g.lda + C) * 2u; voffB[i] = (unsigned)(Rb * g.ldb + C) * 2u; }
    const size_t kstep = (size_t)(BK * 2);
    const size_t hstepA = (size_t)HALF * g.lda * 2, hstepB = (size_t)HALF * g.ldb * 2;
    const size_t tstepA = 2 * hstepA, tstepB = 2 * hstepB;
    const unsigned ldsw = (unsigned)wid * 1024u;
    const int aoff = lds_byte(wr * 64 + fr, fq * 8), boff = lds_byte(wc * 32 + fr, fq * 8);
#define PG8_SA(b, h) (((b) * 2 + (h)) * HTB)
#define PG8_SB(b, h) ((4 + (b) * 2 + (h)) * HTB)
#define PG8_STAGE(bufoff, gbase, voff) do { _Pragma("unroll") for (int _i = 0; _i < 2; ++_i) \
        __builtin_amdgcn_global_load_lds((const unsigned*)((const char*)(gbase) + (voff)[_i]), (PG8_LAS unsigned*)(lds + (bufoff) + ldsw + _i * 8192), 16, 0, 0); } while (0)
#define PG8_LDA(dst, b, h) do { _Pragma("unroll") for (int m = 0; m < 4; ++m) if (!QUARTER || m == cur.q) _Pragma("unroll") for (int k = 0; k < 2; ++k) dst[m][k] = *(const PG8_LAS bf16x8*)(lds + PG8_SA(b, h) + aoff + m * 2048 + k * 1024); } while (0)
#define PG8_LDB(dst, b, h) do { _Pragma("unroll") for (int n = 0; n < 2; ++n) _Pragma("unroll") for (int k = 0; k < 2; ++k) dst[n][k] = *(const PG8_LAS bf16x8*)(lds + PG8_SB(b, h) + boff + n * 2048 + k * 1024); } while (0)
#define PG8_MMA(ai, bj, At, Bt) do { __builtin_amdgcn_s_setprio(1); _Pragma("unroll") for (int m = 0; m < 4; ++m) if (!QUARTER || m == cur.q) _Pragma("unroll") for (int n = 0; n < 2; ++n) _Pragma("unroll") for (int k = 0; k < 2; ++k) \
        acc[ai][bj][m][n] = __builtin_amdgcn_mfma_f32_16x16x32_bf16(Bt[n][k], At[m][k], acc[ai][bj][m][n], 0, 0, 0); __builtin_amdgcn_s_setprio(0); } while (0)
#define PG8_WAIT_V(n) asm volatile("s_waitcnt vmcnt(" #n ")" ::: "memory")
#define PG8_WAIT_L(n) asm volatile("s_waitcnt lgkmcnt(" #n ")" ::: "memory")
#define PG8_BAR __builtin_amdgcn_s_barrier()
#define PG8_SCHED __builtin_amdgcn_sched_barrier(0)
    Unit cur, nxt; int ui = 0;
    if (!S.next(0, cur)) return;
    f32x4 acc[2][2][4][2];
#pragma unroll
    for (int a = 0; a < 2; ++a)
#pragma unroll
        for (int b = 0; b < 2; ++b)
#pragma unroll
            for (int m = 0; m < 4; ++m)
#pragma unroll
                for (int n = 0; n < 2; ++n) acc[a][b][m][n] = (f32x4){0.f, 0.f, 0.f, 0.f};
    bf16x8 At[4][2], B0[2][2], B1[2][2];
    const char* cA = (const char*)(g.A + (size_t)cur.z * g.zA) + (size_t)cur.pm * tstepA; const char* cB = (const char*)(g.Bt + (size_t)cur.z * g.zB) + (size_t)cur.pn * tstepB;
    if constexpr (SP2) {
        PG8_STAGE(PG8_SB(0, 0), cB, voffB); PG8_STAGE(PG8_SB(0, 1), cB + hstepB, voffB); PG8_STAGE(PG8_SA(0, 0), cA, voffA); PG8_STAGE(PG8_SA(0, 1), cA + hstepA, voffA);
        if (wr == 1) PG8_BAR;
        PG8_WAIT_V(2); PG8_BAR;
        PG8_STAGE(PG8_SB(1, 0), cB + kstep, voffB); PG8_STAGE(PG8_SA(1, 0), cA + kstep, voffA); PG8_STAGE(PG8_SB(1, 1), cB + hstepB + kstep, voffB);
        PG8_WAIT_V(6); PG8_BAR;
    } else {
        PG8_STAGE(PG8_SB(0, 0), cB, voffB); PG8_STAGE(PG8_SA(0, 0), cA, voffA); PG8_STAGE(PG8_SB(0, 1), cB + hstepB, voffB); PG8_STAGE(PG8_SA(0, 1), cA + hstepA, voffA);
        if (wr == 1) PG8_BAR;
        PG8_WAIT_V(4); PG8_BAR;
        PG8_STAGE(PG8_SB(1, 0), cB + kstep, voffB); PG8_STAGE(PG8_SA(1, 0), cA + kstep, voffA); PG8_STAGE(PG8_SB(1, 1), cB + hstepB + kstep, voffB);
        PG8_WAIT_V(6); PG8_BAR;
    }
    for (;;) {
        const bool has_next = S.next(ui + 1, nxt);
        const char* nA = has_next ? (const char*)(g.A + (size_t)nxt.z * g.zA) + (size_t)nxt.pm * tstepA : cA; const char* nB = has_next ? (const char*)(g.Bt + (size_t)nxt.z * g.zB) + (size_t)nxt.pn * tstepB : cB;
        for (int t = 0; t < nt; t += 2) {
            const bool last = (t == nt - 2);
            const char* a1 = cA + (size_t)(t + 1) * kstep;
            const char* a2 = last ? nA : cA + (size_t)(t + 2) * kstep; const char* b2 = last ? nB : cB + (size_t)(t + 2) * kstep;
            const char* a3 = a2 + kstep; const char* b3 = b2 + kstep;
            if constexpr (SP2) {
            PG8_LDB(B0, 0, 0); PG8_LDB(B1, 0, 1); PG8_SCHED; PG8_LDA(At, 0, 0); PG8_STAGE(PG8_SA(1, 1), a1 + hstepA, voffA);
            PG8_WAIT_V(8); PG8_WAIT_L(0); PG8_BAR; PG8_MMA(0, 0, At, B0); PG8_MMA(0, 1, At, B1); PG8_BAR; PG8_SCHED;
            PG8_LDA(At, 0, 1); PG8_STAGE(PG8_SB(0, 0), b2, voffB); PG8_STAGE(PG8_SB(0, 1), b2 + hstepB, voffB); PG8_STAGE(PG8_SA(0, 0), a2, voffA);
            PG8_WAIT_V(8); PG8_WAIT_L(0); PG8_BAR; PG8_MMA(1, 0, At, B0); PG8_MMA(1, 1, At, B1); PG8_BAR; PG8_SCHED;
            PG8_LDB(B0, 1, 0); PG8_LDB(B1, 1, 1); PG8_SCHED; PG8_LDA(At, 1, 0); PG8_STAGE(PG8_SA(0, 1), a2 + hstepA, voffA);
            PG8_WAIT_V(8); PG8_WAIT_L(0); PG8_BAR; PG8_MMA(0, 0, At, B0); PG8_MMA(0, 1, At, B1); PG8_BAR; PG8_SCHED;
            PG8_LDA(At, 1, 1); PG8_STAGE(PG8_SB(1, 0), b3, voffB); PG8_STAGE(PG8_SB(1, 1), b3 + hstepB, voffB); PG8_STAGE(PG8_SA(1, 0), a3, voffA);
            PG8_WAIT_V(8); PG8_WAIT_L(0); PG8_BAR; PG8_MMA(1, 0, At, B0); PG8_MMA(1, 1, At, B1); PG8_BAR; PG8_SCHED;
            } else {
            PG8_LDB(B0, 0, 0); PG8_SCHED; PG8_LDA(At, 0, 0); PG8_STAGE(PG8_SA(1, 1), a1 + hstepA, voffA);
            PG8_WAIT_L(8); PG8_BAR; PG8_WAIT_L(0); PG8_MMA(0, 0, At, B0); PG8_BAR; PG8_SCHED;
            PG8_LDB(B1, 0, 1); PG8_STAGE(PG8_SB(0, 0), b2, voffB);
            PG8_BAR; PG8_WAIT_L(0); PG8_MMA(0, 1, At, B1); PG8_BAR;
            PG8_LDA(At, 0, 1); PG8_STAGE(PG8_SA(0, 0), a2, voffA);
            PG8_BAR; PG8_WAIT_L(0); PG8_MMA(1, 0, At, B0); PG8_BAR; PG8_SCHED;
            PG8_STAGE(PG8_SB(0, 1), b2 + hstepB, voffB);
            PG8_WAIT_V(6); PG8_BAR; PG8_MMA(1, 1, At, B1); PG8_BAR;
            PG8_LDB(B0, 1, 0); PG8_SCHED; PG8_LDA(At, 1, 0); PG8_STAGE(PG8_SA(0, 1), a2 + hstepA, voffA);
            PG8_WAIT_L(8); PG8_BAR; PG8_WAIT_L(0); PG8_MMA(0, 0, At, B0); PG8_BAR; PG8_SCHED;
            PG8_LDB(B1, 1, 1); PG8_STAGE(PG8_SB(1, 0), b3, voffB);
            PG8_BAR; PG8_WAIT_L(0); PG8_MMA(0, 1, At, B1); PG8_BAR;
            PG8_LDA(At, 1, 1); PG8_STAGE(PG8_SA(1, 0), a3, voffA);
            PG8_BAR; PG8_WAIT_L(0); PG8_MMA(1, 0, At, B0); PG8_BAR; PG8_SCHED;
            PG8_STAGE(PG8_SB(1, 1), b3 + hstepB, voffB);
            PG8_WAIT_V(6); PG8_BAR; PG8_MMA(1, 1, At, B1); PG8_BAR;
            }
        }
        if constexpr (ALIGN_EPI) { if (wr == 0) PG8_BAR; }
        E(acc, cur, wr, wc, fr, fq);
        if (!has_next) break;
#pragma unroll
        for (int a = 0; a < 2; ++a)
#pragma unroll
            for (int b = 0; b < 2; ++b)
#pragma unroll
                for (int m = 0; m < 4; ++m)
#pragma unroll
                    for (int n = 0; n < 2; ++n) acc[a][b][m][n] = (f32x4){0.f, 0.f, 0.f, 0.f};
        cur = nxt; cA = nA; cB = nB; ++ui;
        if constexpr (ALIGN_EPI) { if (wr == 1) PG8_BAR; }
    }
    PG8_WAIT_V(0);
    if constexpr (!ALIGN_EPI) { if (wr == 0) PG8_BAR; }
    PG8_BAR;
#undef PG8_SA
#undef PG8_SB
#undef PG8_STAGE
#undef PG8_LDA
#undef PG8_LDB
#undef PG8_MMA
#undef PG8_WAIT_V
#undef PG8_WAIT_L
#undef PG8_BAR
#undef PG8_SCHED
}

template <class F> struct EpiRow8 {
    static constexpr bool PERM = true;
    F f;
    __device__ __forceinline__ void operator()(const f32x4 (&acc)[2][2][4][2], const Unit& u, int wr, int wc, int fr, int fq) const {
        const int row0 = u.pm * BM + wr * 64 + fr, col0 = u.pn * BM + wc * 32 + 8 * fq;
#pragma unroll
        for (int ai = 0; ai < 2; ++ai)
#pragma unroll
            for (int m = 0; m < 4; ++m) { if (u.q >= 0 && m != u.q) continue;
#pragma unroll
                for (int bj = 0; bj < 2; ++bj) f(u, row0 + ai * HALF + m * 16, col0 + bj * HALF, acc[ai][bj][m][0], acc[ai][bj][m][1]); }
    }
};
template <class F> struct EpiPair8 {
    static constexpr bool PERM = true;
    F f;
    __device__ __forceinline__ void operator()(const f32x4 (&acc)[2][2][4][2], const Unit& u, int wr, int wc, int fr, int fq) const {
        const int row0 = u.pm * BM + wr * 64 + fr, cp = u.pn * HALF + wc * 32 + 8 * fq;
#pragma unroll
        for (int ai = 0; ai < 2; ++ai)
#pragma unroll
            for (int m = 0; m < 4; ++m) { if (u.q >= 0 && m != u.q) continue; f(u, row0 + ai * HALF + m * 16, cp, acc[ai][0][m][0], acc[ai][0][m][1], acc[ai][1][m][0], acc[ai][1][m][1]); }
    }
};
}
using pg8::cvt_pk_bf16;
__device__ __forceinline__ v4u pack8(f32x4 a, f32x4 b) { v4u w; w.x = cvt_pk_bf16(a[0], a[1]); w.y = cvt_pk_bf16(a[2], a[3]); w.z = cvt_pk_bf16(b[0], b[1]); w.w = cvt_pk_bf16(b[2], b[3]); return w; }

__device__ __forceinline__ void unpack8(v4u w, float (&f)[8]) { f[0] = bflo(w.x); f[1] = bfhi(w.x); f[2] = bflo(w.y); f[3] = bfhi(w.y); f[4] = bflo(w.z); f[5] = bfhi(w.z); f[6] = bflo(w.w); f[7] = bfhi(w.w); }
__device__ __forceinline__ int pg8_opq(int x) { asm volatile("" : "+v"(x)); return x; }
template <bool BASE_BF16> struct EpiResid {
    static constexpr bool PERM = true;
    const float* xp; const float* xs;
    const bf16* xb;
    bf16* XO; float* SS;
    __device__ __forceinline__ void operator()(const pg8::f32x4 (&acc)[2][2][4][2], const pg8::Unit& u, int wr, int wc, int fr_, int fq_) const {
        const int fr = pg8_opq(fr_), fq = pg8_opq(fq_);
        const int row0 = u.pm * 256 + wr * 64 + fr, col0 = u.pn * 256 + wc * 32 + 8 * fq;
#pragma unroll
        for (int ai = 0; ai < 2; ++ai)
#pragma unroll
            for (int m = 0; m < 4; ++m) { if (u.q >= 0 && m != u.q) continue;
                const int row = row0 + ai * 128 + m * 16;
                float ss = 0.f;
#pragma unroll
                for (int bj = 0; bj < 2; ++bj) {
                    const int col = col0 + bj * 128; f32x4 x0, x1;
                    if (BASE_BF16) { float f[8]; unpack8(*(const GAS v4u*)(xb + (size_t)row * D + col), f); x0 = (f32x4){f[0], f[1], f[2], f[3]}; x1 = (f32x4){f[4], f[5], f[6], f[7]}; }
                    else { const float* br = (row < MP) ? xp + (size_t)row * D : xs + (size_t)(row - MP) * D; x0 = *(const GAS f32x4*)(br + col); x1 = *(const GAS f32x4*)(br + col + 4); }
                    x0 += acc[ai][bj][m][0]; x1 += acc[ai][bj][m][1];
                    ss += (x0[0] * x0[0] + x0[1] * x0[1]) + (x0[2] * x0[2] + x0[3] * x0[3]) + (x1[0] * x1[0] + x1[1] * x1[1]) + (x1[2] * x1[2] + x1[3] * x1[3]);
                    *(GAS v4u*)(XO + (size_t)row * D + col) = pack8(x0, x1);
                }
                ss = rows_sum(ss);
                if (fq == 0) SS[(size_t)row * 16 + u.pn * 4 + wc] = ss;
            }
    }
};
__device__ __forceinline__ float row_rs(const float* SS, int row) {
    const f32x4 a = *(const GAS f32x4*)(SS + (size_t)row * 16), b = *(const GAS f32x4*)(SS + (size_t)row * 16 + 4), c = *(const GAS f32x4*)(SS + (size_t)row * 16 + 8), d = *(const GAS f32x4*)(SS + (size_t)row * 16 + 12);
    const float s = ((a[0] + a[1]) + (a[2] + a[3])) + ((b[0] + b[1]) + (b[2] + b[3])) + ((c[0] + c[1]) + (c[2] + c[3])) + ((d[0] + d[1]) + (d[2] + d[3]));
    return 1.0f / sqrtf(s * (1.f / D) + EPS);
}
struct EpiUp {
    static constexpr bool PERM = true;
    const float* SS; bf16* UPB;
    __device__ __forceinline__ void operator()(const pg8::f32x4 (&acc)[2][2][4][2], const pg8::Unit& u, int wr, int wc, int fr, int fq) const {
        const int row0 = u.pm * 256 + wr * 64 + fr, col0 = u.pn * 256 + wc * 32 + 8 * fq;
#pragma unroll
        for (int ai = 0; ai < 2; ++ai)
#pragma unroll
            for (int m = 0; m < 4; ++m) { if (u.q >= 0 && m != u.q) continue; const int row = row0 + ai * 128 + m * 16; const float rs = row_rs(SS, row);
#pragma unroll
                for (int bj = 0; bj < 2; ++bj) *(GAS v4u*)(UPB + (size_t)row * UPW + col0 + bj * 128) = pack8(acc[ai][bj][m][0] * rs, acc[ai][bj][m][1] * rs); }
    }
};

__device__ __forceinline__ float dpp_ror1(float x) { return __builtin_bit_cast(float, __builtin_amdgcn_update_dpp(0, __builtin_bit_cast(int, x), 0x121, 0xF, 0xF, false)); }
__device__ __forceinline__ float dpp_ror2(float x) { return __builtin_bit_cast(float, __builtin_amdgcn_update_dpp(0, __builtin_bit_cast(int, x), 0x122, 0xF, 0xF, false)); }
struct EpiUpConv {
    static constexpr bool PERM = true;
    const float* SS; bf16* HB; bf16* UPF; bf16* UPL; float* out; const float* conv_w; const float* conv_b; const float* state_conv; LAS unsigned char* scr; unsigned* cnt;
    template <bool SAMPLE> __device__ __forceinline__ void body(const pg8::f32x4 (&acc)[2][2][4][2], const pg8::Unit& u, int wr, int fr, int cl0_, int acol0, LAS float* CW, LAS float* BD, LAS float* RSL) const {
#pragma unroll
        for (int ai = 0; ai < 2; ++ai)
#pragma unroll
            for (int m = 0; m < 4; ++m) {
                const int fro = pg8_opq(fr), cl0 = pg8_opq(cl0_);
                const int rl = ai * 128 + wr * 64 + m * 16 + fro, row = u.pm * 256 + rl; const float rs = RSL[rl];
#pragma unroll
                for (int n = 0; n < 2; ++n) {
                    f32x4 cv2[2];
#pragma unroll
                    for (int bj = 0; bj < 2; ++bj) {
                        const int cl = bj * 128 + cl0 + 4 * n, gcol = bj * DFF + acol0 + cl0 + 4 * n; const f32x4 x = acc[ai][bj][m][n] * rs;
                        f32x4 s1, s2;
#pragma unroll
                        for (int i = 0; i < 4; ++i) { s1[i] = dpp_ror1(x[i]); s2[i] = dpp_ror2(x[i]); }
                        if (SAMPLE) { const int t = fro & 3; const float* sp = state_conv + (size_t)((row - MP) >> 2) * 2 * UPW + gcol;
                            const f32x4 S0 = *(const GAS f32x4*)sp, S1 = *(const GAS f32x4*)(sp + UPW);
#pragma unroll
                            for (int i = 0; i < 4; ++i) { s1[i] = (t >= 1) ? s1[i] : S1[i]; s2[i] = (t >= 2) ? s2[i] : (t == 1 ? S1[i] : S0[i]); }
                            if (t >= 2) *(GAS f32x4*)(out + O_CVS + ((size_t)((row - MP) >> 2) * 2 + (t - 2)) * UPW + gcol) = x;
                        } else if (m > 0) { const f32x4 xp = acc[ai][bj][m > 0 ? m - 1 : 0][n] * RSL[rl - 16];
#pragma unroll
                            for (int i = 0; i < 4; ++i) { s1[i] = dpp_ror1(fro == 15 ? xp[i] : x[i]); s2[i] = dpp_ror2(fro >= 14 ? xp[i] : x[i]); }
                        } else { const int pb = (wr == 1) ? ai * 2 : 1;
                            const int pr0 = (pb >> 1) * 128 + (pb & 1) * 64 + 62;
                            const f32x4 b2 = *(const LAS f32x4*)(BD + (pb * 2 + 0) * 256 + cl) * RSL[pr0], b1 = *(const LAS f32x4*)(BD + (pb * 2 + 1) * 256 + cl) * RSL[pr0 + 1];
#pragma unroll
                            for (int i = 0; i < 4; ++i) { s1[i] = (fro >= 1) ? s1[i] : b1[i]; s2[i] = (fro >= 2) ? s2[i] : (fro == 1 ? b1[i] : b2[i]); }
                        }
                        const f32x4 w0 = *(const LAS f32x4*)(CW + cl), w1 = *(const LAS f32x4*)(CW + 256 + cl), w2 = *(const LAS f32x4*)(CW + 512 + cl), cb = *(const LAS f32x4*)(CW + 768 + cl);
                        cv2[bj] = cb + s2 * w0 + s1 * w1 + x * w2;
                        if (!SAMPLE && ai == 0 && m == 0) { if (rl < 2) { v2u w; w.x = cvt_pk_bf16(x[0], x[1]); w.y = cvt_pk_bf16(x[2], x[3]); *(GAS v2u*)(UPF + ((size_t)u.pm * 2 + rl) * UPW + gcol) = w; } }
                        if (!SAMPLE && ai == 1 && m == 3) { if (rl >= 254) { v2u w; w.x = cvt_pk_bf16(x[0], x[1]); w.y = cvt_pk_bf16(x[2], x[3]); *(GAS v2u*)(UPL + ((size_t)u.pm * 2 + (rl - 254)) * UPW + gcol) = w;
                                if ((u.pm & 31) == 31) *(GAS f32x4*)(out + O_CVP + ((size_t)(u.pm >> 5) * 2 + (rl - 254)) * UPW + gcol) = x; } }
                    }
                    if (SAMPLE || rl >= 2) { v2u w; w.x = cvt_pk_bf16(gelu_tanh(cv2[0][0]) * cv2[1][0], gelu_tanh(cv2[0][1]) * cv2[1][1]); w.y = cvt_pk_bf16(gelu_tanh(cv2[0][2]) * cv2[1][2], gelu_tanh(cv2[0][3]) * cv2[1][3]);
                        if (SAMPLE) asm volatile("global_store_dwordx2 %0, %1, off sc1" :: "v"(HB + (size_t)row * DFF + acol0 + cl0 + 4 * n), "v"(w) : "memory");
                        else *(GAS v2u*)(HB + (size_t)row * DFF + acol0 + cl0 + 4 * n) = w; }
                    asm volatile("" ::: "memory"); __builtin_amdgcn_sched_barrier(0);
                }
            }
    }
    __device__ __forceinline__ void operator()(const pg8::f32x4 (&acc)[2][2][4][2], const pg8::Unit& u, int wr, int wc, int fr_, int fq_) const {
        const int tid = pg8_opq(threadIdx.x), fr = pg8_opq(fr_), fq = pg8_opq(fq_);
        LAS float* CW = (LAS float*)scr;
        LAS float* BD = CW + 1024;
        const int acol0 = u.pn * 128, cl0_ = wc * 32 + 8 * fq;
        for (int e = tid; e < 1024; e += 512) { const int k = e >> 8, cl = e & 255, gcol = (cl >> 7) * DFF + acol0 + (cl & 127); CW[e] = (k < 3) ? conv_w[k * UPW + gcol] : conv_b[gcol]; }
        LAS float* RSL = BD + 2048;
        if (tid < 256) RSL[tid] = row_rs(SS, u.pm * 256 + tid);
        if (fr >= 14) {
#pragma unroll
            for (int ai = 0; ai < 2; ++ai)
#pragma unroll
                for (int bj = 0; bj < 2; ++bj)
#pragma unroll
                    for (int n = 0; n < 2; ++n) *(LAS f32x4*)(BD + ((ai * 2 + wr) * 2 + (fr - 14)) * 256 + bj * 128 + cl0_ + 4 * n) = acc[ai][bj][3][n];
        }
        asm volatile("s_waitcnt vmcnt(0) lgkmcnt(0)" ::: "memory"); __builtin_amdgcn_s_barrier(); asm volatile("" ::: "memory");
        if (u.pm >= MP / 256) { body<true>(acc, u, wr, fr, cl0_, acol0, CW, BD, RSL);
            asm volatile("s_waitcnt vmcnt(0)" ::: "memory"); if ((tid & 63) == 0) __hip_atomic_fetch_add(cnt + 64 * u.pm, 1u, __ATOMIC_RELAXED, __HIP_MEMORY_SCOPE_AGENT); }
        else body<false>(acc, u, wr, fr, cl0_, acol0, CW, BD, RSL);
        asm volatile("s_waitcnt lgkmcnt(0)" ::: "memory"); __builtin_amdgcn_s_barrier(); asm volatile("" ::: "memory");
    }
};
struct EpiPle {
    static constexpr bool PERM = true;
    const float* SS; const bf16* X2B; const bf16* PPB; float* Y;
    __device__ __forceinline__ void operator()(const pg8::f32x4 (&acc)[2][2][4][2], const pg8::Unit& u, int wr, int wc, int fr, int fq) const {
        const int row0 = u.pm * 256 + wr * 64 + fr, col0 = u.pn * 256 + wc * 32 + 8 * fq;
#pragma unroll
        for (int ai = 0; ai < 2; ++ai)
#pragma unroll
            for (int m = 0; m < 4; ++m) { if (u.q >= 0 && m != u.q) continue; const int row = row0 + ai * 128 + m * 16; const float rs = row_rs(SS, row);
#pragma unroll
                for (int bj = 0; bj < 2; ++bj) { const int col = col0 + bj * 128; const size_t o = (size_t)row * D + col;
                    float pw[8], xw[8]; unpack8(*(const GAS v4u*)(PPB + o), pw); unpack8(*(const GAS v4u*)(X2B + o), xw);
                    const f32x4 a = acc[ai][bj][m][0] * rs, b = acc[ai][bj][m][1] * rs; f32x4 y0, y1;
#pragma unroll
                    for (int i = 0; i < 4; ++i) { y0[i] = xw[i] + sigmoidf_(a[i]) * pw[i]; y1[i] = xw[4 + i] + sigmoidf_(b[i]) * pw[4 + i]; }
                    *(GAS f32x4*)(Y + o) = y0; *(GAS f32x4*)(Y + o + 4) = y1; } }
    }
};


struct EpiInproj {
    static constexpr bool PERM = true;
    bf16* Zp; bf16* CQNp; bf16* CKVNp; bf16* AYp; float* out; const float* g_ckv; LAS unsigned char* scr;
    __device__ __forceinline__ void operator()(const pg8::f32x4 (&acc)[2][2][4][2], const pg8::Unit& u, int wr, int wc, int fr, int fq) const {
        const int row0 = u.pm * 256 + wr * 64 + fr, colw = wc * 32 + 8 * fq;
        if (u.pn == 0) {
            LAS float* part = (LAS float*)scr;
#pragma unroll
            for (int ai = 0; ai < 2; ++ai)
#pragma unroll
                for (int m = 0; m < 4; ++m) { float ss = 0.f;
#pragma unroll
                    for (int bj = 0; bj < 2; ++bj)
#pragma unroll
                        for (int n = 0; n < 2; ++n) { const f32x4 v = acc[ai][bj][m][n]; ss += (v[0] * v[0] + v[1] * v[1]) + (v[2] * v[2] + v[3] * v[3]); }
                    ss = rows_sum(ss);
                    if (fq == 0) part[(ai * 128 + wr * 64 + m * 16 + fr) * 4 + wc] = ss; }
            asm volatile("s_waitcnt lgkmcnt(0)" ::: "memory"); __builtin_amdgcn_s_barrier(); asm volatile("" ::: "memory");
#pragma unroll
            for (int ai = 0; ai < 2; ++ai)
#pragma unroll
                for (int m = 0; m < 4; ++m) { const int rl = ai * 128 + wr * 64 + m * 16 + fr, row = u.pm * 256 + rl; const f32x4 p = *(const LAS f32x4*)(part + rl * 4);
                    const float rs = 1.0f / sqrtf(((p[0] + p[1]) + (p[2] + p[3])) * (1.f / KVL) + EPS);
                    float* dst = (row < MP) ? out + O_CKVP + (size_t)row * KVL : out + O_CKVS + (size_t)(row - MP) * KVL;
#pragma unroll
                    for (int bj = 0; bj < 2; ++bj) { const int col = colw + bj * 128; const f32x4 g0 = *(const GAS f32x4*)(g_ckv + col), g1 = *(const GAS f32x4*)(g_ckv + col + 4);
                        const f32x4 o0 = acc[ai][bj][m][0] * rs * g0, o1 = acc[ai][bj][m][1] * rs * g1;
                        *(GAS f32x4*)(dst + col) = o0; *(GAS f32x4*)(dst + col + 4) = o1; *(GAS v4u*)(CKVNp + (size_t)row * KVL + col) = pack8(o0, o1); } }
            asm volatile("s_waitcnt lgkmcnt(0)" ::: "memory"); __builtin_amdgcn_s_barrier(); asm volatile("" ::: "memory");
            return;
        }
#pragma unroll
        for (int ai = 0; ai < 2; ++ai)
#pragma unroll
            for (int m = 0; m < 4; ++m) { const int row = row0 + ai * 128 + m * 16;
#pragma unroll
                for (int bj = 0; bj < 2; ++bj) { const int col = u.pn * 256 + colw + bj * 128; f32x4 a = acc[ai][bj][m][0], b = acc[ai][bj][m][1];
                    if (u.pn <= 2) {
                        if (col < ZC_KR) *(GAS v4u*)(CQNp + (size_t)row * QL + (col - ZC_CQ)) = pack8(a, b);
                        else if (col < ZC_KR + QKR) { float* dst = ((row < MP) ? out + O_KRP + (size_t)row * QKR : out + O_KRS + (size_t)(row - MP) * QKR) + (col - ZC_KR); *(GAS f32x4*)dst = a; *(GAS f32x4*)(dst + 4) = b; }
                    } else if (u.pn <= 4) {
                        const v4u w = pack8(a, b); const int c = col - ZC_U;
                        if (row < MP) *(GAS v4u*)(AYp + ((size_t)(c >> 4) * SCH + (row >> 5)) * SKA + (row & 31) * GRP + (c & 15)) = w;
                        else *(GAS v4u*)(Zp + (size_t)row * NZ + col) = w;
                    } else {
#pragma unroll
                        for (int i = 0; i < 4; ++i) { a[i] = sigmoidf_(a[i]); b[i] = sigmoidf_(b[i]); }
                        *(GAS v4u*)(Zp + (size_t)row * NZ + col) = pack8(a, b);
                    } } }
    }
};

#define XB_TMO      128
#define XB_XCNT(j)  (256  + 64 * (j))
#define XB_XSUB(j)  (1280 + 64 * (j))
#define XB_XGEN(j)  (2304 + 64 * (j))
#define XB_TOP      3328
#define XB_TOPGEN   3392
#define XCD_BAR_WORDS 3456
#define XB_SPIN_CAP (1u << 18)
__device__ __forceinline__ unsigned xb_ld(unsigned* p)              { return __hip_atomic_load(p, __ATOMIC_RELAXED, __HIP_MEMORY_SCOPE_AGENT); }
__device__ __forceinline__ unsigned xb_add(unsigned* p, unsigned v) { return __hip_atomic_fetch_add(p, v, __ATOMIC_RELAXED, __HIP_MEMORY_SCOPE_AGENT); }
__device__ __forceinline__ unsigned xb_xcc_id() { return (unsigned)__builtin_amdgcn_s_getreg((3 << 11) | 20) & 0xFu; }
#define XB_SPIN(cond, bar) do { unsigned _sp = 0; while (cond) { __builtin_amdgcn_s_sleep(1); \
    if ((++_sp & 255u) == 0u) { if (xb_ld(&(bar)[XB_TMO])) break; if (_sp > XB_SPIN_CAP) { atomicAdd(&(bar)[XB_TMO], 1u); break; } } } } while (0)
struct XcdBarrier { unsigned* bar; unsigned x; volatile LAS unsigned* st; };
__device__ __forceinline__ XcdBarrier xcd_barrier_post(unsigned* bar, volatile LAS unsigned* st) {
    XcdBarrier b; b.bar = bar; b.x = xb_xcc_id(); b.st = st;
    if (threadIdx.x == 0) (void)xb_add(&bar[XB_XCNT(b.x)], 1u);
    return b;
}
__device__ __forceinline__ void xcd_barrier_complete(unsigned* bar, unsigned x, unsigned& nloc, unsigned& nx) {
    const unsigned G = gridDim.x * gridDim.y * gridDim.z;
    unsigned sum, cnt, mine, sp = 0u;
    for (;;) {
        sum = 0u; cnt = 0u; mine = 0u;
#pragma unroll
        for (unsigned j = 0; j < 16; ++j) { const unsigned c = xb_ld(&bar[XB_XCNT(j)]); sum += c; cnt += (c > 0u) ? 1u : 0u; mine = (j == x) ? c : mine; }
        if (sum == G) break;
        __builtin_amdgcn_s_sleep(1);
        if ((++sp & 255u) == 0u) { if (xb_ld(&bar[XB_TMO])) break; if (sp > XB_SPIN_CAP) { atomicAdd(&bar[XB_TMO], 1u); break; } }
    }
    nloc = mine > 0u ? mine : 1u; nx = cnt > 0u ? cnt : 1u;
}
__device__ __forceinline__ void xcd_barrier(const XcdBarrier& b) {
    asm volatile("s_waitcnt vmcnt(0)" ::: "memory");
    __syncthreads();
    if (threadIdx.x == 0) {
        unsigned* bar = b.bar;
        __builtin_amdgcn_s_waitcnt(0);
        unsigned nloc = b.st[0], nx = b.st[1];
        if (nloc == 0u) { xcd_barrier_complete(bar, b.x, nloc, nx); b.st[0] = nloc; b.st[1] = nx; }
        const unsigned old = xb_add(&bar[XB_XSUB(b.x)], 1u);
        const unsigned gen = old / nloc;
        if (old + 1u == (gen + 1u) * nloc) {
            __builtin_amdgcn_fence(__ATOMIC_RELEASE, "agent");
            asm volatile("s_waitcnt vmcnt(0)" ::: "memory");
            const unsigned og = xb_add(&bar[XB_TOP], 1u);
            const unsigned tg = og / nx;
            if (og + 1u == (tg + 1u) * nx) xb_add(&bar[XB_TOPGEN], 1u);
            else XB_SPIN(xb_ld(&bar[XB_TOPGEN]) == tg, bar);
            __builtin_amdgcn_fence(__ATOMIC_ACQUIRE, "agent");
            xb_add(&bar[XB_XGEN(b.x)], 1u);
            asm volatile("s_waitcnt vmcnt(0)" ::: "memory");
        } else {
            XB_SPIN(xb_ld(&bar[XB_XGEN(b.x)]) == gen, bar);
            __builtin_amdgcn_fence(__ATOMIC_ACQUIRE, "agent");
            asm volatile("s_waitcnt vmcnt(0)" ::: "memory");
        }
    }
    __syncthreads();
}

constexpr int NWAVES = 8;
constexpr int RING_OFF = 0, RING_BYTES = 159744;
constexpr int LDSCTL_OFF = RING_BYTES, MISC_OFF = LDSCTL_OFF + 320;
constexpr int LDS_BYTES = 163840;

struct Args { const void* in[39]; float* out; unsigned char* ws; int ph_lo, ph_hi; };
static_assert(sizeof(Args) == 39 * 8 + 8 + 8 + 8, "Args has no padding");

__device__ __forceinline__ void tr_item(const float* W, int ldw, int k0, int n0s, bf16* WT, int ldt, int n0d, LAS float* scr, int lane, const float* kg = nullptr) {
    if (W) {
        f32x4 v[8];
#pragma unroll
        for (int i = 0; i < 8; ++i) v[i] = *(const GAS f32x4*)(W + (size_t)(k0 + (lane >> 3) + 8 * i) * ldw + n0s + (lane & 7) * 4);
#pragma unroll
        for (int i = 0; i < 8; ++i) { LAS float* d = scr + ((lane >> 3) + 8 * i) * 33 + (lane & 7) * 4; const float gk = kg ? kg[k0 + (lane >> 3) + 8 * i] : 1.0f; d[0] = v[i].x * gk; d[1] = v[i].y * gk; d[2] = v[i].z * gk; d[3] = v[i].w * gk; }
    } else {
#pragma unroll 8
        for (int i = 0; i < 32; ++i) { const int kk = 2 * i + (lane >> 5); scr[kk * 33 + (lane & 31)] = 0.f; }
    }
    LDS_WAIT(); asm volatile("" ::: "memory");
    const int c = lane & 7;
#pragma unroll
    for (int j = 0; j < 4; ++j) { const int n = (lane >> 3) + 8 * j; const LAS float* s = scr + (8 * c) * 33 + n;
        v4u o; o.x = pk2(s[0 * 33], s[1 * 33]); o.y = pk2(s[2 * 33], s[3 * 33]); o.z = pk2(s[4 * 33], s[5 * 33]); o.w = pk2(s[6 * 33], s[7 * 33]);
        *(GAS v4u*)(WT + (size_t)(n0d + n) * ldt + k0 + 8 * c) = o; }
    LDS_WAIT(); asm volatile("" ::: "memory");
}
__device__ __forceinline__ void tr_plain(const float* W, int K, int N, bf16* WT, int it, LAS float* scr, int lane, const float* kg = nullptr) {
    const int nblk = N / 32, kb = it / nblk, nb = it % nblk;
    tr_item(W, N, 64 * kb, 32 * nb, WT, K, 32 * nb, scr, lane, kg);
}

__device__ __forceinline__ void glds16(const void* gsrc, unsigned lds_dst) { unsigned keep;
    asm volatile("s_mov_b32 %0, m0\n\ts_mov_b32 m0, %2\n\ts_nop 0\n\tglobal_load_lds_dwordx4 %1, off\n\ts_mov_b32 m0, %0" : "=&s"(keep) : "v"(gsrc), "s"(lds_dst) : "memory"); }
__device__ __forceinline__ int opq(int x) { asm volatile("" : "+v"(x)); return x; }
namespace pa {
typedef float f32x16 __attribute__((ext_vector_type(16)));
typedef short s16x4 __attribute__((ext_vector_type(4)));
constexpr int KSLOT = 12288, VSLOT = 8192, SLOT = KSLOT + VSLOT;
__device__ __forceinline__ int crow(int r, int hi) { return (r & 3) + 8 * (r >> 2) + 4 * hi; }
__device__ __forceinline__ s16x4 vtr(const LAS unsigned char* p) { return __builtin_bit_cast(s16x4, __builtin_amdgcn_ds_read_tr16_b64_v4i16((LAS s16x4*)p)); }
__device__ __forceinline__ float swap_max(float v) { auto rr = __builtin_amdgcn_permlane32_swap(__float_as_uint(v), __float_as_uint(v), false, false); return fmaxf(__uint_as_float(rr[0]), __uint_as_float(rr[1])); }
__device__ __forceinline__ float swap_sum(float v) { auto rr = __builtin_amdgcn_permlane32_swap(__float_as_uint(v), __float_as_uint(v), false, false); return __uint_as_float(rr[0]) + __uint_as_float(rr[1]); }

__device__ __forceinline__ void issue_tile(const bf16* Kg, const bf16* Vg, LAS unsigned char* slot, int kv0, int wave, int lane) {
    const unsigned s0 = (unsigned)(uintptr_t)slot;
    { const bf16* src = Kg + (size_t)(kv0 + lane) * 768 + wave * 8;
      glds16(src, (unsigned)__builtin_amdgcn_readfirstlane(s0 + wave * 1024));
      if (wave < 4) glds16(src + 64, (unsigned)__builtin_amdgcn_readfirstlane(s0 + (8 + wave) * 1024)); }
    { const bf16* src = Vg + (size_t)(kv0 + 16 * (wave & 3) + (lane >> 2)) * 1024 + (wave >> 2) * 32 + (lane & 3) * 8;
      glds16(src, (unsigned)__builtin_amdgcn_readfirstlane(s0 + KSLOT + wave * 1024)); }
}

__device__ __forceinline__ void attn_unit(const bf16* Q, const bf16* K, const bf16* V, bf16* O, int b, int h, int qb, float sref, LAS unsigned char* lds, int wave, int lane_) {
    const int lane = opq(lane_), r32 = lane & 31, hi = lane >> 5;
    const size_t rowbase = (size_t)b * SEQ; const int q0 = qb * 256, qw = q0 + wave * 32;
    const bf16* Kg = K + rowbase * 768 + h * QKH; const bf16* Vg = V + rowbase * 1024 + h * VH;
    const int NT = (q0 + 256) / 64;
    bf16x8 qf[6];
    { const bf16* qp = Q + (rowbase + qw + r32) * 768 + h * QKH + hi * 8;
#pragma unroll
      for (int s = 0; s < 6; ++s) qf[s] = *(const GAS bf16x8*)(qp + 16 * s); }
    asm volatile("s_waitcnt vmcnt(0)" ::: "memory");
#pragma unroll
    for (int s = 0; s < 6; ++s) asm volatile("" : "+v"(qf[s]));
    issue_tile(Kg, Vg, lds, 0, wave, lane); issue_tile(Kg, Vg, lds + SLOT, 64, wave, lane);
    f32x16 o0 = {}, o1 = {};
    float l = 0.f;
    const int qrow = qw + r32;
    const int vaddr = ((lane >> 4) & 1) * 32 + (lane & 3) * 8 + (4 * hi + ((lane & 15) >> 2)) * 64;
    const int tmax = (qw + 31) >> 6;
#define PA_S(P0, P1, t_, slot_) do { const LAS unsigned char* ks = lds + (slot_) * SLOT; const int kv0 = (t_) * 64; \
        _Pragma("unroll") for (int r = 0; r < 16; ++r) { P0[r] = -sref; P1[r] = -sref; } \
        _Pragma("unroll") for (int s_ = 0; s_ < 6; ++s_) { \
            const bf16x8 a0 = *(const LAS bf16x8*)(ks + (2 * s_ + hi) * 1024 + r32 * 16), a1 = *(const LAS bf16x8*)(ks + (2 * s_ + hi) * 1024 + 512 + r32 * 16); \
            P0 = __builtin_amdgcn_mfma_f32_32x32x16_bf16(a0, qf[s_], P0, 0, 0, 0); P1 = __builtin_amdgcn_mfma_f32_32x32x16_bf16(a1, qf[s_], P1, 0, 0, 0); } \
        if (kv0 + 63 > qw) { _Pragma("unroll") for (int r = 0; r < 16; ++r) { const int kv = kv0 + crow(r, hi); if (kv > qrow) P0[r] = -1e30f; if (kv + 32 > qrow) P1[r] = -1e30f; } } } while (0)
#define PA_PV(P0, P1, slot_) do { const LAS unsigned char* vs = lds + (slot_) * SLOT + KSLOT; float rs = 0.f; \
        _Pragma("unroll") for (int r = 0; r < 16; ++r) { P0[r] = __builtin_amdgcn_exp2f(P0[r]); P1[r] = __builtin_amdgcn_exp2f(P1[r]); rs += P0[r] + P1[r]; } \
        l += rs; \
        _Pragma("unroll") for (int kstep = 0; kstep < 4; ++kstep) { v4u pw; const int rb = 8 * (kstep & 1); \
            if (kstep < 2) { pw.x = cvt_pk_bf16(P0[rb], P0[rb + 1]); pw.y = cvt_pk_bf16(P0[rb + 2], P0[rb + 3]); pw.z = cvt_pk_bf16(P0[rb + 4], P0[rb + 5]); pw.w = cvt_pk_bf16(P0[rb + 6], P0[rb + 7]); } \
            else { pw.x = cvt_pk_bf16(P1[rb], P1[rb + 1]); pw.y = cvt_pk_bf16(P1[rb + 2], P1[rb + 3]); pw.z = cvt_pk_bf16(P1[rb + 4], P1[rb + 5]); pw.w = cvt_pk_bf16(P1[rb + 6], P1[rb + 7]); } \
            const bf16x8 pb = __builtin_bit_cast(bf16x8, pw); \
            _Pragma("unroll") for (int d0 = 0; d0 < 2; ++d0) { \
                const s16x4 lo = vtr(vs + vaddr + d0 * 4096 + kstep * 1024), hh = vtr(vs + vaddr + d0 * 4096 + kstep * 1024 + 512); \
                const bf16x8 va = (bf16x8){lo[0], lo[1], lo[2], lo[3], hh[0], hh[1], hh[2], hh[3]}; \
                if (d0 == 0) o0 = __builtin_amdgcn_mfma_f32_32x32x16_bf16(va, pb, o0, 0, 0, 0); else o1 = __builtin_amdgcn_mfma_f32_32x32x16_bf16(va, pb, o1, 0, 0, 0); } } } while (0)
#define PA_BAR() do { asm volatile("s_waitcnt lgkmcnt(0)" ::: "memory"); __builtin_amdgcn_s_barrier(); asm volatile("" ::: "memory"); } while (0)
#define PA_SB() __builtin_amdgcn_sched_barrier(0)
#define PA_KRD(s_, o_) (*(const LAS bf16x8*)(ks + (2 * (s_) + hi) * 1024 + (o_) + r32 * 16))
#define PA_SX(PN0, PN1, t_, slot_, PC0, PC1) do { const LAS unsigned char* ks = lds + (slot_) * SLOT; const int kv0 = (t_) * 64; float rs = 0.f; \
        _Pragma("unroll") for (int r = 0; r < 16; ++r) { PN0[r] = -sref; PN1[r] = -sref; } \
        bf16x8 a0 = PA_KRD(0, 0), a1 = PA_KRD(0, 512); \
        _Pragma("unroll") for (int s_ = 0; s_ < 6; ++s_) { bf16x8 b0 = a0, b1 = a1; const int r0 = s_ < 4 ? 3 * s_ : 12 + 2 * (s_ - 4), r1 = r0 + (s_ < 4 ? 3 : 2); \
            if (s_ < 5) { b0 = PA_KRD(s_ + 1, 0); b1 = PA_KRD(s_ + 1, 512); } \
            PN0 = __builtin_amdgcn_mfma_f32_32x32x16_bf16(a0, qf[s_], PN0, 0, 0, 0); asm volatile("" : "+v"(PN0)); PA_SB(); \
            _Pragma("unroll") for (int r = r0; r < r1; ++r) PC0[r] = __builtin_amdgcn_exp2f(PC0[r]); asm volatile("" : "+v"(PC0)); \
            _Pragma("unroll") for (int r = r0; r < r1; ++r) rs += PC0[r]; asm volatile("" : "+v"(rs)); PA_SB(); \
            PN1 = __builtin_amdgcn_mfma_f32_32x32x16_bf16(a1, qf[s_], PN1, 0, 0, 0); asm volatile("" : "+v"(PN1)); PA_SB(); \
            _Pragma("unroll") for (int r = r0; r < r1; ++r) PC1[r] = __builtin_amdgcn_exp2f(PC1[r]); asm volatile("" : "+v"(PC1)); \
            _Pragma("unroll") for (int r = r0; r < r1; ++r) rs += PC1[r]; asm volatile("" : "+v"(rs)); PA_SB(); \
            a0 = b0; a1 = b1; } \
        l += rs; \
        if (kv0 + 63 > qw) { _Pragma("unroll") for (int r = 0; r < 16; ++r) { const int kv = kv0 + crow(r, hi); if (kv > qrow) PN0[r] = -1e30f; if (kv + 32 > qrow) PN1[r] = -1e30f; } } } while (0)
#define PA_PVN(P0, P1, slot_) do { const LAS unsigned char* vs = lds + (slot_) * SLOT + KSLOT + vaddr; s16x4 lo[4][2], hh[4][2]; \
        _Pragma("unroll") for (int d0 = 0; d0 < 2; ++d0) { lo[0][d0] = vtr(vs + d0 * 4096); hh[0][d0] = vtr(vs + d0 * 4096 + 512); } \
        _Pragma("unroll") for (int kstep = 0; kstep < 4; ++kstep) { v4u pw; const int rb = 8 * (kstep & 1); \
            if (kstep < 3) { _Pragma("unroll") for (int d0 = 0; d0 < 2; ++d0) { lo[kstep + 1][d0] = vtr(vs + d0 * 4096 + (kstep + 1) * 1024); hh[kstep + 1][d0] = vtr(vs + d0 * 4096 + (kstep + 1) * 1024 + 512); } }     \
            if (kstep < 2) { pw.x = cvt_pk_bf16(P0[rb], P0[rb + 1]); pw.y = cvt_pk_bf16(P0[rb + 2], P0[rb + 3]); pw.z = cvt_pk_bf16(P0[rb + 4], P0[rb + 5]); pw.w = cvt_pk_bf16(P0[rb + 6], P0[rb + 7]); } \
            else { pw.x = cvt_pk_bf16(P1[rb], P1[rb + 1]); pw.y = cvt_pk_bf16(P1[rb + 2], P1[rb + 3]); pw.z = cvt_pk_bf16(P1[rb + 4], P1[rb + 5]); pw.w = cvt_pk_bf16(P1[rb + 6], P1[rb + 7]); } \
            const bf16x8 pb = __builtin_bit_cast(bf16x8, pw); PA_SB(); \
            { const bf16x8 va = (bf16x8){lo[kstep][0][0], lo[kstep][0][1], lo[kstep][0][2], lo[kstep][0][3], hh[kstep][0][0], hh[kstep][0][1], hh[kstep][0][2], hh[kstep][0][3]}; o0 = __builtin_amdgcn_mfma_f32_32x32x16_bf16(va, pb, o0, 0, 0, 0); } \
            { const bf16x8 va = (bf16x8){lo[kstep][1][0], lo[kstep][1][1], lo[kstep][1][2], lo[kstep][1][3], hh[kstep][1][0], hh[kstep][1][1], hh[kstep][1][2], hh[kstep][1][3]}; o1 = __builtin_amdgcn_mfma_f32_32x32x16_bf16(va, pb, o1, 0, 0, 0); } \
            PA_SB(); } } while (0)
    f32x16 pA0, pA1, pB0, pB1;
    if (wave < 4) asm volatile("s_waitcnt vmcnt(3)" ::: "memory"); else asm volatile("s_waitcnt vmcnt(2)" ::: "memory");
    PA_BAR();
    PA_S(pA0, pA1, 0, 0);
    int sl = 0, s1 = 1;
    for (int t = 0; ; t += 2) {
        const int s2 = (s1 == 2) ? 0 : s1 + 1;
        asm volatile("s_waitcnt vmcnt(0)" ::: "memory"); PA_BAR();
        if (t + 2 < NT) issue_tile(Kg, Vg, lds + s2 * SLOT, (t + 2) * 64, wave, lane);
        PA_SX(pB0, pB1, t + 1, s1, pA0, pA1); PA_PVN(pA0, pA1, sl);
        asm volatile("s_waitcnt vmcnt(0)" ::: "memory"); PA_BAR();
        if (t + 2 >= NT) break;
        if (t + 3 < NT) issue_tile(Kg, Vg, lds + sl * SLOT, (t + 3) * 64, wave, lane);
        PA_SX(pA0, pA1, t + 2, s2, pB0, pB1); PA_PVN(pB0, pB1, s1);
        sl = s2; s1 = (s2 == 2) ? 0 : s2 + 1;
    }
    PA_PV(pB0, pB1, s1);
#undef PA_S
#undef PA_PV
#undef PA_BAR
#undef PA_SB
#undef PA_KRD
#undef PA_SX
#undef PA_PVN
    const float il = 1.0f / swap_sum(l);
    bf16* op = O + (rowbase + qw + r32) * ATTW + h * VH + 4 * hi;
#pragma unroll
    for (int g = 0; g < 4; ++g) {
        v2u w0, w1; w0.x = cvt_pk_bf16(o0[4 * g] * il, o0[4 * g + 1] * il); w0.y = cvt_pk_bf16(o0[4 * g + 2] * il, o0[4 * g + 3] * il);
        w1.x = cvt_pk_bf16(o1[4 * g] * il, o1[4 * g + 1] * il); w1.y = cvt_pk_bf16(o1[4 * g + 2] * il, o1[4 * g + 3] * il);
        *(GAS v2u*)(op + 8 * g) = w0; *(GAS v2u*)(op + 32 + 8 * g) = w1;
    }
    asm volatile("s_waitcnt vmcnt(0) lgkmcnt(0)" ::: "memory");
    __syncthreads();
}
}

namespace sa {
using pa::f32x16; using pa::s16x4; using pa::crow; using pa::vtr; using pa::swap_max; using pa::swap_sum;
constexpr int HK = 64;
constexpr int CHS = (HK + 1) * 16;
constexpr int CSB = 36 * CHS;
constexpr int C8S = (HK + 1) * 32, C8B = 8 * C8S;
constexpr int OFF_CS = 0, OFF_C8 = 2 * CSB;
constexpr int OFF_QA = OFF_C8 + 2 * C8B;
constexpr int PSTR = 144, OFF_P = OFF_QA + 18432;
constexpr int OFF_RS = OFF_P + 32 * PSTR;
constexpr int OFF_KSS = OFF_RS + 2048;
constexpr int OFF_PSUM = OFF_KSS + 512, OFF_PHYS = OFF_PSUM + 512, OFF_GK = OFF_PHYS + 128, SA_LDS = OFF_GK + 128;
static_assert(SA_LDS <= RING_BYTES, "sample attention LDS");
constexpr int PO_STRIDE = 32 * 256;
#define SA_BAR() do { asm volatile("s_waitcnt lgkmcnt(0)" ::: "memory"); __builtin_amdgcn_s_barrier(); asm volatile("" ::: "memory"); } while (0)

__device__ __forceinline__ void gld16(f32x4& d, const void* p) { asm volatile("global_load_dwordx4 %0, %1, off" : "=v"(d) : "v"(p) : "memory"); }
__device__ __forceinline__ void gld8(v2u& d, const void* p) { asm volatile("global_load_dwordx2 %0, %1, off" : "=v"(d) : "v"(p) : "memory"); }
template <int MODE> __device__ __forceinline__ void item(const void* const* in, const bf16* QABS, const unsigned char* W8, const bf16* ROPEB, float* PO, float* PL, float sref, int b, int half, LAS unsigned char* lds, int tid_, int wave, int lane_) {
    const int tid = opq(tid_), lane = tid & 63;
    (void)lane_;
    const float* cache_ckv = (const float*)in[4]; const float* cache_kr = (const float*)in[5]; const int* page_table = (const int*)in[6]; const float* g_k = (const float*)in[18];
    const int r32 = lane & 31, hi = lane >> 5;
    typedef int v8i __attribute__((ext_vector_type(8)));
    for (int e = tid; e < 36 * 32; e += 512) *(LAS v4u*)(lds + OFF_QA + e * 16) = *(const GAS v4u*)(QABS + ((size_t)b * 36 * 32 + e) * 8);
    if (tid < NPAGES / 2) *(LAS int*)(lds + OFF_PHYS + tid * 4) = page_table[b * NPAGES + half * (NPAGES / 2) + tid];
    v8i wf[4][2];
#pragma unroll
    for (int s = 0; s < 4; ++s)
#pragma unroll
        for (int nb = 0; nb < 2; ++nb) { const GAS v4u* wp = (const GAS v4u*)(W8 + (size_t)(wave * QKN + 32 * nb + r32) * KVL + 64 * s + 32 * hi); const v4u a = wp[0], bq = wp[1];
            wf[s][nb] = (v8i){(int)a.x, (int)a.y, (int)a.z, (int)a.w, (int)bq.x, (int)bq.y, (int)bq.z, (int)bq.w}; }
    if (tid < 32) *(LAS float*)(lds + OFF_GK + tid * 4) = g_k[64 + tid];
    asm volatile("s_waitcnt vmcnt(0) lgkmcnt(0)" ::: "memory");
#pragma unroll
    for (int s = 0; s < 4; ++s) asm volatile("" : "+v"(wf[s][0]), "+v"(wf[s][1]));
    __builtin_amdgcn_s_barrier(); asm volatile("" ::: "memory");
    f32x16 o = {};
    float l_run = 0.f;
    const int kq = wave >> 1;
    constexpr int NHP = NPAGES;
#define SA_IDS() const int tq = opq(tid), lq = tq & 63, r32 = lq & 31, hi = lq >> 5, kkey = tq >> 2, qd = tq & 3, cs_col = 16 * (wave & 1) + (lq & 15), quad = lq >> 4; (void)r32; (void)hi; (void)kkey; (void)qd; (void)cs_col; (void)quad
    f32x4 va[4], vb[4], x1 = {}, x2 = {}; v2u cw = {}, sw = {};
#define SA_SRC(hp_) const int sub_ = (hp_) & 1; const int phys_ = *(const LAS int*)(lds + OFF_PHYS + ((hp_) >> 1) * 4); const float* src_ = cache_ckv + ((size_t)phys_ * PAGE + sub_ * HK + 2 * wave) * KVL + lq * 4
#define SA_LD(i_) do { gld16(va[i_], src_ + (size_t)(i_) * 16 * KVL); gld16(vb[i_], src_ + (size_t)(i_) * 16 * KVL + KVL); } while (0)
#define SA_LDK(hp_) do { if (wave < 4) { const float* krp_ = cache_kr + ((size_t)phys_ * PAGE + sub_ * HK + kkey) * QKR; gld16(x1, krp_ + 4 * qd); gld16(x2, krp_ + 16 + 4 * qd); \
            const bf16* rp_ = ROPEB + ((size_t)(half * (NPAGES / 2) + ((hp_) >> 1)) * PAGE + sub_ * HK + kkey) * 32; gld8(cw, rp_ + 4 * qd); gld8(sw, rp_ + 16 + 4 * qd); } } while (0)
#define SA_AKR(CSW, KSSW) do { \
            const f32x4 rc_ = {bflo(cw.x), bfhi(cw.x), bflo(cw.y), bfhi(cw.y)}, rs_ = {bflo(sw.x), bfhi(sw.x), bflo(sw.y), bfhi(sw.y)}; \
            float ss = (x1[0] * x1[0] + x1[1] * x1[1]) + (x1[2] * x1[2] + x1[3] * x1[3]) + (x2[0] * x2[0] + x2[1] * x2[1]) + (x2[2] * x2[2] + x2[3] * x2[3]); \
            ss = sum4(ss); \
            const f32x4 ga = *(const LAS f32x4*)(lds + OFF_GK + qd * 16), gb = *(const LAS f32x4*)(lds + OFF_GK + 64 + qd * 16); \
            const f32x4 a = x1 * ga, bb = x2 * gb; const f32x4 y1 = a * rc_ - bb * rs_, y2 = a * rs_ + bb * rc_; \
            v2u w1, w2; w1.x = cvt_pk_bf16(y1[0], y1[1]); w1.y = cvt_pk_bf16(y1[2], y1[3]); w2.x = cvt_pk_bf16(y2[0], y2[1]); w2.y = cvt_pk_bf16(y2[2], y2[3]); \
            const int c1 = 32 + (qd >> 1), c2 = 34 + (qd >> 1); \
            *(LAS v2u*)((CSW) + c1 * CHS + kkey * 16 + 8 * (qd & 1)) = w1; *(LAS v2u*)((CSW) + c2 * CHS + kkey * 16 + 8 * (qd & 1)) = w2; \
            if (qd == 0) *(LAS float*)(lds + (KSSW) + kkey * 4) = ss; } while (0)
#define SA_R(CF, kb, s2) do { const LAS v4u* cp = (const LAS v4u*)(c8 + (2 * (s2) + hi) * C8S + (32 * (kb) + r32) * 32); const v4u a = cp[0], bq = cp[1]; \
            CF = (v8i){(int)a.x, (int)a.y, (int)a.z, (int)a.w, (int)bq.x, (int)bq.y, (int)bq.z, (int)bq.w}; } while (0)
#define SA_M(ACC, s2, nb, CF) do { ACC = __builtin_amdgcn_mfma_scale_f32_32x32x64_f8f6f4(wf[s2][nb], CF, ACC, 0, 0, 0, 127, 0, 127); asm volatile("" : "+v"(ACC)); } while (0)
#define SA_PA(i, kk, CSW) do { const int key_ = 2 * wave + (kk) + 16 * (i), ch8 = lq >> 1, hf = lq & 1; const f32x4 v = (kk) ? vb[i] : va[i]; \
            v2u w; w.x = cvt_pk_bf16(v[0], v[1]); w.y = cvt_pk_bf16(v[2], v[3]); *(LAS v2u*)((CSW) + ch8 * CHS + key_ * 16 + hf * 8) = w; } while (0)
#define SA_PB(i, kk, C8W) do { const int key_ = 2 * wave + (kk) + 16 * (i), ch8 = lq >> 1, hf = lq & 1; const f32x4 v = (kk) ? vb[i] : va[i]; \
            int w8 = 0; w8 = __builtin_amdgcn_cvt_pk_fp8_f32(v[0], v[1], w8, false); w8 = __builtin_amdgcn_cvt_pk_fp8_f32(v[2], v[3], w8, true); \
            *(LAS int*)((C8W) + (ch8 >> 2) * C8S + key_ * 32 + (ch8 & 3) * 8 + hf * 4) = w8; } while (0)
#define SA_SEG(T0, T1, s2a, i, HOOK, RN0, RN1) do { \
            SA_M(T0, s2a, 0, cfa); SA_SB(); HOOK; SA_PA(i, 0, csn); SA_SB(); \
            SA_M(T1, s2a, 1, cfa); SA_SB(); SA_PB(i, 0, c8n); RN0; SA_SB(); \
            SA_M(T0, (s2a) + 1, 0, cfb); SA_SB(); SA_PA(i, 1, csn); SA_SB(); \
            SA_M(T1, (s2a) + 1, 1, cfb); SA_SB(); SA_PB(i, 1, c8n); RN1; SA_SB(); } while (0)
#define SA_BRED(T0, T1, kb, KSSR) do { const int key_ = 32 * (kb) + r32; const f32x16 sq = T0 * T0 + T1 * T1; \
            const f32x4 s4 = (f32x4){sq[0], sq[1], sq[2], sq[3]} + (f32x4){sq[4], sq[5], sq[6], sq[7]} + ((f32x4){sq[8], sq[9], sq[10], sq[11]} + (f32x4){sq[12], sq[13], sq[14], sq[15]}); \
            float ss = (s4[0] + s4[1]) + (s4[2] + s4[3]); \
            ss = swap_sum(ss) * (1.0f / 4096.0f) + *(const LAS float*)(lds + (KSSR) + key_ * 4); \
            if (hi == 0) *(LAS float*)(lds + OFF_RS + (key_ * 8 + wave) * 4) = __builtin_amdgcn_rsqf(ss * (1.f / QKH) + EPS); } while (0)
#define SA_SB() __builtin_amdgcn_sched_barrier(0)
    { SA_IDS(); { SA_SRC(0); SA_LD(0); SA_LD(1); SA_LD(2); SA_LD(3); SA_LDK(0); }
      asm volatile("s_waitcnt vmcnt(0)" ::: "memory");
      asm volatile("" : "+v"(va[0]), "+v"(va[1]), "+v"(va[2]), "+v"(va[3]), "+v"(vb[0]), "+v"(vb[1]), "+v"(vb[2]), "+v"(vb[3]));
      asm volatile("" : "+v"(x1), "+v"(x2), "+v"(cw), "+v"(sw));
      LAS unsigned char* cs0 = lds + OFF_CS; LAS unsigned char* c80 = lds + OFF_C8; SA_SRC(1);
      _Pragma("unroll") for (int i = 0; i < 4; ++i) { SA_PA(i, 0, cs0); SA_PB(i, 0, c80); SA_PA(i, 1, cs0); SA_PB(i, 1, c80); SA_SB(); SA_LD(i); SA_SB(); }
      if (tid < 256) SA_AKR(cs0, OFF_KSS);
      SA_SB(); SA_LDK(1);
      SA_BAR(); }
#pragma unroll 1
    for (int hp = 0; hp < NHP; ++hp) { SA_IDS();
        const int par = hp & 1;
        LAS unsigned char* cs = lds + OFF_CS + par * CSB; LAS unsigned char* c8 = lds + OFF_C8 + par * C8B;
        LAS unsigned char* csn = lds + OFF_CS + (par ^ 1) * CSB; LAS unsigned char* c8n = lds + OFF_C8 + (par ^ 1) * C8B;
        const int kssr = OFF_KSS + par * 256, kssw = OFF_KSS + (par ^ 1) * 256;
        const bool more = hp + 2 < NHP; const int hn = more ? hp + 2 : hp; SA_SRC(hn);
        asm volatile("s_waitcnt vmcnt(0)" ::: "memory");
        asm volatile("" : "+v"(va[0]), "+v"(va[1]), "+v"(va[2]), "+v"(va[3]), "+v"(vb[0]), "+v"(vb[1]), "+v"(vb[2]), "+v"(vb[3]));
        asm volatile("" : "+v"(x1), "+v"(x2), "+v"(cw), "+v"(sw));
        { f32x16 t0 = {}, t1 = {}, t2 = {}, t3 = {}; v8i cfa, cfb;
          SA_R(cfa, 0, 0); SA_R(cfb, 0, 1); SA_SB();
          SA_SEG(t0, t1, 0, 0, (void)0, SA_R(cfa, 0, 2), SA_R(cfb, 0, 3)); if (more) SA_LD(0); SA_SB();
          SA_SEG(t0, t1, 2, 1, (void)0, SA_R(cfa, 1, 0), SA_R(cfb, 1, 1)); if (more) SA_LD(1); SA_SB();
          if (tid < 256) SA_AKR(csn, kssw);
          SA_SB(); if (more) SA_LDK(hn); SA_SB();
          SA_SEG(t2, t3, 0, 2, SA_BRED(t0, t1, 0, kssr); SA_SB(), SA_R(cfa, 1, 2), SA_R(cfb, 1, 3)); if (more) SA_LD(2); SA_SB();
          SA_SEG(t2, t3, 2, 3, (void)0, (void)0, (void)0); if (more) SA_LD(3); SA_SB();
          SA_BRED(t2, t3, 1, kssr); }
        SA_BAR();
        { f32x4 p4 = {0.f, 0.f, 0.f, 0.f}, p5 = {0.f, 0.f, 0.f, 0.f}; const int key = 16 * kq + (lq & 15);
          bf16x8 cf[9], qf[9];
          { LAS unsigned char* cb = cs + quad * CHS + key * 16; LAS unsigned char* qb = lds + OFF_QA + quad * 512 + cs_col * 16;
#pragma unroll
            for (int s2 = 0; s2 < 9; ++s2) { cf[s2] = *(const LAS bf16x8*)(cb + s2 * 4 * CHS); qf[s2] = *(const LAS bf16x8*)(qb + s2 * 2048); } }
#pragma unroll
          for (int s2 = 0; s2 < 9; ++s2) { if (s2 & 1) p5 = __builtin_amdgcn_mfma_f32_16x16x32_bf16(cf[s2], qf[s2], p5, 0, 0, 0); else p4 = __builtin_amdgcn_mfma_f32_16x16x32_bf16(cf[s2], qf[s2], p4, 0, 0, 0); }
          p4 += p5;
          float rsum = 0.f;
#pragma unroll
          for (int r = 0; r < 4; ++r) { p4[r] = __builtin_amdgcn_exp2f(p4[r] * *(const LAS float*)(lds + OFF_RS + ((16 * kq + 4 * quad + r) * 8 + (cs_col & 7)) * 4) - sref); rsum += p4[r]; }
          rsum = rows_sum(rsum);
          if (lq < 16) *(LAS float*)(lds + OFF_PSUM + (kq * 32 + cs_col) * 4) = rsum;
          v2u w; w.x = cvt_pk_bf16(p4[0], p4[1]); w.y = cvt_pk_bf16(p4[2], p4[3]);
          *(LAS v2u*)(lds + OFF_P + cs_col * PSTR + (16 * kq + 4 * quad) * 2) = w; }
        SA_BAR();
        l_run += ((*(const LAS float*)(lds + OFF_PSUM + r32 * 4) + *(const LAS float*)(lds + OFF_PSUM + (32 + r32) * 4)) + (*(const LAS float*)(lds + OFF_PSUM + (64 + r32) * 4) + *(const LAS float*)(lds + OFF_PSUM + (96 + r32) * 4)));
        { const int dim = 32 * wave + 16 * ((lq >> 4) & 1) + 4 * (lq & 3), ch = dim >> 3, k0 = 8 * hi + ((lq & 15) >> 2);
          s16x4 lo[4], hh[4]; bf16x8 pb[4];
          { LAS unsigned char* tb = cs + ch * CHS + k0 * 16 + 8 * (lq & 1); LAS unsigned char* pp = lds + OFF_P + r32 * PSTR + 16 * hi;
#pragma unroll
            for (int ks = 0; ks < 4; ++ks) { lo[ks] = vtr(tb + ks * 256); hh[ks] = vtr(tb + ks * 256 + 64); pb[ks] = *(const LAS bf16x8*)(pp + ks * 32); } }
#pragma unroll
          for (int ks = 0; ks < 4; ++ks) { const bf16x8 ca = (bf16x8){lo[ks][0], lo[ks][1], lo[ks][2], lo[ks][3], hh[ks][0], hh[ks][1], hh[ks][2], hh[ks][3]};
              o = __builtin_amdgcn_mfma_f32_32x32x16_bf16(ca, pb[ks], o, 0, 0, 0); } }
        SA_BAR();
    }
#undef SA_R
#undef SA_M
#undef SA_PA
#undef SA_PB
#undef SA_SEG
#undef SA_AKR
#undef SA_BRED
#undef SA_SB
#undef SA_IDS
#undef SA_SRC
#undef SA_LD
#undef SA_LDK
    asm volatile("s_waitcnt vmcnt(0)" ::: "memory");
    float* po = PO + (size_t)(b * 2 + half) * PO_STRIDE + (size_t)r32 * 256 + 32 * wave + 4 * hi;
#pragma unroll
    for (int g = 0; g < 4; ++g) *(GAS f32x4*)(po + 8 * g) = (f32x4){o[4 * g], o[4 * g + 1], o[4 * g + 2], o[4 * g + 3]};
    if (wave == 0 && hi == 0) PL[(b * 2 + half) * 32 + r32] = l_run;
    asm volatile("s_waitcnt vmcnt(0) lgkmcnt(0)" ::: "memory"); __syncthreads();
}

__device__ __forceinline__ void combine_item(const void* const* in, const bf16* Q, const bf16* K, const bf16* CKVN, const float* PO, const float* PL, float sref, bf16* ATT, int h, int rc, LAS unsigned char* lds, int tid, int wave, int lane) {
    const float* w_uv = (const float*)in[16];
    LAS float* WU = (LAS float*)lds;
    LAS float* OL = WU + 256 * 64;
    f32x4 wreg[8];
#pragma unroll
    for (int i = 0; i < 8; ++i) { const int e4 = tid + 512 * i, c = e4 >> 4, d4 = (e4 & 15) * 4; wreg[i] = *(const GAS f32x4*)(w_uv + (size_t)c * 512 + h * VH + d4); }
    { f32x4 v0[2], v1[2]; float pl0[2], pl1[2]; v4u qc[2], kc[2][4]; v2u cw_[2][4];
#pragma unroll
      for (int rr = 0; rr < 2; ++rr) { const int r = rc * 16 + 2 * wave + rr, b = r >> 2, t = r & 3, col = t * 8 + h; const size_t row = (size_t)MP + r;
          pl0[rr] = PL[(b * 2) * 32 + col]; pl1[rr] = PL[(b * 2 + 1) * 32 + col];
          v0[rr] = *(const GAS f32x4*)(PO + (size_t)(b * 2) * PO_STRIDE + (size_t)col * 256 + 4 * lane); v1[rr] = *(const GAS f32x4*)(PO + (size_t)(b * 2 + 1) * PO_STRIDE + (size_t)col * 256 + 4 * lane);
          const int c = lane < 12 ? lane : 0;
          qc[rr] = *(const GAS v4u*)(Q + row * 768 + h * QKH + 8 * c);
#pragma unroll
          for (int s2 = 0; s2 < 4; ++s2) { const size_t kr_ = (size_t)MP + b * DECT + s2; kc[rr][s2] = *(const GAS v4u*)(K + kr_ * 768 + h * QKH + 8 * c); cw_[rr][s2] = *(const GAS v2u*)(CKVN + kr_ * KVL + 4 * lane); } }
#pragma unroll
      for (int rr = 0; rr < 2; ++rr) { const int rl = 2 * wave + rr, r = rc * 16 + rl, t = r & 3;
          float l = pl0[rr] + pl1[rr]; float acc[4];
#pragma unroll
          for (int i = 0; i < 4; ++i) acc[i] = v0[rr][i] + v1[rr][i];
          float qf[8]; unpack8(qc[rr], qf);
#pragma unroll
          for (int s2 = 0; s2 < 4; ++s2) { float f[8]; unpack8(kc[rr][s2], f); float sc = 0.f;
#pragma unroll
              for (int i = 0; i < 8; ++i) sc += qf[i] * f[i];
              sc = wave_sum(lane < 12 ? sc : 0.f);
              const float pr = (s2 <= t) ? __builtin_amdgcn_exp2f(sc - sref) : 0.f;
              l += pr; const v2u w = cw_[rr][s2];
              acc[0] += pr * bflo(w.x); acc[1] += pr * bfhi(w.x); acc[2] += pr * bflo(w.y); acc[3] += pr * bfhi(w.y); }
          const float il = 1.0f / l;
          *(LAS f32x4*)(OL + rl * 256 + 4 * lane) = (f32x4){acc[0] * il, acc[1] * il, acc[2] * il, acc[3] * il}; } }
#pragma unroll
    for (int i = 0; i < 8; ++i) { const int e4 = tid + 512 * i, c = e4 >> 4, d4 = (e4 & 15) * 4; *(LAS f32x4*)(WU + c * 64 + d4) = wreg[i]; }
    LDS_WAIT(); __syncthreads();
    { const int rl = tid >> 5, dp = tid & 31; float o0 = 0.f, o1 = 0.f;
#pragma unroll 8
      for (int c = 0; c < KVL; ++c) { const float ov = OL[rl * 256 + c]; const f32x2 w = *(const LAS f32x2*)(WU + c * 64 + 2 * dp); o0 += ov * w.x; o1 += ov * w.y; }
      *(GAS unsigned*)(ATT + ((size_t)MP + rc * 16 + rl) * ATTW + h * VH + 2 * dp) = pk2(o0, o1); }
    LDS_WAIT(); __syncthreads();
}
}


__device__ __forceinline__ void qabs_item(const void* const* in, const bf16* QRAW, const bf16* WKV, const float* ROPE, bf16* QABS, int h, int rg, LAS unsigned char* lds, int tid) {
    const float* g_q = (const float*)in[17]; const float* g_k = (const float*)in[18];
    LAS unsigned char* WH = lds;
    LAS float* QG = (LAS float*)(lds + 32768);
#pragma unroll
    for (int i = 0; i < 4; ++i) *(LAS v4u*)(WH + (tid + 512 * i) * 16) = *(const GAS v4u*)(WKV + (size_t)(h * QKN) * KVL + (size_t)(tid + 512 * i) * 8);
    { const int rl = tid >> 3, sub = tid & 7, sr = rg * 64 + rl, pos = SEQ + (sr & 3);
      const bf16* qr = QRAW + ((size_t)MP + sr) * 768 + h * QKH; float n[8]; unpack8(*(const GAS v4u*)(qr + 8 * sub), n);
      const unsigned wa = *(const GAS unsigned*)(qr + 64 + 2 * sub), wb = *(const GAS unsigned*)(qr + 80 + 2 * sub);
      float a0 = bflo(wa), a1 = bfhi(wa), b0 = bflo(wb), b1 = bfhi(wb);
      float ss = (a0 * a0 + a1 * a1) + (b0 * b0 + b1 * b1);
#pragma unroll
      for (int i = 0; i < 8; ++i) ss += n[i] * n[i];
      ss = sum8(ss);
      const float rs = QSCALE / sqrtf(ss * (1.f / QKH) + EPS);
      const float* rp = ROPE + (size_t)pos * 32; const f32x2 cs = *(const GAS f32x2*)(rp + 2 * sub), sn = *(const GAS f32x2*)(rp + 16 + 2 * sub);
#pragma unroll
      for (int i = 0; i < 8; ++i) QG[rl * 64 + 8 * sub + i] = bf2f((bf16)f2bf(n[i] * rs * g_q[8 * sub + i])) * g_k[8 * sub + i];
      a0 *= rs * g_q[64 + 2 * sub]; a1 *= rs * g_q[65 + 2 * sub]; b0 *= rs * g_q[80 + 2 * sub]; b1 *= rs * g_q[81 + 2 * sub];
      const unsigned r1 = pk2(a0 * cs.x - b0 * sn.x, a1 * cs.y - b1 * sn.y), r2 = pk2(a0 * sn.x + b0 * cs.x, a1 * sn.y + b1 * cs.y);
      bf16* qab = QABS + (size_t)(sr >> 2) * 36 * 32 * 8 + ((sr & 3) * 8 + h) * 8;
      *(GAS unsigned*)(qab + (32 + (sub >> 2)) * 256 + 2 * (sub & 3)) = r1; *(GAS unsigned*)(qab + (34 + (sub >> 2)) * 256 + 2 * (sub & 3)) = r2; }
    LDS_WAIT(); __syncthreads();
    { const int r4 = tid >> 5, ch = tid & 31; float acc[4][8];
#pragma unroll
      for (int r = 0; r < 4; ++r)
#pragma unroll
          for (int i = 0; i < 8; ++i) acc[r][i] = 0.f;
#pragma unroll 4
      for (int d = 0; d < QKN; ++d) { float w[8]; unpack8(*(const LAS v4u*)(WH + d * 512 + ch * 16), w);
#pragma unroll
          for (int r = 0; r < 4; ++r) { const float qg = QG[(r4 * 4 + r) * 64 + d];
#pragma unroll
              for (int i = 0; i < 8; ++i) acc[r][i] += qg * w[i]; } }
#pragma unroll
      for (int r = 0; r < 4; ++r) { const int sr = rg * 64 + r4 * 4 + r; v4u o; o.x = pk2(acc[r][0], acc[r][1]); o.y = pk2(acc[r][2], acc[r][3]); o.z = pk2(acc[r][4], acc[r][5]); o.w = pk2(acc[r][6], acc[r][7]);
          *(GAS v4u*)(QABS + (size_t)(sr >> 2) * 36 * 32 * 8 + ch * 256 + ((sr & 3) * 8 + h) * 8) = o; } }
    LDS_WAIT(); __syncthreads();
}

__device__ __forceinline__ void ssm_tables_item(const void* const* in, int g, int dq, LAS unsigned char* lds, bf16* MBT, bf16* TYT, float* A32, int tid) {
    const float* a_re = (const float*)in[19]; const float* a_im = (const float*)in[20]; const float* log_dt = (const float*)in[21];
    const float* b_re = (const float*)in[22]; const float* b_im = (const float*)in[23]; const float* c_re = (const float*)in[24]; const float* c_im = (const float*)in[25]; const float* d_skip = (const float*)in[26];
    LAS float* ap = (LAS float*)lds;
    LAS float* bb = ap + 64 * 33 * 2;
    LAS float* cc = bb + 2048;
    LAS float* kj = cc + 2048;
    if (tid < 64) { const int p = tid;
        const double dt = exp((double)log_dt[g]); const double are = a_re[g * NST + p], aim = a_im[g * NST + p];
        const double mag = exp(dt * are), abr = mag * cos(dt * aim), abi = mag * sin(dt * aim), den = are * are + aim * aim, nr = abr - 1.0;
        const double fre = (nr * are + abi * aim) / den, fim = (abi * are - nr * aim) / den;
        double pr = 1.0, pi = 0.0;
        for (int j = 0; j <= 32; ++j) { ap[(p * 33 + j) * 2] = (float)pr; ap[(p * 33 + j) * 2 + 1] = (float)pi; const double t = pr * abr - pi * abi; pi = pr * abi + pi * abr; pr = t; }
        for (int i = 0; i < 16; ++i) { const double br = b_re[(g * NST + p) * GRP + i], bi = b_im[(g * NST + p) * GRP + i]; bb[(p * 16 + i) * 2] = (float)(fre * br - fim * bi); bb[(p * 16 + i) * 2 + 1] = (float)(fre * bi + fim * br); }
        if (dq == 0) { A32[(g * NST + p) * 2] = ap[(p * 33 + 32) * 2]; A32[(g * NST + p) * 2 + 1] = ap[(p * 33 + 32) * 2 + 1];
            A32[4096 + (g * NST + p) * 2] = (float)abr; A32[4096 + (g * NST + p) * 2 + 1] = (float)abi;
            for (int i = 0; i < 16; ++i) { A32[8192 + ((g * NST + p) * 16 + i) * 2] = bb[(p * 16 + i) * 2]; A32[8192 + ((g * NST + p) * 16 + i) * 2 + 1] = bb[(p * 16 + i) * 2 + 1]; } }
    }
    for (int e = tid; e < 1024; e += 512) { const int i = e >> 6, p = e & 63; cc[e * 2] = c_re[(g * GRP + i) * NST + p]; cc[e * 2 + 1] = c_im[(g * GRP + i) * NST + p]; }
    LDS_WAIT(); __syncthreads();
    for (int e = tid; e < 1024; e += 512) { const int dd = e >> 8, i = (e >> 4) & 15, j = e & 15, d = 4 * dq + dd; float acc = 0.f;
        for (int p = 0; p < 64; ++p) { const float cr = cc[(i * 64 + p) * 2], ci = cc[(i * 64 + p) * 2 + 1], ar = ap[(p * 33 + d) * 2], ai = ap[(p * 33 + d) * 2 + 1], br = bb[(p * 16 + j) * 2], bi = bb[(p * 16 + j) * 2 + 1];
            const float tr = cr * ar - ci * ai, ti = cr * ai + ci * ar; acc += tr * br - ti * bi; }
        if (d == 0 && i == j) acc += d_skip[g * GRP + i];
        kj[e] = acc; }
    LDS_WAIT(); __syncthreads();
    for (int e = tid; e < 4 * 32 * 16; e += 512) { const int dd = e >> 9, t = (e >> 4) & 31, i = e & 15, d = 4 * dq + dd; bf16* rowp = TYT + ((size_t)g * 512 + t * 16 + i) * SKA;
        if (t >= d) { const LAS float* kp = kj + dd * 256 + i * 16; v4u w0, w1; w0.x = pk2(kp[0], kp[1]); w0.y = pk2(kp[2], kp[3]); w0.z = pk2(kp[4], kp[5]); w0.w = pk2(kp[6], kp[7]);
            w1.x = pk2(kp[8], kp[9]); w1.y = pk2(kp[10], kp[11]); w1.z = pk2(kp[12], kp[13]); w1.w = pk2(kp[14], kp[15]);
            *(GAS v4u*)(rowp + (t - d) * 16) = w0; *(GAS v4u*)(rowp + (t - d) * 16 + 8) = w1; }
        if (d >= 1 && t + d <= 31) { const v4u z = {0u, 0u, 0u, 0u}; *(GAS v4u*)(rowp + (t + d) * 16) = z; *(GAS v4u*)(rowp + (t + d) * 16 + 8) = z; } }
    for (int e = tid; e < 4 * 16 * 64; e += 512) { const int tt = e >> 10, i = (e >> 6) & 15, p = e & 63, t = 4 * dq + tt;
        const float cr = cc[(i * 64 + p) * 2], ci = cc[(i * 64 + p) * 2 + 1], ar = ap[(p * 33 + t + 1) * 2], ai = ap[(p * 33 + t + 1) * 2 + 1];
        bf16* rowp = TYT + ((size_t)g * 512 + t * 16 + i) * SKA; rowp[512 + p] = (bf16)f2bf(cr * ar - ci * ai); rowp[576 + p] = (bf16)f2bf(-(cr * ai + ci * ar)); }
    for (int e = tid; e < 64 * 4 * 16; e += 512) { const int p = e >> 6, tt = (e >> 4) & 3, i = e & 15, t = 4 * dq + tt;
        const float ar = ap[(p * 33 + 31 - t) * 2], ai = ap[(p * 33 + 31 - t) * 2 + 1], br = bb[(p * 16 + i) * 2], bi = bb[(p * 16 + i) * 2 + 1];
        MBT[((size_t)g * 256 + p) * SKU + t * 16 + i] = (bf16)f2bf(ar * br - ai * bi); MBT[((size_t)g * 256 + 64 + p) * SKU + t * 16 + i] = (bf16)f2bf(ar * bi + ai * br); }
    for (int e = tid; e < 128 * 8; e += 512) { const int r = e >> 3, c8 = e & 7; const v4u z = {0u, 0u, 0u, 0u}; *(GAS v4u*)(MBT + ((size_t)g * 256 + 128 + r) * SKU + 64 * dq + 8 * c8) = z; }
    LDS_WAIT(); __syncthreads();
}

__device__ __forceinline__ float reduce16(float (&v)[16], int lane) {
#pragma unroll
    for (int st = 0; st < 4; ++st) { const int half = 8 >> st, bit = 1 << st; const bool hi = (lane & bit) != 0;
#pragma unroll
        for (int j = 0; j < half; ++j) { const float send = hi ? v[j] : v[j + half], keep = hi ? v[j + half] : v[j]; v[j] = keep + __shfl_xor(send, bit); } }
    return rows_sum(v[0]);
}
__device__ __forceinline__ void ssm_sample(const void* const* in, const float* TAB, const bf16* Z, bf16* GY, float* out, int g, int b0, int bstride, LAS float* scr, int lane) {
    const float* c_re = (const float*)in[24]; const float* c_im = (const float*)in[25]; const float* d_skip = (const float*)in[26];
    const int p = lane;
    const float abr = TAB[4096 + (g * NST + p) * 2], abi = TAB[4096 + (g * NST + p) * 2 + 1];
    float bbr[16], bbi[16], cr[16], ci[16], dsk[16];
    { const GAS f32x4* bp = (const GAS f32x4*)(TAB + 8192 + (size_t)(g * NST + p) * 32);
#pragma unroll
      for (int i = 0; i < 8; ++i) { const f32x4 v = bp[i]; bbr[2 * i] = v[0]; bbi[2 * i] = v[1]; bbr[2 * i + 1] = v[2]; bbi[2 * i + 1] = v[3]; } }
#pragma unroll
    for (int i = 0; i < 16; ++i) { cr[i] = c_re[(g * GRP + i) * NST + p]; ci[i] = c_im[(g * GRP + i) * NST + p]; dsk[i] = (p == 0) ? d_skip[g * GRP + i] : 0.f; }
    for (int b = b0; b < DECB; b += bstride) {
    const int row0 = MP + b * DECT;
    float hr = ((const float*)in[7])[(b * NG + g) * NST + p], hi = ((const float*)in[8])[(b * NG + g) * NST + p];
    v4u uw[DECT][2];
#pragma unroll
    for (int t = 0; t < DECT; ++t) { const bf16* zr = Z + (size_t)(row0 + t) * NZ + ZC_U + GRP * g; uw[t][0] = *(const GAS v4u*)zr; uw[t][1] = *(const GAS v4u*)(zr + 8); }
#pragma unroll
    for (int t = 0; t < DECT; ++t) {
        float u[16]; { float a[8], b[8]; unpack8(uw[t][0], a); unpack8(uw[t][1], b);
#pragma unroll
            for (int i = 0; i < 8; ++i) { u[i] = a[i]; u[8 + i] = b[i]; } }
        float bur = 0.f, bui = 0.f;
#pragma unroll
        for (int i = 0; i < 16; ++i) { bur += bbr[i] * u[i]; bui += bbi[i] * u[i]; }
        const float nhr = abr * hr - abi * hi + bur, nhi = abr * hi + abi * hr + bui; hr = nhr; hi = nhi;
        float z[16];
#pragma unroll
        for (int i = 0; i < 16; ++i) z[i] = cr[i] * hr - ci[i] * hi + dsk[i] * u[i];
#pragma unroll
        for (int i = 0; i < 16; ++i) scr[lane * 17 + i] = z[i];
        LDS_WAIT(); asm volatile("" ::: "memory");
        float y = 0.f;
#pragma unroll
        for (int k = 0; k < 16; ++k) y += scr[((lane >> 4) * 16 + k) * 17 + (lane & 15)];
        y = rows_sum(y);
        LDS_WAIT(); asm volatile("" ::: "memory");
        if (lane < 16) GY[(size_t)(row0 + t) * SSMW + GRP * g + lane] = (bf16)f2bf(gelu_tanh(y));
    }
    out[O_SRES + (size_t)(b * NG + g) * NST + p] = hr; out[O_SIMS + (size_t)(b * NG + g) * NST + p] = hi;
    }
}
__device__ __forceinline__ void ssm_carry_item(const float* TAB, const float* SST, bf16* AY, float* out, int b, int g, int ph, LAS unsigned char* lds, int tid) {
    const int pl = tid & 31, sup = tid >> 5, p = 32 * ph + pl;
    const float ar = TAB[(g * NST + p) * 2], ai = TAB[(g * NST + p) * 2 + 1];
    float sr[16], si[16];
#pragma unroll
    for (int i = 0; i < 16; ++i) { const int ch = b * 256 + sup * 16 + i; const float* sp = SST + ((size_t)ch * NG + g) * 128; sr[i] = sp[p]; si[i] = sp[64 + p]; }
    float hr = 0.f, hi = 0.f;
#pragma unroll
    for (int i = 0; i < 16; ++i) { const float nr = ar * hr - ai * hi + sr[i], ni = ar * hi + ai * hr + si[i]; hr = nr; hi = ni; sr[i] = hr; si[i] = hi; }
    LAS float* tot = (LAS float*)lds;
    LAS float* car = tot + 1024;
    tot[(sup * 32 + pl) * 2] = hr; tot[(sup * 32 + pl) * 2 + 1] = hi;
    LDS_WAIT(); __syncthreads();
    if (sup == 0) { float br = ar, bi = ai;
#pragma unroll
        for (int k = 0; k < 4; ++k) { const float t = br * br - bi * bi; bi = 2.f * br * bi; br = t; }
        float cr = 0.f, ci = 0.f;
        for (int s2 = 0; s2 < 16; ++s2) { car[(s2 * 32 + pl) * 2] = cr; car[(s2 * 32 + pl) * 2 + 1] = ci; const float tr = tot[(s2 * 32 + pl) * 2], ti = tot[(s2 * 32 + pl) * 2 + 1];
            const float nr = br * cr - bi * ci + tr, ni = br * ci + bi * cr + ti; cr = nr; ci = ni; }
        out[O_SREP + (b * NG + g) * NST + p] = cr; out[O_SIMP + (b * NG + g) * NST + p] = ci; }
    LDS_WAIT(); __syncthreads();
    float er = car[(sup * 32 + pl) * 2], ei = car[(sup * 32 + pl) * 2 + 1], lr = 0.f, li = 0.f;
#pragma unroll
    for (int i = 0; i < 16; ++i) { const int ch = b * 256 + sup * 16 + i; bf16* ay = AY + ((size_t)g * SCH + ch) * SKA;
        ay[512 + p] = (bf16)f2bf(er + lr); ay[576 + p] = (bf16)f2bf(ei + li);
        const float nr = ar * er - ai * ei, ni = ar * ei + ai * er; er = nr; ei = ni; lr = sr[i]; li = si[i]; }
    LDS_WAIT(); __syncthreads();
}

#define TAIL_FILL(nbusy, NIT, ...) do { const int ntail_ = ((nbusy) < G) ? (nbusy) : 0; LAS float* scr = (LAS float*)(lds + RING_OFF + wave * 16384); \
        if (ntail_ == 0) { for (int r = gw; r < (NIT); r += NGW) { __VA_ARGS__; } } \
        else if (bx >= ntail_) { for (int r = (bx - ntail_) * NWAVES + wave; r < (NIT); r += (G - ntail_) * NWAVES) { __VA_ARGS__; } } } while (0)

__device__ __forceinline__ float softmax_ref(const float* g_q, const float* g_k, int lane) {
    float a = fmaxf(fabsf(g_q[lane]), fabsf(g_q[64 + (lane & 31)])), b = fmaxf(fabsf(g_k[lane]), fabsf(g_k[64 + (lane & 31)]));
#pragma unroll
    for (int o = 1; o < 64; o <<= 1) { a = fmaxf(a, __shfl_xor(a, o)); b = fmaxf(b, __shfl_xor(b, o)); }
    return QSCALE * 96.0f * a * b * 1.015f + 0.25f;
}

__device__ __forceinline__ void wait_panel(unsigned* cnt, int pm, unsigned target, unsigned* tmo) {
    if (threadIdx.x < 64) {
        unsigned sp = 0;
        while (__hip_atomic_load(cnt + 64 * pm, __ATOMIC_RELAXED, __HIP_MEMORY_SCOPE_AGENT) < target) {
            __builtin_amdgcn_s_sleep(2);
            if ((++sp & 1023u) == 0u && sp > (1u << 22)) { if (threadIdx.x == 0) __hip_atomic_store(tmo, 1u, __ATOMIC_RELAXED, __HIP_MEMORY_SCOPE_AGENT); break; }
        }
        __builtin_amdgcn_fence(__ATOMIC_ACQUIRE, "agent");
        asm volatile("s_waitcnt vmcnt(0)" ::: "memory");
    }
    __syncthreads();
}
#define GEMM_PS(g, nN_, base_p, base_s, E) do { \
      { pg8::Order S_; S_.init(MP / 256, (nN_), 1, G, bx, (base_p)); pg8::gemm_phase<decltype(E), true, true, false>(lds + RING_OFF, g, S_, E); } \
      { pg8::Order S_; S_.init(MS / 256, (nN_), 1, G, bx, (base_s), MP / 256, 4); pg8::gemm_phase<decltype(E), true, true, true>(lds + RING_OFF, g, S_, E); } } while (0)
#define GEMM_P(g, nN_, base_p, E) do { pg8::Order S_; S_.init(MP / 256, (nN_), 1, G, bx, (base_p)); pg8::gemm_phase<decltype(E), true, true, false>(lds + RING_OFF, g, S_, E); } while (0)
#define GEMM_S(g, nN_, base_s, E) do { pg8::Order S_; S_.init(MS / 256, (nN_), 1, G, bx, (base_s), MP / 256, 4); pg8::gemm_phase<decltype(E), true, true, true>(lds + RING_OFF, g, S_, E); } while (0)

__device__ __forceinline__ unsigned char* opqp(unsigned char* p) { asm volatile("" : "+s"(p)); return p; }
#define WIN ((bf16*)(ws + WS_WIN))
#define WUQ ((bf16*)(ws + WS_WUQ))
#define WKV ((bf16*)(ws + WS_WKV))
#define WGLU ((bf16*)(ws + WS_WGLU))
#define WOA ((bf16*)(ws + WS_WOA))
#define WOS ((bf16*)(ws + WS_WOS))
#define WOUT ((bf16*)(ws + WS_WOUT))
#define WPG ((bf16*)(ws + WS_WPG))
#define WPP ((bf16*)(ws + WS_WPP))
#define WUP ((bf16*)(ws + WS_WUP))
#define WDN ((bf16*)(ws + WS_WDN))
#define XN ((bf16*)(ws + WS_XN))
#define Z ((bf16*)(ws + WS_Z))
#define CQN ((bf16*)(ws + WS_CQN))
#define CKVN ((bf16*)(ws + WS_CKVN))
#define PB ((bf16*)(ws + WS_PB))
#define AY ((bf16*)(ws + WS_AY))
#define RT ((float*)(ws + WS_ROPE))
#define RB ((bf16*)(ws + WS_ROPEB))
#define QRAW ((bf16*)(ws + WS_QRAW))
#define KVRAW ((bf16*)(ws + WS_KVRAW))
#define PP ((bf16*)(ws + WS_PP))
#define Q ((bf16*)(ws + WS_Q))
#define K ((bf16*)(ws + WS_K))
#define ATT ((bf16*)(ws + WS_ATT))
#define GY ((bf16*)(ws + WS_GY))
#define YG ((bf16*)(ws + WS_YG))
#define T1 ((bf16*)(ws + WS_T1))
#define MIX ((bf16*)(ws + WS_MIX))
#define SS1 ((float*)(ws + WS_SS1))
#define SS2 ((float*)(ws + WS_SS2))
#define UPB ((bf16*)(ws + WS_UP))
#define HB ((bf16*)(ws + WS_H))
#define X2B ((bf16*)(ws + WS_X2))
#define CB ((bf16*)(ws + WS_CB))
#define KNC ((bf16*)(ws + WS_KNC))
#define ROPE ((float*)(ws + WS_ROPE))
#define SST ((float*)(ws + WS_SST))
__global__ void __launch_bounds__(NWAVES * 64, 2) mk_fwd(Args args) {
    extern __shared__ __attribute__((aligned(16))) unsigned char lds_raw[];
    LAS unsigned char* lds = (LAS unsigned char*)lds_raw;
    volatile LAS unsigned* MISC = (volatile LAS unsigned*)(lds + MISC_OFF);
    const int tid0 = threadIdx.x;
    const int G = gridDim.x, bx = blockIdx.x;
    const int vcu = (G % 8 == 0) ? (bx % 8) * (G / 8) + bx / 8 : bx;
    const int NGW = G * NWAVES;
    unsigned char* ws0 = args.ws;
    unsigned* ctl = (unsigned*)(ws0 + WS_CTL);
    float* out = args.out;
    for (int u = opq(tid0); u < (LDS_BYTES - LDSCTL_OFF) / 4; u += NWAVES * 64) ((LAS unsigned*)(lds + LDSCTL_OFF))[u] = 0u;
    __syncthreads();
    XcdBarrier bar; bar.bar = ctl + CW_BAR; bar.x = 0; bar.st = nullptr;
#if MK_ONE_LAUNCH
    bar = xcd_barrier_post(ctl + CW_BAR, MISC + 8);
#define GRID_BAR() xcd_barrier(bar)
#else
#define GRID_BAR() do {} while (0)
#endif
    const int lo = args.ph_lo, hi = args.ph_hi;
#ifndef PHMASK
#define PHMASK 0xFFFFFFFFu
#endif
#define IN(k) ((((PHMASK) >> (k)) & 1u) && lo <= (k) && (k) < hi)
#define BOTH(k) (IN(k) && IN((k) + 1))

    const float* x_prompt = (const float*)args.in[0]; const float* x_sample = (const float*)args.in[1];
    const float* p_prompt = (const float*)args.in[2]; const float* p_sample = (const float*)args.in[3];
    if (IN(0)) REPLOOP(0) { unsigned char* ws = opqp(ws0); const int tid = opq(tid0), lane = tid & 63, wave = __builtin_amdgcn_readfirstlane(tid >> 6), gw = vcu * NWAVES + wave; (void)lane; (void)gw;
        _Pragma("unroll") for (int rq_ = 0; rq_ < P0A; ++rq_)
        for (int it = bx; it < NG * 8; it += G) ssm_tables_item(args.in, it >> 3, it & 7, lds + RING_OFF, (bf16*)(ws + WS_MBT), (bf16*)(ws + WS_TYT), (float*)(ws + WS_SSMT), tid);
        LAS float* scr = (LAS float*)(lds + RING_OFF + wave * 16384);
        constexpr int I_WIN = 16 * (NZ / 32);
        _Pragma("unroll") for (int rq_ = 0; rq_ < P0B; ++rq_)
        for (int r = gw; r < I_WIN; r += NGW) { const int nblk = NZ / 32, kb = r / nblk, nb = r % nblk, nd = 32 * nb; int ns; bool pad = false;
                if (nd < 256) ns = 384 + nd; else if (nd < 640) ns = nd - 256; else if (nd < 672) ns = nd; else if (nd < 768) { ns = 0; pad = true; }
                else if (nd < 1280) ns = 672 + (nd - 768); else if (nd < 2304) ns = 1184 + (nd - 1280); else ns = 2208 + (nd - 2304);
                tr_item(pad ? nullptr : (const float*)args.in[11], 3232, 64 * kb, ns, WIN, 1024, nd, scr, lane); }
        const float* gmix = (const float*)args.in[10];
        f32x4 gm[4];
#pragma unroll
        for (int j = 0; j < 4; ++j) gm[j] = ((const GAS f32x4*)gmix)[lane + 64 * j];
        for (int m0 = gw; m0 < M; m0 += 2 * NGW) { const int m1 = m0 + NGW; const bool two = m1 < M;
            f32x4 v[2][4], pv[2];
#pragma unroll
            for (int r = 0; r < 2; ++r) { const int m = (r == 0 || two) ? (r == 0 ? m0 : m1) : m0;
                const float* xrow = (m < MP) ? x_prompt + (size_t)m * D : x_sample + (size_t)(m - MP) * D; const GAS f32x4* xr = (const GAS f32x4*)xrow + lane;
#pragma unroll
                for (int j = 0; j < 4; ++j) v[r][j] = xr[64 * j];
                const float* prow = (m < MP) ? p_prompt + (size_t)m * PLE : p_sample + (size_t)(m - MP) * PLE; pv[r] = ((const GAS f32x4*)prow)[lane]; }
#pragma unroll
            for (int r = 0; r < 2; ++r) { if (r == 1 && !two) break; const int m = r == 0 ? m0 : m1; float sq = 0.f;
#pragma unroll
                for (int j = 0; j < 4; ++j) sq += (v[r][j].x * v[r][j].x + v[r][j].y * v[r][j].y) + (v[r][j].z * v[r][j].z + v[r][j].w * v[r][j].w);
                const float rs = 1.0f / sqrtf(wave_sum(sq) * (1.f / D) + EPS);
                GAS v2u* o8 = (GAS v2u*)(XN + (size_t)m * D) + lane;
#pragma unroll
                for (int j = 0; j < 4; ++j) { v2u w; w.x = pk2(v[r][j].x * rs * gm[j].x, v[r][j].y * rs * gm[j].y); w.y = pk2(v[r][j].z * rs * gm[j].z, v[r][j].w * rs * gm[j].w); o8[64 * j] = w; }
                v2u w; w.x = pk2(pv[r].x, pv[r].y); w.y = pk2(pv[r].z, pv[r].w); ((GAS v2u*)(PB + (size_t)m * PLE))[lane] = w; }
        }
        if (BOTH(0)) GRID_BAR();
    }

    if (IN(1)) REPLOOP(1) { unsigned char* ws = opqp(ws0); const int tid = opq(tid0), lane = tid & 63, wave = __builtin_amdgcn_readfirstlane(tid >> 6), gw = vcu * NWAVES + wave; (void)lane; (void)gw;
        pg8::Gemm g{XN, WIN, D, D, D, 0, 0}; pg8::Order S; S.init(M / 256, NZ / 256, 1, G, bx, 0);
        EpiInproj E{Z, CQN, CKVN, AY, out, (const float*)args.in[13], lds + 131072};
        pg8::gemm_phase(lds + RING_OFF, g, S, E);
        { constexpr int I_WUQ = 6 * 24, I_WUK = 4 * 16, I_WUV = 4 * 16, I_WGLU = 8 * 32, I_WOA = 8 * 32, I_WOS = 8 * 32, I_WOUT = 16 * 32, I_WPP = 4 * 32;
          constexpr int NIT1 = I_WUQ + I_WUK + I_WUV + I_WGLU + I_WOA + I_WOS + I_WOUT + I_WPP;
          TAIL_FILL(((M / 256) * (NZ / 256)) % G, NIT1, { int q = r;
            if (q < I_WUQ) { tr_plain((const float*)args.in[14], 384, 768, WUQ, q, scr, lane, (const float*)args.in[12]); continue; } q -= I_WUQ;
            if (q < I_WUK) { tr_plain((const float*)args.in[15], 256, 512, WKV, q, scr, lane); continue; } q -= I_WUK;
            if (q < I_WUV) { tr_plain((const float*)args.in[16], 256, 512, WKV + 512 * 256, q, scr, lane); continue; } q -= I_WUV;
            if (q < I_WGLU) { const int kb = q / 32, nb = q % 32, nd = 32 * nb; const int pn = nd >> 8, bj = (nd >> 7) & 1, c = nd & 127; const int ns = bj * 512 + 128 * pn + c;
                tr_item((const float*)args.in[27], 1024, 64 * kb, ns, WGLU, 512, nd, scr, lane); continue; } q -= I_WGLU;
            if (q < I_WOA) { tr_plain((const float*)args.in[28], 512, 1024, WOA, q, scr, lane); continue; } q -= I_WOA;
            if (q < I_WOS) { tr_plain((const float*)args.in[29], 512, 1024, WOS, q, scr, lane); continue; } q -= I_WOS;
            if (q < I_WOUT) { tr_plain((const float*)args.in[30], 1024, 1024, WOUT, q, scr, lane); continue; } q -= I_WOUT;
            tr_plain((const float*)args.in[38], 256, 1024, WPP, q, scr, lane); });
          TAIL_FILL(((M / 256) * (NZ / 256)) % G, 16 * 176, { const int kb_ = r / 176, nd_ = 32 * (r % 176), ns_ = ((nd_ >> 7) & 1) * DFF + 128 * (nd_ >> 8) + (nd_ & 127);     \
            tr_item((const float*)args.in[32], UPW, 64 * kb_, ns_, WUP, 1024, nd_, scr, lane, (const float*)args.in[31]); });
          const int nb1 = ((M / 256) * (NZ / 256)) % G, b0_ = (nb1 && bx >= nb1) ? bx - nb1 : (nb1 ? -1 : bx), gs_ = nb1 ? G - nb1 : G;
          if (b0_ >= 0) {
        { for (int i = b0_ * 512 + tid; i < (SEQ + DECT) * 16; i += gs_ * 512) { const int pos = i >> 4, k = i & 15;
              const float inv = (float)exp(-(double)k * (1.0 / 16.0) * 9.210340371976184); const float ang = (float)pos * inv; const float c = cosf(ang), sn = sinf(ang);
              RT[pos * 32 + k] = c; RT[pos * 32 + 16 + k] = sn; RB[pos * 32 + k] = (bf16)f2bf(c); RB[pos * 32 + 16 + k] = (bf16)f2bf(sn); } }
        { unsigned* W8 = (unsigned*)(ws + WS_W8); const float* w_uk = (const float*)args.in[15];
          for (int i = b0_ * 512 + tid; i < 512 * 64; i += gs_ * 512) { const int row = i & 511, k4 = (i >> 9) * 4; int w = 0;
              w = __builtin_amdgcn_cvt_pk_fp8_f32(64.f * w_uk[(size_t)k4 * 512 + row], 64.f * w_uk[(size_t)(k4 + 1) * 512 + row], w, false);
              w = __builtin_amdgcn_cvt_pk_fp8_f32(64.f * w_uk[(size_t)(k4 + 2) * 512 + row], 64.f * w_uk[(size_t)(k4 + 3) * 512 + row], w, true);
              W8[row * 64 + (k4 >> 2)] = (unsigned)w; } }
          } }
        if (BOTH(1)) GRID_BAR();
    }

    constexpr int NMT = M / 256;

    if (IN(3)) REPLOOP(3) { unsigned char* ws = opqp(ws0); const int tid = opq(tid0), lane = tid & 63, wave = __builtin_amdgcn_readfirstlane(tid >> 6), gw = vcu * NWAVES + wave; (void)lane; (void)gw;
        {
          constexpr int NPR = MP / 256;
          pg8::Gemm gq{CQN, WUQ, QL, QL, QL, 0, 0}; auto fq_ = [=](const pg8::Unit& u, int row, int col, f32x4 a, f32x4 b) { *(GAS v4u*)(QRAW + (size_t)row * 768 + col) = pack8(a, b); }; pg8::EpiRow8<decltype(fq_)> Eq{fq_};
          pg8::Gemm gk{CKVN, WKV, KVL, KVL, KVL, 0, 0}; auto fk_ = [=](const pg8::Unit& u, int row, int col, f32x4 a, f32x4 b) { *(GAS v4u*)(KVRAW + (size_t)row * 1024 + col) = pack8(a, b); }; pg8::EpiRow8<decltype(fk_)> Ek{fk_};
          GEMM_P(gq, 3, 0, Eq); GEMM_P(gk, 4, NPR * 3, Ek);
          { pg8::Gemm g{AY, (const bf16*)(ws + WS_MBT), SKA, SKU, SKU, (size_t)SCH * SKA, (size_t)256 * SKU}; pg8::Order S; S.init(SCH / 256, 1, NG, G, bx, NPR * 7);
            auto f = [=](const pg8::Unit& u, int row, int col, f32x4 a, f32x4 b) { if (col < 128) { float* d = SST + ((size_t)row * NG + u.z) * 128 + col; *(GAS f32x4*)d = a; *(GAS f32x4*)(d + 4) = b; } };
            pg8::EpiRow8<decltype(f)> E{f}; pg8::gemm_phase(lds + RING_OFF, g, S, E); }
          constexpr int B2 = NPR * 7 + 64;
          GEMM_S(gq, 3, B2, Eq); GEMM_S(gk, 4, B2 + 24, Ek); }
        if (BOTH(3)) GRID_BAR();
    }

    if (IN(4)) REPLOOP(4) { unsigned char* ws = opqp(ws0); const int tid = opq(tid0), lane = tid & 63, wave = __builtin_amdgcn_readfirstlane(tid >> 6), gw = vcu * NWAVES + wave; (void)lane; (void)gw;
        _Pragma("unroll") for (int rpc_ = 0; rpc_ < P4C; ++rpc_)
        for (int it = bx; it < NBATCH * NG * 2; it += G) ssm_carry_item((const float*)(ws + WS_SSMT), (const float*)(ws + WS_SST), AY, out, it >> 6, (it >> 1) & 31, it & 1, lds + RING_OFF, tid);
        _Pragma("unroll") for (int rpd_ = 0; rpd_ < P4D; ++rpd_)
        for (int it = G - 1 - bx; it < NH * (MS / 64); it += G) qabs_item(args.in, QRAW, WKV, ROPE, (bf16*)(ws + WS_QABS), it & 7, it >> 3, lds + RING_OFF, tid);
        const float* g_q = (const float*)args.in[17]; const float* g_k = (const float*)args.in[18];
        const int h = lane >> 3, sub = lane & 7;
        float gq[12], gk[12];
#pragma unroll
        for (int i = 0; i < 8; ++i) { gq[i] = g_q[8 * sub + i]; gk[i] = g_k[8 * sub + i]; }
        gq[8] = g_q[64 + 2 * sub]; gq[9] = g_q[65 + 2 * sub]; gq[10] = g_q[80 + 2 * sub]; gq[11] = g_q[81 + 2 * sub];
        gk[8] = g_k[64 + 2 * sub]; gk[9] = g_k[65 + 2 * sub]; gk[10] = g_k[80 + 2 * sub]; gk[11] = g_k[81 + 2 * sub];
        _Pragma("unroll") for (int rpa_ = 0; rpa_ < P4A; ++rpa_)
        for (int m0 = gw; m0 < M; m0 += 2 * NGW) {
            const int m1 = m0 + NGW; const bool two = m1 < M;
            f32x2 cs[2], sn[2]; v4u qn8[2], kn8[2]; unsigned qa[2], qb[2]; f32x2 xa[2], xb[2];
#pragma unroll
            for (int j = 0; j < 2; ++j) { const int m = (j == 0 || two) ? (j == 0 ? m0 : m1) : m0;
                const int pos = (m < MP) ? (m & (SEQ - 1)) : SEQ + ((m - MP) & 3);
                const float* rp = ROPE + (size_t)pos * 32; cs[j] = *(const GAS f32x2*)(rp + 2 * sub); sn[j] = *(const GAS f32x2*)(rp + 16 + 2 * sub);
                const bf16* qr = QRAW + (size_t)m * 768 + h * QKH; qn8[j] = *(const GAS v4u*)(qr + 8 * sub); qa[j] = *(const GAS unsigned*)(qr + 64 + 2 * sub); qb[j] = *(const GAS unsigned*)(qr + 80 + 2 * sub);
                kn8[j] = *(const GAS v4u*)(KVRAW + (size_t)m * 1024 + h * QKN + 8 * sub);
                const float* krp = (m < MP) ? out + O_KRP + (size_t)m * QKR : out + O_KRS + (size_t)(m - MP) * QKR; xa[j] = *(const GAS f32x2*)(krp + 2 * sub); xb[j] = *(const GAS f32x2*)(krp + 16 + 2 * sub); }
#pragma unroll
            for (int j = 0; j < 2; ++j) { if (j == 1 && !two) break; const int m = j == 0 ? m0 : m1;
            { float n[8]; unpack8(qn8[j], n);
              float a0 = bflo(qa[j]), a1 = bfhi(qa[j]), b0 = bflo(qb[j]), b1 = bfhi(qb[j]);
              float ss = (a0 * a0 + a1 * a1) + (b0 * b0 + b1 * b1);
#pragma unroll
              for (int i = 0; i < 8; ++i) ss += n[i] * n[i];
              ss = sum8(ss);
              const float rs = QSCALE / sqrtf(ss * (1.f / QKH) + EPS);
#pragma unroll
              for (int i = 0; i < 8; ++i) n[i] *= rs * gq[i];
              a0 *= rs * gq[8]; a1 *= rs * gq[9]; b0 *= rs * gq[10]; b1 *= rs * gq[11];
              bf16* qo = Q + (size_t)m * 768 + h * QKH;
              v4u w; w.x = pk2(n[0], n[1]); w.y = pk2(n[2], n[3]); w.z = pk2(n[4], n[5]); w.w = pk2(n[6], n[7]); *(GAS v4u*)(qo + 8 * sub) = w;
              *(GAS unsigned*)(qo + 64 + 2 * sub) = pk2(a0 * cs[j].x - b0 * sn[j].x, a1 * cs[j].y - b1 * sn[j].y); *(GAS unsigned*)(qo + 80 + 2 * sub) = pk2(a0 * sn[j].x + b0 * cs[j].x, a1 * sn[j].y + b1 * cs[j].y); }
            { float n[8]; unpack8(kn8[j], n);
              float a0 = xa[j].x, a1 = xa[j].y, b0 = xb[j].x, b1 = xb[j].y;
              float ss = (a0 * a0 + a1 * a1) + (b0 * b0 + b1 * b1);
#pragma unroll
              for (int i = 0; i < 8; ++i) ss += n[i] * n[i];
              ss = sum8(ss);
              const float rs = 1.0f / sqrtf(ss * (1.f / QKH) + EPS);
#pragma unroll
              for (int i = 0; i < 8; ++i) n[i] *= rs * gk[i];
              a0 *= rs * gk[8]; a1 *= rs * gk[9]; b0 *= rs * gk[10]; b1 *= rs * gk[11];
              bf16* ko = K + (size_t)m * 768 + h * QKH;
              v4u w; w.x = pk2(n[0], n[1]); w.y = pk2(n[2], n[3]); w.z = pk2(n[4], n[5]); w.w = pk2(n[6], n[7]); *(GAS v4u*)(ko + 8 * sub) = w;
              *(GAS unsigned*)(ko + 64 + 2 * sub) = pk2(a0 * cs[j].x - b0 * sn[j].x, a1 * cs[j].y - b1 * sn[j].y);
              *(GAS unsigned*)(ko + 80 + 2 * sub) = pk2(a0 * sn[j].x + b0 * cs[j].x, a1 * sn[j].y + b1 * cs[j].y); } }
        }
        _Pragma("unroll") for (int rpb_ = 0; rpb_ < P4B; ++rpb_)
        if (NGW % NG == 0) ssm_sample(args.in, (const float*)(ws + WS_SSMT), Z, GY, out, gw % NG, gw / NG, NGW / NG, (LAS float*)(lds + RING_OFF + wave * 16384), lane);
        else for (int it = gw; it < DECB * NG; it += NGW) ssm_sample(args.in, (const float*)(ws + WS_SSMT), Z, GY, out, it % NG, it / NG, DECB, (LAS float*)(lds + RING_OFF + wave * 16384), lane);
        if (BOTH(4)) GRID_BAR();
    }

    if (IN(5)) REPLOOP(5) { unsigned char* ws = opqp(ws0); const int tid = opq(tid0), lane = tid & 63, wave = __builtin_amdgcn_readfirstlane(tid >> 6), gw = vcu * NWAVES + wave; (void)lane; (void)gw;
        const bool sa_first = SA_FIRST_ALL ? true : ((vcu & 1) != 0);
        const float sref = softmax_ref((const float*)args.in[17], (const float*)args.in[18], lane);
        if (sa_first)
            for (int it = bx; it < DECB * 2; it += G)
                sa::item<0>(args.in, (const bf16*)(ws + WS_QABS), (const unsigned char*)(ws + WS_W8), (const bf16*)(ws + WS_ROPEB), (float*)(ws + WS_PO), (float*)(ws + WS_PL), sref, it >> 1, it & 1, lds + RING_OFF, tid, wave, lane);
        for (int pi = vcu; pi < 256; pi += G) { const int bh = pi >> 4, s_ = pi & 15;
            pa::attn_unit(Q, K, KVRAW + 512, ATT, bh >> 3, bh & 7, s_, sref, lds + RING_OFF, wave, lane);
            pa::attn_unit(Q, K, KVRAW + 512, ATT, bh >> 3, bh & 7, 31 - s_, sref, lds + RING_OFF, wave, lane); }
        if (!sa_first)
            for (int it = bx; it < DECB * 2; it += G)
                sa::item<0>(args.in, (const bf16*)(ws + WS_QABS), (const unsigned char*)(ws + WS_W8), (const bf16*)(ws + WS_ROPEB), (float*)(ws + WS_PO), (float*)(ws + WS_PL), sref, it >> 1, it & 1, lds + RING_OFF, tid, wave, lane);
        if (BOTH(5)) GRID_BAR();
    }

    if (IN(6)) REPLOOP(6) { unsigned char* ws = opqp(ws0); const int tid = opq(tid0), lane = tid & 63, wave = __builtin_amdgcn_readfirstlane(tid >> 6), gw = vcu * NWAVES + wave; (void)lane; (void)gw;
        const float sref6 = softmax_ref((const float*)args.in[17], (const float*)args.in[18], lane);
        const int GH = G / 2;
        _Pragma("unroll") for (int rq_ = 0; rq_ < P6A; ++rq_)
        if (bx >= GH) for (int it = bx - GH; it < NH * (MS / 16); it += G - GH)
            sa::combine_item(args.in, Q, K, CKVN, (const float*)(ws + WS_PO), (const float*)(ws + WS_PL), sref6, ATT, it & 7, it >> 3, lds + RING_OFF, tid, wave, lane);
        { pg8::Gemm g{AY, (const bf16*)(ws + WS_TYT), SKA, SKA, SKA, (size_t)SCH * SKA, (size_t)512 * SKA}; pg8::Order S; S.init(SCH / 256, 2, NG, GH, bx, 0);
          auto f = [=](const pg8::Unit& u, int row, int col, f32x4 a, f32x4 b) {
#pragma unroll
              for (int i = 0; i < 4; ++i) { a[i] = gelu_tanh(a[i]); b[i] = gelu_tanh(b[i]); }
              *(GAS v4u*)(GY + ((size_t)row * SL + (col >> 4)) * SSMW + u.z * GRP + (col & 15)) = pack8(a, b); };
          pg8::EpiRow8<decltype(f)> E{f}; if (bx < GH) pg8::gemm_phase(lds + RING_OFF, g, S, E); }
        if (BOTH(6)) GRID_BAR();
    }

    if (IN(7)) REPLOOP(7) { unsigned char* ws = opqp(ws0); const int tid = opq(tid0), lane = tid & 63, wave = __builtin_amdgcn_readfirstlane(tid >> 6), gw = vcu * NWAVES + wave; (void)lane; (void)gw;
        { pg8::Gemm gg{GY, WGLU, SSMW, SSMW, SSMW, 0, 0};
          auto fg_ = [=](const pg8::Unit& u, int row, int cp, f32x4 a0, f32x4 a1, f32x4 b0, f32x4 b1) {
#pragma unroll
              for (int i = 0; i < 4; ++i) { a0[i] *= sigmoidf_(b0[i]); a1[i] *= sigmoidf_(b1[i]); }
              *(GAS v4u*)(YG + (size_t)row * SSMW + cp) = pack8(a0, a1); };
          pg8::EpiPair8<decltype(fg_)> Eg{fg_};
          pg8::Gemm ga_{ATT, WOA, ATTW, ATTW, ATTW, 0, 0};
          auto fa_ = [=](const pg8::Unit& u, int row, int col, f32x4 a, f32x4 b) { float gt[8]; unpack8(*(const GAS v4u*)(Z + (size_t)row * NZ + ZC_GA + col), gt);
#pragma unroll
              for (int i = 0; i < 4; ++i) { a[i] *= gt[i]; b[i] *= gt[4 + i]; }
              *(GAS v4u*)(T1 + (size_t)row * D + col) = pack8(a, b); };
          pg8::EpiRow8<decltype(fa_)> Ea{fa_};
          GEMM_P(gg, 4, 0, Eg); GEMM_P(ga_, 4, 256, Ea); GEMM_S(gg, 4, 512, Eg); GEMM_S(ga_, 4, 544, Ea); }
        if (BOTH(7)) GRID_BAR();
    }

    if (IN(8)) REPLOOP(8) { unsigned char* ws = opqp(ws0); const int tid = opq(tid0), lane = tid & 63, wave = __builtin_amdgcn_readfirstlane(tid >> 6), gw = vcu * NWAVES + wave; (void)lane; (void)gw;
        pg8::Gemm g{YG, WOS, SSMW, SSMW, SSMW, 0, 0};
        auto f = [=](const pg8::Unit& u, int row, int col, f32x4 a, f32x4 b) { float gt[8], t1[8]; unpack8(*(const GAS v4u*)(Z + (size_t)row * NZ + ZC_GS + col), gt); unpack8(*(const GAS v4u*)(T1 + (size_t)row * D + col), t1);
#pragma unroll
            for (int i = 0; i < 4; ++i) { a[i] = t1[i] + a[i] * gt[i]; b[i] = t1[4 + i] + b[i] * gt[4 + i]; }
            *(GAS v4u*)(MIX + (size_t)row * D + col) = pack8(a, b); };
        pg8::EpiRow8<decltype(f)> E{f}; GEMM_PS(g, 4, 0, 256, E);
        TAIL_FILL(32, 44 * 32, tr_plain((const float*)args.in[35], DFF, 1024, WDN, r, scr, lane));
        if (BOTH(8)) GRID_BAR();
    }

    if (IN(9)) REPLOOP(9) { unsigned char* ws = opqp(ws0); const int tid = opq(tid0), lane = tid & 63, wave = __builtin_amdgcn_readfirstlane(tid >> 6), gw = vcu * NWAVES + wave; (void)lane; (void)gw;
        pg8::Gemm g{MIX, WOUT, D, D, D, 0, 0};
        EpiResid<false> E{x_prompt, x_sample, nullptr, XN, SS1};
        GEMM_PS(g, 4, 0, 256, E);
        TAIL_FILL(32, 16 * 32, tr_plain((const float*)args.in[37], 1024, 1024, WPG, r, scr, lane, (const float*)args.in[36]));
        if (BOTH(9)) GRID_BAR();
    }

    if (IN(10)) REPLOOP(10) { unsigned char* ws = opqp(ws0); const int tid = opq(tid0), lane = tid & 63, wave = __builtin_amdgcn_readfirstlane(tid >> 6), gw = vcu * NWAVES + wave; (void)lane; (void)gw;
        pg8::Gemm g{XN, WUP, D, D, D, 0, 0};
        EpiUpConv E{SS1, HB, (bf16*)(ws + WS_UPF), (bf16*)(ws + WS_UPL), out, (const float*)args.in[33], (const float*)args.in[34], (const float*)args.in[9], lds + 131072, ctl + CW_PAN};
        constexpr int NUS = (MS / 256) * (UPW / 256), NUP = (MP / 256) * (UPW / 256);
        { pg8::Order Sa, Sb; Sa.init(MS / 256, UPW / 256, 1, G, bx, 0, MP / 256, 1); Sb.init(MP / 256, UPW / 256, 1, G, bx, NUS); pg8::OrderSeq S; S.init(Sa, Sb, NUS, G, bx);
          pg8::gemm_phase<EpiUpConv, true, true, false, pg8::OrderSeq>(lds + RING_OFF, g, S, E); }
        {
          pg8::Gemm gp{PB, WPP, PLE, PLE, PLE, 0, 0}; auto fp_ = [=](const pg8::Unit& u, int row, int col, f32x4 a, f32x4 b) { *(GAS v4u*)(PP + (size_t)row * 1024 + col) = pack8(a, b); }; pg8::EpiRow8<decltype(fp_)> Ep{fp_};
          const int nb_ = (NUS + NUP) % G; const int nidle = nb_ ? G - nb_ : G, ci = nb_ ? bx - nb_ : bx;
          const int nd_ = (nidle > 64) ? 32 : 0;
          if (ci >= 0 && ci < nd_) { pg8::Gemm gd{HB, WDN, DFF, DFF, DFF, 0, 0}; EpiResid<true> Ed{nullptr, nullptr, XN, X2B, SS2};
              pg8::Order Sd; Sd.init(MS / 256, 4, 1, nd_, ci, 0, MP / 256, 4); pg8::Unit uo;
              for (int i = 0; Sd.next(i, uo); ++i) wait_panel(ctl + CW_PAN, uo.pm, (unsigned)(UPW / 256) * 8u, ctl + CW_PTMO);
              pg8::gemm_phase<EpiResid<true>, true, true, true>(lds + RING_OFF, gd, Sd, Ed); }
          else if (ci >= nd_) { pg8::Order So; So.init(NMT, 4, 1, nidle - nd_, ci - nd_, 0); pg8::gemm_phase(lds + RING_OFF, gp, So, Ep); } }
        if (BOTH(10)) GRID_BAR();
    }


    if (IN(12)) REPLOOP(12) { unsigned char* ws = opqp(ws0); const int tid = opq(tid0), lane = tid & 63, wave = __builtin_amdgcn_readfirstlane(tid >> 6), gw = vcu * NWAVES + wave; (void)lane; (void)gw;
        { const float* conv_w = (const float*)args.in[33]; const float* conv_b = (const float*)args.in[34]; const bf16* UPF = (const bf16*)(ws + WS_UPF); const bf16* UPL = (const bf16*)(ws + WS_UPL);
          constexpr int NCG = DFF / 8; pg8::Order So; So.init(MP / 256, 4, 1, G, bx, 0); pg8::Unit uo;
          for (int ui = 0; So.next(ui, uo); ++ui) { const int pm = uo.pm;
          for (int it = tid; it < 2 * NCG; it += 512) {
            const int cg = it % NCG, rr = it / NCG, c0 = 8 * cg; const bool first = (pm & 31) == 0;
            float cur[16], p1[16], p2[16];
            unpack8(*(const GAS v4u*)(UPF + ((size_t)pm * 2 + rr) * UPW + c0), *(float(*)[8])&cur[0]); unpack8(*(const GAS v4u*)(UPF + ((size_t)pm * 2 + rr) * UPW + DFF + c0), *(float(*)[8])&cur[8]);
#pragma unroll
            for (int i = 0; i < 16; ++i) { p1[i] = 0.f; p2[i] = 0.f; }
            if (rr == 1) { unpack8(*(const GAS v4u*)(UPF + ((size_t)pm * 2) * UPW + c0), *(float(*)[8])&p1[0]); unpack8(*(const GAS v4u*)(UPF + ((size_t)pm * 2) * UPW + DFF + c0), *(float(*)[8])&p1[8]); }
            if (!first) {
                if (rr == 0) { unpack8(*(const GAS v4u*)(UPL + ((size_t)(pm - 1) * 2 + 1) * UPW + c0), *(float(*)[8])&p1[0]); unpack8(*(const GAS v4u*)(UPL + ((size_t)(pm - 1) * 2 + 1) * UPW + DFF + c0), *(float(*)[8])&p1[8]);
                               unpack8(*(const GAS v4u*)(UPL + ((size_t)(pm - 1) * 2) * UPW + c0), *(float(*)[8])&p2[0]); unpack8(*(const GAS v4u*)(UPL + ((size_t)(pm - 1) * 2) * UPW + DFF + c0), *(float(*)[8])&p2[8]); }
                else { unpack8(*(const GAS v4u*)(UPL + ((size_t)(pm - 1) * 2 + 1) * UPW + c0), *(float(*)[8])&p2[0]); unpack8(*(const GAS v4u*)(UPL + ((size_t)(pm - 1) * 2 + 1) * UPW + DFF + c0), *(float(*)[8])&p2[8]); }
            }
            float hh[8];
#pragma unroll
            for (int i = 0; i < 8; ++i) { const float ca = conv_b[c0 + i] + p2[i] * conv_w[c0 + i] + p1[i] * conv_w[UPW + c0 + i] + cur[i] * conv_w[2 * UPW + c0 + i];
                const float cv = conv_b[DFF + c0 + i] + p2[8 + i] * conv_w[DFF + c0 + i] + p1[8 + i] * conv_w[UPW + DFF + c0 + i] + cur[8 + i] * conv_w[2 * UPW + DFF + c0 + i]; hh[i] = gelu_tanh(ca) * cv; }
            v4u o; o.x = pk2(hh[0], hh[1]); o.y = pk2(hh[2], hh[3]); o.z = pk2(hh[4], hh[5]); o.w = pk2(hh[6], hh[7]);
            *(GAS v4u*)(HB + ((size_t)pm * 256 + rr) * DFF + c0) = o;
        }
          }
          asm volatile("s_waitcnt vmcnt(0)" ::: "memory"); __syncthreads(); }
        pg8::Gemm g{HB, WDN, DFF, DFF, DFF, 0, 0};
        EpiResid<true> E{nullptr, nullptr, XN, X2B, SS2};
        { constexpr int NU10 = (M / 256) * (UPW / 256); const int nb_ = NU10 % G, nidle = nb_ ? G - nb_ : G;
          if (nidle > 64) GEMM_P(g, 4, 0, E); else GEMM_PS(g, 4, 0, 256, E); }
        if (BOTH(12)) GRID_BAR();
    }

    if (IN(13)) REPLOOP(13) { unsigned char* ws = opqp(ws0); const int tid = opq(tid0), lane = tid & 63, wave = __builtin_amdgcn_readfirstlane(tid >> 6), gw = vcu * NWAVES + wave; (void)lane; (void)gw;
        pg8::Gemm g{X2B, WPG, D, D, D, 0, 0};
        EpiPle E{SS2, X2B, PP, out + O_Y};
        GEMM_PS(g, 4, 0, 256, E);
    }
#undef IN
#undef BOTH
}

#undef WIN
#undef WUQ
#undef WKV
#undef WGLU
#undef WOA
#undef WOS
#undef WOUT
#undef WPG
#undef WPP
#undef WUP
#undef WDN
#undef XN
#undef Z
#undef CQN
#undef CKVN
#undef PB
#undef AY
#undef RT
#undef RB
#undef QRAW
#undef KVRAW
#undef PP
#undef Q
#undef K
#undef ATT
#undef GY
#undef YG
#undef T1
#undef MIX
#undef SS1
#undef SS2
#undef UPB
#undef HB
#undef X2B
#undef CB
#undef KNC
#undef ROPE
#undef SST
constexpr int N_PHASES = 14;
extern "C" void kernel_launch(void* const* d_in, const int* in_sizes, int n_in, void* d_out, int out_size, void* d_ws, size_t ws_size, hipStream_t stream) {
    static int grid = 0;
    if (grid == 0) {
        if (n_in != 39 || (size_t)out_size != O_END || ws_size < WS_END) { fprintf(stderr, "kernel_launch: unexpected sizes n_in %d out %d ws %zu\n", n_in, out_size, ws_size); grid = -1; return; }
        int dev = 0, cus = 0, per_cu = 0;
        if (hipGetDevice(&dev) != hipSuccess || hipDeviceGetAttribute(&cus, hipDeviceAttributeMultiprocessorCount, dev) != hipSuccess) { grid = -1; return; }
        if (hipFuncSetAttribute((const void*)mk_fwd, hipFuncAttributeMaxDynamicSharedMemorySize, LDS_BYTES) != hipSuccess) { fprintf(stderr, "kernel_launch: hipFuncSetAttribute failed\n"); grid = -1; return; }
        if (hipOccupancyMaxActiveBlocksPerMultiprocessor(&per_cu, (const void*)mk_fwd, NWAVES * 64, LDS_BYTES) != hipSuccess || per_cu < 1)
            fprintf(stderr, "kernel_launch: occupancy query reports %d\n", per_cu);
        (void)hipGetLastError();
        grid = cus;
    }
    if (grid < 0) return;
    if (hipMemsetAsync((char*)d_ws + WS_CTL, 0, CTL_ZERO_BYTES, stream) != hipSuccess) return;
    Args a{};
    for (int i = 0; i < 39; ++i) a.in[i] = d_in[i];
    a.out = (float*)d_out; a.ws = (unsigned char*)d_ws;
#if MK_ONE_LAUNCH
    a.ph_lo = 0; a.ph_hi = N_PHASES;
    hipLaunchKernelGGL(mk_fwd, dim3(grid), dim3(NWAVES * 64), LDS_BYTES, stream, a);
#else
    for (int p = 0; p < N_PHASES; ++p) { a.ph_lo = p; a.ph_hi = p + 1;
        hipLaunchKernelGGL(mk_fwd, dim3(grid), dim3(NWAVES * 64), LDS_BYTES, stream, a); }
#endif
}
```

```cpp
#include <hip/hip_runtime.h>
#include <cstdio>
#include <cstdint>

#define REP_PA 1
#define REP_SA 1
#define SA_PROBE 0
#define P0A 1
#define P0B 1
#define P0C 1
#define P6A 1
#define P4A 1
#define P4B 1
#define P4C 1
#define P4D 1
#define SA_FIRST_ALL 0
#define SA_ALLREG 1
#define REP_G 0x0
#if REP_G
#define REPLOOP(k) _Pragma("unroll") for (int rep_ = 0; rep_ < 1 + (((REP_G) >> (k)) & 1); ++rep_)
#else
#define REPLOOP(k)
#endif
#ifndef MK_ONE_LAUNCH
#define MK_ONE_LAUNCH 1
#endif

constexpr int D = 1024, SEQ = 8192, NBATCH = 2, MP = NBATCH * SEQ, DECB = 128, DECT = 4, MS = DECB * DECT, M = MP + MS;
constexpr int NH = 8, QKN = 64, QKR = 32, QKH = 96, VH = 64, QL = 384, KVL = 256, ATTW = 512;
constexpr int SSMW = 512, GRP = 16, NG = 32, NST = 64;
constexpr int DFF = 2816, UPW = 2 * DFF, PLE = 256;
constexpr int NPAGES = 64, PAGE = 128, NPOOL = 10240;
constexpr float EPS = 1e-6f;
constexpr int NZ = 3328, ZC_CKV = 0, ZC_CQ = 256, ZC_KR = 640, ZC_U = 768, ZC_GA = 1280, ZC_GS = 2304;
constexpr size_t O_Y = 0, O_CKVP = (size_t)M * D, O_KRP = O_CKVP + (size_t)MP * KVL, O_CKVS = O_KRP + (size_t)MP * QKR, O_KRS = O_CKVS + (size_t)MS * KVL,
                 O_SREP = O_KRS + (size_t)MS * QKR, O_SIMP = O_SREP + NBATCH * NG * NST, O_SRES = O_SIMP + NBATCH * NG * NST, O_SIMS = O_SRES + (size_t)DECB * NG * NST,
                 O_CVP = O_SIMS + (size_t)DECB * NG * NST, O_CVS = O_CVP + (size_t)NBATCH * 2 * UPW, O_END = O_CVS + (size_t)DECB * 2 * UPW;
static_assert(O_END == 24164352, "output size");
constexpr int SL = 32, SCH = MP / SL  , SKU = SL * GRP  , SKA = SKU + 2 * NST  ;

constexpr size_t MiB = 1u << 20;
constexpr size_t WS_CTL = 0, CTL_ZERO_BYTES = 1 * MiB;
constexpr size_t WS_WIN = 2 * MiB;
constexpr size_t WS_WUQ = 10 * MiB;
constexpr size_t WS_WKV = 11 * MiB;
constexpr size_t WS_WGLU = 12 * MiB;
constexpr size_t WS_WOA = 13 * MiB, WS_WOS = 14 * MiB;
constexpr size_t WS_WOUT = 15 * MiB;
constexpr size_t WS_WPG = 17 * MiB;
constexpr size_t WS_WPP = 19 * MiB;
constexpr size_t WS_WUP = 20 * MiB;
constexpr size_t WS_WDN = 32 * MiB;
constexpr size_t WS_ROPE = 38 * MiB;
constexpr size_t WS_SSMT = 40 * MiB;
constexpr size_t WS_MBT = 44 * MiB;
constexpr size_t WS_TYT = 52 * MiB;
constexpr size_t WS_KJ = 72 * MiB;
constexpr size_t WS_XN = 80 * MiB;
constexpr size_t WS_Z = 116 * MiB;
constexpr size_t WS_CQN = 226 * MiB;
constexpr size_t WS_CKVN = 240 * MiB;
constexpr size_t WS_PB = 250 * MiB;
constexpr size_t WS_AY = 260 * MiB;
constexpr size_t WS_QRAW = 300 * MiB;
constexpr size_t WS_KVRAW = 330 * MiB;
constexpr size_t WS_PP = 370 * MiB;
constexpr size_t WS_Q = 410 * MiB;
constexpr size_t WS_K = 440 * MiB;
constexpr size_t WS_ATT = 470 * MiB;
constexpr size_t WS_GY = 490 * MiB;
constexpr size_t WS_YG = 510 * MiB;
constexpr size_t WS_T1 = 530 * MiB;
constexpr size_t WS_MIX = 570 * MiB;
constexpr size_t WS_X1 = 610 * MiB;
constexpr size_t WS_SS1 = 690 * MiB;
constexpr size_t WS_SS2 = 692 * MiB;
constexpr size_t WS_UP = 700 * MiB;
constexpr size_t WS_H = 890 * MiB;
constexpr size_t WS_X2 = 990 * MiB;
constexpr size_t WS_PO = 1080 * MiB;
constexpr size_t WS_PM = 1089 * MiB, WS_PL = 1090 * MiB;
constexpr size_t WS_W8 = 1095 * MiB;
constexpr size_t WS_ROPEB = 1096 * MiB;
constexpr size_t WS_UPF = 1097 * MiB, WS_UPL = 1099 * MiB;
constexpr size_t WS_QABS = 1092 * MiB;
constexpr size_t WS_SST = 1070 * MiB;
constexpr size_t WS_CB = 1100 * MiB;
constexpr size_t WS_KNC = 1650 * MiB;
constexpr size_t WS_END = 2700 * MiB;
constexpr float QSCALE = 0.10206207261596575f * 1.4426950408889634f;

constexpr int CW_BAR = 4096, CW_PAN = 16384, CW_PTMO = 8192;

#define GAS __attribute__((address_space(1)))
#define LAS __attribute__((address_space(3)))
typedef unsigned short bf16;
typedef unsigned v4u __attribute__((ext_vector_type(4)));
typedef unsigned v2u __attribute__((ext_vector_type(2)));
typedef float f32x4 __attribute__((ext_vector_type(4)));
typedef float f32x2 __attribute__((ext_vector_type(2)));
typedef short bf16x8 __attribute__((ext_vector_type(8)));
#define LDS_WAIT() asm volatile("s_waitcnt lgkmcnt(0)" ::: "memory")
#define VM_WAIT() asm volatile("s_waitcnt vmcnt(0)" ::: "memory")
__device__ __forceinline__ unsigned f2bf(float f) { unsigned u = __builtin_bit_cast(unsigned, f); return (u + 0x7fffu + ((u >> 16) & 1u)) >> 16; }
__device__ __forceinline__ unsigned pk2(float lo, float hi) { return f2bf(lo) | (f2bf(hi) << 16); }
__device__ __forceinline__ float bflo(unsigned w) { return __builtin_bit_cast(float, w << 16); }
__device__ __forceinline__ float bfhi(unsigned w) { return __builtin_bit_cast(float, w & 0xffff0000u); }
__device__ __forceinline__ float bf2f(bf16 h) { return __builtin_bit_cast(float, (unsigned)h << 16); }
__device__ __forceinline__ float sigmoidf_(float x) { return __builtin_amdgcn_rcpf(1.0f + __builtin_amdgcn_exp2f(-1.4426950408889634f * x)); }
__device__ __forceinline__ float gelu_tanh(float x) { const float u = 1.5957691216057308f * (x + 0.044715f * x * x * x); return x * sigmoidf_(u); }
__device__ __forceinline__ float wave_sum(float v) {
#pragma unroll
    for (int o = 1; o < 64; o <<= 1) v += __shfl_xor(v, o);
    return v;
}

namespace pg8 {
#define PG8_LAS __attribute__((address_space(3)))
typedef unsigned short bf16_t;
typedef short bf16x8 __attribute__((ext_vector_type(8)));
typedef float f32x4 __attribute__((ext_vector_type(4)));
typedef unsigned u32x4 __attribute__((ext_vector_type(4)));
constexpr int BM = 256, BK = 64, HALF = 128, HTB = HALF * BK * 2, STAGE_BYTES = 8 * HTB, NXCD = 8, WGM = 8;

__host__ __device__ __forceinline__ int lds_byte(int r, int c) { const int st = (r >> 4) * 2 + (c >> 5), rr = r & 15, cc = c & 31, ob = rr * 64 + cc * 2; return st * 1024 + (ob ^ (((ob >> 9) & 1) << 5)); }
__host__ __device__ __forceinline__ void stage_rc(int b, int& R, int& C) { const int st = b / 1024, sb = b % 1024, swz = sb ^ (((sb >> 9) & 1) << 5); R = (st >> 1) * 16 + swz / 64; C = (st & 1) * 32 + (swz % 64) / 2; }
__host__ __device__ __forceinline__ int perm32(int rho) { const int n = rho >> 4, i = rho & 15; return 8 * (i >> 2) + 4 * n + (i & 3); }

struct Unit { int pm, pn, z, q; };
struct Gemm { const bf16_t* A; const bf16_t* Bt; int lda, ldb, K; size_t zA, zB; };

struct Order {
    int nM, nN, n, first, G, pm0, nQ;
    __device__ __forceinline__ void init(int nM_, int nN_, int nZ_, int G_, int c, int base, int pm0_ = 0, int nQ_ = 1) {
        nM = nM_; nN = nN_; n = nM_ * nN_ * nZ_ * nQ_; G = G_; pm0 = pm0_; nQ = nQ_;
        const int i0 = (base > c) ? (base - c + G_ - 1) / G_ : 0;
        first = c + i0 * G_ - base;
    }
    __device__ __forceinline__ bool next(int i, Unit& u) const {
        const long L = (long)first + (long)i * G; if (L >= n) return false;
        int w = (int)L; u.q = -1; if (nQ > 1) { u.q = w % nQ; w /= nQ; }
        const int per = nM * nN; u.z = w / per; int wgid = w % per;
        { const int q = per / NXCD, r = per % NXCD, xcd = wgid % NXCD, off = wgid / NXCD; wgid = (xcd < r ? xcd * (q + 1) : r * (q + 1) + (xcd - r) * q) + off; }
        const int nig = WGM * nN, gid = wgid / nig, fm = gid * WGM, gsz = (nM - fm) < WGM ? (nM - fm) : WGM;
        u.pm = pm0 + fm + ((wgid % nig) % gsz); u.pn = (wgid % nig) / gsz; return true;
    }
};

struct OrderSeq {
    Order a, b; int na;
    __device__ __forceinline__ void init(const Order& a_, const Order& b_, int n1, int G_, int c) { a = a_; b = b_; na = (n1 > c) ? (n1 - c + G_ - 1) / G_ : 0; }
    __device__ __forceinline__ bool next(int i, Unit& u) const { return (i < na) ? a.next(i, u) : b.next(i - na, u); }
};
__device__ __forceinline__ unsigned cvt_pk_bf16(float lo, float hi) { unsigned r; asm volatile("v_cvt_pk_bf16_f32 %0, %1, %2" : "=v"(r) : "v"(lo), "v"(hi)); return r; }

template <class Epi, bool ALIGN_EPI = true, bool SP2 = true, bool QUARTER = false, class Sched = Order>
__device__ __forceinline__ void gemm_phase(PG8_LAS unsigned char* lds, const Gemm g, const Sched& S, const Epi& E) {
    int tid = threadIdx.x; asm volatile("" : "+v"(tid));
    const int wid = __builtin_amdgcn_readfirstlane(tid >> 6), lane = tid & 63, wr = wid >> 2, wc = wid & 3, fr = lane & 15, fq = lane >> 4;
    int K = g.K; asm volatile("" : "+s"(K));
    const int nt = K / BK;
    unsigned voffA[2], voffB[2];
#pragma unroll
    for (int i = 0; i < 2; ++i) { int R, C; stage_rc(tid * 16 + i * 8192, R, C); const int Rb = Epi::PERM ? ((R & ~31) + perm32(R & 31)) : R;
        voffA[i] = (unsigned)(R * g.lda + C) * 2u; voffB[i] = (unsigned)(Rb * g.ldb + C) * 2u; }
    const size_t kstep = (size_t)(BK * 2);
    const size_t hstepA = (size_t)HALF * g.lda * 2, hstepB = (size_t)HALF * g.ldb * 2;
    const size_t tstepA = 2 * hstepA, tstepB = 2 * hstepB;
    const unsigned ldsw = (unsigned)wid * 1024u;
    const int aoff = lds_byte(wr * 64 + fr, fq * 8), boff = lds_byte(wc * 32 + fr, fq * 8);
#define PG8_SA(b, h) (((b) * 2 + (h)) * HTB)
#define PG8_SB(b, h) ((4 + (b) * 2 + (h)) * HTB)
#define PG8_STAGE(bufoff, gbase, voff) do { _Pragma("unroll") for (int _i = 0; _i < 2; ++_i) \
        __builtin_amdgcn_global_load_lds((const unsigned*)((const char*)(gbase) + (voff)[_i]), (PG8_LAS unsigned*)(lds + (bufoff) + ldsw + _i * 8192), 16, 0, 0); } while (0)
#define PG8_LDA(dst, b, h) do { _Pragma("unroll") for (int m = 0; m < 4; ++m) if (!QUARTER || m == cur.q) _Pragma("unroll") for (int k = 0; k < 2; ++k) dst[m][k] = *(const PG8_LAS bf16x8*)(lds + PG8_SA(b, h) + aoff + m * 2048 + k * 1024); } while (0)
#define PG8_LDB(dst, b, h) do { _Pragma("unroll") for (int n = 0; n < 2; ++n) _Pragma("unroll") for (int k = 0; k < 2; ++k) dst[n][k] = *(const PG8_LAS bf16x8*)(lds + PG8_SB(b, h) + boff + n * 2048 + k * 1024); } while (0)
#define PG8_MMA(ai, bj, At, Bt) do { __builtin_amdgcn_s_setprio(1); _Pragma("unroll") for (int m = 0; m < 4; ++m) if (!QUARTER || m == cur.q) _Pragma("unroll") for (int n = 0; n < 2; ++n) _Pragma("unroll") for (int k = 0; k < 2; ++k) \
        acc[ai][bj][m][n] = __builtin_amdgcn_mfma_f32_16x16x32_bf16(Bt[n][k], At[m][k], acc[ai][bj][m][n], 0, 0, 0); __builtin_amdgcn_s_setprio(0); } while (0)
#define PG8_WAIT_V(n) asm volatile("s_waitcnt vmcnt(" #n ")" ::: "memory")
#define PG8_WAIT_L(n) asm volatile("s_waitcnt lgkmcnt(" #n ")" ::: "memory")
#define PG8_BAR __builtin_amdgcn_s_barrier()
#define PG8_SCHED __builtin_amdgcn_sched_barrier(0)
    Unit cur, nxt; int ui = 0;
    if (!S.next(0, cur)) return;
    f32x4 acc[2][2][4][2];
#pragma unroll
    for (int a = 0; a < 2; ++a)
#pragma unroll
        for (int b = 0; b < 2; ++b)
#pragma unroll
            for (int m = 0; m < 4; ++m)
#pragma unroll
                for (int n = 0; n < 2; ++n) acc[a][b][m][n] = (f32x4){0.f, 0.f, 0.f, 0.f};
    bf16x8 At[4][2], B0[2][2], B1[2][2];
    const char* cA = (const char*)(g.A + (size_t)cur.z * g.zA) + (size_t)cur.pm * tstepA; const char* cB = (const char*)(g.Bt + (size_t)cur.z * g.zB) + (size_t)cur.pn * tstepB;
    if constexpr (SP2) {
        PG8_STAGE(PG8_SB(0, 0), cB, voffB); PG8_STAGE(PG8_SB(0, 1), cB + hstepB, voffB); PG8_STAGE(PG8_SA(0, 0), cA, voffA); PG8_STAGE(PG8_SA(0, 1), cA + hstepA, voffA);
        if (wr == 1) PG8_BAR;
        PG8_WAIT_V(2); PG8_BAR;
        PG8_STAGE(PG8_SB(1, 0), cB + kstep, voffB); PG8_STAGE(PG8_SA(1, 0), cA + kstep, voffA); PG8_STAGE(PG8_SB(1, 1), cB + hstepB + kstep, voffB);
        PG8_WAIT_V(6); PG8_BAR;
    } else {
        PG8_STAGE(PG8_SB(0, 0), cB, voffB); PG8_STAGE(PG8_SA(0, 0), cA, voffA); PG8_STAGE(PG8_SB(0, 1), cB + hstepB, voffB); PG8_STAGE(PG8_SA(0, 1), cA + hstepA, voffA);
        if (wr == 1) PG8_BAR;
        PG8_WAIT_V(4); PG8_BAR;
        PG8_STAGE(PG8_SB(1, 0), cB + kstep, voffB); PG8_STAGE(PG8_SA(1, 0), cA + kstep, voffA); PG8_STAGE(PG8_SB(1, 1), cB + hstepB + kstep, voffB);
        PG8_WAIT_V(6); PG8_BAR;
    }
    for (;;) {
        const bool has_next = S.next(ui + 1, nxt);
        const char* nA = has_next ? (const char*)(g.A + (size_t)nxt.z * g.zA) + (size_t)nxt.pm * tstepA : cA; const char* nB = has_next ? (const char*)(g.Bt + (size_t)nxt.z * g.zB) + (size_t)nxt.pn * tstepB : cB;
        for (int t = 0; t < nt; t += 2) {
            const bool last = (t == nt - 2);
            const char* a1 = cA + (size_t)(t + 1) * kstep;
            const char* a2 = last ? nA : cA + (size_t)(t + 2) * kstep; const char* b2 = last ? nB : cB + (size_t)(t + 2) * kstep;
            const char* a3 = a2 + kstep; const char* b3 = b2 + kstep;
            if constexpr (SP2) {
            PG8_LDB(B0, 0, 0); PG8_LDB(B1, 0, 1); PG8_SCHED; PG8_LDA(At, 0, 0); PG8_STAGE(PG8_SA(1, 1), a1 + hstepA, voffA);
            PG8_WAIT_V(8); PG8_WAIT_L(0); PG8_BAR; PG8_MMA(0, 0, At, B0); PG8_MMA(0, 1, At, B1); PG8_BAR; PG8_SCHED;
            PG8_LDA(At, 0, 1); PG8_STAGE(PG8_SB(0, 0), b2, voffB); PG8_STAGE(PG8_SB(0, 1), b2 + hstepB, voffB); PG8_STAGE(PG8_SA(0, 0), a2, voffA);
            PG8_WAIT_V(8); PG8_WAIT_L(0); PG8_BAR; PG8_MMA(1, 0, At, B0); PG8_MMA(1, 1, At, B1); PG8_BAR; PG8_SCHED;
            PG8_LDB(B0, 1, 0); PG8_LDB(B1, 1, 1); PG8_SCHED; PG8_LDA(At, 1, 0); PG8_STAGE(PG8_SA(0, 1), a2 + hstepA, voffA);
            PG8_WAIT_V(8); PG8_WAIT_L(0); PG8_BAR; PG8_MMA(0, 0, At, B0); PG8_MMA(0, 1, At, B1); PG8_BAR; PG8_SCHED;
            PG8_LDA(At, 1, 1); PG8_STAGE(PG8_SB(1, 0), b3, voffB); PG8_STAGE(PG8_SB(1, 1), b3 + hstepB, voffB); PG8_STAGE(PG8_SA(1, 0), a3, voffA);
            PG8_WAIT_V(8); PG8_WAIT_L(0); PG8_BAR; PG8_MMA(1, 0, At, B0); PG8_MMA(1, 1, At, B1); PG8_BAR; PG8_SCHED;
            } else {
            PG8_LDB(B0, 0, 0); PG8_SCHED; PG8_LDA(At, 0, 0); PG8_STAGE(PG8_SA(1, 1), a1 + hstepA, voffA);
            PG8_WAIT_L(8); PG8_BAR; PG8_WAIT_L(0); PG8_MMA(0, 0, At, B0); PG8_BAR; PG8_SCHED;
            PG8_LDB(B1, 0, 1); PG8_STAGE(PG8_SB(0, 0), b2, voffB);
            PG8_BAR; PG8_WAIT_L(0); PG8_MMA(0, 1, At, B1); PG8_BAR;
            PG8_LDA(At, 0, 1); PG8_STAGE(PG8_SA(0, 0), a2, voffA);
            PG8_BAR; PG8_WAIT_L(0); PG8_MMA(1, 0, At, B0); PG8_BAR; PG8_SCHED;
            PG8_STAGE(PG8_SB(0, 1), b2 + hstepB, voffB);
            PG8_WAIT_V(6); PG8_BAR; PG8_MMA(1, 1, At, B1); PG8_BAR;
            PG8_LDB(B0, 1, 0); PG8_SCHED; PG8_LDA(At, 1, 0); PG8_STAGE(PG8_SA(0, 1), a2 + hstepA, voffA);
            PG8_WAIT_L(8); PG8_BAR; PG8_WAIT_L(0); PG8_MMA(0, 0, At, B0); PG8_BAR; PG8_SCHED;
            PG8_LDB(B1, 1, 1); PG8_STAGE(PG8_SB(1, 0), b3, voffB);
            PG8_BAR; PG8_WAIT_L(0); PG8_MMA(0, 1, At, B1); PG8_BAR;
            PG8_LDA(At, 1, 1); PG8_STAGE(PG8_SA(1, 0), a3, voffA);
            PG8_BAR; PG8_WAIT_L(0); PG8_MMA(1, 0, At, B0); PG8_BAR; PG8_SCHED;
            PG8_STAGE(PG8_SB(1, 1), b3 + hstepB, voffB);
            PG8_WAIT_V(6); PG8_BAR; PG8_MMA(1, 1, At, B1); PG8_BAR;
            }
        }
        if constexpr (ALIGN_EPI) { if (wr == 0) PG8_BAR; }
        E(acc, cur, wr, wc, fr, fq);
        if (!has_next) break;
#pragma unroll
        for (int a = 0; a < 2; ++a)
#pragma unroll
            for (int b = 0; b < 2; ++b)
#pragma unroll
                for (int m = 0; m < 4; ++m)
#pragma unroll
                    for (int n = 0; n < 2; ++n) acc[a][b][m][n] = (f32x4){0.f, 0.f, 0.f, 0.f};
        cur = nxt; cA = nA; cB = nB; ++ui;
        if constexpr (ALIGN_EPI) { if (wr == 1) PG8_BAR; }
    }
    PG8_WAIT_V(0);
    if constexpr (!ALIGN_EPI) { if (wr == 0) PG8_BAR; }
    PG8_BAR;
#undef PG8_SA
#undef PG8_SB
#undef PG8_STAGE
#undef PG8_LDA
#undef PG8_LDB
#undef PG8_MMA
#undef PG8_WAIT_V
#undef PG8_WAIT_L
#undef PG8_BAR
#undef PG8_SCHED
}

template <class F> struct EpiRow8 {
    static constexpr bool PERM = true;
    F f;
    __device__ __forceinline__ void operator()(const f32x4 (&acc)[2][2][4][2], const Unit& u, int wr, int wc, int fr, int fq) const {
        const int row0 = u.pm * BM + wr * 64 + fr, col0 = u.pn * BM + wc * 32 + 8 * fq;
#pragma unroll
        for (int ai = 0; ai < 2; ++ai)
#pragma unroll
            for (int m = 0; m < 4; ++m) { if (u.q >= 0 && m != u.q) continue;
#pragma unroll
                for (int bj = 0; bj < 2; ++bj) f(u, row0 + ai * HALF + m * 16, col0 + bj * HALF, acc[ai][bj][m][0], acc[ai][bj][m][1]); }
    }
};
template <class F> struct EpiPair8 {
    static constexpr bool PERM = true;
    F f;
    __device__ __forceinline__ void operator()(const f32x4 (&acc)[2][2][4][2], const Unit& u, int wr, int wc, int fr, int fq) const {
        const int row0 = u.pm * BM + wr * 64 + fr, cp = u.pn * HALF + wc * 32 + 8 * fq;
#pragma unroll
        for (int ai = 0; ai < 2; ++ai)
#pragma unroll
            for (int m = 0; m < 4; ++m) { if (u.q >= 0 && m != u.q) continue; f(u, row0 + ai * HALF + m * 16, cp, acc[ai][0][m][0], acc[ai][0][m][1], acc[ai][1][m][0], acc[ai][1][m][1]); }
    }
};
}
using pg8::cvt_pk_bf16;
__device__ __forceinline__ v4u pack8(f32x4 a, f32x4 b) { v4u w; w.x = cvt_pk_bf16(a[0], a[1]); w.y = cvt_pk_bf16(a[2], a[3]); w.z = cvt_pk_bf16(b[0], b[1]); w.w = cvt_pk_bf16(b[2], b[3]); return w; }

__device__ __forceinline__ void unpack8(v4u w, float (&f)[8]) { f[0] = bflo(w.x); f[1] = bfhi(w.x); f[2] = bflo(w.y); f[3] = bfhi(w.y); f[4] = bflo(w.z); f[5] = bfhi(w.z); f[6] = bflo(w.w); f[7] = bfhi(w.w); }
__device__ __forceinline__ int pg8_opq(int x) { asm volatile("" : "+v"(x)); return x; }
template <bool BASE_BF16> struct EpiResid {
    static constexpr bool PERM = true;
    const float* xp; const float* xs;
    const bf16* xb;
    bf16* XO; float* SS;
    __device__ __forceinline__ void operator()(const pg8::f32x4 (&acc)[2][2][4][2], const pg8::Unit& u, int wr, int wc, int fr_, int fq_) const {
        const int fr = pg8_opq(fr_), fq = pg8_opq(fq_);
        const int row0 = u.pm * 256 + wr * 64 + fr, col0 = u.pn * 256 + wc * 32 + 8 * fq;
#pragma unroll
        for (int ai = 0; ai < 2; ++ai)
#pragma unroll
            for (int m = 0; m < 4; ++m) { if (u.q >= 0 && m != u.q) continue;
                const int row = row0 + ai * 128 + m * 16;
                float ss = 0.f;
#pragma unroll
                for (int bj = 0; bj < 2; ++bj) {
                    const int col = col0 + bj * 128; f32x4 x0, x1;
                    if (BASE_BF16) { float f[8]; unpack8(*(const GAS v4u*)(xb + (size_t)row * D + col), f); x0 = (f32x4){f[0], f[1], f[2], f[3]}; x1 = (f32x4){f[4], f[5], f[6], f[7]}; }
                    else { const float* br = (row < MP) ? xp + (size_t)row * D : xs + (size_t)(row - MP) * D; x0 = *(const GAS f32x4*)(br + col); x1 = *(const GAS f32x4*)(br + col + 4); }
                    x0 += acc[ai][bj][m][0]; x1 += acc[ai][bj][m][1];
                    ss += (x0[0] * x0[0] + x0[1] * x0[1]) + (x0[2] * x0[2] + x0[3] * x0[3]) + (x1[0] * x1[0] + x1[1] * x1[1]) + (x1[2] * x1[2] + x1[3] * x1[3]);
                    *(GAS v4u*)(XO + (size_t)row * D + col) = pack8(x0, x1);
                }
                ss += __shfl_xor(ss, 16); ss += __shfl_xor(ss, 32);
                if (fq == 0) SS[(size_t)row * 16 + u.pn * 4 + wc] = ss;
            }
    }
};
__device__ __forceinline__ float row_rs(const float* SS, int row) {
    const f32x4 a = *(const GAS f32x4*)(SS + (size_t)row * 16), b = *(const GAS f32x4*)(SS + (size_t)row * 16 + 4), c = *(const GAS f32x4*)(SS + (size_t)row * 16 + 8), d = *(const GAS f32x4*)(SS + (size_t)row * 16 + 12);
    const float s = ((a[0] + a[1]) + (a[2] + a[3])) + ((b[0] + b[1]) + (b[2] + b[3])) + ((c[0] + c[1]) + (c[2] + c[3])) + ((d[0] + d[1]) + (d[2] + d[3]));
    return 1.0f / sqrtf(s * (1.f / D) + EPS);
}
struct EpiUp {
    static constexpr bool PERM = true;
    const float* SS; bf16* UPB;
    __device__ __forceinline__ void operator()(const pg8::f32x4 (&acc)[2][2][4][2], const pg8::Unit& u, int wr, int wc, int fr, int fq) const {
        const int row0 = u.pm * 256 + wr * 64 + fr, col0 = u.pn * 256 + wc * 32 + 8 * fq;
#pragma unroll
        for (int ai = 0; ai < 2; ++ai)
#pragma unroll
            for (int m = 0; m < 4; ++m) { if (u.q >= 0 && m != u.q) continue; const int row = row0 + ai * 128 + m * 16; const float rs = row_rs(SS, row);
#pragma unroll
                for (int bj = 0; bj < 2; ++bj) *(GAS v4u*)(UPB + (size_t)row * UPW + col0 + bj * 128) = pack8(acc[ai][bj][m][0] * rs, acc[ai][bj][m][1] * rs); }
    }
};

__device__ __forceinline__ float dpp_ror1(float x) { return __builtin_bit_cast(float, __builtin_amdgcn_update_dpp(0, __builtin_bit_cast(int, x), 0x121, 0xF, 0xF, false)); }
__device__ __forceinline__ float dpp_ror2(float x) { return __builtin_bit_cast(float, __builtin_amdgcn_update_dpp(0, __builtin_bit_cast(int, x), 0x122, 0xF, 0xF, false)); }
struct EpiUpConv {
    static constexpr bool PERM = true;
    const float* SS; bf16* HB; bf16* UPF; bf16* UPL; float* out; const float* conv_w; const float* conv_b; const float* state_conv; LAS unsigned char* scr; unsigned* cnt;
    template <bool SAMPLE> __device__ __forceinline__ void body(const pg8::f32x4 (&acc)[2][2][4][2], const pg8::Unit& u, int wr, int fr, int cl0_, int acol0, LAS float* CW, LAS float* BD, LAS float* RSL) const {
#pragma unroll
        for (int ai = 0; ai < 2; ++ai)
#pragma unroll
            for (int m = 0; m < 4; ++m) {
                const int fro = pg8_opq(fr), cl0 = pg8_opq(cl0_);
                const int rl = ai * 128 + wr * 64 + m * 16 + fro, row = u.pm * 256 + rl; const float rs = RSL[rl];
                v4u hw;
#pragma unroll
                for (int n = 0; n < 2; ++n) {
                    f32x4 cv2[2];
#pragma unroll
                    for (int bj = 0; bj < 2; ++bj) {
                        const int cl = bj * 128 + cl0 + 4 * n, gcol = bj * DFF + acol0 + cl0 + 4 * n; const f32x4 x = acc[ai][bj][m][n] * rs;
                        f32x4 s1, s2;
#pragma unroll
                        for (int i = 0; i < 4; ++i) { s1[i] = dpp_ror1(x[i]); s2[i] = dpp_ror2(x[i]); }
                        if (SAMPLE) { const int t = fro & 3; const float* sp = state_conv + (size_t)((row - MP) >> 2) * 2 * UPW + gcol;
                            const f32x4 S0 = *(const GAS f32x4*)sp, S1 = *(const GAS f32x4*)(sp + UPW);
#pragma unroll
                            for (int i = 0; i < 4; ++i) { s1[i] = (t >= 1) ? s1[i] : S1[i]; s2[i] = (t >= 2) ? s2[i] : (t == 1 ? S1[i] : S0[i]); }
                            if (t >= 2) *(GAS f32x4*)(out + O_CVS + ((size_t)((row - MP) >> 2) * 2 + (t - 2)) * UPW + gcol) = x;
                        } else if (m > 0) { const f32x4 xp = acc[ai][bj][m > 0 ? m - 1 : 0][n] * RSL[rl - 16];
#pragma unroll
                            for (int i = 0; i < 4; ++i) { s1[i] = dpp_ror1(fro == 15 ? xp[i] : x[i]); s2[i] = dpp_ror2(fro >= 14 ? xp[i] : x[i]); }
                        } else { const int pb = (wr == 1) ? ai * 2 : 1;
                            const int pr0 = (pb >> 1) * 128 + (pb & 1) * 64 + 62;
                            const f32x4 b2 = *(const LAS f32x4*)(BD + (pb * 2 + 0) * 256 + cl) * RSL[pr0], b1 = *(const LAS f32x4*)(BD + (pb * 2 + 1) * 256 + cl) * RSL[pr0 + 1];
#pragma unroll
                            for (int i = 0; i < 4; ++i) { s1[i] = (fro >= 1) ? s1[i] : b1[i]; s2[i] = (fro >= 2) ? s2[i] : (fro == 1 ? b1[i] : b2[i]); }
                        }
                        const f32x4 w0 = *(const LAS f32x4*)(CW + cl), w1 = *(const LAS f32x4*)(CW + 256 + cl), w2 = *(const LAS f32x4*)(CW + 512 + cl), cb = *(const LAS f32x4*)(CW + 768 + cl);
                        cv2[bj] = cb + s2 * w0 + s1 * w1 + x * w2;
                        if (!SAMPLE && ai == 0 && m == 0) { if (rl < 2) { v2u w; w.x = cvt_pk_bf16(x[0], x[1]); w.y = cvt_pk_bf16(x[2], x[3]); *(GAS v2u*)(UPF + ((size_t)u.pm * 2 + rl) * UPW + gcol) = w; } }
                        if (!SAMPLE && ai == 1 && m == 3) { if (rl >= 254) { v2u w; w.x = cvt_pk_bf16(x[0], x[1]); w.y = cvt_pk_bf16(x[2], x[3]); *(GAS v2u*)(UPL + ((size_t)u.pm * 2 + (rl - 254)) * UPW + gcol) = w;
                                if ((u.pm & 31) == 31) *(GAS f32x4*)(out + O_CVP + ((size_t)(u.pm >> 5) * 2 + (rl - 254)) * UPW + gcol) = x; } }
                    }
                    { const unsigned h0 = cvt_pk_bf16(gelu_tanh(cv2[0][0]) * cv2[1][0], gelu_tanh(cv2[0][1]) * cv2[1][1]), h1 = cvt_pk_bf16(gelu_tanh(cv2[0][2]) * cv2[1][2], gelu_tanh(cv2[0][3]) * cv2[1][3]);
                      if (n == 0) { hw.x = h0; hw.y = h1; }
                      else { hw.z = h0; hw.w = h1;
                        if (SAMPLE) asm volatile("global_store_dwordx4 %0, %1, off sc1\n\ts_nop 1" :: "v"(HB + (size_t)row * DFF + acol0 + cl0), "v"(hw) : "memory");
                        else if (rl >= 2) *(GAS v4u*)(HB + (size_t)row * DFF + acol0 + cl0) = hw; } }
                    asm volatile("" ::: "memory"); __builtin_amdgcn_sched_barrier(0);
                }
            }
    }
    __device__ __forceinline__ void operator()(const pg8::f32x4 (&acc)[2][2][4][2], const pg8::Unit& u, int wr, int wc, int fr_, int fq_) const {
        const int tid = pg8_opq(threadIdx.x), fr = pg8_opq(fr_), fq = pg8_opq(fq_);
        LAS float* CW = (LAS float*)scr;
        LAS float* BD = CW + 1024;
        const int acol0 = u.pn * 128, cl0_ = wc * 32 + 8 * fq;
        for (int e = tid; e < 1024; e += 512) { const int k = e >> 8, cl = e & 255, gcol = (cl >> 7) * DFF + acol0 + (cl & 127); CW[e] = (k < 3) ? conv_w[k * UPW + gcol] : conv_b[gcol]; }
        LAS float* RSL = BD + 2048;
        if (tid < 256) RSL[tid] = row_rs(SS, u.pm * 256 + tid);
        if (fr >= 14) {
#pragma unroll
            for (int ai = 0; ai < 2; ++ai)
#pragma unroll
                for (int bj = 0; bj < 2; ++bj)
#pragma unroll
                    for (int n = 0; n < 2; ++n) *(LAS f32x4*)(BD + ((ai * 2 + wr) * 2 + (fr - 14)) * 256 + bj * 128 + cl0_ + 4 * n) = acc[ai][bj][3][n];
        }
        asm volatile("s_waitcnt vmcnt(0) lgkmcnt(0)" ::: "memory"); __builtin_amdgcn_s_barrier(); asm volatile("" ::: "memory");
        if (u.pm >= MP / 256) { body<true>(acc, u, wr, fr, cl0_, acol0, CW, BD, RSL);
            asm volatile("s_waitcnt vmcnt(0)" ::: "memory"); if ((tid & 63) == 0) __hip_atomic_fetch_add(cnt + 64 * u.pm, 1u, __ATOMIC_RELAXED, __HIP_MEMORY_SCOPE_AGENT); }
        else body<false>(acc, u, wr, fr, cl0_, acol0, CW, BD, RSL);
        asm volatile("s_waitcnt lgkmcnt(0)" ::: "memory"); __builtin_amdgcn_s_barrier(); asm volatile("" ::: "memory");
    }
};
struct EpiPle {
    static constexpr bool PERM = true;
    const float* SS; const bf16* X2B; const bf16* PPB; float* Y;
    __device__ __forceinline__ void operator()(const pg8::f32x4 (&acc)[2][2][4][2], const pg8::Unit& u, int wr, int wc, int fr, int fq) const {
        const int row0 = u.pm * 256 + wr * 64 + fr, col0 = u.pn * 256 + wc * 32 + 8 * fq;
#pragma unroll
        for (int ai = 0; ai < 2; ++ai)
#pragma unroll
            for (int m = 0; m < 4; ++m) { if (u.q >= 0 && m != u.q) continue; const int row = row0 + ai * 128 + m * 16; const float rs = row_rs(SS, row);
#pragma unroll
                for (int bj = 0; bj < 2; ++bj) { const int col = col0 + bj * 128; const size_t o = (size_t)row * D + col;
                    float pw[8], xw[8]; unpack8(*(const GAS v4u*)(PPB + o), pw); unpack8(*(const GAS v4u*)(X2B + o), xw);
                    const f32x4 a = acc[ai][bj][m][0] * rs, b = acc[ai][bj][m][1] * rs; f32x4 y0, y1;
#pragma unroll
                    for (int i = 0; i < 4; ++i) { y0[i] = xw[i] + sigmoidf_(a[i]) * pw[i]; y1[i] = xw[4 + i] + sigmoidf_(b[i]) * pw[4 + i]; }
                    *(GAS f32x4*)(Y + o) = y0; *(GAS f32x4*)(Y + o + 4) = y1; } }
    }
};


struct EpiInproj {
    static constexpr bool PERM = true;
    bf16* Zp; bf16* CQNp; bf16* CKVNp; bf16* AYp; float* out; const float* g_ckv; LAS unsigned char* scr;
    __device__ __forceinline__ void operator()(const pg8::f32x4 (&acc)[2][2][4][2], const pg8::Unit& u, int wr, int wc, int fr, int fq) const {
        const int row0 = u.pm * 256 + wr * 64 + fr, colw = wc * 32 + 8 * fq;
        if (u.pn == 0) {
            LAS float* part = (LAS float*)scr;
#pragma unroll
            for (int ai = 0; ai < 2; ++ai)
#pragma unroll
                for (int m = 0; m < 4; ++m) { float ss = 0.f;
#pragma unroll
                    for (int bj = 0; bj < 2; ++bj)
#pragma unroll
                        for (int n = 0; n < 2; ++n) { const f32x4 v = acc[ai][bj][m][n]; ss += (v[0] * v[0] + v[1] * v[1]) + (v[2] * v[2] + v[3] * v[3]); }
                    ss += __shfl_xor(ss, 16); ss += __shfl_xor(ss, 32);
                    if (fq == 0) part[(ai * 128 + wr * 64 + m * 16 + fr) * 4 + wc] = ss; }
            asm volatile("s_waitcnt lgkmcnt(0)" ::: "memory"); __builtin_amdgcn_s_barrier(); asm volatile("" ::: "memory");
#pragma unroll
            for (int ai = 0; ai < 2; ++ai)
#pragma unroll
                for (int m = 0; m < 4; ++m) { const int rl = ai * 128 + wr * 64 + m * 16 + fr, row = u.pm * 256 + rl; const f32x4 p = *(const LAS f32x4*)(part + rl * 4);
                    const float rs = 1.0f / sqrtf(((p[0] + p[1]) + (p[2] + p[3])) * (1.f / KVL) + EPS);
                    float* dst = (row < MP) ? out + O_CKVP + (size_t)row * KVL : out + O_CKVS + (size_t)(row - MP) * KVL;
#pragma unroll
                    for (int bj = 0; bj < 2; ++bj) { const int col = colw + bj * 128; const f32x4 g0 = *(const GAS f32x4*)(g_ckv + col), g1 = *(const GAS f32x4*)(g_ckv + col + 4);
                        const f32x4 o0 = acc[ai][bj][m][0] * rs * g0, o1 = acc[ai][bj][m][1] * rs * g1;
                        *(GAS f32x4*)(dst + col) = o0; *(GAS f32x4*)(dst + col + 4) = o1; *(GAS v4u*)(CKVNp + (size_t)row * KVL + col) = pack8(o0, o1); } }
            asm volatile("s_waitcnt lgkmcnt(0)" ::: "memory"); __builtin_amdgcn_s_barrier(); asm volatile("" ::: "memory");
            return;
        }
#pragma unroll
        for (int ai = 0; ai < 2; ++ai)
#pragma unroll
            for (int m = 0; m < 4; ++m) { const int row = row0 + ai * 128 + m * 16;
#pragma unroll
                for (int bj = 0; bj < 2; ++bj) { const int col = u.pn * 256 + colw + bj * 128; f32x4 a = acc[ai][bj][m][0], b = acc[ai][bj][m][1];
                    if (u.pn <= 2) {
                        if (col < ZC_KR) *(GAS v4u*)(CQNp + (size_t)row * QL + (col - ZC_CQ)) = pack8(a, b);
                        else if (col < ZC_KR + QKR) { float* dst = ((row < MP) ? out + O_KRP + (size_t)row * QKR : out + O_KRS + (size_t)(row - MP) * QKR) + (col - ZC_KR); *(GAS f32x4*)dst = a; *(GAS f32x4*)(dst + 4) = b; }
                    } else if (u.pn <= 4) {
                        const v4u w = pack8(a, b); const int c = col - ZC_U;
                        if (row < MP) *(GAS v4u*)(AYp + ((size_t)(c >> 4) * SCH + (row >> 5)) * SKA + (row & 31) * GRP + (c & 15)) = w;
                        else *(GAS v4u*)(Zp + (size_t)row * NZ + col) = w;
                    } else {
#pragma unroll
                        for (int i = 0; i < 4; ++i) { a[i] = sigmoidf_(a[i]); b[i] = sigmoidf_(b[i]); }
                        *(GAS v4u*)(Zp + (size_t)row * NZ + col) = pack8(a, b);
                    } } }
    }
};

#define XB_TMO      128
#define XB_XCNT(j)  (256  + 64 * (j))
#define XB_XSUB(j)  (1280 + 64 * (j))
#define XB_XGEN(j)  (2304 + 64 * (j))
#define XB_TOP      3328
#define XB_TOPGEN   3392
#define XCD_BAR_WORDS 3456
#define XB_SPIN_CAP (1u << 18)
__device__ __forceinline__ unsigned xb_ld(unsigned* p)              { return __hip_atomic_load(p, __ATOMIC_RELAXED, __HIP_MEMORY_SCOPE_AGENT); }
__device__ __forceinline__ unsigned xb_add(unsigned* p, unsigned v) { return __hip_atomic_fetch_add(p, v, __ATOMIC_RELAXED, __HIP_MEMORY_SCOPE_AGENT); }
__device__ __forceinline__ unsigned xb_xcc_id() { return (unsigned)__builtin_amdgcn_s_getreg((3 << 11) | 20) & 0xFu; }
#define XB_SPIN(cond, bar) do { unsigned _sp = 0; while (cond) { __builtin_amdgcn_s_sleep(1); \
    if ((++_sp & 255u) == 0u) { if (xb_ld(&(bar)[XB_TMO])) break; if (_sp > XB_SPIN_CAP) { atomicAdd(&(bar)[XB_TMO], 1u); break; } } } } while (0)
struct XcdBarrier { unsigned* bar; unsigned x; volatile LAS unsigned* st; };
__device__ __forceinline__ XcdBarrier xcd_barrier_post(unsigned* bar, volatile LAS unsigned* st) {
    XcdBarrier b; b.bar = bar; b.x = xb_xcc_id(); b.st = st;
    if (threadIdx.x == 0) (void)xb_add(&bar[XB_XCNT(b.x)], 1u);
    return b;
}
__device__ __forceinline__ void xcd_barrier_complete(unsigned* bar, unsigned x, unsigned& nloc, unsigned& nx) {
    const unsigned G = gridDim.x * gridDim.y * gridDim.z;
    unsigned sum, cnt, mine, sp = 0u;
    for (;;) {
        sum = 0u; cnt = 0u; mine = 0u;
#pragma unroll
        for (unsigned j = 0; j < 16; ++j) { const unsigned c = xb_ld(&bar[XB_XCNT(j)]); sum += c; cnt += (c > 0u) ? 1u : 0u; mine = (j == x) ? c : mine; }
        if (sum == G) break;
        __builtin_amdgcn_s_sleep(1);
        if ((++sp & 255u) == 0u) { if (xb_ld(&bar[XB_TMO])) break; if (sp > XB_SPIN_CAP) { atomicAdd(&bar[XB_TMO], 1u); break; } }
    }
    nloc = mine > 0u ? mine : 1u; nx = cnt > 0u ? cnt : 1u;
}
__device__ __forceinline__ void xcd_barrier(const XcdBarrier& b) {
    asm volatile("s_waitcnt vmcnt(0)" ::: "memory");
    __syncthreads();
    if (threadIdx.x == 0) {
        unsigned* bar = b.bar;
        __builtin_amdgcn_s_waitcnt(0);
        unsigned nloc = b.st[0], nx = b.st[1];
        if (nloc == 0u) { xcd_barrier_complete(bar, b.x, nloc, nx); b.st[0] = nloc; b.st[1] = nx; }
        const unsigned old = xb_add(&bar[XB_XSUB(b.x)], 1u);
        const unsigned gen = old / nloc;
        if (old + 1u == (gen + 1u) * nloc) {
            __builtin_amdgcn_fence(__ATOMIC_RELEASE, "agent");
            asm volatile("s_waitcnt vmcnt(0)" ::: "memory");
            const unsigned og = xb_add(&bar[XB_TOP], 1u);
            const unsigned tg = og / nx;
            if (og + 1u == (tg + 1u) * nx) xb_add(&bar[XB_TOPGEN], 1u);
            else XB_SPIN(xb_ld(&bar[XB_TOPGEN]) == tg, bar);
            __builtin_amdgcn_fence(__ATOMIC_ACQUIRE, "agent");
            xb_add(&bar[XB_XGEN(b.x)], 1u);
            asm volatile("s_waitcnt vmcnt(0)" ::: "memory");
        } else {
            XB_SPIN(xb_ld(&bar[XB_XGEN(b.x)]) == gen, bar);
            __builtin_amdgcn_fence(__ATOMIC_ACQUIRE, "agent");
            asm volatile("s_waitcnt vmcnt(0)" ::: "memory");
        }
    }
    __syncthreads();
}

constexpr int NWAVES = 8;
constexpr int RING_OFF = 0, RING_BYTES = 159744;
constexpr int LDSCTL_OFF = RING_BYTES, MISC_OFF = LDSCTL_OFF + 320;
constexpr int LDS_BYTES = 163840;

struct Args { const void* in[39]; float* out; unsigned char* ws; int ph_lo, ph_hi; };
static_assert(sizeof(Args) == 39 * 8 + 8 + 8 + 8, "Args has no padding");

__device__ __forceinline__ void tr_item(const float* W, int ldw, int k0, int n0s, bf16* WT, int ldt, int n0d, LAS float* scr, int lane, const float* kg = nullptr) {
    if (W) {
        f32x4 v[8];
#pragma unroll
        for (int i = 0; i < 8; ++i) v[i] = *(const GAS f32x4*)(W + (size_t)(k0 + (lane >> 3) + 8 * i) * ldw + n0s + (lane & 7) * 4);
#pragma unroll
        for (int i = 0; i < 8; ++i) { LAS float* d = scr + ((lane >> 3) + 8 * i) * 33 + (lane & 7) * 4; const float gk = kg ? kg[k0 + (lane >> 3) + 8 * i] : 1.0f; d[0] = v[i].x * gk; d[1] = v[i].y * gk; d[2] = v[i].z * gk; d[3] = v[i].w * gk; }
    } else {
#pragma unroll 8
        for (int i = 0; i < 32; ++i) { const int kk = 2 * i + (lane >> 5); scr[kk * 33 + (lane & 31)] = 0.f; }
    }
    LDS_WAIT(); asm volatile("" ::: "memory");
    const int c = lane & 7;
#pragma unroll
    for (int j = 0; j < 4; ++j) { const int n = (lane >> 3) + 8 * j; const LAS float* s = scr + (8 * c) * 33 + n;
        v4u o; o.x = pk2(s[0 * 33], s[1 * 33]); o.y = pk2(s[2 * 33], s[3 * 33]); o.z = pk2(s[4 * 33], s[5 * 33]); o.w = pk2(s[6 * 33], s[7 * 33]);
        *(GAS v4u*)(WT + (size_t)(n0d + n) * ldt + k0 + 8 * c) = o; }
    LDS_WAIT(); asm volatile("" ::: "memory");
}
__device__ __forceinline__ void tr_plain(const float* W, int K, int N, bf16* WT, int it, LAS float* scr, int lane, const float* kg = nullptr) {
    const int nblk = N / 32, kb = it / nblk, nb = it % nblk;
    tr_item(W, N, 64 * kb, 32 * nb, WT, K, 32 * nb, scr, lane, kg);
}

__device__ __forceinline__ void glds16(const void* gsrc, unsigned lds_dst) { unsigned keep;
    asm volatile("s_mov_b32 %0, m0\n\ts_mov_b32 m0, %2\n\ts_nop 0\n\tglobal_load_lds_dwordx4 %1, off\n\ts_mov_b32 m0, %0" : "=&s"(keep) : "v"(gsrc), "s"(lds_dst) : "memory"); }
__device__ __forceinline__ int opq(int x) { asm volatile("" : "+v"(x)); return x; }
namespace pa {
typedef float f32x16 __attribute__((ext_vector_type(16)));
typedef short s16x4 __attribute__((ext_vector_type(4)));
constexpr int KSLOT = 12288, VSLOT = 8192, SLOT = KSLOT + VSLOT;
__device__ __forceinline__ int crow(int r, int hi) { return (r & 3) + 8 * (r >> 2) + 4 * hi; }
__device__ __forceinline__ s16x4 vtr(const LAS unsigned char* p) { return __builtin_bit_cast(s16x4, __builtin_amdgcn_ds_read_tr16_b64_v4i16((LAS s16x4*)p)); }
__device__ __forceinline__ float swap_max(float v) { auto rr = __builtin_amdgcn_permlane32_swap(__float_as_uint(v), __float_as_uint(v), false, false); return fmaxf(__uint_as_float(rr[0]), __uint_as_float(rr[1])); }
__device__ __forceinline__ float swap_sum(float v) { auto rr = __builtin_amdgcn_permlane32_swap(__float_as_uint(v), __float_as_uint(v), false, false); return __uint_as_float(rr[0]) + __uint_as_float(rr[1]); }

__device__ __forceinline__ void issue_tile(const bf16* Kg, const bf16* Vg, LAS unsigned char* slot, int kv0, int wave, int lane) {
    const unsigned s0 = (unsigned)(uintptr_t)slot;
    { const bf16* src = Kg + (size_t)(kv0 + lane) * 768 + wave * 8;
      glds16(src, (unsigned)__builtin_amdgcn_readfirstlane(s0 + wave * 1024));
      if (wave < 4) glds16(src + 64, (unsigned)__builtin_amdgcn_readfirstlane(s0 + (8 + wave) * 1024)); }
    { const bf16* src = Vg + (size_t)(kv0 + 16 * (wave & 3) + (lane >> 2)) * 1024 + (wave >> 2) * 32 + (lane & 3) * 8;
      glds16(src, (unsigned)__builtin_amdgcn_readfirstlane(s0 + KSLOT + wave * 1024)); }
}

__device__ __forceinline__ void attn_unit(const bf16* Q, const bf16* K, const bf16* V, bf16* O, int b, int h, int qb, float sref, LAS unsigned char* lds, int wave, int lane_) {
    const int lane = opq(lane_), r32 = lane & 31, hi = lane >> 5;
    const size_t rowbase = (size_t)b * SEQ; const int q0 = qb * 256, qw = q0 + wave * 32;
    const bf16* Kg = K + rowbase * 768 + h * QKH; const bf16* Vg = V + rowbase * 1024 + h * VH;
    const int NT = (q0 + 256) / 64;
    bf16x8 qf[6];
    { const bf16* qp = Q + (rowbase + qw + r32) * 768 + h * QKH + hi * 8;
#pragma unroll
      for (int s = 0; s < 6; ++s) qf[s] = *(const GAS bf16x8*)(qp + 16 * s); }
    asm volatile("s_waitcnt vmcnt(0)" ::: "memory");
#pragma unroll
    for (int s = 0; s < 6; ++s) asm volatile("" : "+v"(qf[s]));
    issue_tile(Kg, Vg, lds, 0, wave, lane); issue_tile(Kg, Vg, lds + SLOT, 64, wave, lane);
    f32x16 o0 = {}, o1 = {};
    float l = 0.f;
    const int qrow = qw + r32;
    const int vaddr = ((lane >> 4) & 1) * 32 + (lane & 3) * 8 + (4 * hi + ((lane & 15) >> 2)) * 64;
    const int tmax = (qw + 31) >> 6;
#define PA_S(P0, P1, t_, slot_) do { const LAS unsigned char* ks = lds + (slot_) * SLOT; const int kv0 = (t_) * 64; \
        _Pragma("unroll") for (int r = 0; r < 16; ++r) { P0[r] = -sref; P1[r] = -sref; } \
        _Pragma("unroll") for (int s_ = 0; s_ < 6; ++s_) { \
            const bf16x8 a0 = *(const LAS bf16x8*)(ks + (2 * s_ + hi) * 1024 + r32 * 16), a1 = *(const LAS bf16x8*)(ks + (2 * s_ + hi) * 1024 + 512 + r32 * 16); \
            P0 = __builtin_amdgcn_mfma_f32_32x32x16_bf16(a0, qf[s_], P0, 0, 0, 0); P1 = __builtin_amdgcn_mfma_f32_32x32x16_bf16(a1, qf[s_], P1, 0, 0, 0); } \
        if (kv0 + 63 > qw) { _Pragma("unroll") for (int r = 0; r < 16; ++r) { const int kv = kv0 + crow(r, hi); if (kv > qrow) P0[r] = -1e30f; if (kv + 32 > qrow) P1[r] = -1e30f; } } } while (0)
#define PA_PV(P0, P1, slot_) do { const LAS unsigned char* vs = lds + (slot_) * SLOT + KSLOT; float rs = 0.f; \
        _Pragma("unroll") for (int r = 0; r < 16; ++r) { P0[r] = __builtin_amdgcn_exp2f(P0[r]); P1[r] = __builtin_amdgcn_exp2f(P1[r]); rs += P0[r] + P1[r]; } \
        l += rs; \
        _Pragma("unroll") for (int kstep = 0; kstep < 4; ++kstep) { v4u pw; const int rb = 8 * (kstep & 1); \
            if (kstep < 2) { pw.x = cvt_pk_bf16(P0[rb], P0[rb + 1]); pw.y = cvt_pk_bf16(P0[rb + 2], P0[rb + 3]); pw.z = cvt_pk_bf16(P0[rb + 4], P0[rb + 5]); pw.w = cvt_pk_bf16(P0[rb + 6], P0[rb + 7]); } \
            else { pw.x = cvt_pk_bf16(P1[rb], P1[rb + 1]); pw.y = cvt_pk_bf16(P1[rb + 2], P1[rb + 3]); pw.z = cvt_pk_bf16(P1[rb + 4], P1[rb + 5]); pw.w = cvt_pk_bf16(P1[rb + 6], P1[rb + 7]); } \
            const bf16x8 pb = __builtin_bit_cast(bf16x8, pw); \
            _Pragma("unroll") for (int d0 = 0; d0 < 2; ++d0) { \
                const s16x4 lo = vtr(vs + vaddr + d0 * 4096 + kstep * 1024), hh = vtr(vs + vaddr + d0 * 4096 + kstep * 1024 + 512); \
                const bf16x8 va = (bf16x8){lo[0], lo[1], lo[2], lo[3], hh[0], hh[1], hh[2], hh[3]}; \
                if (d0 == 0) o0 = __builtin_amdgcn_mfma_f32_32x32x16_bf16(va, pb, o0, 0, 0, 0); else o1 = __builtin_amdgcn_mfma_f32_32x32x16_bf16(va, pb, o1, 0, 0, 0); } } } while (0)
#define PA_BAR() do { asm volatile("s_waitcnt lgkmcnt(0)" ::: "memory"); __builtin_amdgcn_s_barrier(); asm volatile("" ::: "memory"); } while (0)
#define PA_SB() __builtin_amdgcn_sched_barrier(0)
#define PA_KRD(s_, o_) (*(const LAS bf16x8*)(ks + (2 * (s_) + hi) * 1024 + (o_) + r32 * 16))
#define PA_SX(PN0, PN1, t_, slot_, PC0, PC1) do { const LAS unsigned char* ks = lds + (slot_) * SLOT; const int kv0 = (t_) * 64; float rs = 0.f; \
        _Pragma("unroll") for (int r = 0; r < 16; ++r) { PN0[r] = -sref; PN1[r] = -sref; } \
        bf16x8 a0 = PA_KRD(0, 0), a1 = PA_KRD(0, 512); \
        _Pragma("unroll") for (int s_ = 0; s_ < 6; ++s_) { bf16x8 b0 = a0, b1 = a1; const int r0 = s_ < 4 ? 3 * s_ : 12 + 2 * (s_ - 4), r1 = r0 + (s_ < 4 ? 3 : 2); \
            if (s_ < 5) { b0 = PA_KRD(s_ + 1, 0); b1 = PA_KRD(s_ + 1, 512); } \
            PN0 = __builtin_amdgcn_mfma_f32_32x32x16_bf16(a0, qf[s_], PN0, 0, 0, 0); asm volatile("" : "+v"(PN0)); PA_SB(); \
            _Pragma("unroll") for (int r = r0; r < r1; ++r) PC0[r] = __builtin_amdgcn_exp2f(PC0[r]); asm volatile("" : "+v"(PC0)); \
            _Pragma("unroll") for (int r = r0; r < r1; ++r) rs += PC0[r]; asm volatile("" : "+v"(rs)); PA_SB(); \
            PN1 = __builtin_amdgcn_mfma_f32_32x32x16_bf16(a1, qf[s_], PN1, 0, 0, 0); asm volatile("" : "+v"(PN1)); PA_SB(); \
            _Pragma("unroll") for (int r = r0; r < r1; ++r) PC1[r] = __builtin_amdgcn_exp2f(PC1[r]); asm volatile("" : "+v"(PC1)); \
            _Pragma("unroll") for (int r = r0; r < r1; ++r) rs += PC1[r]; asm volatile("" : "+v"(rs)); PA_SB(); \
            a0 = b0; a1 = b1; } \
        l += rs; \
        if (kv0 + 63 > qw) { _Pragma("unroll") for (int r = 0; r < 16; ++r) { const int kv = kv0 + crow(r, hi); if (kv > qrow) PN0[r] = -1e30f; if (kv + 32 > qrow) PN1[r] = -1e30f; } } } while (0)
#define PA_PVN(P0, P1, slot_) do { const LAS unsigned char* vs = lds + (slot_) * SLOT + KSLOT + vaddr; s16x4 lo[4][2], hh[4][2]; \
        _Pragma("unroll") for (int d0 = 0; d0 < 2; ++d0) { lo[0][d0] = vtr(vs + d0 * 4096); hh[0][d0] = vtr(vs + d0 * 4096 + 512); } \
        _Pragma("unroll") for (int kstep = 0; kstep < 4; ++kstep) { v4u pw; const int rb = 8 * (kstep & 1); \
            if (kstep < 3) { _Pragma("unroll") for (int d0 = 0; d0 < 2; ++d0) { lo[kstep + 1][d0] = vtr(vs + d0 * 4096 + (kstep + 1) * 1024); hh[kstep + 1][d0] = vtr(vs + d0 * 4096 + (kstep + 1) * 1024 + 512); } }     \
            if (kstep < 2) { pw.x = cvt_pk_bf16(P0[rb], P0[rb + 1]); pw.y = cvt_pk_bf16(P0[rb + 2], P0[rb + 3]); pw.z = cvt_pk_bf16(P0[rb + 4], P0[rb + 5]); pw.w = cvt_pk_bf16(P0[rb + 6], P0[rb + 7]); } \
            else { pw.x = cvt_pk_bf16(P1[rb], P1[rb + 1]); pw.y = cvt_pk_bf16(P1[rb + 2], P1[rb + 3]); pw.z = cvt_pk_bf16(P1[rb + 4], P1[rb + 5]); pw.w = cvt_pk_bf16(P1[rb + 6], P1[rb + 7]); } \
            const bf16x8 pb = __builtin_bit_cast(bf16x8, pw); PA_SB(); \
            { const bf16x8 va = (bf16x8){lo[kstep][0][0], lo[kstep][0][1], lo[kstep][0][2], lo[kstep][0][3], hh[kstep][0][0], hh[kstep][0][1], hh[kstep][0][2], hh[kstep][0][3]}; o0 = __builtin_amdgcn_mfma_f32_32x32x16_bf16(va, pb, o0, 0, 0, 0); } \
            { const bf16x8 va = (bf16x8){lo[kstep][1][0], lo[kstep][1][1], lo[kstep][1][2], lo[kstep][1][3], hh[kstep][1][0], hh[kstep][1][1], hh[kstep][1][2], hh[kstep][1][3]}; o1 = __builtin_amdgcn_mfma_f32_32x32x16_bf16(va, pb, o1, 0, 0, 0); } \
            PA_SB(); } } while (0)
    f32x16 pA0, pA1, pB0, pB1;
    if (wave < 4) asm volatile("s_waitcnt vmcnt(3)" ::: "memory"); else asm volatile("s_waitcnt vmcnt(2)" ::: "memory");
    PA_BAR();
    PA_S(pA0, pA1, 0, 0);
    int sl = 0, s1 = 1;
    for (int t = 0; ; t += 2) {
        const int s2 = (s1 == 2) ? 0 : s1 + 1;
        asm volatile("s_waitcnt vmcnt(0)" ::: "memory"); PA_BAR();
        if (t + 2 < NT) issue_tile(Kg, Vg, lds + s2 * SLOT, (t + 2) * 64, wave, lane);
        PA_SX(pB0, pB1, t + 1, s1, pA0, pA1); PA_PVN(pA0, pA1, sl);
        asm volatile("s_waitcnt vmcnt(0)" ::: "memory"); PA_BAR();
        if (t + 2 >= NT) break;
        if (t + 3 < NT) issue_tile(Kg, Vg, lds + sl * SLOT, (t + 3) * 64, wave, lane);
        PA_SX(pA0, pA1, t + 2, s2, pB0, pB1); PA_PVN(pB0, pB1, s1);
        sl = s2; s1 = (s2 == 2) ? 0 : s2 + 1;
    }
    PA_PV(pB0, pB1, s1);
#undef PA_S
#undef PA_PV
#undef PA_BAR
#undef PA_SB
#undef PA_KRD
#undef PA_SX
#undef PA_PVN
    const float il = 1.0f / swap_sum(l);
    bf16* op = O + (rowbase + qw + r32) * ATTW + h * VH + 4 * hi;
#pragma unroll
    for (int g = 0; g < 4; ++g) {
        v2u w0, w1; w0.x = cvt_pk_bf16(o0[4 * g] * il, o0[4 * g + 1] * il); w0.y = cvt_pk_bf16(o0[4 * g + 2] * il, o0[4 * g + 3] * il);
        w1.x = cvt_pk_bf16(o1[4 * g] * il, o1[4 * g + 1] * il); w1.y = cvt_pk_bf16(o1[4 * g + 2] * il, o1[4 * g + 3] * il);
        *(GAS v2u*)(op + 8 * g) = w0; *(GAS v2u*)(op + 32 + 8 * g) = w1;
    }
    asm volatile("s_waitcnt vmcnt(0) lgkmcnt(0)" ::: "memory");
    __syncthreads();
}
}

namespace sa {
using pa::f32x16; using pa::s16x4; using pa::crow; using pa::vtr; using pa::swap_max; using pa::swap_sum;
constexpr int HK = 64;
constexpr int CHS = (HK + 1) * 16;
constexpr int CSB = 36 * CHS;
constexpr int C8S = (HK + 1) * 32, C8B = 8 * C8S;
constexpr int OFF_CS = 0, OFF_C8 = 2 * CSB;
constexpr int OFF_QA = OFF_C8 + 2 * C8B;
constexpr int PSTR = 144, OFF_P = OFF_QA + 18432;
constexpr int OFF_RS = OFF_P + 32 * PSTR;
constexpr int OFF_KSS = OFF_RS + 2048;
constexpr int OFF_PSUM = OFF_KSS + 512, OFF_PHYS = OFF_PSUM + 512, OFF_GK = OFF_PHYS + 128, SA_LDS = OFF_GK + 128;
static_assert(SA_LDS <= RING_BYTES, "sample attention LDS");
constexpr int PO_STRIDE = 32 * 256;
#define SA_BAR() do { asm volatile("s_waitcnt lgkmcnt(0)" ::: "memory"); __builtin_amdgcn_s_barrier(); asm volatile("" ::: "memory"); } while (0)

__device__ __forceinline__ void gld16(f32x4& d, const void* p) { asm volatile("global_load_dwordx4 %0, %1, off" : "=v"(d) : "v"(p) : "memory"); }
__device__ __forceinline__ void gld8(v2u& d, const void* p) { asm volatile("global_load_dwordx2 %0, %1, off" : "=v"(d) : "v"(p) : "memory"); }
template <int MODE> __device__ __forceinline__ void item(const void* const* in, const bf16* QABS, const unsigned char* W8, const bf16* ROPEB, float* PO, float* PL, float sref, int b, int half, LAS unsigned char* lds, int tid_, int wave, int lane_) {
    const int tid = opq(tid_), lane = tid & 63;
    (void)lane_;
    const float* cache_ckv = (const float*)in[4]; const float* cache_kr = (const float*)in[5]; const int* page_table = (const int*)in[6]; const float* g_k = (const float*)in[18];
    const int r32 = lane & 31, hi = lane >> 5;
    typedef int v8i __attribute__((ext_vector_type(8)));
    for (int e = tid; e < 36 * 32; e += 512) *(LAS v4u*)(lds + OFF_QA + e * 16) = *(const GAS v4u*)(QABS + ((size_t)b * 36 * 32 + e) * 8);
    if (tid < NPAGES / 2) *(LAS int*)(lds + OFF_PHYS + tid * 4) = page_table[b * NPAGES + half * (NPAGES / 2) + tid];
    v8i wf[4][2];
#pragma unroll
    for (int s = 0; s < 4; ++s)
#pragma unroll
        for (int nb = 0; nb < 2; ++nb) { const GAS v4u* wp = (const GAS v4u*)(W8 + (size_t)(wave * QKN + 32 * nb + r32) * KVL + 64 * s + 32 * hi); const v4u a = wp[0], bq = wp[1];
            wf[s][nb] = (v8i){(int)a.x, (int)a.y, (int)a.z, (int)a.w, (int)bq.x, (int)bq.y, (int)bq.z, (int)bq.w}; }
    if (tid < 32) *(LAS float*)(lds + OFF_GK + tid * 4) = g_k[64 + tid];
    asm volatile("s_waitcnt vmcnt(0) lgkmcnt(0)" ::: "memory");
#pragma unroll
    for (int s = 0; s < 4; ++s) asm volatile("" : "+v"(wf[s][0]), "+v"(wf[s][1]));
    __builtin_amdgcn_s_barrier(); asm volatile("" ::: "memory");
    f32x16 o = {};
    float l_run = 0.f;
    const int kq = wave >> 1;
    constexpr int NHP = NPAGES;
#define SA_IDS() const int tq = opq(tid), lq = tq & 63, r32 = lq & 31, hi = lq >> 5, kkey = tq >> 2, qd = tq & 3, cs_col = 16 * (wave & 1) + (lq & 15), quad = lq >> 4; (void)r32; (void)hi; (void)kkey; (void)qd; (void)cs_col; (void)quad
    f32x4 va[4], vb[4], x1 = {}, x2 = {}; v2u cw = {}, sw = {};
#define SA_SRC(hp_) const int sub_ = (hp_) & 1; const int phys_ = *(const LAS int*)(lds + OFF_PHYS + ((hp_) >> 1) * 4); const float* src_ = cache_ckv + ((size_t)phys_ * PAGE + sub_ * HK + 2 * wave) * KVL + lq * 4
#define SA_LD(i_) do { gld16(va[i_], src_ + (size_t)(i_) * 16 * KVL); gld16(vb[i_], src_ + (size_t)(i_) * 16 * KVL + KVL); } while (0)
#define SA_LDK(hp_) do { if (wave < 4) { const float* krp_ = cache_kr + ((size_t)phys_ * PAGE + sub_ * HK + kkey) * QKR; gld16(x1, krp_ + 4 * qd); gld16(x2, krp_ + 16 + 4 * qd); \
            const bf16* rp_ = ROPEB + ((size_t)(half * (NPAGES / 2) + ((hp_) >> 1)) * PAGE + sub_ * HK + kkey) * 32; gld8(cw, rp_ + 4 * qd); gld8(sw, rp_ + 16 + 4 * qd); } } while (0)
#define SA_AKR(CSW, KSSW) do { \
            const f32x4 rc_ = {bflo(cw.x), bfhi(cw.x), bflo(cw.y), bfhi(cw.y)}, rs_ = {bflo(sw.x), bfhi(sw.x), bflo(sw.y), bfhi(sw.y)}; \
            float ss = (x1[0] * x1[0] + x1[1] * x1[1]) + (x1[2] * x1[2] + x1[3] * x1[3]) + (x2[0] * x2[0] + x2[1] * x2[1]) + (x2[2] * x2[2] + x2[3] * x2[3]); \
            ss += __shfl_xor(ss, 1); ss += __shfl_xor(ss, 2); \
            const f32x4 ga = *(const LAS f32x4*)(lds + OFF_GK + qd * 16), gb = *(const LAS f32x4*)(lds + OFF_GK + 64 + qd * 16); \
            const f32x4 a = x1 * ga, bb = x2 * gb; const f32x4 y1 = a * rc_ - bb * rs_, y2 = a * rs_ + bb * rc_; \
            v2u w1, w2; w1.x = cvt_pk_bf16(y1[0], y1[1]); w1.y = cvt_pk_bf16(y1[2], y1[3]); w2.x = cvt_pk_bf16(y2[0], y2[1]); w2.y = cvt_pk_bf16(y2[2], y2[3]); \
            const int c1 = 32 + (qd >> 1), c2 = 34 + (qd >> 1); \
            *(LAS v2u*)((CSW) + c1 * CHS + kkey * 16 + 8 * (qd & 1)) = w1; *(LAS v2u*)((CSW) + c2 * CHS + kkey * 16 + 8 * (qd & 1)) = w2; \
            if (qd == 0) *(LAS float*)(lds + (KSSW) + kkey * 4) = ss; } while (0)
#define SA_R(CF, kb, s2) do { const LAS v4u* cp = (const LAS v4u*)(c8 + (2 * (s2) + hi) * C8S + (32 * (kb) + r32) * 32); const v4u a = cp[0], bq = cp[1]; \
            CF = (v8i){(int)a.x, (int)a.y, (int)a.z, (int)a.w, (int)bq.x, (int)bq.y, (int)bq.z, (int)bq.w}; } while (0)
#define SA_M(ACC, s2, nb, CF) do { ACC = __builtin_amdgcn_mfma_scale_f32_32x32x64_f8f6f4(wf[s2][nb], CF, ACC, 0, 0, 0, 127, 0, 127); asm volatile("" : "+v"(ACC)); } while (0)
#define SA_PA(i, kk, CSW) do { const int key_ = 2 * wave + (kk) + 16 * (i), ch8 = lq >> 1, hf = lq & 1; const f32x4 v = (kk) ? vb[i] : va[i]; \
            v2u w; w.x = cvt_pk_bf16(v[0], v[1]); w.y = cvt_pk_bf16(v[2], v[3]); *(LAS v2u*)((CSW) + ch8 * CHS + key_ * 16 + hf * 8) = w; } while (0)
#define SA_PB(i, kk, C8W) do { const int key_ = 2 * wave + (kk) + 16 * (i), ch8 = lq >> 1, hf = lq & 1; const f32x4 v = (kk) ? vb[i] : va[i]; \
            int w8 = 0; w8 = __builtin_amdgcn_cvt_pk_fp8_f32(v[0], v[1], w8, false); w8 = __builtin_amdgcn_cvt_pk_fp8_f32(v[2], v[3], w8, true); \
            *(LAS int*)((C8W) + (ch8 >> 2) * C8S + key_ * 32 + (ch8 & 3) * 8 + hf * 4) = w8; } while (0)
#define SA_SEG(T0, T1, s2a, i, HOOK, RN0, RN1) do { \
            SA_M(T0, s2a, 0, cfa); SA_SB(); HOOK; SA_PA(i, 0, csn); SA_SB(); \
            SA_M(T1, s2a, 1, cfa); SA_SB(); SA_PB(i, 0, c8n); RN0; SA_SB(); \
            SA_M(T0, (s2a) + 1, 0, cfb); SA_SB(); SA_PA(i, 1, csn); SA_SB(); \
            SA_M(T1, (s2a) + 1, 1, cfb); SA_SB(); SA_PB(i, 1, c8n); RN1; SA_SB(); } while (0)
#define SA_BRED(T0, T1, kb, KSSR) do { const int key_ = 32 * (kb) + r32; const f32x16 sq = T0 * T0 + T1 * T1; \
            const f32x4 s4 = (f32x4){sq[0], sq[1], sq[2], sq[3]} + (f32x4){sq[4], sq[5], sq[6], sq[7]} + ((f32x4){sq[8], sq[9], sq[10], sq[11]} + (f32x4){sq[12], sq[13], sq[14], sq[15]}); \
            float ss = (s4[0] + s4[1]) + (s4[2] + s4[3]); \
            ss = swap_sum(ss) * (1.0f / 4096.0f) + *(const LAS float*)(lds + (KSSR) + key_ * 4); \
            if (hi == 0) *(LAS float*)(lds + OFF_RS + (key_ * 8 + wave) * 4) = __builtin_amdgcn_rsqf(ss * (1.f / QKH) + EPS); } while (0)
#define SA_SB() __builtin_amdgcn_sched_barrier(0)
    { SA_IDS(); { SA_SRC(0); SA_LD(0); SA_LD(1); SA_LD(2); SA_LD(3); SA_LDK(0); }
      asm volatile("s_waitcnt vmcnt(0)" ::: "memory");
      asm volatile("" : "+v"(va[0]), "+v"(va[1]), "+v"(va[2]), "+v"(va[3]), "+v"(vb[0]), "+v"(vb[1]), "+v"(vb[2]), "+v"(vb[3]));
      asm volatile("" : "+v"(x1), "+v"(x2), "+v"(cw), "+v"(sw));
      LAS unsigned char* cs0 = lds + OFF_CS; LAS unsigned char* c80 = lds + OFF_C8; SA_SRC(1);
      _Pragma("unroll") for (int i = 0; i < 4; ++i) { SA_PA(i, 0, cs0); SA_PB(i, 0, c80); SA_PA(i, 1, cs0); SA_PB(i, 1, c80); SA_SB(); SA_LD(i); SA_SB(); }
      if (tid < 256) SA_AKR(cs0, OFF_KSS);
      SA_SB(); SA_LDK(1);
      SA_BAR(); }
#pragma unroll 1
    for (int hp = 0; hp < NHP; ++hp) { SA_IDS();
        const int par = hp & 1;
        LAS unsigned char* cs = lds + OFF_CS + par * CSB; LAS unsigned char* c8 = lds + OFF_C8 + par * C8B;
        LAS unsigned char* csn = lds + OFF_CS + (par ^ 1) * CSB; LAS unsigned char* c8n = lds + OFF_C8 + (par ^ 1) * C8B;
        const int kssr = OFF_KSS + par * 256, kssw = OFF_KSS + (par ^ 1) * 256;
        const bool more = hp + 2 < NHP; const int hn = more ? hp + 2 : hp; SA_SRC(hn);
        asm volatile("s_waitcnt vmcnt(0)" ::: "memory");
        asm volatile("" : "+v"(va[0]), "+v"(va[1]), "+v"(va[2]), "+v"(va[3]), "+v"(vb[0]), "+v"(vb[1]), "+v"(vb[2]), "+v"(vb[3]));
        asm volatile("" : "+v"(x1), "+v"(x2), "+v"(cw), "+v"(sw));
        { f32x16 t0 = {}, t1 = {}, t2 = {}, t3 = {}; v8i cfa, cfb;
          SA_R(cfa, 0, 0); SA_R(cfb, 0, 1); SA_SB();
          SA_SEG(t0, t1, 0, 0, (void)0, SA_R(cfa, 0, 2), SA_R(cfb, 0, 3)); if (more) SA_LD(0); SA_SB();
          SA_SEG(t0, t1, 2, 1, (void)0, SA_R(cfa, 1, 0), SA_R(cfb, 1, 1)); if (more) SA_LD(1); SA_SB();
          if (tid < 256) SA_AKR(csn, kssw);
          SA_SB(); if (more) SA_LDK(hn); SA_SB();
          SA_SEG(t2, t3, 0, 2, SA_BRED(t0, t1, 0, kssr); SA_SB(), SA_R(cfa, 1, 2), SA_R(cfb, 1, 3)); if (more) SA_LD(2); SA_SB();
          SA_SEG(t2, t3, 2, 3, (void)0, (void)0, (void)0); if (more) SA_LD(3); SA_SB();
          SA_BRED(t2, t3, 1, kssr); }
        SA_BAR();
        { f32x4 p4 = {0.f, 0.f, 0.f, 0.f}, p5 = {0.f, 0.f, 0.f, 0.f}; const int key = 16 * kq + (lq & 15);
          bf16x8 cf[9], qf[9];
          { LAS unsigned char* cb = cs + quad * CHS + key * 16; LAS unsigned char* qb = lds + OFF_QA + quad * 512 + cs_col * 16;
#pragma unroll
            for (int s2 = 0; s2 < 9; ++s2) { cf[s2] = *(const LAS bf16x8*)(cb + s2 * 4 * CHS); qf[s2] = *(const LAS bf16x8*)(qb + s2 * 2048); } }
#pragma unroll
          for (int s2 = 0; s2 < 9; ++s2) { if (s2 & 1) p5 = __builtin_amdgcn_mfma_f32_16x16x32_bf16(cf[s2], qf[s2], p5, 0, 0, 0); else p4 = __builtin_amdgcn_mfma_f32_16x16x32_bf16(cf[s2], qf[s2], p4, 0, 0, 0); }
          p4 += p5;
          float rsum = 0.f;
#pragma unroll
          for (int r = 0; r < 4; ++r) { p4[r] = __builtin_amdgcn_exp2f(p4[r] * *(const LAS float*)(lds + OFF_RS + ((16 * kq + 4 * quad + r) * 8 + (cs_col & 7)) * 4) - sref); rsum += p4[r]; }
          rsum += __shfl_xor(rsum, 16); rsum += __shfl_xor(rsum, 32);
          if (lq < 16) *(LAS float*)(lds + OFF_PSUM + (kq * 32 + cs_col) * 4) = rsum;
          v2u w; w.x = cvt_pk_bf16(p4[0], p4[1]); w.y = cvt_pk_bf16(p4[2], p4[3]);
          *(LAS v2u*)(lds + OFF_P + cs_col * PSTR + (16 * kq + 4 * quad) * 2) = w; }
        SA_BAR();
        l_run += ((*(const LAS float*)(lds + OFF_PSUM + r32 * 4) + *(const LAS float*)(lds + OFF_PSUM + (32 + r32) * 4)) + (*(const LAS float*)(lds + OFF_PSUM + (64 + r32) * 4) + *(const LAS float*)(lds + OFF_PSUM + (96 + r32) * 4)));
        { const int dim = 32 * wave + 16 * ((lq >> 4) & 1) + 4 * (lq & 3), ch = dim >> 3, k0 = 8 * hi + ((lq & 15) >> 2);
          s16x4 lo[4], hh[4]; bf16x8 pb[4];
          { LAS unsigned char* tb = cs + ch * CHS + k0 * 16 + 8 * (lq & 1); LAS unsigned char* pp = lds + OFF_P + r32 * PSTR + 16 * hi;
#pragma unroll
            for (int ks = 0; ks < 4; ++ks) { lo[ks] = vtr(tb + ks * 256); hh[ks] = vtr(tb + ks * 256 + 64); pb[ks] = *(const LAS bf16x8*)(pp + ks * 32); } }
#pragma unroll
          for (int ks = 0; ks < 4; ++ks) { const bf16x8 ca = (bf16x8){lo[ks][0], lo[ks][1], lo[ks][2], lo[ks][3], hh[ks][0], hh[ks][1], hh[ks][2], hh[ks][3]};
              o = __builtin_amdgcn_mfma_f32_32x32x16_bf16(ca, pb[ks], o, 0, 0, 0); } }
        SA_BAR();
    }
#undef SA_R
#undef SA_M
#undef SA_PA
#undef SA_PB
#undef SA_SEG
#undef SA_AKR
#undef SA_BRED
#undef SA_SB
#undef SA_IDS
#undef SA_SRC
#undef SA_LD
#undef SA_LDK
    asm volatile("s_waitcnt vmcnt(0)" ::: "memory");
    float* po = PO + (size_t)(b * 2 + half) * PO_STRIDE + (size_t)r32 * 256 + 32 * wave + 4 * hi;
#pragma unroll
    for (int g = 0; g < 4; ++g) *(GAS f32x4*)(po + 8 * g) = (f32x4){o[4 * g], o[4 * g + 1], o[4 * g + 2], o[4 * g + 3]};
    if (wave == 0 && hi == 0) PL[(b * 2 + half) * 32 + r32] = l_run;
    asm volatile("s_waitcnt vmcnt(0) lgkmcnt(0)" ::: "memory"); __syncthreads();
}

__device__ __forceinline__ void combine_item(const void* const* in, const bf16* Q, const bf16* K, const bf16* CKVN, const float* PO, const float* PL, float sref, bf16* ATT, int h, int rc, LAS unsigned char* lds, int tid, int wave, int lane) {
    const float* w_uv = (const float*)in[16];
    LAS float* WU = (LAS float*)lds;
    LAS float* OL = WU + 256 * 64;
    f32x4 wreg[8];
#pragma unroll
    for (int i = 0; i < 8; ++i) { const int e4 = tid + 512 * i, c = e4 >> 4, d4 = (e4 & 15) * 4; wreg[i] = *(const GAS f32x4*)(w_uv + (size_t)c * 512 + h * VH + d4); }
    { f32x4 v0[2], v1[2]; float pl0[2], pl1[2]; v4u qc[2], kc[2][4]; v2u cw_[2][4];
#pragma unroll
      for (int rr = 0; rr < 2; ++rr) { const int r = rc * 16 + 2 * wave + rr, b = r >> 2, t = r & 3, col = t * 8 + h; const size_t row = (size_t)MP + r;
          pl0[rr] = PL[(b * 2) * 32 + col]; pl1[rr] = PL[(b * 2 + 1) * 32 + col];
          v0[rr] = *(const GAS f32x4*)(PO + (size_t)(b * 2) * PO_STRIDE + (size_t)col * 256 + 4 * lane); v1[rr] = *(const GAS f32x4*)(PO + (size_t)(b * 2 + 1) * PO_STRIDE + (size_t)col * 256 + 4 * lane);
          const int c = lane < 12 ? lane : 0;
          qc[rr] = *(const GAS v4u*)(Q + row * 768 + h * QKH + 8 * c);
#pragma unroll
          for (int s2 = 0; s2 < 4; ++s2) { const size_t kr_ = (size_t)MP + b * DECT + s2; kc[rr][s2] = *(const GAS v4u*)(K + kr_ * 768 + h * QKH + 8 * c); cw_[rr][s2] = *(const GAS v2u*)(CKVN + kr_ * KVL + 4 * lane); } }
#pragma unroll
      for (int rr = 0; rr < 2; ++rr) { const int rl = 2 * wave + rr, r = rc * 16 + rl, t = r & 3;
          float l = pl0[rr] + pl1[rr]; float acc[4];
#pragma unroll
          for (int i = 0; i < 4; ++i) acc[i] = v0[rr][i] + v1[rr][i];
          float qf[8]; unpack8(qc[rr], qf);
#pragma unroll
          for (int s2 = 0; s2 < 4; ++s2) { float f[8]; unpack8(kc[rr][s2], f); float sc = 0.f;
#pragma unroll
              for (int i = 0; i < 8; ++i) sc += qf[i] * f[i];
              sc = wave_sum(lane < 12 ? sc : 0.f);
              const float pr = (s2 <= t) ? __builtin_amdgcn_exp2f(sc - sref) : 0.f;
              l += pr; const v2u w = cw_[rr][s2];
              acc[0] += pr * bflo(w.x); acc[1] += pr * bfhi(w.x); acc[2] += pr * bflo(w.y); acc[3] += pr * bfhi(w.y); }
          const float il = 1.0f / l;
          *(LAS f32x4*)(OL + rl * 256 + 4 * lane) = (f32x4){acc[0] * il, acc[1] * il, acc[2] * il, acc[3] * il}; } }
#pragma unroll
    for (int i = 0; i < 8; ++i) { const int e4 = tid + 512 * i, c = e4 >> 4, d4 = (e4 & 15) * 4; *(LAS f32x4*)(WU + c * 64 + d4) = wreg[i]; }
    LDS_WAIT(); __syncthreads();
    { const int rl = tid >> 5, dp = tid & 31; float o0 = 0.f, o1 = 0.f;
#pragma unroll 8
      for (int c = 0; c < KVL; ++c) { const float ov = OL[rl * 256 + c]; const f32x2 w = *(const LAS f32x2*)(WU + c * 64 + 2 * dp); o0 += ov * w.x; o1 += ov * w.y; }
      *(GAS unsigned*)(ATT + ((size_t)MP + rc * 16 + rl) * ATTW + h * VH + 2 * dp) = pk2(o0, o1); }
    LDS_WAIT(); __syncthreads();
}
}


__device__ __forceinline__ void qabs_item(const void* const* in, const bf16* QRAW, const bf16* WKV, const float* ROPE, bf16* QABS, int h, int rg, LAS unsigned char* lds, int tid) {
    const float* g_q = (const float*)in[17]; const float* g_k = (const float*)in[18];
    LAS unsigned char* WH = lds;
    LAS float* QG = (LAS float*)(lds + 32768);
#pragma unroll
    for (int i = 0; i < 4; ++i) *(LAS v4u*)(WH + (tid + 512 * i) * 16) = *(const GAS v4u*)(WKV + (size_t)(h * QKN) * KVL + (size_t)(tid + 512 * i) * 8);
    { const int rl = tid >> 3, sub = tid & 7, sr = rg * 64 + rl, pos = SEQ + (sr & 3);
      const bf16* qr = QRAW + ((size_t)MP + sr) * 768 + h * QKH; float n[8]; unpack8(*(const GAS v4u*)(qr + 8 * sub), n);
      const unsigned wa = *(const GAS unsigned*)(qr + 64 + 2 * sub), wb = *(const GAS unsigned*)(qr + 80 + 2 * sub);
      float a0 = bflo(wa), a1 = bfhi(wa), b0 = bflo(wb), b1 = bfhi(wb);
      float ss = (a0 * a0 + a1 * a1) + (b0 * b0 + b1 * b1);
#pragma unroll
      for (int i = 0; i < 8; ++i) ss += n[i] * n[i];
      ss += __shfl_xor(ss, 1); ss += __shfl_xor(ss, 2); ss += __shfl_xor(ss, 4);
      const float rs = QSCALE / sqrtf(ss * (1.f / QKH) + EPS);
      const float* rp = ROPE + (size_t)pos * 32; const f32x2 cs = *(const GAS f32x2*)(rp + 2 * sub), sn = *(const GAS f32x2*)(rp + 16 + 2 * sub);
#pragma unroll
      for (int i = 0; i < 8; ++i) QG[rl * 64 + 8 * sub + i] = bf2f((bf16)f2bf(n[i] * rs * g_q[8 * sub + i])) * g_k[8 * sub + i];
      a0 *= rs * g_q[64 + 2 * sub]; a1 *= rs * g_q[65 + 2 * sub]; b0 *= rs * g_q[80 + 2 * sub]; b1 *= rs * g_q[81 + 2 * sub];
      const unsigned r1 = pk2(a0 * cs.x - b0 * sn.x, a1 * cs.y - b1 * sn.y), r2 = pk2(a0 * sn.x + b0 * cs.x, a1 * sn.y + b1 * cs.y);
      bf16* qab = QABS + (size_t)(sr >> 2) * 36 * 32 * 8 + ((sr & 3) * 8 + h) * 8;
      *(GAS unsigned*)(qab + (32 + (sub >> 2)) * 256 + 2 * (sub & 3)) = r1; *(GAS unsigned*)(qab + (34 + (sub >> 2)) * 256 + 2 * (sub & 3)) = r2; }
    LDS_WAIT(); __syncthreads();
    { const int r4 = tid >> 5, ch = tid & 31; float acc[4][8];
#pragma unroll
      for (int r = 0; r < 4; ++r)
#pragma unroll
          for (int i = 0; i < 8; ++i) acc[r][i] = 0.f;
#pragma unroll 4
      for (int d = 0; d < QKN; ++d) { float w[8]; unpack8(*(const LAS v4u*)(WH + d * 512 + ch * 16), w);
#pragma unroll
          for (int r = 0; r < 4; ++r) { const float qg = QG[(r4 * 4 + r) * 64 + d];
#pragma unroll
              for (int i = 0; i < 8; ++i) acc[r][i] += qg * w[i]; } }
#pragma unroll
      for (int r = 0; r < 4; ++r) { const int sr = rg * 64 + r4 * 4 + r; v4u o; o.x = pk2(acc[r][0], acc[r][1]); o.y = pk2(acc[r][2], acc[r][3]); o.z = pk2(acc[r][4], acc[r][5]); o.w = pk2(acc[r][6], acc[r][7]);
          *(GAS v4u*)(QABS + (size_t)(sr >> 2) * 36 * 32 * 8 + ch * 256 + ((sr & 3) * 8 + h) * 8) = o; } }
    LDS_WAIT(); __syncthreads();
}

__device__ __forceinline__ void ssm_tables_item(const void* const* in, int g, int dq, LAS unsigned char* lds, bf16* MBT, bf16* TYT, float* A32, int tid) {
    const float* a_re = (const float*)in[19]; const float* a_im = (const float*)in[20]; const float* log_dt = (const float*)in[21];
    const float* b_re = (const float*)in[22]; const float* b_im = (const float*)in[23]; const float* c_re = (const float*)in[24]; const float* c_im = (const float*)in[25]; const float* d_skip = (const float*)in[26];
    LAS float* ap = (LAS float*)lds;
    LAS float* bb = ap + 64 * 33 * 2;
    LAS float* cc = bb + 2048;
    LAS float* kj = cc + 2048;
    if (tid < 64) { const int p = tid;
        const double dt = exp((double)log_dt[g]); const double are = a_re[g * NST + p], aim = a_im[g * NST + p];
        const double mag = exp(dt * are), abr = mag * cos(dt * aim), abi = mag * sin(dt * aim), den = are * are + aim * aim, nr = abr - 1.0;
        const double fre = (nr * are + abi * aim) / den, fim = (abi * are - nr * aim) / den;
        double pr = 1.0, pi = 0.0;
        for (int j = 0; j <= 32; ++j) { ap[(p * 33 + j) * 2] = (float)pr; ap[(p * 33 + j) * 2 + 1] = (float)pi; const double t = pr * abr - pi * abi; pi = pr * abi + pi * abr; pr = t; }
        for (int i = 0; i < 16; ++i) { const double br = b_re[(g * NST + p) * GRP + i], bi = b_im[(g * NST + p) * GRP + i]; bb[(p * 16 + i) * 2] = (float)(fre * br - fim * bi); bb[(p * 16 + i) * 2 + 1] = (float)(fre * bi + fim * br); }
        if (dq == 0) { A32[(g * NST + p) * 2] = ap[(p * 33 + 32) * 2]; A32[(g * NST + p) * 2 + 1] = ap[(p * 33 + 32) * 2 + 1];
            A32[4096 + (g * NST + p) * 2] = (float)abr; A32[4096 + (g * NST + p) * 2 + 1] = (float)abi;
            for (int i = 0; i < 16; ++i) { A32[8192 + ((g * NST + p) * 16 + i) * 2] = bb[(p * 16 + i) * 2]; A32[8192 + ((g * NST + p) * 16 + i) * 2 + 1] = bb[(p * 16 + i) * 2 + 1]; } }
    }
    for (int e = tid; e < 1024; e += 512) { const int i = e >> 6, p = e & 63; cc[e * 2] = c_re[(g * GRP + i) * NST + p]; cc[e * 2 + 1] = c_im[(g * GRP + i) * NST + p]; }
    LDS_WAIT(); __syncthreads();
    for (int e = tid; e < 1024; e += 512) { const int dd = e >> 8, i = (e >> 4) & 15, j = e & 15, d = 4 * dq + dd; float acc = 0.f;
        for (int p = 0; p < 64; ++p) { const float cr = cc[(i * 64 + p) * 2], ci = cc[(i * 64 + p) * 2 + 1], ar = ap[(p * 33 + d) * 2], ai = ap[(p * 33 + d) * 2 + 1], br = bb[(p * 16 + j) * 2], bi = bb[(p * 16 + j) * 2 + 1];
            const float tr = cr * ar - ci * ai, ti = cr * ai + ci * ar; acc += tr * br - ti * bi; }
        if (d == 0 && i == j) acc += d_skip[g * GRP + i];
        kj[e] = acc; }
    LDS_WAIT(); __syncthreads();
    for (int e = tid; e < 4 * 32 * 16; e += 512) { const int dd = e >> 9, t = (e >> 4) & 31, i = e & 15, d = 4 * dq + dd; bf16* rowp = TYT + ((size_t)g * 512 + t * 16 + i) * SKA;
        if (t >= d) { const LAS float* kp = kj + dd * 256 + i * 16; v4u w0, w1; w0.x = pk2(kp[0], kp[1]); w0.y = pk2(kp[2], kp[3]); w0.z = pk2(kp[4], kp[5]); w0.w = pk2(kp[6], kp[7]);
            w1.x = pk2(kp[8], kp[9]); w1.y = pk2(kp[10], kp[11]); w1.z = pk2(kp[12], kp[13]); w1.w = pk2(kp[14], kp[15]);
            *(GAS v4u*)(rowp + (t - d) * 16) = w0; *(GAS v4u*)(rowp + (t - d) * 16 + 8) = w1; }
        if (d >= 1 && t + d <= 31) { const v4u z = {0u, 0u, 0u, 0u}; *(GAS v4u*)(rowp + (t + d) * 16) = z; *(GAS v4u*)(rowp + (t + d) * 16 + 8) = z; } }
    for (int e = tid; e < 4 * 16 * 64; e += 512) { const int tt = e >> 10, i = (e >> 6) & 15, p = e & 63, t = 4 * dq + tt;
        const float cr = cc[(i * 64 + p) * 2], ci = cc[(i * 64 + p) * 2 + 1], ar = ap[(p * 33 + t + 1) * 2], ai = ap[(p * 33 + t + 1) * 2 + 1];
        bf16* rowp = TYT + ((size_t)g * 512 + t * 16 + i) * SKA; rowp[512 + p] = (bf16)f2bf(cr * ar - ci * ai); rowp[576 + p] = (bf16)f2bf(-(cr * ai + ci * ar)); }
    for (int e = tid; e < 64 * 4 * 16; e += 512) { const int p = e >> 6, tt = (e >> 4) & 3, i = e & 15, t = 4 * dq + tt;
        const float ar = ap[(p * 33 + 31 - t) * 2], ai = ap[(p * 33 + 31 - t) * 2 + 1], br = bb[(p * 16 + i) * 2], bi = bb[(p * 16 + i) * 2 + 1];
        MBT[((size_t)g * 256 + p) * SKU + t * 16 + i] = (bf16)f2bf(ar * br - ai * bi); MBT[((size_t)g * 256 + 64 + p) * SKU + t * 16 + i] = (bf16)f2bf(ar * bi + ai * br); }
    for (int e = tid; e < 128 * 8; e += 512) { const int r = e >> 3, c8 = e & 7; const v4u z = {0u, 0u, 0u, 0u}; *(GAS v4u*)(MBT + ((size_t)g * 256 + 128 + r) * SKU + 64 * dq + 8 * c8) = z; }
    LDS_WAIT(); __syncthreads();
}

__device__ __forceinline__ float reduce16(float (&v)[16], int lane) {
#pragma unroll
    for (int st = 0; st < 4; ++st) { const int half = 8 >> st, bit = 1 << st; const bool hi = (lane & bit) != 0;
#pragma unroll
        for (int j = 0; j < half; ++j) { const float send = hi ? v[j] : v[j + half], keep = hi ? v[j + half] : v[j]; v[j] = keep + __shfl_xor(send, bit); } }
    float r = v[0]; r += __shfl_xor(r, 16); r += __shfl_xor(r, 32); return r;
}
__device__ __forceinline__ void ssm_sample(const void* const* in, const float* TAB, const bf16* Z, bf16* GY, float* out, int g, int b0, int bstride, LAS float* scr, int lane) {
    const float* c_re = (const float*)in[24]; const float* c_im = (const float*)in[25]; const float* d_skip = (const float*)in[26];
    const int p = lane;
    const float abr = TAB[4096 + (g * NST + p) * 2], abi = TAB[4096 + (g * NST + p) * 2 + 1];
    float bbr[16], bbi[16], cr[16], ci[16], dsk[16];
    { const GAS f32x4* bp = (const GAS f32x4*)(TAB + 8192 + (size_t)(g * NST + p) * 32);
#pragma unroll
      for (int i = 0; i < 8; ++i) { const f32x4 v = bp[i]; bbr[2 * i] = v[0]; bbi[2 * i] = v[1]; bbr[2 * i + 1] = v[2]; bbi[2 * i + 1] = v[3]; } }
#pragma unroll
    for (int i = 0; i < 16; ++i) { cr[i] = c_re[(g * GRP + i) * NST + p]; ci[i] = c_im[(g * GRP + i) * NST + p]; dsk[i] = (p == 0) ? d_skip[g * GRP + i] : 0.f; }
    for (int b = b0; b < DECB; b += bstride) {
    const int row0 = MP + b * DECT;
    float hr = ((const float*)in[7])[(b * NG + g) * NST + p], hi = ((const float*)in[8])[(b * NG + g) * NST + p];
    v4u uw[DECT][2];
#pragma unroll
    for (int t = 0; t < DECT; ++t) { const bf16* zr = Z + (size_t)(row0 + t) * NZ + ZC_U + GRP * g; uw[t][0] = *(const GAS v4u*)zr; uw[t][1] = *(const GAS v4u*)(zr + 8); }
#pragma unroll
    for (int t = 0; t < DECT; ++t) {
        float u[16]; { float a[8], b[8]; unpack8(uw[t][0], a); unpack8(uw[t][1], b);
#pragma unroll
            for (int i = 0; i < 8; ++i) { u[i] = a[i]; u[8 + i] = b[i]; } }
        float bur = 0.f, bui = 0.f;
#pragma unroll
        for (int i = 0; i < 16; ++i) { bur += bbr[i] * u[i]; bui += bbi[i] * u[i]; }
        const float nhr = abr * hr - abi * hi + bur, nhi = abr * hi + abi * hr + bui; hr = nhr; hi = nhi;
        float z[16];
#pragma unroll
        for (int i = 0; i < 16; ++i) z[i] = cr[i] * hr - ci[i] * hi + dsk[i] * u[i];
#pragma unroll
        for (int i = 0; i < 16; ++i) scr[lane * 17 + i] = z[i];
        LDS_WAIT(); asm volatile("" ::: "memory");
        float y = 0.f;
#pragma unroll
        for (int k = 0; k < 16; ++k) y += scr[((lane >> 4) * 16 + k) * 17 + (lane & 15)];
        y += __shfl_xor(y, 16); y += __shfl_xor(y, 32);
        LDS_WAIT(); asm volatile("" ::: "memory");
        if (lane < 16) GY[(size_t)(row0 + t) * SSMW + GRP * g + lane] = (bf16)f2bf(gelu_tanh(y));
    }
    out[O_SRES + (size_t)(b * NG + g) * NST + p] = hr; out[O_SIMS + (size_t)(b * NG + g) * NST + p] = hi;
    }
}
__device__ __forceinline__ void ssm_carry_item(const float* TAB, const float* SST, bf16* AY, float* out, int b, int g, int ph, LAS unsigned char* lds, int tid) {
    const int pl = tid & 31, sup = tid >> 5, p = 32 * ph + pl;
    const float ar = TAB[(g * NST + p) * 2], ai = TAB[(g * NST + p) * 2 + 1];
    float sr[16], si[16];
#pragma unroll
    for (int i = 0; i < 16; ++i) { const int ch = b * 256 + sup * 16 + i; const float* sp = SST + ((size_t)ch * NG + g) * 128; sr[i] = sp[p]; si[i] = sp[64 + p]; }
    float hr = 0.f, hi = 0.f;
#pragma unroll
    for (int i = 0; i < 16; ++i) { const float nr = ar * hr - ai * hi + sr[i], ni = ar * hi + ai * hr + si[i]; hr = nr; hi = ni; sr[i] = hr; si[i] = hi; }
    LAS float* tot = (LAS float*)lds;
    LAS float* car = tot + 1024;
    tot[(sup * 32 + pl) * 2] = hr; tot[(sup * 32 + pl) * 2 + 1] = hi;
    LDS_WAIT(); __syncthreads();
    if (sup == 0) { float br = ar, bi = ai;
#pragma unroll
        for (int k = 0; k < 4; ++k) { const float t = br * br - bi * bi; bi = 2.f * br * bi; br = t; }
        float cr = 0.f, ci = 0.f;
        for (int s2 = 0; s2 < 16; ++s2) { car[(s2 * 32 + pl) * 2] = cr; car[(s2 * 32 + pl) * 2 + 1] = ci; const float tr = tot[(s2 * 32 + pl) * 2], ti = tot[(s2 * 32 + pl) * 2 + 1];
            const float nr = br * cr - bi * ci + tr, ni = br * ci + bi * cr + ti; cr = nr; ci = ni; }
        out[O_SREP + (b * NG + g) * NST + p] = cr; out[O_SIMP + (b * NG + g) * NST + p] = ci; }
    LDS_WAIT(); __syncthreads();
    float er = car[(sup * 32 + pl) * 2], ei = car[(sup * 32 + pl) * 2 + 1], lr = 0.f, li = 0.f;
#pragma unroll
    for (int i = 0; i < 16; ++i) { const int ch = b * 256 + sup * 16 + i; bf16* ay = AY + ((size_t)g * SCH + ch) * SKA;
        ay[512 + p] = (bf16)f2bf(er + lr); ay[576 + p] = (bf16)f2bf(ei + li);
        const float nr = ar * er - ai * ei, ni = ar * ei + ai * er; er = nr; ei = ni; lr = sr[i]; li = si[i]; }
    LDS_WAIT(); __syncthreads();
}

#define TAIL_FILL(nbusy, NIT, ...) do { const int ntail_ = ((nbusy) < G) ? (nbusy) : 0; LAS float* scr = (LAS float*)(lds + RING_OFF + wave * 16384); \
        if (ntail_ == 0) { for (int r = gw; r < (NIT); r += NGW) { __VA_ARGS__; } } \
        else if (bx >= ntail_) { for (int r = (bx - ntail_) * NWAVES + wave; r < (NIT); r += (G - ntail_) * NWAVES) { __VA_ARGS__; } } } while (0)

__device__ __forceinline__ float softmax_ref(const float* g_q, const float* g_k, int lane) {
    float a = fmaxf(fabsf(g_q[lane]), fabsf(g_q[64 + (lane & 31)])), b = fmaxf(fabsf(g_k[lane]), fabsf(g_k[64 + (lane & 31)]));
#pragma unroll
    for (int o = 1; o < 64; o <<= 1) { a = fmaxf(a, __shfl_xor(a, o)); b = fmaxf(b, __shfl_xor(b, o)); }
    return QSCALE * 96.0f * a * b * 1.015f + 0.25f;
}

__device__ __forceinline__ void wait_panel(unsigned* cnt, int pm, unsigned target, unsigned* tmo) {
    if (threadIdx.x < 64) {
        unsigned sp = 0;
        while (__hip_atomic_load(cnt + 64 * pm, __ATOMIC_RELAXED, __HIP_MEMORY_SCOPE_AGENT) < target) {
            __builtin_amdgcn_s_sleep(2);
            if ((++sp & 1023u) == 0u && sp > (1u << 22)) { if (threadIdx.x == 0) __hip_atomic_store(tmo, 1u, __ATOMIC_RELAXED, __HIP_MEMORY_SCOPE_AGENT); break; }
        }
        __builtin_amdgcn_fence(__ATOMIC_ACQUIRE, "agent");
        asm volatile("s_waitcnt vmcnt(0)" ::: "memory");
    }
    __syncthreads();
}
#define GEMM_PS(g, nN_, base_p, base_s, E) do { \
      { pg8::Order S_; S_.init(MP / 256, (nN_), 1, G, bx, (base_p)); pg8::gemm_phase<decltype(E), true, true, false>(lds + RING_OFF, g, S_, E); } \
      { pg8::Order S_; S_.init(MS / 256, (nN_), 1, G, bx, (base_s), MP / 256, 4); pg8::gemm_phase<decltype(E), true, true, true>(lds + RING_OFF, g, S_, E); } } while (0)
#define GEMM_P(g, nN_, base_p, E) do { pg8::Order S_; S_.init(MP / 256, (nN_), 1, G, bx, (base_p)); pg8::gemm_phase<decltype(E), true, true, false>(lds + RING_OFF, g, S_, E); } while (0)
#define GEMM_S(g, nN_, base_s, E) do { pg8::Order S_; S_.init(MS / 256, (nN_), 1, G, bx, (base_s), MP / 256, 4); pg8::gemm_phase<decltype(E), true, true, true>(lds + RING_OFF, g, S_, E); } while (0)

__device__ __forceinline__ unsigned char* opqp(unsigned char* p) { asm volatile("" : "+s"(p)); return p; }
#define WIN ((bf16*)(ws + WS_WIN))
#define WUQ ((bf16*)(ws + WS_WUQ))
#define WKV ((bf16*)(ws + WS_WKV))
#define WGLU ((bf16*)(ws + WS_WGLU))
#define WOA ((bf16*)(ws + WS_WOA))
#define WOS ((bf16*)(ws + WS_WOS))
#define WOUT ((bf16*)(ws + WS_WOUT))
#define WPG ((bf16*)(ws + WS_WPG))
#define WPP ((bf16*)(ws + WS_WPP))
#define WUP ((bf16*)(ws + WS_WUP))
#define WDN ((bf16*)(ws + WS_WDN))
#define XN ((bf16*)(ws + WS_XN))
#define Z ((bf16*)(ws + WS_Z))
#define CQN ((bf16*)(ws + WS_CQN))
#define CKVN ((bf16*)(ws + WS_CKVN))
#define PB ((bf16*)(ws + WS_PB))
#define AY ((bf16*)(ws + WS_AY))
#define RT ((float*)(ws + WS_ROPE))
#define RB ((bf16*)(ws + WS_ROPEB))
#define QRAW ((bf16*)(ws + WS_QRAW))
#define KVRAW ((bf16*)(ws + WS_KVRAW))
#define PP ((bf16*)(ws + WS_PP))
#define Q ((bf16*)(ws + WS_Q))
#define K ((bf16*)(ws + WS_K))
#define ATT ((bf16*)(ws + WS_ATT))
#define GY ((bf16*)(ws + WS_GY))
#define YG ((bf16*)(ws + WS_YG))
#define T1 ((bf16*)(ws + WS_T1))
#define MIX ((bf16*)(ws + WS_MIX))
#define SS1 ((float*)(ws + WS_SS1))
#define SS2 ((float*)(ws + WS_SS2))
#define UPB ((bf16*)(ws + WS_UP))
#define HB ((bf16*)(ws + WS_H))
#define X2B ((bf16*)(ws + WS_X2))
#define CB ((bf16*)(ws + WS_CB))
#define KNC ((bf16*)(ws + WS_KNC))
#define ROPE ((float*)(ws + WS_ROPE))
#define SST ((float*)(ws + WS_SST))
__global__ void __launch_bounds__(NWAVES * 64, 2) mk_fwd(Args args) {
    extern __shared__ __attribute__((aligned(16))) unsigned char lds_raw[];
    LAS unsigned char* lds = (LAS unsigned char*)lds_raw;
    volatile LAS unsigned* MISC = (volatile LAS unsigned*)(lds + MISC_OFF);
    const int tid0 = threadIdx.x;
    const int G = gridDim.x, bx = blockIdx.x;
    const int vcu = (G % 8 == 0) ? (bx % 8) * (G / 8) + bx / 8 : bx;
    const int NGW = G * NWAVES;
    unsigned char* ws0 = args.ws;
    unsigned* ctl = (unsigned*)(ws0 + WS_CTL);
    float* out = args.out;
    for (int u = opq(tid0); u < (LDS_BYTES - LDSCTL_OFF) / 4; u += NWAVES * 64) ((LAS unsigned*)(lds + LDSCTL_OFF))[u] = 0u;
    __syncthreads();
    XcdBarrier bar; bar.bar = ctl + CW_BAR; bar.x = 0; bar.st = nullptr;
#if MK_ONE_LAUNCH
    bar = xcd_barrier_post(ctl + CW_BAR, MISC + 8);
#define GRID_BAR() xcd_barrier(bar)
#else
#define GRID_BAR() do {} while (0)
#endif
    const int lo = args.ph_lo, hi = args.ph_hi;
#ifndef PHMASK
#define PHMASK 0xFFFFFFFFu
#endif
#define IN(k) ((((PHMASK) >> (k)) & 1u) && lo <= (k) && (k) < hi)
#define BOTH(k) (IN(k) && IN((k) + 1))

    const float* x_prompt = (const float*)args.in[0]; const float* x_sample = (const float*)args.in[1];
    const float* p_prompt = (const float*)args.in[2]; const float* p_sample = (const float*)args.in[3];
    if (IN(0)) REPLOOP(0) { unsigned char* ws = opqp(ws0); const int tid = opq(tid0), lane = tid & 63, wave = __builtin_amdgcn_readfirstlane(tid >> 6), gw = vcu * NWAVES + wave; (void)lane; (void)gw;
        _Pragma("unroll") for (int rq_ = 0; rq_ < P0A; ++rq_)
        for (int it = bx; it < NG * 8; it += G) ssm_tables_item(args.in, it >> 3, it & 7, lds + RING_OFF, (bf16*)(ws + WS_MBT), (bf16*)(ws + WS_TYT), (float*)(ws + WS_SSMT), tid);
        LAS float* scr = (LAS float*)(lds + RING_OFF + wave * 16384);
        constexpr int I_WIN = 16 * (NZ / 32);
        _Pragma("unroll") for (int rq_ = 0; rq_ < P0B; ++rq_)
        for (int r = gw; r < I_WIN; r += NGW) { const int nblk = NZ / 32, kb = r / nblk, nb = r % nblk, nd = 32 * nb; int ns; bool pad = false;
                if (nd < 256) ns = 384 + nd; else if (nd < 640) ns = nd - 256; else if (nd < 672) ns = nd; else if (nd < 768) { ns = 0; pad = true; }
                else if (nd < 1280) ns = 672 + (nd - 768); else if (nd < 2304) ns = 1184 + (nd - 1280); else ns = 2208 + (nd - 2304);
                tr_item(pad ? nullptr : (const float*)args.in[11], 3232, 64 * kb, ns, WIN, 1024, nd, scr, lane); }
        const float* gmix = (const float*)args.in[10];
        f32x4 gm[4];
#pragma unroll
        for (int j = 0; j < 4; ++j) gm[j] = ((const GAS f32x4*)gmix)[lane + 64 * j];
        for (int m0 = gw; m0 < M; m0 += 2 * NGW) { const int m1 = m0 + NGW; const bool two = m1 < M;
            f32x4 v[2][4], pv[2];
#pragma unroll
            for (int r = 0; r < 2; ++r) { const int m = (r == 0 || two) ? (r == 0 ? m0 : m1) : m0;
                const float* xrow = (m < MP) ? x_prompt + (size_t)m * D : x_sample + (size_t)(m - MP) * D; const GAS f32x4* xr = (const GAS f32x4*)xrow + lane;
#pragma unroll
                for (int j = 0; j < 4; ++j) v[r][j] = xr[64 * j];
                const float* prow = (m < MP) ? p_prompt + (size_t)m * PLE : p_sample + (size_t)(m - MP) * PLE; pv[r] = ((const GAS f32x4*)prow)[lane]; }
#pragma unroll
            for (int r = 0; r < 2; ++r) { if (r == 1 && !two) break; const int m = r == 0 ? m0 : m1; float sq = 0.f;
#pragma unroll
                for (int j = 0; j < 4; ++j) sq += (v[r][j].x * v[r][j].x + v[r][j].y * v[r][j].y) + (v[r][j].z * v[r][j].z + v[r][j].w * v[r][j].w);
                const float rs = 1.0f / sqrtf(wave_sum(sq) * (1.f / D) + EPS);
                GAS v2u* o8 = (GAS v2u*)(XN + (size_t)m * D) + lane;
#pragma unroll
                for (int j = 0; j < 4; ++j) { v2u w; w.x = pk2(v[r][j].x * rs * gm[j].x, v[r][j].y * rs * gm[j].y); w.y = pk2(v[r][j].z * rs * gm[j].z, v[r][j].w * rs * gm[j].w); o8[64 * j] = w; }
                v2u w; w.x = pk2(pv[r].x, pv[r].y); w.y = pk2(pv[r].z, pv[r].w); ((GAS v2u*)(PB + (size_t)m * PLE))[lane] = w; }
        }
        if (BOTH(0)) GRID_BAR();
    }

    if (IN(1)) REPLOOP(1) { unsigned char* ws = opqp(ws0); const int tid = opq(tid0), lane = tid & 63, wave = __builtin_amdgcn_readfirstlane(tid >> 6), gw = vcu * NWAVES + wave; (void)lane; (void)gw;
        pg8::Gemm g{XN, WIN, D, D, D, 0, 0}; pg8::Order S; S.init(M / 256, NZ / 256, 1, G, bx, 0);
        EpiInproj E{Z, CQN, CKVN, AY, out, (const float*)args.in[13], lds + 131072};
        pg8::gemm_phase(lds + RING_OFF, g, S, E);
        { constexpr int I_WUQ = 6 * 24, I_WUK = 4 * 16, I_WUV = 4 * 16, I_WGLU = 8 * 32, I_WOA = 8 * 32, I_WOS = 8 * 32, I_WOUT = 16 * 32, I_WPP = 4 * 32;
          constexpr int NIT1 = I_WUQ + I_WUK + I_WUV + I_WGLU + I_WOA + I_WOS + I_WOUT + I_WPP;
          TAIL_FILL(((M / 256) * (NZ / 256)) % G, NIT1, { int q = r;
            if (q < I_WUQ) { tr_plain((const float*)args.in[14], 384, 768, WUQ, q, scr, lane, (const float*)args.in[12]); continue; } q -= I_WUQ;
            if (q < I_WUK) { tr_plain((const float*)args.in[15], 256, 512, WKV, q, scr, lane); continue; } q -= I_WUK;
            if (q < I_WUV) { tr_plain((const float*)args.in[16], 256, 512, WKV + 512 * 256, q, scr, lane); continue; } q -= I_WUV;
            if (q < I_WGLU) { const int kb = q / 32, nb = q % 32, nd = 32 * nb; const int pn = nd >> 8, bj = (nd >> 7) & 1, c = nd & 127; const int ns = bj * 512 + 128 * pn + c;
                tr_item((const float*)args.in[27], 1024, 64 * kb, ns, WGLU, 512, nd, scr, lane); continue; } q -= I_WGLU;
            if (q < I_WOA) { tr_plain((const float*)args.in[28], 512, 1024, WOA, q, scr, lane); continue; } q -= I_WOA;
            if (q < I_WOS) { tr_plain((const float*)args.in[29], 512, 1024, WOS, q, scr, lane); continue; } q -= I_WOS;
            if (q < I_WOUT) { tr_plain((const float*)args.in[30], 1024, 1024, WOUT, q, scr, lane); continue; } q -= I_WOUT;
            tr_plain((const float*)args.in[38], 256, 1024, WPP, q, scr, lane); });
          TAIL_FILL(((M / 256) * (NZ / 256)) % G, 16 * 176, { const int kb_ = r / 176, nd_ = 32 * (r % 176), ns_ = ((nd_ >> 7) & 1) * DFF + 128 * (nd_ >> 8) + (nd_ & 127);     \
            tr_item((const float*)args.in[32], UPW, 64 * kb_, ns_, WUP, 1024, nd_, scr, lane, (const float*)args.in[31]); });
          const int nb1 = ((M / 256) * (NZ / 256)) % G, b0_ = (nb1 && bx >= nb1) ? bx - nb1 : (nb1 ? -1 : bx), gs_ = nb1 ? G - nb1 : G;
          if (b0_ >= 0) {
        { for (int i = b0_ * 512 + tid; i < (SEQ + DECT) * 16; i += gs_ * 512) { const int pos = i >> 4, k = i & 15;
              const float inv = (float)exp(-(double)k * (1.0 / 16.0) * 9.210340371976184); const float ang = (float)pos * inv; const float c = cosf(ang), sn = sinf(ang);
              RT[pos * 32 + k] = c; RT[pos * 32 + 16 + k] = sn; RB[pos * 32 + k] = (bf16)f2bf(c); RB[pos * 32 + 16 + k] = (bf16)f2bf(sn); } }
        { unsigned* W8 = (unsigned*)(ws + WS_W8); const float* w_uk = (const float*)args.in[15];
          for (int i = b0_ * 512 + tid; i < 512 * 64; i += gs_ * 512) { const int row = i & 511, k4 = (i >> 9) * 4; int w = 0;
              w = __builtin_amdgcn_cvt_pk_fp8_f32(64.f * w_uk[(size_t)k4 * 512 + row], 64.f * w_uk[(size_t)(k4 + 1) * 512 + row], w, false);
              w = __builtin_amdgcn_cvt_pk_fp8_f32(64.f * w_uk[(size_t)(k4 + 2) * 512 + row], 64.f * w_uk[(size_t)(k4 + 3) * 512 + row], w, true);
              W8[row * 64 + (k4 >> 2)] = (unsigned)w; } }
          } }
        if (BOTH(1)) GRID_BAR();
    }

    constexpr int NMT = M / 256;

    if (IN(3)) REPLOOP(3) { unsigned char* ws = opqp(ws0); const int tid = opq(tid0), lane = tid & 63, wave = __builtin_amdgcn_readfirstlane(tid >> 6), gw = vcu * NWAVES + wave; (void)lane; (void)gw;
        {
          constexpr int NPR = MP / 256;
          pg8::Gemm gq{CQN, WUQ, QL, QL, QL, 0, 0}; auto fq_ = [=](const pg8::Unit& u, int row, int col, f32x4 a, f32x4 b) { *(GAS v4u*)(QRAW + (size_t)row * 768 + col) = pack8(a, b); }; pg8::EpiRow8<decltype(fq_)> Eq{fq_};
          pg8::Gemm gk{CKVN, WKV, KVL, KVL, KVL, 0, 0}; auto fk_ = [=](const pg8::Unit& u, int row, int col, f32x4 a, f32x4 b) { *(GAS v4u*)(KVRAW + (size_t)row * 1024 + col) = pack8(a, b); }; pg8::EpiRow8<decltype(fk_)> Ek{fk_};
          GEMM_P(gq, 3, 0, Eq); GEMM_P(gk, 4, NPR * 3, Ek);
          { pg8::Gemm g{AY, (const bf16*)(ws + WS_MBT), SKA, SKU, SKU, (size_t)SCH * SKA, (size_t)256 * SKU}; pg8::Order S; S.init(SCH / 256, 1, NG, G, bx, NPR * 7);
            auto f = [=](const pg8::Unit& u, int row, int col, f32x4 a, f32x4 b) { if (col < 128) { float* d = SST + ((size_t)row * NG + u.z) * 128 + col; *(GAS f32x4*)d = a; *(GAS f32x4*)(d + 4) = b; } };
            pg8::EpiRow8<decltype(f)> E{f}; pg8::gemm_phase(lds + RING_OFF, g, S, E); }
          constexpr int B2 = NPR * 7 + 64;
          GEMM_S(gq, 3, B2, Eq); GEMM_S(gk, 4, B2 + 24, Ek); }
        if (BOTH(3)) GRID_BAR();
    }

    if (IN(4)) REPLOOP(4) { unsigned char* ws = opqp(ws0); const int tid = opq(tid0), lane = tid & 63, wave = __builtin_amdgcn_readfirstlane(tid >> 6), gw = vcu * NWAVES + wave; (void)lane; (void)gw;
        _Pragma("unroll") for (int rpc_ = 0; rpc_ < P4C; ++rpc_)
        for (int it = bx; it < NBATCH * NG * 2; it += G) ssm_carry_item((const float*)(ws + WS_SSMT), (const float*)(ws + WS_SST), AY, out, it >> 6, (it >> 1) & 31, it & 1, lds + RING_OFF, tid);
        _Pragma("unroll") for (int rpd_ = 0; rpd_ < P4D; ++rpd_)
        for (int it = G - 1 - bx; it < NH * (MS / 64); it += G) qabs_item(args.in, QRAW, WKV, ROPE, (bf16*)(ws + WS_QABS), it & 7, it >> 3, lds + RING_OFF, tid);
        const float* g_q = (const float*)args.in[17]; const float* g_k = (const float*)args.in[18];
        const int h = lane >> 3, sub = lane & 7;
        float gq[12], gk[12];
#pragma unroll
        for (int i = 0; i < 8; ++i) { gq[i] = g_q[8 * sub + i]; gk[i] = g_k[8 * sub + i]; }
        gq[8] = g_q[64 + 2 * sub]; gq[9] = g_q[65 + 2 * sub]; gq[10] = g_q[80 + 2 * sub]; gq[11] = g_q[81 + 2 * sub];
        gk[8] = g_k[64 + 2 * sub]; gk[9] = g_k[65 + 2 * sub]; gk[10] = g_k[80 + 2 * sub]; gk[11] = g_k[81 + 2 * sub];
        _Pragma("unroll") for (int rpa_ = 0; rpa_ < P4A; ++rpa_)
        for (int m0 = gw; m0 < M; m0 += 2 * NGW) {
            const int m1 = m0 + NGW; const bool two = m1 < M;
            f32x2 cs[2], sn[2]; v4u qn8[2], kn8[2]; unsigned qa[2], qb[2]; f32x2 xa[2], xb[2];
#pragma unroll
            for (int j = 0; j < 2; ++j) { const int m = (j == 0 || two) ? (j == 0 ? m0 : m1) : m0;
                const int pos = (m < MP) ? (m & (SEQ - 1)) : SEQ + ((m - MP) & 3);
                const float* rp = ROPE + (size_t)pos * 32; cs[j] = *(const GAS f32x2*)(rp + 2 * sub); sn[j] = *(const GAS f32x2*)(rp + 16 + 2 * sub);
                const bf16* qr = QRAW + (size_t)m * 768 + h * QKH; qn8[j] = *(const GAS v4u*)(qr + 8 * sub); qa[j] = *(const GAS unsigned*)(qr + 64 + 2 * sub); qb[j] = *(const GAS unsigned*)(qr + 80 + 2 * sub);
                kn8[j] = *(const GAS v4u*)(KVRAW + (size_t)m * 1024 + h * QKN + 8 * sub);
                const float* krp = (m < MP) ? out + O_KRP + (size_t)m * QKR : out + O_KRS + (size_t)(m - MP) * QKR; xa[j] = *(const GAS f32x2*)(krp + 2 * sub); xb[j] = *(const GAS f32x2*)(krp + 16 + 2 * sub); }
#pragma unroll
            for (int j = 0; j < 2; ++j) { if (j == 1 && !two) break; const int m = j == 0 ? m0 : m1;
            { float n[8]; unpack8(qn8[j], n);
              float a0 = bflo(qa[j]), a1 = bfhi(qa[j]), b0 = bflo(qb[j]), b1 = bfhi(qb[j]);
              float ss = (a0 * a0 + a1 * a1) + (b0 * b0 + b1 * b1);
#pragma unroll
              for (int i = 0; i < 8; ++i) ss += n[i] * n[i];
              ss += __shfl_xor(ss, 1); ss += __shfl_xor(ss, 2); ss += __shfl_xor(ss, 4);
              const float rs = QSCALE / sqrtf(ss * (1.f / QKH) + EPS);
#pragma unroll
              for (int i = 0; i < 8; ++i) n[i] *= rs * gq[i];
              a0 *= rs * gq[8]; a1 *= rs * gq[9]; b0 *= rs * gq[10]; b1 *= rs * gq[11];
              bf16* qo = Q + (size_t)m * 768 + h * QKH;
              v4u w; w.x = pk2(n[0], n[1]); w.y = pk2(n[2], n[3]); w.z = pk2(n[4], n[5]); w.w = pk2(n[6], n[7]); *(GAS v4u*)(qo + 8 * sub) = w;
              *(GAS unsigned*)(qo + 64 + 2 * sub) = pk2(a0 * cs[j].x - b0 * sn[j].x, a1 * cs[j].y - b1 * sn[j].y); *(GAS unsigned*)(qo + 80 + 2 * sub) = pk2(a0 * sn[j].x + b0 * cs[j].x, a1 * sn[j].y + b1 * cs[j].y); }
            { float n[8]; unpack8(kn8[j], n);
              float a0 = xa[j].x, a1 = xa[j].y, b0 = xb[j].x, b1 = xb[j].y;
              float ss = (a0 * a0 + a1 * a1) + (b0 * b0 + b1 * b1);
#pragma unroll
              for (int i = 0; i < 8; ++i) ss += n[i] * n[i];
              ss += __shfl_xor(ss, 1); ss += __shfl_xor(ss, 2); ss += __shfl_xor(ss, 4);
              const float rs = 1.0f / sqrtf(ss * (1.f / QKH) + EPS);
#pragma unroll
              for (int i = 0; i < 8; ++i) n[i] *= rs * gk[i];
              a0 *= rs * gk[8]; a1 *= rs * gk[9]; b0 *= rs * gk[10]; b1 *= rs * gk[11];
              bf16* ko = K + (size_t)m * 768 + h * QKH;
              v4u w; w.x = pk2(n[0], n[1]); w.y = pk2(n[2], n[3]); w.z = pk2(n[4], n[5]); w.w = pk2(n[6], n[7]); *(GAS v4u*)(ko + 8 * sub) = w;
              *(GAS unsigned*)(ko + 64 + 2 * sub) = pk2(a0 * cs[j].x - b0 * sn[j].x, a1 * cs[j].y - b1 * sn[j].y);
              *(GAS unsigned*)(ko + 80 + 2 * sub) = pk2(a0 * sn[j].x + b0 * cs[j].x, a1 * sn[j].y + b1 * cs[j].y); } }
        }
        _Pragma("unroll") for (int rpb_ = 0; rpb_ < P4B; ++rpb_)
        if (NGW % NG == 0) ssm_sample(args.in, (const float*)(ws + WS_SSMT), Z, GY, out, gw % NG, gw / NG, NGW / NG, (LAS float*)(lds + RING_OFF + wave * 16384), lane);
        else for (int it = gw; it < DECB * NG; it += NGW) ssm_sample(args.in, (const float*)(ws + WS_SSMT), Z, GY, out, it % NG, it / NG, DECB, (LAS float*)(lds + RING_OFF + wave * 16384), lane);
        if (BOTH(4)) GRID_BAR();
    }

    if (IN(5)) REPLOOP(5) { unsigned char* ws = opqp(ws0); const int tid = opq(tid0), lane = tid & 63, wave = __builtin_amdgcn_readfirstlane(tid >> 6), gw = vcu * NWAVES + wave; (void)lane; (void)gw;
        const bool sa_first = SA_FIRST_ALL ? true : ((vcu & 1) != 0);
        const float sref = softmax_ref((const float*)args.in[17], (const float*)args.in[18], lane);
        if (sa_first)
            for (int it = bx; it < DECB * 2; it += G)
                sa::item<0>(args.in, (const bf16*)(ws + WS_QABS), (const unsigned char*)(ws + WS_W8), (const bf16*)(ws + WS_ROPEB), (float*)(ws + WS_PO), (float*)(ws + WS_PL), sref, it >> 1, it & 1, lds + RING_OFF, tid, wave, lane);
        for (int pi = vcu; pi < 256; pi += G) { const int bh = pi >> 4, s_ = pi & 15;
            pa::attn_unit(Q, K, KVRAW + 512, ATT, bh >> 3, bh & 7, s_, sref, lds + RING_OFF, wave, lane);
            pa::attn_unit(Q, K, KVRAW + 512, ATT, bh >> 3, bh & 7, 31 - s_, sref, lds + RING_OFF, wave, lane); }
        if (!sa_first)
            for (int it = bx; it < DECB * 2; it += G)
                sa::item<0>(args.in, (const bf16*)(ws + WS_QABS), (const unsigned char*)(ws + WS_W8), (const bf16*)(ws + WS_ROPEB), (float*)(ws + WS_PO), (float*)(ws + WS_PL), sref, it >> 1, it & 1, lds + RING_OFF, tid, wave, lane);
        if (BOTH(5)) GRID_BAR();
    }

    if (IN(6)) REPLOOP(6) { unsigned char* ws = opqp(ws0); const int tid = opq(tid0), lane = tid & 63, wave = __builtin_amdgcn_readfirstlane(tid >> 6), gw = vcu * NWAVES + wave; (void)lane; (void)gw;
        const float sref6 = softmax_ref((const float*)args.in[17], (const float*)args.in[18], lane);
        const int GH = G / 2;
        _Pragma("unroll") for (int rq_ = 0; rq_ < P6A; ++rq_)
        if (bx >= GH) for (int it = bx - GH; it < NH * (MS / 16); it += G - GH)
            sa::combine_item(args.in, Q, K, CKVN, (const float*)(ws + WS_PO), (const float*)(ws + WS_PL), sref6, ATT, it & 7, it >> 3, lds + RING_OFF, tid, wave, lane);
        { pg8::Gemm g{AY, (const bf16*)(ws + WS_TYT), SKA, SKA, SKA, (size_t)SCH * SKA, (size_t)512 * SKA}; pg8::Order S; S.init(SCH / 256, 2, NG, GH, bx, 0);
          auto f = [=](const pg8::Unit& u, int row, int col, f32x4 a, f32x4 b) {
#pragma unroll
              for (int i = 0; i < 4; ++i) { a[i] = gelu_tanh(a[i]); b[i] = gelu_tanh(b[i]); }
              *(GAS v4u*)(GY + ((size_t)row * SL + (col >> 4)) * SSMW + u.z * GRP + (col & 15)) = pack8(a, b); };
          pg8::EpiRow8<decltype(f)> E{f}; if (bx < GH) pg8::gemm_phase(lds + RING_OFF, g, S, E); }
        if (BOTH(6)) GRID_BAR();
    }

    if (IN(7)) REPLOOP(7) { unsigned char* ws = opqp(ws0); const int tid = opq(tid0), lane = tid & 63, wave = __builtin_amdgcn_readfirstlane(tid >> 6), gw = vcu * NWAVES + wave; (void)lane; (void)gw;
        { pg8::Gemm gg{GY, WGLU, SSMW, SSMW, SSMW, 0, 0};
          auto fg_ = [=](const pg8::Unit& u, int row, int cp, f32x4 a0, f32x4 a1, f32x4 b0, f32x4 b1) {
#pragma unroll
              for (int i = 0; i < 4; ++i) { a0[i] *= sigmoidf_(b0[i]); a1[i] *= sigmoidf_(b1[i]); }
              *(GAS v4u*)(YG + (size_t)row * SSMW + cp) = pack8(a0, a1); };
          pg8::EpiPair8<decltype(fg_)> Eg{fg_};
          pg8::Gemm ga_{ATT, WOA, ATTW, ATTW, ATTW, 0, 0};
          auto fa_ = [=](const pg8::Unit& u, int row, int col, f32x4 a, f32x4 b) { float gt[8]; unpack8(*(const GAS v4u*)(Z + (size_t)row * NZ + ZC_GA + col), gt);
#pragma unroll
              for (int i = 0; i < 4; ++i) { a[i] *= gt[i]; b[i] *= gt[4 + i]; }
              *(GAS v4u*)(T1 + (size_t)row * D + col) = pack8(a, b); };
          pg8::EpiRow8<decltype(fa_)> Ea{fa_};
          GEMM_P(gg, 4, 0, Eg); GEMM_P(ga_, 4, 256, Ea); GEMM_S(gg, 4, 512, Eg); GEMM_S(ga_, 4, 544, Ea); }
        if (BOTH(7)) GRID_BAR();
    }

    if (IN(8)) REPLOOP(8) { unsigned char* ws = opqp(ws0); const int tid = opq(tid0), lane = tid & 63, wave = __builtin_amdgcn_readfirstlane(tid >> 6), gw = vcu * NWAVES + wave; (void)lane; (void)gw;
        pg8::Gemm g{YG, WOS, SSMW, SSMW, SSMW, 0, 0};
        auto f = [=](const pg8::Unit& u, int row, int col, f32x4 a, f32x4 b) { float gt[8], t1[8]; unpack8(*(const GAS v4u*)(Z + (size_t)row * NZ + ZC_GS + col), gt); unpack8(*(const GAS v4u*)(T1 + (size_t)row * D + col), t1);
#pragma unroll
            for (int i = 0; i < 4; ++i) { a[i] = t1[i] + a[i] * gt[i]; b[i] = t1[4 + i] + b[i] * gt[4 + i]; }
            *(GAS v4u*)(MIX + (size_t)row * D + col) = pack8(a, b); };
        pg8::EpiRow8<decltype(f)> E{f}; GEMM_PS(g, 4, 0, 256, E);
        TAIL_FILL(32, 44 * 32, tr_plain((const float*)args.in[35], DFF, 1024, WDN, r, scr, lane));
        if (BOTH(8)) GRID_BAR();
    }

    if (IN(9)) REPLOOP(9) { unsigned char* ws = opqp(ws0); const int tid = opq(tid0), lane = tid & 63, wave = __builtin_amdgcn_readfirstlane(tid >> 6), gw = vcu * NWAVES + wave; (void)lane; (void)gw;
        pg8::Gemm g{MIX, WOUT, D, D, D, 0, 0};
        EpiResid<false> E{x_prompt, x_sample, nullptr, XN, SS1};
        GEMM_PS(g, 4, 0, 256, E);
        TAIL_FILL(32, 16 * 32, tr_plain((const float*)args.in[37], 1024, 1024, WPG, r, scr, lane, (const float*)args.in[36]));
        if (BOTH(9)) GRID_BAR();
    }

    if (IN(10)) REPLOOP(10) { unsigned char* ws = opqp(ws0); const int tid = opq(tid0), lane = tid & 63, wave = __builtin_amdgcn_readfirstlane(tid >> 6), gw = vcu * NWAVES + wave; (void)lane; (void)gw;
        pg8::Gemm g{XN, WUP, D, D, D, 0, 0};
        EpiUpConv E{SS1, HB, (bf16*)(ws + WS_UPF), (bf16*)(ws + WS_UPL), out, (const float*)args.in[33], (const float*)args.in[34], (const float*)args.in[9], lds + 131072, ctl + CW_PAN};
        constexpr int NUS = (MS / 256) * (UPW / 256), NUP = (MP / 256) * (UPW / 256);
        { pg8::Order Sa, Sb; Sa.init(MS / 256, UPW / 256, 1, G, bx, 0, MP / 256, 1); Sb.init(MP / 256, UPW / 256, 1, G, bx, NUS); pg8::OrderSeq S; S.init(Sa, Sb, NUS, G, bx);
          pg8::gemm_phase<EpiUpConv, true, true, false, pg8::OrderSeq>(lds + RING_OFF, g, S, E); }
        {
          pg8::Gemm gp{PB, WPP, PLE, PLE, PLE, 0, 0}; auto fp_ = [=](const pg8::Unit& u, int row, int col, f32x4 a, f32x4 b) { *(GAS v4u*)(PP + (size_t)row * 1024 + col) = pack8(a, b); }; pg8::EpiRow8<decltype(fp_)> Ep{fp_};
          const int nb_ = (NUS + NUP) % G; const int nidle = nb_ ? G - nb_ : G, ci = nb_ ? bx - nb_ : bx;
          const int nd_ = (nidle > 64) ? 32 : 0;
          if (ci >= 0 && ci < nd_) { pg8::Gemm gd{HB, WDN, DFF, DFF, DFF, 0, 0}; EpiResid<true> Ed{nullptr, nullptr, XN, X2B, SS2};
              pg8::Order Sd; Sd.init(MS / 256, 4, 1, nd_, ci, 0, MP / 256, 4); pg8::Unit uo;
              for (int i = 0; Sd.next(i, uo); ++i) wait_panel(ctl + CW_PAN, uo.pm, (unsigned)(UPW / 256) * 8u, ctl + CW_PTMO);
              pg8::gemm_phase<EpiResid<true>, true, true, true>(lds + RING_OFF, gd, Sd, Ed); }
          else if (ci >= nd_) { pg8::Order So; So.init(NMT, 4, 1, nidle - nd_, ci - nd_, 0); pg8::gemm_phase(lds + RING_OFF, gp, So, Ep); } }
        if (BOTH(10)) GRID_BAR();
    }


    if (IN(12)) REPLOOP(12) { unsigned char* ws = opqp(ws0); const int tid = opq(tid0), lane = tid & 63, wave = __builtin_amdgcn_readfirstlane(tid >> 6), gw = vcu * NWAVES + wave; (void)lane; (void)gw;
        { const float* conv_w = (const float*)args.in[33]; const float* conv_b = (const float*)args.in[34]; const bf16* UPF = (const bf16*)(ws + WS_UPF); const bf16* UPL = (const bf16*)(ws + WS_UPL);
          constexpr int NCG = DFF / 8; pg8::Order So; So.init(MP / 256, 4, 1, G, bx, 0); pg8::Unit uo;
          for (int ui = 0; So.next(ui, uo); ++ui) { const int pm = uo.pm;
          for (int it = tid; it < 2 * NCG; it += 512) {
            const int cg = it % NCG, rr = it / NCG, c0 = 8 * cg; const bool first = (pm & 31) == 0;
            float cur[16], p1[16], p2[16];
            unpack8(*(const GAS v4u*)(UPF + ((size_t)pm * 2 + rr) * UPW + c0), *(float(*)[8])&cur[0]); unpack8(*(const GAS v4u*)(UPF + ((size_t)pm * 2 + rr) * UPW + DFF + c0), *(float(*)[8])&cur[8]);
#pragma unroll
            for (int i = 0; i < 16; ++i) { p1[i] = 0.f; p2[i] = 0.f; }
            if (rr == 1) { unpack8(*(const GAS v4u*)(UPF + ((size_t)pm * 2) * UPW + c0), *(float(*)[8])&p1[0]); unpack8(*(const GAS v4u*)(UPF + ((size_t)pm * 2) * UPW + DFF + c0), *(float(*)[8])&p1[8]); }
            if (!first) {
                if (rr == 0) { unpack8(*(const GAS v4u*)(UPL + ((size_t)(pm - 1) * 2 + 1) * UPW + c0), *(float(*)[8])&p1[0]); unpack8(*(const GAS v4u*)(UPL + ((size_t)(pm - 1) * 2 + 1) * UPW + DFF + c0), *(float(*)[8])&p1[8]);
                               unpack8(*(const GAS v4u*)(UPL + ((size_t)(pm - 1) * 2) * UPW + c0), *(float(*)[8])&p2[0]); unpack8(*(const GAS v4u*)(UPL + ((size_t)(pm - 1) * 2) * UPW + DFF + c0), *(float(*)[8])&p2[8]); }
                else { unpack8(*(const GAS v4u*)(UPL + ((size_t)(pm - 1) * 2 + 1) * UPW + c0), *(float(*)[8])&p2[0]); unpack8(*(const GAS v4u*)(UPL + ((size_t)(pm - 1) * 2 + 1) * UPW + DFF + c0), *(float(*)[8])&p2[8]); }
            }
            float hh[8];
#pragma unroll
            for (int i = 0; i < 8; ++i) { const float ca = conv_b[c0 + i] + p2[i] * conv_w[c0 + i] + p1[i] * conv_w[UPW + c0 + i] + cur[i] * conv_w[2 * UPW + c0 + i];
                const float cv = conv_b[DFF + c0 + i] + p2[8 + i] * conv_w[DFF + c0 + i] + p1[8 + i] * conv_w[UPW + DFF + c0 + i] + cur[8 + i] * conv_w[2 * UPW + DFF + c0 + i]; hh[i] = gelu_tanh(ca) * cv; }
            v4u o; o.x = pk2(hh[0], hh[1]); o.y = pk2(hh[2], hh[3]); o.z = pk2(hh[4], hh[5]); o.w = pk2(hh[6], hh[7]);
            *(GAS v4u*)(HB + ((size_t)pm * 256 + rr) * DFF + c0) = o;
        }
          }
          asm volatile("s_waitcnt vmcnt(0)" ::: "memory"); __syncthreads(); }
        pg8::Gemm g{HB, WDN, DFF, DFF, DFF, 0, 0};
        EpiResid<true> E{nullptr, nullptr, XN, X2B, SS2};
        { constexpr int NU10 = (M / 256) * (UPW / 256); const int nb_ = NU10 % G, nidle = nb_ ? G - nb_ : G;
          if (nidle > 64) GEMM_P(g, 4, 0, E); else GEMM_PS(g, 4, 0, 256, E); }
        if (BOTH(12)) GRID_BAR();
    }

    if (IN(13)) REPLOOP(13) { unsigned char* ws = opqp(ws0); const int tid = opq(tid0), lane = tid & 63, wave = __builtin_amdgcn_readfirstlane(tid >> 6), gw = vcu * NWAVES + wave; (void)lane; (void)gw;
        pg8::Gemm g{X2B, WPG, D, D, D, 0, 0};
        EpiPle E{SS2, X2B, PP, out + O_Y};
        GEMM_PS(g, 4, 0, 256, E);
    }
#undef IN
#undef BOTH
}

#undef WIN
#undef WUQ
#undef WKV
#undef WGLU
#undef WOA
#undef WOS
#undef WOUT
#undef WPG
#undef WPP
#undef WUP
#undef WDN
#undef XN
#undef Z
#undef CQN
#undef CKVN
#undef PB
#undef AY
#undef RT
#undef RB
#undef QRAW
#undef KVRAW
#undef PP
#undef Q
#undef K
#undef ATT
#undef GY
#undef YG
#undef T1
#undef MIX
#undef SS1
#undef SS2
#undef UPB
#undef HB
#undef X2B
#undef CB
#undef KNC
#undef ROPE
#undef SST
constexpr int N_PHASES = 14;
extern "C" void kernel_launch(void* const* d_in, const int* in_sizes, int n_in, void* d_out, int out_size, void* d_ws, size_t ws_size, hipStream_t stream) {
    static int grid = 0;
    if (grid == 0) {
        if (n_in != 39 || (size_t)out_size != O_END || ws_size < WS_END) { fprintf(stderr, "kernel_launch: unexpected sizes n_in %d out %d ws %zu\n", n_in, out_size, ws_size); grid = -1; return; }
        int dev = 0, cus = 0, per_cu = 0;
        if (hipGetDevice(&dev) != hipSuccess || hipDeviceGetAttribute(&cus, hipDeviceAttributeMultiprocessorCount, dev) != hipSuccess) { grid = -1; return; }
        if (hipFuncSetAttribute((const void*)mk_fwd, hipFuncAttributeMaxDynamicSharedMemorySize, LDS_BYTES) != hipSuccess) { fprintf(stderr, "kernel_launch: hipFuncSetAttribute failed\n"); grid = -1; return; }
        if (hipOccupancyMaxActiveBlocksPerMultiprocessor(&per_cu, (const void*)mk_fwd, NWAVES * 64, LDS_BYTES) != hipSuccess || per_cu < 1)
            fprintf(stderr, "kernel_launch: occupancy query reports %d\n", per_cu);
        (void)hipGetLastError();
        grid = cus;
    }
    if (grid < 0) return;
    if (hipMemsetAsync((char*)d_ws + WS_CTL, 0, CTL_ZERO_BYTES, stream) != hipSuccess) return;
    Args a{};
    for (int i = 0; i < 39; ++i) a.in[i] = d_in[i];
    a.out = (float*)d_out; a.ws = (unsigned char*)d_ws;
#if MK_ONE_LAUNCH
    a.ph_lo = 0; a.ph_hi = N_PHASES;
    hipLaunchKernelGGL(mk_fwd, dim3(grid), dim3(NWAVES * 64), LDS_BYTES, stream, a);
#else
    for (int p = 0; p < N_PHASES; ++p) { a.ph_lo = p; a.ph_hi = p + 1;
        hipLaunchKernelGGL(mk_fwd, dim3(grid), dim3(NWAVES * 64), LDS_BYTES, stream, a); }
#endif
}
```

```cpp
#include <hip/hip_runtime.h>
#include <cstdio>
#include <cstdint>

#define REP_PA 1
#define REP_SA 1
#define SA_PROBE 0
#define P0A 1
#define P0B 1
#define P0C 1
#define P6A 1
#define P4A 1
#define P4B 1
#define P4C 1
#define P4D 1
#define SA_FIRST_ALL 0
#define SA_ALLREG 1
#define REP_G 0x0
#if REP_G
#define REPLOOP(k) _Pragma("unroll") for (int rep_ = 0; rep_ < 1 + (((REP_G) >> (k)) & 1); ++rep_)
#else
#define REPLOOP(k)
#endif
#ifndef MK_ONE_LAUNCH
#define MK_ONE_LAUNCH 1
#endif

constexpr int D = 1024, SEQ = 8192, NBATCH = 2, MP = NBATCH * SEQ, DECB = 128, DECT = 4, MS = DECB * DECT, M = MP + MS;
constexpr int NH = 8, QKN = 64, QKR = 32, QKH = 96, VH = 64, QL = 384, KVL = 256, ATTW = 512;
constexpr int SSMW = 512, GRP = 16, NG = 32, NST = 64;
constexpr int DFF = 2816, UPW = 2 * DFF, PLE = 256;
constexpr int NPAGES = 64, PAGE = 128, NPOOL = 10240;
constexpr float EPS = 1e-6f;
constexpr int NZ = 3328, ZC_CKV = 0, ZC_CQ = 256, ZC_KR = 640, ZC_U = 768, ZC_GA = 1280, ZC_GS = 2304;
constexpr size_t O_Y = 0, O_CKVP = (size_t)M * D, O_KRP = O_CKVP + (size_t)MP * KVL, O_CKVS = O_KRP + (size_t)MP * QKR, O_KRS = O_CKVS + (size_t)MS * KVL,
                 O_SREP = O_KRS + (size_t)MS * QKR, O_SIMP = O_SREP + NBATCH * NG * NST, O_SRES = O_SIMP + NBATCH * NG * NST, O_SIMS = O_SRES + (size_t)DECB * NG * NST,
                 O_CVP = O_SIMS + (size_t)DECB * NG * NST, O_CVS = O_CVP + (size_t)NBATCH * 2 * UPW, O_END = O_CVS + (size_t)DECB * 2 * UPW;
static_assert(O_END == 24164352, "output size");
constexpr int SL = 32, SCH = MP / SL  , SKU = SL * GRP  , SKA = SKU + 2 * NST  ;

constexpr size_t MiB = 1u << 20;
constexpr size_t WS_CTL = 0, CTL_ZERO_BYTES = 1 * MiB;
constexpr size_t WS_WIN = 2 * MiB;
constexpr size_t WS_WUQ = 10 * MiB;
constexpr size_t WS_WKV = 11 * MiB;
constexpr size_t WS_WGLU = 12 * MiB;
constexpr size_t WS_WOA = 13 * MiB, WS_WOS = 14 * MiB;
constexpr size_t WS_WOUT = 15 * MiB;
constexpr size_t WS_WPG = 17 * MiB;
constexpr size_t WS_WPP = 19 * MiB;
constexpr size_t WS_WUP = 20 * MiB;
constexpr size_t WS_WDN = 32 * MiB;
constexpr size_t WS_ROPE = 38 * MiB;
constexpr size_t WS_SSMT = 40 * MiB;
constexpr size_t WS_MBT = 44 * MiB;
constexpr size_t WS_TYT = 52 * MiB;
constexpr size_t WS_KJ = 72 * MiB;
constexpr size_t WS_XN = 80 * MiB;
constexpr size_t WS_Z = 116 * MiB;
constexpr size_t WS_CQN = 226 * MiB;
constexpr size_t WS_CKVN = 240 * MiB;
constexpr size_t WS_PB = 250 * MiB;
constexpr size_t WS_AY = 260 * MiB;
constexpr size_t WS_QRAW = 300 * MiB;
constexpr size_t WS_KVRAW = 330 * MiB;
constexpr size_t WS_PP = 370 * MiB;
constexpr size_t WS_Q = 410 * MiB;
constexpr size_t WS_K = 440 * MiB;
constexpr size_t WS_ATT = 470 * MiB;
constexpr size_t WS_GY = 490 * MiB;
constexpr size_t WS_YG = 510 * MiB;
constexpr size_t WS_T1 = 530 * MiB;
constexpr size_t WS_MIX = 570 * MiB;
constexpr size_t WS_X1 = 610 * MiB;
constexpr size_t WS_SS1 = 690 * MiB;
constexpr size_t WS_SS2 = 692 * MiB;
constexpr size_t WS_UP = 700 * MiB;
constexpr size_t WS_H = 890 * MiB;
constexpr size_t WS_X2 = 990 * MiB;
constexpr size_t WS_PO = 1080 * MiB;
constexpr size_t WS_PM = 1089 * MiB, WS_PL = 1090 * MiB;
constexpr size_t WS_W8 = 1095 * MiB;
constexpr size_t WS_ROPEB = 1096 * MiB;
constexpr size_t WS_UPF = 1097 * MiB, WS_UPL = 1099 * MiB;
constexpr size_t WS_QABS = 1092 * MiB;
constexpr size_t WS_SST = 1070 * MiB;
constexpr size_t WS_CB = 1100 * MiB;
constexpr size_t WS_KNC = 1650 * MiB;
constexpr size_t WS_END = 2700 * MiB;
constexpr float QSCALE = 0.10206207261596575f * 1.4426950408889634f;

constexpr int CW_BAR = 4096, CW_PAN = 16384, CW_PTMO = 8192;

#define GAS __attribute__((address_space(1)))
#define LAS __attribute__((address_space(3)))
typedef unsigned short bf16;
typedef unsigned v4u __attribute__((ext_vector_type(4)));
typedef unsigned v2u __attribute__((ext_vector_type(2)));
typedef float f32x4 __attribute__((ext_vector_type(4)));
typedef float f32x2 __attribute__((ext_vector_type(2)));
typedef short bf16x8 __attribute__((ext_vector_type(8)));
#define LDS_WAIT() asm volatile("s_waitcnt lgkmcnt(0)" ::: "memory")
#define VM_WAIT() asm volatile("s_waitcnt vmcnt(0)" ::: "memory")
__device__ __forceinline__ unsigned f2bf(float f) { unsigned u = __builtin_bit_cast(unsigned, f); return (u + 0x7fffu + ((u >> 16) & 1u)) >> 16; }
__device__ __forceinline__ unsigned pk2(float lo, float hi) { return f2bf(lo) | (f2bf(hi) << 16); }
__device__ __forceinline__ float bflo(unsigned w) { return __builtin_bit_cast(float, w << 16); }
__device__ __forceinline__ float bfhi(unsigned w) { return __builtin_bit_cast(float, w & 0xffff0000u); }
__device__ __forceinline__ float bf2f(bf16 h) { return __builtin_bit_cast(float, (unsigned)h << 16); }
__device__ __forceinline__ float sigmoidf_(float x) { return __builtin_amdgcn_rcpf(1.0f + __builtin_amdgcn_exp2f(-1.4426950408889634f * x)); }
__device__ __forceinline__ float gelu_tanh(float x) { const float u = 1.5957691216057308f * (x + 0.044715f * x * x * x); return x * sigmoidf_(u); }
#define DPPF(x, ctrl) __builtin_bit_cast(float, __builtin_amdgcn_update_dpp(0, __builtin_bit_cast(int, (x)), (ctrl), 0xF, 0xF, false))
__device__ __forceinline__ float sum4(float v) { v += DPPF(v, 0xB1); v += DPPF(v, 0x4E); return v; }
__device__ __forceinline__ float sum8(float v) { v = sum4(v); v += DPPF(v, 0x141); return v; }
__device__ __forceinline__ float sum16(float v) { v = sum8(v); v += DPPF(v, 0x140); return v; }
__device__ __forceinline__ float rows_sum(float v) {
    auto r1 = __builtin_amdgcn_permlane16_swap(__float_as_uint(v), __float_as_uint(v), false, false); v = __uint_as_float(r1[0]) + __uint_as_float(r1[1]);
    auto r2 = __builtin_amdgcn_permlane32_swap(__float_as_uint(v), __float_as_uint(v), false, false); return __uint_as_float(r2[0]) + __uint_as_float(r2[1]); }
__device__ __forceinline__ float wave_sum(float v) { return rows_sum(sum16(v)); }

namespace pg8 {
#define PG8_LAS __attribute__((address_space(3)))
typedef unsigned short bf16_t;
typedef short bf16x8 __attribute__((ext_vector_type(8)));
typedef float f32x4 __attribute__((ext_vector_type(4)));
typedef unsigned u32x4 __attribute__((ext_vector_type(4)));
constexpr int BM = 256, BK = 64, HALF = 128, HTB = HALF * BK * 2, STAGE_BYTES = 8 * HTB, NXCD = 8, WGM = 8;

__host__ __device__ __forceinline__ int lds_byte(int r, int c) { const int st = (r >> 4) * 2 + (c >> 5), rr = r & 15, cc = c & 31, ob = rr * 64 + cc * 2; return st * 1024 + (ob ^ (((ob >> 9) & 1) << 5)); }
__host__ __device__ __forceinline__ void stage_rc(int b, int& R, int& C) { const int st = b / 1024, sb = b % 1024, swz = sb ^ (((sb >> 9) & 1) << 5); R = (st >> 1) * 16 + swz / 64; C = (st & 1) * 32 + (swz % 64) / 2; }
__host__ __device__ __forceinline__ int perm32(int rho) { const int n = rho >> 4, i = rho & 15; return 8 * (i >> 2) + 4 * n + (i & 3); }

struct Unit { int pm, pn, z, q; };
struct Gemm { const bf16_t* A; const bf16_t* Bt; int lda, ldb, K; size_t zA, zB; };

struct Order {
    int nM, nN, n, first, G, pm0, nQ;
    __device__ __forceinline__ void init(int nM_, int nN_, int nZ_, int G_, int c, int base, int pm0_ = 0, int nQ_ = 1) {
        nM = nM_; nN = nN_; n = nM_ * nN_ * nZ_ * nQ_; G = G_; pm0 = pm0_; nQ = nQ_;
        const int i0 = (base > c) ? (base - c + G_ - 1) / G_ : 0;
        first = c + i0 * G_ - base;
    }
    __device__ __forceinline__ bool next(int i, Unit& u) const {
        const long L = (long)first + (long)i * G; if (L >= n) return false;
        int w = (int)L; u.q = -1; if (nQ > 1) { u.q = w % nQ; w /= nQ; }
        const int per = nM * nN; u.z = w / per; int wgid = w % per;
        { const int q = per / NXCD, r = per % NXCD, xcd = wgid % NXCD, off = wgid / NXCD; wgid = (xcd < r ? xcd * (q + 1) : r * (q + 1) + (xcd - r) * q) + off; }
        const int nig = WGM * nN, gid = wgid / nig, fm = gid * WGM, gsz = (nM - fm) < WGM ? (nM - fm) : WGM;
        u.pm = pm0 + fm + ((wgid % nig) % gsz); u.pn = (wgid % nig) / gsz; return true;
    }
};

struct OrderSeq {
    Order a, b; int na;
    __device__ __forceinline__ void init(const Order& a_, const Order& b_, int n1, int G_, int c) { a = a_; b = b_; na = (n1 > c) ? (n1 - c + G_ - 1) / G_ : 0; }
    __device__ __forceinline__ bool next(int i, Unit& u) const { return (i < na) ? a.next(i, u) : b.next(i - na, u); }
};
__device__ __forceinline__ unsigned cvt_pk_bf16(float lo, float hi) { unsigned r; asm volatile("v_cvt_pk_bf16_f32 %0, %1, %2" : "=v"(r) : "v"(lo), "v"(hi)); return r; }

template <class Epi, bool ALIGN_EPI = true, bool SP2 = true, bool QUARTER = false, class Sched = Order>
__device__ __forceinline__ void gemm_phase(PG8_LAS unsigned char* lds, const Gemm g, const Sched& S, const Epi& E) {
    int tid = threadIdx.x; asm volatile("" : "+v"(tid));
    const int wid = __builtin_amdgcn_readfirstlane(tid >> 6), lane = tid & 63, wr = wid >> 2, wc = wid & 3, fr = lane & 15, fq = lane >> 4;
    int K = g.K; asm volatile("" : "+s"(K));
    const int nt = K / BK;
    unsigned voffA[2], voffB[2];
#pragma unroll
    for (int i = 0; i < 2; ++i) { int R, C; stage_rc(tid * 16 + i * 8192, R, C); const int Rb = Epi::PERM ? ((R & ~31) + perm32(R & 31)) : R;
        voffA[i] = (unsigned)(R * g.lda + C) * 2u; voffB[i] = (unsigned)(Rb * g.ldb + C) * 2u; }
    const size_t kstep = (size_t)(BK * 2);
    const size_t hstepA = (size_t)HALF * g.lda * 2, hstepB = (size_t)HALF * g.ldb * 2;
    const size_t tstepA = 2 * hstepA, tstepB = 2 * hstepB;
    const unsigned ldsw = (unsigned)wid * 1024u;
    const int aoff = lds_byte(wr * 64 + fr, fq * 8), boff = lds_byte(wc * 32 + fr, fq * 8);
#define PG8_SA(b, h) (((b) * 2 + (h)) * HTB)
#define PG8_SB(b, h) ((4 + (b) * 2 + (h)) * HTB)
#define PG8_STAGE(bufoff, gbase, voff) do { _Pragma("unroll") for (int _i = 0; _i < 2; ++_i) \
        __builtin_amdgcn_global_load_lds((const unsigned*)((const char*)(gbase) + (voff)[_i]), (PG8_LAS unsigned*)(lds + (bufoff) + ldsw + _i * 8192), 16, 0, 0); } while (0)
#define PG8_LDA(dst, b, h) do { _Pragma("unroll") for (int m = 0; m < 4; ++m) if (!QUARTER || m == cur.q) _Pragma("unroll") for (int k = 0; k < 2; ++k) dst[m][k] = *(const PG8_LAS bf16x8*)(lds + PG8_SA(b, h) + aoff + m * 2048 + k * 1024); } while (0)
#define PG8_LDB(dst, b, h) do { _Pragma("unroll") for (int n = 0; n < 2; ++n) _Pragma("unroll") for (int k = 0; k < 2; ++k) dst[n][k] = *(const PG8_LAS bf16x8*)(lds + PG8_SB(b, h) + boff + n * 2048 + k * 1024); } while (0)
#define PG8_MMA(ai, bj, At, Bt) do { __builtin_amdgcn_s_setprio(1); _Pragma("unroll") for (int m = 0; m < 4; ++m) if (!QUARTER || m == cur.q) _Pragma("unroll") for (int n = 0; n < 2; ++n) _Pragma("unroll") for (int k = 0; k < 2; ++k) \
        acc[ai][bj][m][n] = __builtin_amdgcn_mfma_f32_16x16x32_bf16(Bt[n][k], At[m][k], acc[ai][bj][m][n], 0, 0, 0); __builtin_amdgcn_s_setprio(0); } while (0)
#define PG8_WAIT_V(n) asm volatile("s_waitcnt vmcnt(" #n ")" ::: "memory")
#define PG8_WAIT_L(n) asm volatile("s_waitcnt lgkmcnt(" #n ")" ::: "memory")
#define PG8_BAR __builtin_amdgcn_s_barrier()
#define PG8_SCHED __builtin_amdgcn_sched_barrier(0)
    Unit cur, nxt; int ui = 0;
    if (!S.next(0, cur)) return;
    f32x4 acc[2][2][4][2];
#pragma unroll
    for (int a = 0; a < 2; ++a)
#pragma unroll
        for (int b = 0; b < 2; ++b)
#pragma unroll
            for (int m = 0; m < 4; ++m)
#pragma unroll
                for (int n = 0; n < 2; ++n) acc[a][b][m][n] = (f32x4){0.f, 0.f, 0.f, 0.f};
    bf16x8 At[4][2], B0[2][2], B1[2][2];
    const char* cA = (const char*)(g.A + (size_t)cur.z * g.zA) + (size_t)cur.pm * tstepA; const char* cB = (const char*)(g.Bt + (size_t)cur.z * g.zB) + (size_t)cur.pn * tstepB;
    if constexpr (SP2) {
        PG8_STAGE(PG8_SB(0, 0), cB, voffB); PG8_STAGE(PG8_SB(0, 1), cB + hstepB, voffB); PG8_STAGE(PG8_SA(0, 0), cA, voffA); PG8_STAGE(PG8_SA(0, 1), cA + hstepA, voffA);
        if (wr == 1) PG8_BAR;
        PG8_WAIT_V(2); PG8_BAR;
        PG8_STAGE(PG8_SB(1, 0), cB + kstep, voffB); PG8_STAGE(PG8_SA(1, 0), cA + kstep, voffA); PG8_STAGE(PG8_SB(1, 1), cB + hstepB + kstep, voffB);
        PG8_WAIT_V(6); PG8_BAR;
    } else {
        PG8_STAGE(PG8_SB(0, 0), cB, voffB); PG8_STAGE(PG8_SA(0, 0), cA, voffA); PG8_STAGE(PG8_SB(0, 1), cB + hstepB, voffB); PG8_STAGE(PG8_SA(0, 1), cA + hstepA, voffA);
        if (wr == 1) PG8_BAR;
        PG8_WAIT_V(4); PG8_BAR;
        PG8_STAGE(PG8_SB(1, 0), cB + kstep, voffB); PG8_STAGE(PG8_SA(1, 0), cA + kstep, voffA); PG8_STAGE(PG8_SB(1, 1), cB + hstepB + kstep, voffB);
        PG8_WAIT_V(6); PG8_BAR;
    }
    for (;;) {
        const bool has_next = S.next(ui + 1, nxt);
        const char* nA = has_next ? (const char*)(g.A + (size_t)nxt.z * g.zA) + (size_t)nxt.pm * tstepA : cA; const char* nB = has_next ? (const char*)(g.Bt + (size_t)nxt.z * g.zB) + (size_t)nxt.pn * tstepB : cB;
        for (int t = 0; t < nt; t += 2) {
            const bool last = (t == nt - 2);
            const char* a1 = cA + (size_t)(t + 1) * kstep;
            const char* a2 = last ? nA : cA + (size_t)(t + 2) * kstep; const char* b2 = last ? nB : cB + (size_t)(t + 2) * kstep;
            const char* a3 = a2 + kstep; const char* b3 = b2 + kstep;
            if constexpr (SP2) {
            PG8_LDB(B0, 0, 0); PG8_LDB(B1, 0, 1); PG8_SCHED; PG8_LDA(At, 0, 0); PG8_STAGE(PG8_SA(1, 1), a1 + hstepA, voffA);
            PG8_WAIT_V(8); PG8_WAIT_L(0); PG8_BAR; PG8_MMA(0, 0, At, B0); PG8_MMA(0, 1, At, B1); PG8_BAR; PG8_SCHED;
            PG8_LDA(At, 0, 1); PG8_STAGE(PG8_SB(0, 0), b2, voffB); PG8_STAGE(PG8_SB(0, 1), b2 + hstepB, voffB); PG8_STAGE(PG8_SA(0, 0), a2, voffA);
            PG8_WAIT_V(8); PG8_WAIT_L(0); PG8_BAR; PG8_MMA(1, 0, At, B0); PG8_MMA(1, 1, At, B1); PG8_BAR; PG8_SCHED;
            PG8_LDB(B0, 1, 0); PG8_LDB(B1, 1, 1); PG8_SCHED; PG8_LDA(At, 1, 0); PG8_STAGE(PG8_SA(0, 1), a2 + hstepA, voffA);
            PG8_WAIT_V(8); PG8_WAIT_L(0); PG8_BAR; PG8_MMA(0, 0, At, B0); PG8_MMA(0, 1, At, B1); PG8_BAR; PG8_SCHED;
            PG8_LDA(At, 1, 1); PG8_STAGE(PG8_SB(1, 0), b3, voffB); PG8_STAGE(PG8_SB(1, 1), b3 + hstepB, voffB); PG8_STAGE(PG8_SA(1, 0), a3, voffA);
            PG8_WAIT_V(8); PG8_WAIT_L(0); PG8_BAR; PG8_MMA(1, 0, At, B0); PG8_MMA(1, 1, At, B1); PG8_BAR; PG8_SCHED;
            } else {
            PG8_LDB(B0, 0, 0); PG8_SCHED; PG8_LDA(At, 0, 0); PG8_STAGE(PG8_SA(1, 1), a1 + hstepA, voffA);
            PG8_WAIT_L(8); PG8_BAR; PG8_WAIT_L(0); PG8_MMA(0, 0, At, B0); PG8_BAR; PG8_SCHED;
            PG8_LDB(B1, 0, 1); PG8_STAGE(PG8_SB(0, 0), b2, voffB);
            PG8_BAR; PG8_WAIT_L(0); PG8_MMA(0, 1, At, B1); PG8_BAR;
            PG8_LDA(At, 0, 1); PG8_STAGE(PG8_SA(0, 0), a2, voffA);
            PG8_BAR; PG8_WAIT_L(0); PG8_MMA(1, 0, At, B0); PG8_BAR; PG8_SCHED;
            PG8_STAGE(PG8_SB(0, 1), b2 + hstepB, voffB);
            PG8_WAIT_V(6); PG8_BAR; PG8_MMA(1, 1, At, B1); PG8_BAR;
            PG8_LDB(B0, 1, 0); PG8_SCHED; PG8_LDA(At, 1, 0); PG8_STAGE(PG8_SA(0, 1), a2 + hstepA, voffA);
            PG8_WAIT_L(8); PG8_BAR; PG8_WAIT_L(0); PG8_MMA(0, 0, At, B0); PG8_BAR; PG8_SCHED;
            PG8_LDB(B1, 1, 1); PG8_STAGE(PG8_SB(1, 0), b3, voffB);
            PG8_BAR; PG8_WAIT_L(0); PG8_MMA(0, 1, At, B1); PG8_BAR;
            PG8_LDA(At, 1, 1); PG8_STAGE(PG8_SA(1, 0), a3, voffA);
            PG8_BAR; PG8_WAIT_L(0); PG8_MMA(1, 0, At, B0); PG8_BAR; PG8_SCHED;
            PG8_STAGE(PG8_SB(1, 1), b3 + hstepB, voffB);
            PG8_WAIT_V(6); PG8_BAR; PG8_MMA(1, 1, At, B1); PG8_BAR;
            }
        }
        if constexpr (ALIGN_EPI) { if (wr == 0) PG8_BAR; }
        E(acc, cur, wr, wc, fr, fq);
        if (!has_next) break;
#pragma unroll
        for (int a = 0; a < 2; ++a)
#pragma unroll
            for (int b = 0; b < 2; ++b)
#pragma unroll
                for (int m = 0; m < 4; ++m)
#pragma unroll
                    for (int n = 0; n < 2; ++n) acc[a][b][m][n] = (f32x4){0.f, 0.f, 0.f, 0.f};
        cur = nxt; cA = nA; cB = nB; ++ui;
        if constexpr (ALIGN_EPI) { if (wr == 1) PG8_BAR; }
    }
    PG8_WAIT_V(0);
    if constexpr (!ALIGN_EPI) { if (wr == 0) PG8_BAR; }
    PG8_BAR;
#undef PG8_SA
#undef PG8_SB
#undef PG8_STAGE
#undef PG8_LDA
#undef PG8_LDB
#undef PG8_MMA
#undef PG8_WAIT_V
#undef PG8_WAIT_L
#undef PG8_BAR
#undef PG8_SCHED
}

template <class F> struct EpiRow8 {
    static constexpr bool PERM = true;
    F f;
    __device__ __forceinline__ void operator()(const f32x4 (&acc)[2][2][4][2], const Unit& u, int wr, int wc, int fr, int fq) const {
        const int row0 = u.pm * BM + wr * 64 + fr, col0 = u.pn * BM + wc * 32 + 8 * fq;
#pragma unroll
        for (int ai = 0; ai < 2; ++ai)
#pragma unroll
            for (int m = 0; m < 4; ++m) { if (u.q >= 0 && m != u.q) continue;
#pragma unroll
                for (int bj = 0; bj < 2; ++bj) f(u, row0 + ai * HALF + m * 16, col0 + bj * HALF, acc[ai][bj][m][0], acc[ai][bj][m][1]); }
    }
};
template <class F> struct EpiPair8 {
    static constexpr bool PERM = true;
    F f;
    __device__ __forceinline__ void operator()(const f32x4 (&acc)[2][2][4][2], const Unit& u, int wr, int wc, int fr, int fq) const {
        const int row0 = u.pm * BM + wr * 64 + fr, cp = u.pn * HALF + wc * 32 + 8 * fq;
#pragma unroll
        for (int ai = 0; ai < 2; ++ai)
#pragma unroll
            for (int m = 0; m < 4; ++m) { if (u.q >= 0 && m != u.q) continue; f(u, row0 + ai * HALF + m * 16, cp, acc[ai][0][m][0], acc[ai][0][m][1], acc[ai][1][m][0], acc[ai][1][m][1]); }
    }
};
}
using pg8::cvt_pk_bf16;
__device__ __forceinline__ v4u pack8(f32x4 a, f32x4 b) { v4u w; w.x = cvt_pk_bf16(a[0], a[1]); w.y = cvt_pk_bf16(a[2], a[3]); w.z = cvt_pk_bf16(b[0], b[1]); w.w = cvt_pk_bf16(b[2], b[3]); return w; }

__device__ __forceinline__ void unpack8(v4u w, float (&f)[8]) { f[0] = bflo(w.x); f[1] = bfhi(w.x); f[2] = bflo(w.y); f[3] = bfhi(w.y); f[4] = bflo(w.z); f[5] = bfhi(w.z); f[6] = bflo(w.w); f[7] = bfhi(w.w); }
__device__ __forceinline__ int pg8_opq(int x) { asm volatile("" : "+v"(x)); return x; }
template <bool BASE_BF16> struct EpiResid {
    static constexpr bool PERM = true;
    const float* xp; const float* xs;
    const bf16* xb;
    bf16* XO; float* SS;
    __device__ __forceinline__ void operator()(const pg8::f32x4 (&acc)[2][2][4][2], const pg8::Unit& u, int wr, int wc, int fr_, int fq_) const {
        const int fr = pg8_opq(fr_), fq = pg8_opq(fq_);
        const int row0 = u.pm * 256 + wr * 64 + fr, col0 = u.pn * 256 + wc * 32 + 8 * fq;
#pragma unroll
        for (int ai = 0; ai < 2; ++ai)
#pragma unroll
            for (int m = 0; m < 4; ++m) { if (u.q >= 0 && m != u.q) continue;
                const int row = row0 + ai * 128 + m * 16;
                float ss = 0.f;
#pragma unroll
                for (int bj = 0; bj < 2; ++bj) {
                    const int col = col0 + bj * 128; f32x4 x0, x1;
                    if (BASE_BF16) { float f[8]; unpack8(*(const GAS v4u*)(xb + (size_t)row * D + col), f); x0 = (f32x4){f[0], f[1], f[2], f[3]}; x1 = (f32x4){f[4], f[5], f[6], f[7]}; }
                    else { const float* br = (row < MP) ? xp + (size_t)row * D : xs + (size_t)(row - MP) * D; x0 = *(const GAS f32x4*)(br + col); x1 = *(const GAS f32x4*)(br + col + 4); }
                    x0 += acc[ai][bj][m][0]; x1 += acc[ai][bj][m][1];
                    ss += (x0[0] * x0[0] + x0[1] * x0[1]) + (x0[2] * x0[2] + x0[3] * x0[3]) + (x1[0] * x1[0] + x1[1] * x1[1]) + (x1[2] * x1[2] + x1[3] * x1[3]);
                    *(GAS v4u*)(XO + (size_t)row * D + col) = pack8(x0, x1);
                }
                ss = rows_sum(ss);
                if (fq == 0) SS[(size_t)row * 16 + u.pn * 4 + wc] = ss;
            }
    }
};
__device__ __forceinline__ float row_rs(const float* SS, int row) {
    const f32x4 a = *(const GAS f32x4*)(SS + (size_t)row * 16), b = *(const GAS f32x4*)(SS + (size_t)row * 16 + 4), c = *(const GAS f32x4*)(SS + (size_t)row * 16 + 8), d = *(const GAS f32x4*)(SS + (size_t)row * 16 + 12);
    const float s = ((a[0] + a[1]) + (a[2] + a[3])) + ((b[0] + b[1]) + (b[2] + b[3])) + ((c[0] + c[1]) + (c[2] + c[3])) + ((d[0] + d[1]) + (d[2] + d[3]));
    return 1.0f / sqrtf(s * (1.f / D) + EPS);
}
struct EpiUp {
    static constexpr bool PERM = true;
    const float* SS; bf16* UPB;
    __device__ __forceinline__ void operator()(const pg8::f32x4 (&acc)[2][2][4][2], const pg8::Unit& u, int wr, int wc, int fr, int fq) const {
        const int row0 = u.pm * 256 + wr * 64 + fr, col0 = u.pn * 256 + wc * 32 + 8 * fq;
#pragma unroll
        for (int ai = 0; ai < 2; ++ai)
#pragma unroll
            for (int m = 0; m < 4; ++m) { if (u.q >= 0 && m != u.q) continue; const int row = row0 + ai * 128 + m * 16; const float rs = row_rs(SS, row);
#pragma unroll
                for (int bj = 0; bj < 2; ++bj) *(GAS v4u*)(UPB + (size_t)row * UPW + col0 + bj * 128) = pack8(acc[ai][bj][m][0] * rs, acc[ai][bj][m][1] * rs); }
    }
};

__device__ __forceinline__ float dpp_ror1(float x) { return __builtin_bit_cast(float, __builtin_amdgcn_update_dpp(0, __builtin_bit_cast(int, x), 0x121, 0xF, 0xF, false)); }
__device__ __forceinline__ float dpp_ror2(float x) { return __builtin_bit_cast(float, __builtin_amdgcn_update_dpp(0, __builtin_bit_cast(int, x), 0x122, 0xF, 0xF, false)); }
struct EpiUpConv {
    static constexpr bool PERM = true;
    const float* SS; bf16* HB; bf16* UPF; bf16* UPL; float* out; const float* conv_w; const float* conv_b; const float* state_conv; LAS unsigned char* scr; unsigned* cnt;
    template <bool SAMPLE> __device__ __forceinline__ void body(const pg8::f32x4 (&acc)[2][2][4][2], const pg8::Unit& u, int wr, int fr, int cl0_, int acol0, LAS float* CW, LAS float* BD, LAS float* RSL) const {
#pragma unroll
        for (int ai = 0; ai < 2; ++ai)
#pragma unroll
            for (int m = 0; m < 4; ++m) {
                const int fro = pg8_opq(fr), cl0 = pg8_opq(cl0_);
                const int rl = ai * 128 + wr * 64 + m * 16 + fro, row = u.pm * 256 + rl; const float rs = RSL[rl];
                v4u hw;
#pragma unroll
                for (int n = 0; n < 2; ++n) {
                    f32x4 cv2[2];
#pragma unroll
                    for (int bj = 0; bj < 2; ++bj) {
                        const int cl = bj * 128 + cl0 + 4 * n, gcol = bj * DFF + acol0 + cl0 + 4 * n; const f32x4 x = acc[ai][bj][m][n] * rs;
                        f32x4 s1, s2;
#pragma unroll
                        for (int i = 0; i < 4; ++i) { s1[i] = dpp_ror1(x[i]); s2[i] = dpp_ror2(x[i]); }
                        if (SAMPLE) { const int t = fro & 3; const float* sp = state_conv + (size_t)((row - MP) >> 2) * 2 * UPW + gcol;
                            const f32x4 S0 = *(const GAS f32x4*)sp, S1 = *(const GAS f32x4*)(sp + UPW);
#pragma unroll
                            for (int i = 0; i < 4; ++i) { s1[i] = (t >= 1) ? s1[i] : S1[i]; s2[i] = (t >= 2) ? s2[i] : (t == 1 ? S1[i] : S0[i]); }
                            if (t >= 2) *(GAS f32x4*)(out + O_CVS + ((size_t)((row - MP) >> 2) * 2 + (t - 2)) * UPW + gcol) = x;
                        } else if (m > 0) { const f32x4 xp = acc[ai][bj][m > 0 ? m - 1 : 0][n] * RSL[rl - 16];
#pragma unroll
                            for (int i = 0; i < 4; ++i) { s1[i] = dpp_ror1(fro == 15 ? xp[i] : x[i]); s2[i] = dpp_ror2(fro >= 14 ? xp[i] : x[i]); }
                        } else { const int pb = (wr == 1) ? ai * 2 : 1;
                            const int pr0 = (pb >> 1) * 128 + (pb & 1) * 64 + 62;
                            const f32x4 b2 = *(const LAS f32x4*)(BD + (pb * 2 + 0) * 256 + cl) * RSL[pr0], b1 = *(const LAS f32x4*)(BD + (pb * 2 + 1) * 256 + cl) * RSL[pr0 + 1];
#pragma unroll
                            for (int i = 0; i < 4; ++i) { s1[i] = (fro >= 1) ? s1[i] : b1[i]; s2[i] = (fro >= 2) ? s2[i] : (fro == 1 ? b1[i] : b2[i]); }
                        }
                        const f32x4 w0 = *(const LAS f32x4*)(CW + cl), w1 = *(const LAS f32x4*)(CW + 256 + cl), w2 = *(const LAS f32x4*)(CW + 512 + cl), cb = *(const LAS f32x4*)(CW + 768 + cl);
                        cv2[bj] = cb + s2 * w0 + s1 * w1 + x * w2;
                        if (!SAMPLE && ai == 0 && m == 0) { if (rl < 2) { v2u w; w.x = cvt_pk_bf16(x[0], x[1]); w.y = cvt_pk_bf16(x[2], x[3]); *(GAS v2u*)(UPF + ((size_t)u.pm * 2 + rl) * UPW + gcol) = w; } }
                        if (!SAMPLE && ai == 1 && m == 3) { if (rl >= 254) { v2u w; w.x = cvt_pk_bf16(x[0], x[1]); w.y = cvt_pk_bf16(x[2], x[3]); *(GAS v2u*)(UPL + ((size_t)u.pm * 2 + (rl - 254)) * UPW + gcol) = w;
                                if ((u.pm & 31) == 31) *(GAS f32x4*)(out + O_CVP + ((size_t)(u.pm >> 5) * 2 + (rl - 254)) * UPW + gcol) = x; } }
                    }
                    { const unsigned h0 = cvt_pk_bf16(gelu_tanh(cv2[0][0]) * cv2[1][0], gelu_tanh(cv2[0][1]) * cv2[1][1]), h1 = cvt_pk_bf16(gelu_tanh(cv2[0][2]) * cv2[1][2], gelu_tanh(cv2[0][3]) * cv2[1][3]);
                      if (n == 0) { hw.x = h0; hw.y = h1; }
                      else { hw.z = h0; hw.w = h1;
                        if (SAMPLE) asm volatile("global_store_dwordx4 %0, %1, off sc1\n\ts_nop 1" :: "v"(HB + (size_t)row * DFF + acol0 + cl0), "v"(hw) : "memory");
                        else if (rl >= 2) *(GAS v4u*)(HB + (size_t)row * DFF + acol0 + cl0) = hw; } }
                    asm volatile("" ::: "memory"); __builtin_amdgcn_sched_barrier(0);
                }
            }
    }
    __device__ __forceinline__ void operator()(const pg8::f32x4 (&acc)[2][2][4][2], const pg8::Unit& u, int wr, int wc, int fr_, int fq_) const {
        const int tid = pg8_opq(threadIdx.x), fr = pg8_opq(fr_), fq = pg8_opq(fq_);
        LAS float* CW = (LAS float*)scr;
        LAS float* BD = CW + 1024;
        const int acol0 = u.pn * 128, cl0_ = wc * 32 + 8 * fq;
        for (int e = tid; e < 1024; e += 512) { const int k = e >> 8, cl = e & 255, gcol = (cl >> 7) * DFF + acol0 + (cl & 127); CW[e] = (k < 3) ? conv_w[k * UPW + gcol] : conv_b[gcol]; }
        LAS float* RSL = BD + 2048;
        if (tid < 256) RSL[tid] = row_rs(SS, u.pm * 256 + tid);
        if (fr >= 14) {
#pragma unroll
            for (int ai = 0; ai < 2; ++ai)
#pragma unroll
                for (int bj = 0; bj < 2; ++bj)
#pragma unroll
                    for (int n = 0; n < 2; ++n) *(LAS f32x4*)(BD + ((ai * 2 + wr) * 2 + (fr - 14)) * 256 + bj * 128 + cl0_ + 4 * n) = acc[ai][bj][3][n];
        }
        asm volatile("s_waitcnt vmcnt(0) lgkmcnt(0)" ::: "memory"); __builtin_amdgcn_s_barrier(); asm volatile("" ::: "memory");
        if (u.pm >= MP / 256) { body<true>(acc, u, wr, fr, cl0_, acol0, CW, BD, RSL);
            asm volatile("s_waitcnt vmcnt(0)" ::: "memory"); if ((tid & 63) == 0) __hip_atomic_fetch_add(cnt + 64 * u.pm, 1u, __ATOMIC_RELAXED, __HIP_MEMORY_SCOPE_AGENT); }
        else body<false>(acc, u, wr, fr, cl0_, acol0, CW, BD, RSL);
        asm volatile("s_waitcnt lgkmcnt(0)" ::: "memory"); __builtin_amdgcn_s_barrier(); asm volatile("" ::: "memory");
    }
};
struct EpiPle {
    static constexpr bool PERM = true;
    const float* SS; const bf16* X2B; const bf16* PPB; float* Y;
    __device__ __forceinline__ void operator()(const pg8::f32x4 (&acc)[2][2][4][2], const pg8::Unit& u, int wr, int wc, int fr, int fq) const {
        const int row0 = u.pm * 256 + wr * 64 + fr, col0 = u.pn * 256 + wc * 32 + 8 * fq;
#pragma unroll
        for (int ai = 0; ai < 2; ++ai)
#pragma unroll
            for (int m = 0; m < 4; ++m) { if (u.q >= 0 && m != u.q) continue; const int row = row0 + ai * 128 + m * 16; const float rs = row_rs(SS, row);
#pragma unroll
                for (int bj = 0; bj < 2; ++bj) { const int col = col0 + bj * 128; const size_t o = (size_t)row * D + col;
                    float pw[8], xw[8]; unpack8(*(const GAS v4u*)(PPB + o), pw); unpack8(*(const GAS v4u*)(X2B + o), xw);
                    const f32x4 a = acc[ai][bj][m][0] * rs, b = acc[ai][bj][m][1] * rs; f32x4 y0, y1;
#pragma unroll
                    for (int i = 0; i < 4; ++i) { y0[i] = xw[i] + sigmoidf_(a[i]) * pw[i]; y1[i] = xw[4 + i] + sigmoidf_(b[i]) * pw[4 + i]; }
                    *(GAS f32x4*)(Y + o) = y0; *(GAS f32x4*)(Y + o + 4) = y1; } }
    }
};


struct EpiInproj {
    static constexpr bool PERM = true;
    bf16* Zp; bf16* CQNp; bf16* CKVNp; bf16* AYp; float* out; const float* g_ckv; LAS unsigned char* scr;
    __device__ __forceinline__ void operator()(const pg8::f32x4 (&acc)[2][2][4][2], const pg8::Unit& u, int wr, int wc, int fr, int fq) const {
        const int row0 = u.pm * 256 + wr * 64 + fr, colw = wc * 32 + 8 * fq;
        if (u.pn == 0) {
            LAS float* part = (LAS float*)scr;
#pragma unroll
            for (int ai = 0; ai < 2; ++ai)
#pragma unroll
                for (int m = 0; m < 4; ++m) { float ss = 0.f;
#pragma unroll
                    for (int bj = 0; bj < 2; ++bj)
#pragma unroll
                        for (int n = 0; n < 2; ++n) { const f32x4 v = acc[ai][bj][m][n]; ss += (v[0] * v[0] + v[1] * v[1]) + (v[2] * v[2] + v[3] * v[3]); }
                    ss = rows_sum(ss);
                    if (fq == 0) part[(ai * 128 + wr * 64 + m * 16 + fr) * 4 + wc] = ss; }
            asm volatile("s_waitcnt lgkmcnt(0)" ::: "memory"); __builtin_amdgcn_s_barrier(); asm volatile("" ::: "memory");
#pragma unroll
            for (int ai = 0; ai < 2; ++ai)
#pragma unroll
                for (int m = 0; m < 4; ++m) { const int rl = ai * 128 + wr * 64 + m * 16 + fr, row = u.pm * 256 + rl; const f32x4 p = *(const LAS f32x4*)(part + rl * 4);
                    const float rs = 1.0f / sqrtf(((p[0] + p[1]) + (p[2] + p[3])) * (1.f / KVL) + EPS);
                    float* dst = (row < MP) ? out + O_CKVP + (size_t)row * KVL : out + O_CKVS + (size_t)(row - MP) * KVL;
#pragma unroll
                    for (int bj = 0; bj < 2; ++bj) { const int col = colw + bj * 128; const f32x4 g0 = *(const GAS f32x4*)(g_ckv + col), g1 = *(const GAS f32x4*)(g_ckv + col + 4);
                        const f32x4 o0 = acc[ai][bj][m][0] * rs * g0, o1 = acc[ai][bj][m][1] * rs * g1;
                        *(GAS f32x4*)(dst + col) = o0; *(GAS f32x4*)(dst + col + 4) = o1; *(GAS v4u*)(CKVNp + (size_t)row * KVL + col) = pack8(o0, o1); } }
            asm volatile("s_waitcnt lgkmcnt(0)" ::: "memory"); __builtin_amdgcn_s_barrier(); asm volatile("" ::: "memory");
            return;
        }
#pragma unroll
        for (int ai = 0; ai < 2; ++ai)
#pragma unroll
            for (int m = 0; m < 4; ++m) { const int row = row0 + ai * 128 + m * 16;
#pragma unroll
                for (int bj = 0; bj < 2; ++bj) { const int col = u.pn * 256 + colw + bj * 128; f32x4 a = acc[ai][bj][m][0], b = acc[ai][bj][m][1];
                    if (u.pn <= 2) {
                        if (col < ZC_KR) *(GAS v4u*)(CQNp + (size_t)row * QL + (col - ZC_CQ)) = pack8(a, b);
                        else if (col < ZC_KR + QKR) { float* dst = ((row < MP) ? out + O_KRP + (size_t)row * QKR : out + O_KRS + (size_t)(row - MP) * QKR) + (col - ZC_KR); *(GAS f32x4*)dst = a; *(GAS f32x4*)(dst + 4) = b; }
                    } else if (u.pn <= 4) {
                        const v4u w = pack8(a, b); const int c = col - ZC_U;
                        if (row < MP) *(GAS v4u*)(AYp + ((size_t)(c >> 4) * SCH + (row >> 5)) * SKA + (row & 31) * GRP + (c & 15)) = w;
                        else *(GAS v4u*)(Zp + (size_t)row * NZ + col) = w;
                    } else {
#pragma unroll
                        for (int i = 0; i < 4; ++i) { a[i] = sigmoidf_(a[i]); b[i] = sigmoidf_(b[i]); }
                        *(GAS v4u*)(Zp + (size_t)row * NZ + col) = pack8(a, b);
                    } } }
    }
};

#define XB_TMO      128
#define XB_XCNT(j)  (256  + 64 * (j))
#define XB_XSUB(j)  (1280 + 64 * (j))
#define XB_XGEN(j)  (2304 + 64 * (j))
#define XB_TOP      3328
#define XB_TOPGEN   3392
#define XCD_BAR_WORDS 3456
#define XB_SPIN_CAP (1u << 18)
__device__ __forceinline__ unsigned xb_ld(unsigned* p)              { return __hip_atomic_load(p, __ATOMIC_RELAXED, __HIP_MEMORY_SCOPE_AGENT); }
__device__ __forceinline__ unsigned xb_add(unsigned* p, unsigned v) { return __hip_atomic_fetch_add(p, v, __ATOMIC_RELAXED, __HIP_MEMORY_SCOPE_AGENT); }
__device__ __forceinline__ unsigned xb_xcc_id() { return (unsigned)__builtin_amdgcn_s_getreg((3 << 11) | 20) & 0xFu; }
#define XB_SPIN(cond, bar) do { unsigned _sp = 0; while (cond) { __builtin_amdgcn_s_sleep(1); \
    if ((++_sp & 255u) == 0u) { if (xb_ld(&(bar)[XB_TMO])) break; if (_sp > XB_SPIN_CAP) { atomicAdd(&(bar)[XB_TMO], 1u); break; } } } } while (0)
struct XcdBarrier { unsigned* bar; unsigned x; volatile LAS unsigned* st; };
__device__ __forceinline__ XcdBarrier xcd_barrier_post(unsigned* bar, volatile LAS unsigned* st) {
    XcdBarrier b; b.bar = bar; b.x = xb_xcc_id(); b.st = st;
    if (threadIdx.x == 0) (void)xb_add(&bar[XB_XCNT(b.x)], 1u);
    return b;
}
__device__ __forceinline__ void xcd_barrier_complete(unsigned* bar, unsigned x, unsigned& nloc, unsigned& nx) {
    const unsigned G = gridDim.x * gridDim.y * gridDim.z;
    unsigned sum, cnt, mine, sp = 0u;
    for (;;) {
        sum = 0u; cnt = 0u; mine = 0u;
#pragma unroll
        for (unsigned j = 0; j < 16; ++j) { const unsigned c = xb_ld(&bar[XB_XCNT(j)]); sum += c; cnt += (c > 0u) ? 1u : 0u; mine = (j == x) ? c : mine; }
        if (sum == G) break;
        __builtin_amdgcn_s_sleep(1);
        if ((++sp & 255u) == 0u) { if (xb_ld(&bar[XB_TMO])) break; if (sp > XB_SPIN_CAP) { atomicAdd(&bar[XB_TMO], 1u); break; } }
    }
    nloc = mine > 0u ? mine : 1u; nx = cnt > 0u ? cnt : 1u;
}
__device__ __forceinline__ void xcd_barrier(const XcdBarrier& b) {
    asm volatile("s_waitcnt vmcnt(0)" ::: "memory");
    __syncthreads();
    if (threadIdx.x == 0) {
        unsigned* bar = b.bar;
        __builtin_amdgcn_s_waitcnt(0);
        unsigned nloc = b.st[0], nx = b.st[1];
        if (nloc == 0u) { xcd_barrier_complete(bar, b.x, nloc, nx); b.st[0] = nloc; b.st[1] = nx; }
        const unsigned old = xb_add(&bar[XB_XSUB(b.x)], 1u);
        const unsigned gen = old / nloc;
        if (old + 1u == (gen + 1u) * nloc) {
            __builtin_amdgcn_fence(__ATOMIC_RELEASE, "agent");
            asm volatile("s_waitcnt vmcnt(0)" ::: "memory");
            const unsigned og = xb_add(&bar[XB_TOP], 1u);
            const unsigned tg = og / nx;
            if (og + 1u == (tg + 1u) * nx) xb_add(&bar[XB_TOPGEN], 1u);
            else XB_SPIN(xb_ld(&bar[XB_TOPGEN]) == tg, bar);
            __builtin_amdgcn_fence(__ATOMIC_ACQUIRE, "agent");
            xb_add(&bar[XB_XGEN(b.x)], 1u);
            asm volatile("s_waitcnt vmcnt(0)" ::: "memory");
        } else {
            XB_SPIN(xb_ld(&bar[XB_XGEN(b.x)]) == gen, bar);
            __builtin_amdgcn_fence(__ATOMIC_ACQUIRE, "agent");
            asm volatile("s_waitcnt vmcnt(0)" ::: "memory");
        }
    }
    __syncthreads();
}

constexpr int NWAVES = 8;
constexpr int RING_OFF = 0, RING_BYTES = 159744;
constexpr int LDSCTL_OFF = RING_BYTES, MISC_OFF = LDSCTL_OFF + 320;
constexpr int LDS_BYTES = 163840;

struct Args { const void* in[39]; float* out; unsigned char* ws; int ph_lo, ph_hi; };
static_assert(sizeof(Args) == 39 * 8 + 8 + 8 + 8, "Args has no padding");

__device__ __forceinline__ void tr_item(const float* W, int ldw, int k0, int n0s, bf16* WT, int ldt, int n0d, LAS float* scr, int lane, const float* kg = nullptr) {
    if (W) {
        f32x4 v[8];
#pragma unroll
        for (int i = 0; i < 8; ++i) v[i] = *(const GAS f32x4*)(W + (size_t)(k0 + (lane >> 3) + 8 * i) * ldw + n0s + (lane & 7) * 4);
#pragma unroll
        for (int i = 0; i < 8; ++i) { LAS float* d = scr + ((lane >> 3) + 8 * i) * 33 + (lane & 7) * 4; const float gk = kg ? kg[k0 + (lane >> 3) + 8 * i] : 1.0f; d[0] = v[i].x * gk; d[1] = v[i].y * gk; d[2] = v[i].z * gk; d[3] = v[i].w * gk; }
    } else {
#pragma unroll 8
        for (int i = 0; i < 32; ++i) { const int kk = 2 * i + (lane >> 5); scr[kk * 33 + (lane & 31)] = 0.f; }
    }
    LDS_WAIT(); asm volatile("" ::: "memory");
    const int c = lane & 7;
#pragma unroll
    for (int j = 0; j < 4; ++j) { const int n = (lane >> 3) + 8 * j; const LAS float* s = scr + (8 * c) * 33 + n;
        v4u o; o.x = pk2(s[0 * 33], s[1 * 33]); o.y = pk2(s[2 * 33], s[3 * 33]); o.z = pk2(s[4 * 33], s[5 * 33]); o.w = pk2(s[6 * 33], s[7 * 33]);
        *(GAS v4u*)(WT + (size_t)(n0d + n) * ldt + k0 + 8 * c) = o; }
    LDS_WAIT(); asm volatile("" ::: "memory");
}
__device__ __forceinline__ void tr_plain(const float* W, int K, int N, bf16* WT, int it, LAS float* scr, int lane, const float* kg = nullptr) {
    const int nblk = N / 32, kb = it / nblk, nb = it % nblk;
    tr_item(W, N, 64 * kb, 32 * nb, WT, K, 32 * nb, scr, lane, kg);
}

__device__ __forceinline__ void glds16(const void* gsrc, unsigned lds_dst) { unsigned keep;
    asm volatile("s_mov_b32 %0, m0\n\ts_mov_b32 m0, %2\n\ts_nop 0\n\tglobal_load_lds_dwordx4 %1, off\n\ts_mov_b32 m0, %0" : "=&s"(keep) : "v"(gsrc), "s"(lds_dst) : "memory"); }
__device__ __forceinline__ int opq(int x) { asm volatile("" : "+v"(x)); return x; }
namespace pa {
typedef float f32x16 __attribute__((ext_vector_type(16)));
typedef short s16x4 __attribute__((ext_vector_type(4)));
constexpr int KSLOT = 12288, VSLOT = 8192, SLOT = KSLOT + VSLOT;
__device__ __forceinline__ int crow(int r, int hi) { return (r & 3) + 8 * (r >> 2) + 4 * hi; }
__device__ __forceinline__ s16x4 vtr(const LAS unsigned char* p) { return __builtin_bit_cast(s16x4, __builtin_amdgcn_ds_read_tr16_b64_v4i16((LAS s16x4*)p)); }
__device__ __forceinline__ float swap_max(float v) { auto rr = __builtin_amdgcn_permlane32_swap(__float_as_uint(v), __float_as_uint(v), false, false); return fmaxf(__uint_as_float(rr[0]), __uint_as_float(rr[1])); }
__device__ __forceinline__ float swap_sum(float v) { auto rr = __builtin_amdgcn_permlane32_swap(__float_as_uint(v), __float_as_uint(v), false, false); return __uint_as_float(rr[0]) + __uint_as_float(rr[1]); }

__device__ __forceinline__ void issue_tile(const bf16* Kg, const bf16* Vg, LAS unsigned char* slot, int kv0, int wave, int lane) {
    const unsigned s0 = (unsigned)(uintptr_t)slot;
    { const bf16* src = Kg + (size_t)(kv0 + lane) * 768 + wave * 8;
      glds16(src, (unsigned)__builtin_amdgcn_readfirstlane(s0 + wave * 1024));
      if (wave < 4) glds16(src + 64, (unsigned)__builtin_amdgcn_readfirstlane(s0 + (8 + wave) * 1024)); }
    { const bf16* src = Vg + (size_t)(kv0 + 16 * (wave & 3) + (lane >> 2)) * 1024 + (wave >> 2) * 32 + (lane & 3) * 8;
      glds16(src, (unsigned)__builtin_amdgcn_readfirstlane(s0 + KSLOT + wave * 1024)); }
}

__device__ __forceinline__ void attn_unit(const bf16* Q, const bf16* K, const bf16* V, bf16* O, int b, int h, int qb, float sref, LAS unsigned char* lds, int wave, int lane_) {
    const int lane = opq(lane_), r32 = lane & 31, hi = lane >> 5;
    const size_t rowbase = (size_t)b * SEQ; const int q0 = qb * 256, qw = q0 + wave * 32;
    const bf16* Kg = K + rowbase * 768 + h * QKH; const bf16* Vg = V + rowbase * 1024 + h * VH;
    const int NT = (q0 + 256) / 64;
    bf16x8 qf[6];
    { const bf16* qp = Q + (rowbase + qw + r32) * 768 + h * QKH + hi * 8;
#pragma unroll
      for (int s = 0; s < 6; ++s) qf[s] = *(const GAS bf16x8*)(qp + 16 * s); }
    asm volatile("s_waitcnt vmcnt(0)" ::: "memory");
#pragma unroll
    for (int s = 0; s < 6; ++s) asm volatile("" : "+v"(qf[s]));
    issue_tile(Kg, Vg, lds, 0, wave, lane); issue_tile(Kg, Vg, lds + SLOT, 64, wave, lane);
    f32x16 o0 = {}, o1 = {};
    float l = 0.f;
    const int qrow = qw + r32;
    const int vaddr = ((lane >> 4) & 1) * 32 + (lane & 3) * 8 + (4 * hi + ((lane & 15) >> 2)) * 64;
    const int tmax = (qw + 31) >> 6;
#define PA_S(P0, P1, t_, slot_) do { const LAS unsigned char* ks = lds + (slot_) * SLOT; const int kv0 = (t_) * 64; \
        _Pragma("unroll") for (int r = 0; r < 16; ++r) { P0[r] = -sref; P1[r] = -sref; } \
        _Pragma("unroll") for (int s_ = 0; s_ < 6; ++s_) { \
            const bf16x8 a0 = *(const LAS bf16x8*)(ks + (2 * s_ + hi) * 1024 + r32 * 16), a1 = *(const LAS bf16x8*)(ks + (2 * s_ + hi) * 1024 + 512 + r32 * 16); \
            P0 = __builtin_amdgcn_mfma_f32_32x32x16_bf16(a0, qf[s_], P0, 0, 0, 0); P1 = __builtin_amdgcn_mfma_f32_32x32x16_bf16(a1, qf[s_], P1, 0, 0, 0); } \
        if (kv0 + 63 > qw) { _Pragma("unroll") for (int r = 0; r < 16; ++r) { const int kv = kv0 + crow(r, hi); if (kv > qrow) P0[r] = -1e30f; if (kv + 32 > qrow) P1[r] = -1e30f; } } } while (0)
#define PA_PV(P0, P1, slot_) do { const LAS unsigned char* vs = lds + (slot_) * SLOT + KSLOT; float rs = 0.f; \
        _Pragma("unroll") for (int r = 0; r < 16; ++r) { P0[r] = __builtin_amdgcn_exp2f(P0[r]); P1[r] = __builtin_amdgcn_exp2f(P1[r]); rs += P0[r] + P1[r]; } \
        l += rs; \
        _Pragma("unroll") for (int kstep = 0; kstep < 4; ++kstep) { v4u pw; const int rb = 8 * (kstep & 1); \
            if (kstep < 2) { pw.x = cvt_pk_bf16(P0[rb], P0[rb + 1]); pw.y = cvt_pk_bf16(P0[rb + 2], P0[rb + 3]); pw.z = cvt_pk_bf16(P0[rb + 4], P0[rb + 5]); pw.w = cvt_pk_bf16(P0[rb + 6], P0[rb + 7]); } \
            else { pw.x = cvt_pk_bf16(P1[rb], P1[rb + 1]); pw.y = cvt_pk_bf16(P1[rb + 2], P1[rb + 3]); pw.z = cvt_pk_bf16(P1[rb + 4], P1[rb + 5]); pw.w = cvt_pk_bf16(P1[rb + 6], P1[rb + 7]); } \
            const bf16x8 pb = __builtin_bit_cast(bf16x8, pw); \
            _Pragma("unroll") for (int d0 = 0; d0 < 2; ++d0) { \
                const s16x4 lo = vtr(vs + vaddr + d0 * 4096 + kstep * 1024), hh = vtr(vs + vaddr + d0 * 4096 + kstep * 1024 + 512); \
                const bf16x8 va = (bf16x8){lo[0], lo[1], lo[2], lo[3], hh[0], hh[1], hh[2], hh[3]}; \
                if (d0 == 0) o0 = __builtin_amdgcn_mfma_f32_32x32x16_bf16(va, pb, o0, 0, 0, 0); else o1 = __builtin_amdgcn_mfma_f32_32x32x16_bf16(va, pb, o1, 0, 0, 0); } } } while (0)
#define PA_BAR() do { asm volatile("s_waitcnt lgkmcnt(0)" ::: "memory"); __builtin_amdgcn_s_barrier(); asm volatile("" ::: "memory"); } while (0)
#define PA_SB() __builtin_amdgcn_sched_barrier(0)
#define PA_KRD(s_, o_) (*(const LAS bf16x8*)(ks + (2 * (s_) + hi) * 1024 + (o_) + r32 * 16))
#define PA_SX(PN0, PN1, t_, slot_, PC0, PC1) do { const LAS unsigned char* ks = lds + (slot_) * SLOT; const int kv0 = (t_) * 64; float rs = 0.f; \
        _Pragma("unroll") for (int r = 0; r < 16; ++r) { PN0[r] = -sref; PN1[r] = -sref; } \
        bf16x8 a0 = PA_KRD(0, 0), a1 = PA_KRD(0, 512); \
        _Pragma("unroll") for (int s_ = 0; s_ < 6; ++s_) { bf16x8 b0 = a0, b1 = a1; const int r0 = s_ < 4 ? 3 * s_ : 12 + 2 * (s_ - 4), r1 = r0 + (s_ < 4 ? 3 : 2); \
            if (s_ < 5) { b0 = PA_KRD(s_ + 1, 0); b1 = PA_KRD(s_ + 1, 512); } \
            PN0 = __builtin_amdgcn_mfma_f32_32x32x16_bf16(a0, qf[s_], PN0, 0, 0, 0); asm volatile("" : "+v"(PN0)); PA_SB(); \
            _Pragma("unroll") for (int r = r0; r < r1; ++r) PC0[r] = __builtin_amdgcn_exp2f(PC0[r]); asm volatile("" : "+v"(PC0)); \
            _Pragma("unroll") for (int r = r0; r < r1; ++r) rs += PC0[r]; asm volatile("" : "+v"(rs)); PA_SB(); \
            PN1 = __builtin_amdgcn_mfma_f32_32x32x16_bf16(a1, qf[s_], PN1, 0, 0, 0); asm volatile("" : "+v"(PN1)); PA_SB(); \
            _Pragma("unroll") for (int r = r0; r < r1; ++r) PC1[r] = __builtin_amdgcn_exp2f(PC1[r]); asm volatile("" : "+v"(PC1)); \
            _Pragma("unroll") for (int r = r0; r < r1; ++r) rs += PC1[r]; asm volatile("" : "+v"(rs)); PA_SB(); \
            a0 = b0; a1 = b1; } \
        l += rs; \
        if (kv0 + 63 > qw) { _Pragma("unroll") for (int r = 0; r < 16; ++r) { const int kv = kv0 + crow(r, hi); if (kv > qrow) PN0[r] = -1e30f; if (kv + 32 > qrow) PN1[r] = -1e30f; } } } while (0)
#define PA_PVN(P0, P1, slot_) do { const LAS unsigned char* vs = lds + (slot_) * SLOT + KSLOT + vaddr; s16x4 lo[4][2], hh[4][2]; \
        _Pragma("unroll") for (int d0 = 0; d0 < 2; ++d0) { lo[0][d0] = vtr(vs + d0 * 4096); hh[0][d0] = vtr(vs + d0 * 4096 + 512); } \
        _Pragma("unroll") for (int kstep = 0; kstep < 4; ++kstep) { v4u pw; const int rb = 8 * (kstep & 1); \
            if (kstep < 3) { _Pragma("unroll") for (int d0 = 0; d0 < 2; ++d0) { lo[kstep + 1][d0] = vtr(vs + d0 * 4096 + (kstep + 1) * 1024); hh[kstep + 1][d0] = vtr(vs + d0 * 4096 + (kstep + 1) * 1024 + 512); } }     \
            if (kstep < 2) { pw.x = cvt_pk_bf16(P0[rb], P0[rb + 1]); pw.y = cvt_pk_bf16(P0[rb + 2], P0[rb + 3]); pw.z = cvt_pk_bf16(P0[rb + 4], P0[rb + 5]); pw.w = cvt_pk_bf16(P0[rb + 6], P0[rb + 7]); } \
            else { pw.x = cvt_pk_bf16(P1[rb], P1[rb + 1]); pw.y = cvt_pk_bf16(P1[rb + 2], P1[rb + 3]); pw.z = cvt_pk_bf16(P1[rb + 4], P1[rb + 5]); pw.w = cvt_pk_bf16(P1[rb + 6], P1[rb + 7]); } \
            const bf16x8 pb = __builtin_bit_cast(bf16x8, pw); PA_SB(); \
            { const bf16x8 va = (bf16x8){lo[kstep][0][0], lo[kstep][0][1], lo[kstep][0][2], lo[kstep][0][3], hh[kstep][0][0], hh[kstep][0][1], hh[kstep][0][2], hh[kstep][0][3]}; o0 = __builtin_amdgcn_mfma_f32_32x32x16_bf16(va, pb, o0, 0, 0, 0); } \
            { const bf16x8 va = (bf16x8){lo[kstep][1][0], lo[kstep][1][1], lo[kstep][1][2], lo[kstep][1][3], hh[kstep][1][0], hh[kstep][1][1], hh[kstep][1][2], hh[kstep][1][3]}; o1 = __builtin_amdgcn_mfma_f32_32x32x16_bf16(va, pb, o1, 0, 0, 0); } \
            PA_SB(); } } while (0)
    f32x16 pA0, pA1, pB0, pB1;
    if (wave < 4) asm volatile("s_waitcnt vmcnt(3)" ::: "memory"); else asm volatile("s_waitcnt vmcnt(2)" ::: "memory");
    PA_BAR();
    PA_S(pA0, pA1, 0, 0);
    int sl = 0, s1 = 1;
    for (int t = 0; ; t += 2) {
        const int s2 = (s1 == 2) ? 0 : s1 + 1;
        asm volatile("s_waitcnt vmcnt(0)" ::: "memory"); PA_BAR();
        if (t + 2 < NT) issue_tile(Kg, Vg, lds + s2 * SLOT, (t + 2) * 64, wave, lane);
        PA_SX(pB0, pB1, t + 1, s1, pA0, pA1); PA_PVN(pA0, pA1, sl);
        asm volatile("s_waitcnt vmcnt(0)" ::: "memory"); PA_BAR();
        if (t + 2 >= NT) break;
        if (t + 3 < NT) issue_tile(Kg, Vg, lds + sl * SLOT, (t + 3) * 64, wave, lane);
        PA_SX(pA0, pA1, t + 2, s2, pB0, pB1); PA_PVN(pB0, pB1, s1);
        sl = s2; s1 = (s2 == 2) ? 0 : s2 + 1;
    }
    PA_PV(pB0, pB1, s1);
#undef PA_S
#undef PA_PV
#undef PA_BAR
#undef PA_SB
#undef PA_KRD
#undef PA_SX
#undef PA_PVN
    const float il = 1.0f / swap_sum(l);
    bf16* op = O + (rowbase + qw + r32) * ATTW + h * VH + 4 * hi;
#pragma unroll
    for (int g = 0; g < 4; ++g) {
        v2u w0, w1; w0.x = cvt_pk_bf16(o0[4 * g] * il, o0[4 * g + 1] * il); w0.y = cvt_pk_bf16(o0[4 * g + 2] * il, o0[4 * g + 3] * il);
        w1.x = cvt_pk_bf16(o1[4 * g] * il, o1[4 * g + 1] * il); w1.y = cvt_pk_bf16(o1[4 * g + 2] * il, o1[4 * g + 3] * il);
        *(GAS v2u*)(op + 8 * g) = w0; *(GAS v2u*)(op + 32 + 8 * g) = w1;
    }
    asm volatile("s_waitcnt vmcnt(0) lgkmcnt(0)" ::: "memory");
    __syncthreads();
}
}

namespace sa {
using pa::f32x16; using pa::s16x4; using pa::crow; using pa::vtr; using pa::swap_max; using pa::swap_sum;
constexpr int HK = 64;
constexpr int CHS = (HK + 1) * 16;
constexpr int CSB = 36 * CHS;
constexpr int C8S = (HK + 1) * 32, C8B = 8 * C8S;
constexpr int OFF_CS = 0, OFF_C8 = 2 * CSB;
constexpr int OFF_QA = OFF_C8 + 2 * C8B;
constexpr int PSTR = 144, OFF_P = OFF_QA + 18432;
constexpr int OFF_RS = OFF_P + 32 * PSTR;
constexpr int OFF_KSS = OFF_RS + 2048;
constexpr int OFF_PSUM = OFF_KSS + 512, OFF_PHYS = OFF_PSUM + 512, OFF_GK = OFF_PHYS + 128, SA_LDS = OFF_GK + 128;
static_assert(SA_LDS <= RING_BYTES, "sample attention LDS");
constexpr int PO_STRIDE = 32 * 256;
#define SA_BAR() do { asm volatile("s_waitcnt lgkmcnt(0)" ::: "memory"); __builtin_amdgcn_s_barrier(); asm volatile("" ::: "memory"); } while (0)

__device__ __forceinline__ void gld16(f32x4& d, const void* p) { asm volatile("global_load_dwordx4 %0, %1, off" : "=v"(d) : "v"(p) : "memory"); }
__device__ __forceinline__ void gld8(v2u& d, const void* p) { asm volatile("global_load_dwordx2 %0, %1, off" : "=v"(d) : "v"(p) : "memory"); }
template <int MODE> __device__ __forceinline__ void item(const void* const* in, const bf16* QABS, const unsigned char* W8, const bf16* ROPEB, float* PO, float* PL, float sref, int b, int half, LAS unsigned char* lds, int tid_, int wave, int lane_) {
    const int tid = opq(tid_), lane = tid & 63;
    (void)lane_;
    const float* cache_ckv = (const float*)in[4]; const float* cache_kr = (const float*)in[5]; const int* page_table = (const int*)in[6]; const float* g_k = (const float*)in[18];
    const int r32 = lane & 31, hi = lane >> 5;
    typedef int v8i __attribute__((ext_vector_type(8)));
    for (int e = tid; e < 36 * 32; e += 512) *(LAS v4u*)(lds + OFF_QA + e * 16) = *(const GAS v4u*)(QABS + ((size_t)b * 36 * 32 + e) * 8);
    if (tid < NPAGES / 2) *(LAS int*)(lds + OFF_PHYS + tid * 4) = page_table[b * NPAGES + half * (NPAGES / 2) + tid];
    v8i wf[4][2];
#pragma unroll
    for (int s = 0; s < 4; ++s)
#pragma unroll
        for (int nb = 0; nb < 2; ++nb) { const GAS v4u* wp = (const GAS v4u*)(W8 + (size_t)(wave * QKN + 32 * nb + r32) * KVL + 64 * s + 32 * hi); const v4u a = wp[0], bq = wp[1];
            wf[s][nb] = (v8i){(int)a.x, (int)a.y, (int)a.z, (int)a.w, (int)bq.x, (int)bq.y, (int)bq.z, (int)bq.w}; }
    if (tid < 32) *(LAS float*)(lds + OFF_GK + tid * 4) = g_k[64 + tid];
    asm volatile("s_waitcnt vmcnt(0) lgkmcnt(0)" ::: "memory");
#pragma unroll
    for (int s = 0; s < 4; ++s) asm volatile("" : "+v"(wf[s][0]), "+v"(wf[s][1]));
    __builtin_amdgcn_s_barrier(); asm volatile("" ::: "memory");
    f32x16 o = {};
    float l_run = 0.f;
    const int kq = wave >> 1;
    constexpr int NHP = NPAGES;
#define SA_IDS() const int tq = opq(tid), lq = tq & 63, r32 = lq & 31, hi = lq >> 5, kkey = tq >> 2, qd = tq & 3, cs_col = 16 * (wave & 1) + (lq & 15), quad = lq >> 4; (void)r32; (void)hi; (void)kkey; (void)qd; (void)cs_col; (void)quad
    f32x4 va[4], vb[4], x1 = {}, x2 = {}; v2u cw = {}, sw = {};
#define SA_SRC(hp_) const int sub_ = (hp_) & 1; const int phys_ = *(const LAS int*)(lds + OFF_PHYS + ((hp_) >> 1) * 4); const float* src_ = cache_ckv + ((size_t)phys_ * PAGE + sub_ * HK + 2 * wave) * KVL + lq * 4
#define SA_LD(i_) do { gld16(va[i_], src_ + (size_t)(i_) * 16 * KVL); gld16(vb[i_], src_ + (size_t)(i_) * 16 * KVL + KVL); } while (0)
#define SA_LDK(hp_) do { if (wave < 4) { const float* krp_ = cache_kr + ((size_t)phys_ * PAGE + sub_ * HK + kkey) * QKR; gld16(x1, krp_ + 4 * qd); gld16(x2, krp_ + 16 + 4 * qd); \
            const bf16* rp_ = ROPEB + ((size_t)(half * (NPAGES / 2) + ((hp_) >> 1)) * PAGE + sub_ * HK + kkey) * 32; gld8(cw, rp_ + 4 * qd); gld8(sw, rp_ + 16 + 4 * qd); } } while (0)
#define SA_AKR(CSW, KSSW) do { \
            const f32x4 rc_ = {bflo(cw.x), bfhi(cw.x), bflo(cw.y), bfhi(cw.y)}, rs_ = {bflo(sw.x), bfhi(sw.x), bflo(sw.y), bfhi(sw.y)}; \
            float ss = (x1[0] * x1[0] + x1[1] * x1[1]) + (x1[2] * x1[2] + x1[3] * x1[3]) + (x2[0] * x2[0] + x2[1] * x2[1]) + (x2[2] * x2[2] + x2[3] * x2[3]); \
            ss = sum4(ss); \
            const f32x4 ga = *(const LAS f32x4*)(lds + OFF_GK + qd * 16), gb = *(const LAS f32x4*)(lds + OFF_GK + 64 + qd * 16); \
            const f32x4 a = x1 * ga, bb = x2 * gb; const f32x4 y1 = a * rc_ - bb * rs_, y2 = a * rs_ + bb * rc_; \
            v2u w1, w2; w1.x = cvt_pk_bf16(y1[0], y1[1]); w1.y = cvt_pk_bf16(y1[2], y1[3]); w2.x = cvt_pk_bf16(y2[0], y2[1]); w2.y = cvt_pk_bf16(y2[2], y2[3]); \
            const int c1 = 32 + (qd >> 1), c2 = 34 + (qd >> 1); \
            *(LAS v2u*)((CSW) + c1 * CHS + kkey * 16 + 8 * (qd & 1)) = w1; *(LAS v2u*)((CSW) + c2 * CHS + kkey * 16 + 8 * (qd & 1)) = w2; \
            if (qd == 0) *(LAS float*)(lds + (KSSW) + kkey * 4) = ss; } while (0)
#define SA_R(CF, kb, s2) do { const LAS v4u* cp = (const LAS v4u*)(c8 + (2 * (s2) + hi) * C8S + (32 * (kb) + r32) * 32); const v4u a = cp[0], bq = cp[1]; \
            CF = (v8i){(int)a.x, (int)a.y, (int)a.z, (int)a.w, (int)bq.x, (int)bq.y, (int)bq.z, (int)bq.w}; } while (0)
#define SA_M(ACC, s2, nb, CF) do { ACC = __builtin_amdgcn_mfma_scale_f32_32x32x64_f8f6f4(wf[s2][nb], CF, ACC, 0, 0, 0, 127, 0, 127); asm volatile("" : "+v"(ACC)); } while (0)
#define SA_PA(i, kk, CSW) do { const int key_ = 2 * wave + (kk) + 16 * (i), ch8 = lq >> 1, hf = lq & 1; const f32x4 v = (kk) ? vb[i] : va[i]; \
            v2u w; w.x = cvt_pk_bf16(v[0], v[1]); w.y = cvt_pk_bf16(v[2], v[3]); *(LAS v2u*)((CSW) + ch8 * CHS + key_ * 16 + hf * 8) = w; } while (0)
#define SA_PB(i, kk, C8W) do { const int key_ = 2 * wave + (kk) + 16 * (i), ch8 = lq >> 1, hf = lq & 1; const f32x4 v = (kk) ? vb[i] : va[i]; \
            int w8 = 0; w8 = __builtin_amdgcn_cvt_pk_fp8_f32(v[0], v[1], w8, false); w8 = __builtin_amdgcn_cvt_pk_fp8_f32(v[2], v[3], w8, true); \
            *(LAS int*)((C8W) + (ch8 >> 2) * C8S + key_ * 32 + (ch8 & 3) * 8 + hf * 4) = w8; } while (0)
#define SA_SEG(T0, T1, s2a, i, HOOK, RN0, RN1) do { \
            SA_M(T0, s2a, 0, cfa); SA_SB(); HOOK; SA_PA(i, 0, csn); SA_SB(); \
            SA_M(T1, s2a, 1, cfa); SA_SB(); SA_PB(i, 0, c8n); RN0; SA_SB(); \
            SA_M(T0, (s2a) + 1, 0, cfb); SA_SB(); SA_PA(i, 1, csn); SA_SB(); \
            SA_M(T1, (s2a) + 1, 1, cfb); SA_SB(); SA_PB(i, 1, c8n); RN1; SA_SB(); } while (0)
#define SA_BRED(T0, T1, kb, KSSR) do { const int key_ = 32 * (kb) + r32; const f32x16 sq = T0 * T0 + T1 * T1; \
            const f32x4 s4 = (f32x4){sq[0], sq[1], sq[2], sq[3]} + (f32x4){sq[4], sq[5], sq[6], sq[7]} + ((f32x4){sq[8], sq[9], sq[10], sq[11]} + (f32x4){sq[12], sq[13], sq[14], sq[15]}); \
            float ss = (s4[0] + s4[1]) + (s4[2] + s4[3]); \
            ss = swap_sum(ss) * (1.0f / 4096.0f) + *(const LAS float*)(lds + (KSSR) + key_ * 4); \
            if (hi == 0) *(LAS float*)(lds + OFF_RS + (key_ * 8 + wave) * 4) = __builtin_amdgcn_rsqf(ss * (1.f / QKH) + EPS); } while (0)
#define SA_SB() __builtin_amdgcn_sched_barrier(0)
    { SA_IDS(); { SA_SRC(0); SA_LD(0); SA_LD(1); SA_LD(2); SA_LD(3); SA_LDK(0); }
      asm volatile("s_waitcnt vmcnt(0)" ::: "memory");
      asm volatile("" : "+v"(va[0]), "+v"(va[1]), "+v"(va[2]), "+v"(va[3]), "+v"(vb[0]), "+v"(vb[1]), "+v"(vb[2]), "+v"(vb[3]));
      asm volatile("" : "+v"(x1), "+v"(x2), "+v"(cw), "+v"(sw));
      LAS unsigned char* cs0 = lds + OFF_CS; LAS unsigned char* c80 = lds + OFF_C8; SA_SRC(1);
      _Pragma("unroll") for (int i = 0; i < 4; ++i) { SA_PA(i, 0, cs0); SA_PB(i, 0, c80); SA_PA(i, 1, cs0); SA_PB(i, 1, c80); SA_SB(); SA_LD(i); SA_SB(); }
      if (tid < 256) SA_AKR(cs0, OFF_KSS);
      SA_SB(); SA_LDK(1);
      SA_BAR(); }
#pragma unroll 1
    for (int hp = 0; hp < NHP; ++hp) { SA_IDS();
        const int par = hp & 1;
        LAS unsigned char* cs = lds + OFF_CS + par * CSB; LAS unsigned char* c8 = lds + OFF_C8 + par * C8B;
        LAS unsigned char* csn = lds + OFF_CS + (par ^ 1) * CSB; LAS unsigned char* c8n = lds + OFF_C8 + (par ^ 1) * C8B;
        const int kssr = OFF_KSS + par * 256, kssw = OFF_KSS + (par ^ 1) * 256;
        const bool more = hp + 2 < NHP; const int hn = more ? hp + 2 : hp; SA_SRC(hn);
        asm volatile("s_waitcnt vmcnt(0)" ::: "memory");
        asm volatile("" : "+v"(va[0]), "+v"(va[1]), "+v"(va[2]), "+v"(va[3]), "+v"(vb[0]), "+v"(vb[1]), "+v"(vb[2]), "+v"(vb[3]));
        asm volatile("" : "+v"(x1), "+v"(x2), "+v"(cw), "+v"(sw));
        { f32x16 t0 = {}, t1 = {}, t2 = {}, t3 = {}; v8i cfa, cfb;
          SA_R(cfa, 0, 0); SA_R(cfb, 0, 1); SA_SB();
          SA_SEG(t0, t1, 0, 0, (void)0, SA_R(cfa, 0, 2), SA_R(cfb, 0, 3)); if (more) SA_LD(0); SA_SB();
          SA_SEG(t0, t1, 2, 1, (void)0, SA_R(cfa, 1, 0), SA_R(cfb, 1, 1)); if (more) SA_LD(1); SA_SB();
          if (tid < 256) SA_AKR(csn, kssw);
          SA_SB(); if (more) SA_LDK(hn); SA_SB();
          SA_SEG(t2, t3, 0, 2, SA_BRED(t0, t1, 0, kssr); SA_SB(), SA_R(cfa, 1, 2), SA_R(cfb, 1, 3)); if (more) SA_LD(2); SA_SB();
          SA_SEG(t2, t3, 2, 3, (void)0, (void)0, (void)0); if (more) SA_LD(3); SA_SB();
          SA_BRED(t2, t3, 1, kssr); }
        SA_BAR();
        { f32x4 p4 = {0.f, 0.f, 0.f, 0.f}, p5 = {0.f, 0.f, 0.f, 0.f}; const int key = 16 * kq + (lq & 15);
          bf16x8 cf[9], qf[9];
          { LAS unsigned char* cb = cs + quad * CHS + key * 16; LAS unsigned char* qb = lds + OFF_QA + quad * 512 + cs_col * 16;
#pragma unroll
            for (int s2 = 0; s2 < 9; ++s2) { cf[s2] = *(const LAS bf16x8*)(cb + s2 * 4 * CHS); qf[s2] = *(const LAS bf16x8*)(qb + s2 * 2048); } }
#pragma unroll
          for (int s2 = 0; s2 < 9; ++s2) { if (s2 & 1) p5 = __builtin_amdgcn_mfma_f32_16x16x32_bf16(cf[s2], qf[s2], p5, 0, 0, 0); else p4 = __builtin_amdgcn_mfma_f32_16x16x32_bf16(cf[s2], qf[s2], p4, 0, 0, 0); }
          p4 += p5;
          float rsum = 0.f;
#pragma unroll
          for (int r = 0; r < 4; ++r) { p4[r] = __builtin_amdgcn_exp2f(p4[r] * *(const LAS float*)(lds + OFF_RS + ((16 * kq + 4 * quad + r) * 8 + (cs_col & 7)) * 4) - sref); rsum += p4[r]; }
          rsum = rows_sum(rsum);
          if (lq < 16) *(LAS float*)(lds + OFF_PSUM + (kq * 32 + cs_col) * 4) = rsum;
          v2u w; w.x = cvt_pk_bf16(p4[0], p4[1]); w.y = cvt_pk_bf16(p4[2], p4[3]);
          *(LAS v2u*)(lds + OFF_P + cs_col * PSTR + (16 * kq + 4 * quad) * 2) = w; }
        SA_BAR();
        l_run += ((*(const LAS float*)(lds + OFF_PSUM + r32 * 4) + *(const LAS float*)(lds + OFF_PSUM + (32 + r32) * 4)) + (*(const LAS float*)(lds + OFF_PSUM + (64 + r32) * 4) + *(const LAS float*)(lds + OFF_PSUM + (96 + r32) * 4)));
        { const int dim = 32 * wave + 16 * ((lq >> 4) & 1) + 4 * (lq & 3), ch = dim >> 3, k0 = 8 * hi + ((lq & 15) >> 2);
          s16x4 lo[4], hh[4]; bf16x8 pb[4];
          { LAS unsigned char* tb = cs + ch * CHS + k0 * 16 + 8 * (lq & 1); LAS unsigned char* pp = lds + OFF_P + r32 * PSTR + 16 * hi;
#pragma unroll
            for (int ks = 0; ks < 4; ++ks) { lo[ks] = vtr(tb + ks * 256); hh[ks] = vtr(tb + ks * 256 + 64); pb[ks] = *(const LAS bf16x8*)(pp + ks * 32); } }
#pragma unroll
          for (int ks = 0; ks < 4; ++ks) { const bf16x8 ca = (bf16x8){lo[ks][0], lo[ks][1], lo[ks][2], lo[ks][3], hh[ks][0], hh[ks][1], hh[ks][2], hh[ks][3]};
              o = __builtin_amdgcn_mfma_f32_32x32x16_bf16(ca, pb[ks], o, 0, 0, 0); } }
        SA_BAR();
    }
#undef SA_R
#undef SA_M
#undef SA_PA
#undef SA_PB
#undef SA_SEG
#undef SA_AKR
#undef SA_BRED
#undef SA_SB
#undef SA_IDS
#undef SA_SRC
#undef SA_LD
#undef SA_LDK
    asm volatile("s_waitcnt vmcnt(0)" ::: "memory");
    float* po = PO + (size_t)(b * 2 + half) * PO_STRIDE + (size_t)r32 * 256 + 32 * wave + 4 * hi;
#pragma unroll
    for (int g = 0; g < 4; ++g) *(GAS f32x4*)(po + 8 * g) = (f32x4){o[4 * g], o[4 * g + 1], o[4 * g + 2], o[4 * g + 3]};
    if (wave == 0 && hi == 0) PL[(b * 2 + half) * 32 + r32] = l_run;
    asm volatile("s_waitcnt vmcnt(0) lgkmcnt(0)" ::: "memory"); __syncthreads();
}

__device__ __forceinline__ void combine_item(const void* const* in, const bf16* Q, const bf16* K, const bf16* CKVN, const float* PO, const float* PL, float sref, bf16* ATT, int h, int rc, LAS unsigned char* lds, int tid, int wave, int lane) {
    const float* w_uv = (const float*)in[16];
    LAS float* WU = (LAS float*)lds;
    LAS float* OL = WU + 256 * 64;
    f32x4 wreg[8];
#pragma unroll
    for (int i = 0; i < 8; ++i) { const int e4 = tid + 512 * i, c = e4 >> 4, d4 = (e4 & 15) * 4; wreg[i] = *(const GAS f32x4*)(w_uv + (size_t)c * 512 + h * VH + d4); }
    { f32x4 v0[2], v1[2]; float pl0[2], pl1[2]; v4u qc[2], kc[2][4]; v2u cw_[2][4];
#pragma unroll
      for (int rr = 0; rr < 2; ++rr) { const int r = rc * 16 + 2 * wave + rr, b = r >> 2, t = r & 3, col = t * 8 + h; const size_t row = (size_t)MP + r;
          pl0[rr] = PL[(b * 2) * 32 + col]; pl1[rr] = PL[(b * 2 + 1) * 32 + col];
          v0[rr] = *(const GAS f32x4*)(PO + (size_t)(b * 2) * PO_STRIDE + (size_t)col * 256 + 4 * lane); v1[rr] = *(const GAS f32x4*)(PO + (size_t)(b * 2 + 1) * PO_STRIDE + (size_t)col * 256 + 4 * lane);
          const int c = lane < 12 ? lane : 0;
          qc[rr] = *(const GAS v4u*)(Q + row * 768 + h * QKH + 8 * c);
#pragma unroll
          for (int s2 = 0; s2 < 4; ++s2) { const size_t kr_ = (size_t)MP + b * DECT + s2; kc[rr][s2] = *(const GAS v4u*)(K + kr_ * 768 + h * QKH + 8 * c); cw_[rr][s2] = *(const GAS v2u*)(CKVN + kr_ * KVL + 4 * lane); } }
#pragma unroll
      for (int rr = 0; rr < 2; ++rr) { const int rl = 2 * wave + rr, r = rc * 16 + rl, t = r & 3;
          float l = pl0[rr] + pl1[rr]; float acc[4];
#pragma unroll
          for (int i = 0; i < 4; ++i) acc[i] = v0[rr][i] + v1[rr][i];
          float qf[8]; unpack8(qc[rr], qf);
#pragma unroll
          for (int s2 = 0; s2 < 4; ++s2) { float f[8]; unpack8(kc[rr][s2], f); float sc = 0.f;
#pragma unroll
              for (int i = 0; i < 8; ++i) sc += qf[i] * f[i];
              sc = wave_sum(lane < 12 ? sc : 0.f);
              const float pr = (s2 <= t) ? __builtin_amdgcn_exp2f(sc - sref) : 0.f;
              l += pr; const v2u w = cw_[rr][s2];
              acc[0] += pr * bflo(w.x); acc[1] += pr * bfhi(w.x); acc[2] += pr * bflo(w.y); acc[3] += pr * bfhi(w.y); }
          const float il = 1.0f / l;
          *(LAS f32x4*)(OL + rl * 256 + 4 * lane) = (f32x4){acc[0] * il, acc[1] * il, acc[2] * il, acc[3] * il}; } }
#pragma unroll
    for (int i = 0; i < 8; ++i) { const int e4 = tid + 512 * i, c = e4 >> 4, d4 = (e4 & 15) * 4; *(LAS f32x4*)(WU + c * 64 + d4) = wreg[i]; }
    LDS_WAIT(); __syncthreads();
    { const int rl = tid >> 5, dp = tid & 31; float o0 = 0.f, o1 = 0.f;
#pragma unroll 8
      for (int c = 0; c < KVL; ++c) { const float ov = OL[rl * 256 + c]; const f32x2 w = *(const LAS f32x2*)(WU + c * 64 + 2 * dp); o0 += ov * w.x; o1 += ov * w.y; }
      *(GAS unsigned*)(ATT + ((size_t)MP + rc * 16 + rl) * ATTW + h * VH + 2 * dp) = pk2(o0, o1); }
    LDS_WAIT(); __syncthreads();
}
}


__device__ __forceinline__ void qabs_item(const void* const* in, const bf16* QRAW, const bf16* WKV, const float* ROPE, bf16* QABS, int h, int rg, LAS unsigned char* lds, int tid) {
    const float* g_q = (const float*)in[17]; const float* g_k = (const float*)in[18];
    LAS unsigned char* WH = lds;
    LAS float* QG = (LAS float*)(lds + 32768);
#pragma unroll
    for (int i = 0; i < 4; ++i) *(LAS v4u*)(WH + (tid + 512 * i) * 16) = *(const GAS v4u*)(WKV + (size_t)(h * QKN) * KVL + (size_t)(tid + 512 * i) * 8);
    { const int rl = tid >> 3, sub = tid & 7, sr = rg * 64 + rl, pos = SEQ + (sr & 3);
      const bf16* qr = QRAW + ((size_t)MP + sr) * 768 + h * QKH; float n[8]; unpack8(*(const GAS v4u*)(qr + 8 * sub), n);
      const unsigned wa = *(const GAS unsigned*)(qr + 64 + 2 * sub), wb = *(const GAS unsigned*)(qr + 80 + 2 * sub);
      float a0 = bflo(wa), a1 = bfhi(wa), b0 = bflo(wb), b1 = bfhi(wb);
      float ss = (a0 * a0 + a1 * a1) + (b0 * b0 + b1 * b1);
#pragma unroll
      for (int i = 0; i < 8; ++i) ss += n[i] * n[i];
      ss = sum8(ss);
      const float rs = QSCALE / sqrtf(ss * (1.f / QKH) + EPS);
      const float* rp = ROPE + (size_t)pos * 32; const f32x2 cs = *(const GAS f32x2*)(rp + 2 * sub), sn = *(const GAS f32x2*)(rp + 16 + 2 * sub);
#pragma unroll
      for (int i = 0; i < 8; ++i) QG[rl * 64 + 8 * sub + i] = bf2f((bf16)f2bf(n[i] * rs * g_q[8 * sub + i])) * g_k[8 * sub + i];
      a0 *= rs * g_q[64 + 2 * sub]; a1 *= rs * g_q[65 + 2 * sub]; b0 *= rs * g_q[80 + 2 * sub]; b1 *= rs * g_q[81 + 2 * sub];
      const unsigned r1 = pk2(a0 * cs.x - b0 * sn.x, a1 * cs.y - b1 * sn.y), r2 = pk2(a0 * sn.x + b0 * cs.x, a1 * sn.y + b1 * cs.y);
      bf16* qab = QABS + (size_t)(sr >> 2) * 36 * 32 * 8 + ((sr & 3) * 8 + h) * 8;
      *(GAS unsigned*)(qab + (32 + (sub >> 2)) * 256 + 2 * (sub & 3)) = r1; *(GAS unsigned*)(qab + (34 + (sub >> 2)) * 256 + 2 * (sub & 3)) = r2; }
    LDS_WAIT(); __syncthreads();
    { const int r4 = tid >> 5, ch = tid & 31; float acc[4][8];
#pragma unroll
      for (int r = 0; r < 4; ++r)
#pragma unroll
          for (int i = 0; i < 8; ++i) acc[r][i] = 0.f;
#pragma unroll 4
      for (int d = 0; d < QKN; ++d) { float w[8]; unpack8(*(const LAS v4u*)(WH + d * 512 + ch * 16), w);
#pragma unroll
          for (int r = 0; r < 4; ++r) { const float qg = QG[(r4 * 4 + r) * 64 + d];
#pragma unroll
              for (int i = 0; i < 8; ++i) acc[r][i] += qg * w[i]; } }
#pragma unroll
      for (int r = 0; r < 4; ++r) { const int sr = rg * 64 + r4 * 4 + r; v4u o; o.x = pk2(acc[r][0], acc[r][1]); o.y = pk2(acc[r][2], acc[r][3]); o.z = pk2(acc[r][4], acc[r][5]); o.w = pk2(acc[r][6], acc[r][7]);
          *(GAS v4u*)(QABS + (size_t)(sr >> 2) * 36 * 32 * 8 + ch * 256 + ((sr & 3) * 8 + h) * 8) = o; } }
    LDS_WAIT(); __syncthreads();
}

__device__ __forceinline__ void ssm_tables_item(const void* const* in, int g, int dq, LAS unsigned char* lds, bf16* MBT, bf16* TYT, float* A32, int tid) {
    const float* a_re = (const float*)in[19]; const float* a_im = (const float*)in[20]; const float* log_dt = (const float*)in[21];
    const float* b_re = (const float*)in[22]; const float* b_im = (const float*)in[23]; const float* c_re = (const float*)in[24]; const float* c_im = (const float*)in[25]; const float* d_skip = (const float*)in[26];
    LAS float* ap = (LAS float*)lds;
    LAS float* bb = ap + 64 * 33 * 2;
    LAS float* cc = bb + 2048;
    LAS float* kj = cc + 2048;
    if (tid < 64) { const int p = tid;
        const double dt = exp((double)log_dt[g]); const double are = a_re[g * NST + p], aim = a_im[g * NST + p];
        const double mag = exp(dt * are), abr = mag * cos(dt * aim), abi = mag * sin(dt * aim), den = are * are + aim * aim, nr = abr - 1.0;
        const double fre = (nr * are + abi * aim) / den, fim = (abi * are - nr * aim) / den;
        double pr = 1.0, pi = 0.0;
        for (int j = 0; j <= 32; ++j) { ap[(p * 33 + j) * 2] = (float)pr; ap[(p * 33 + j) * 2 + 1] = (float)pi; const double t = pr * abr - pi * abi; pi = pr * abi + pi * abr; pr = t; }
        for (int i = 0; i < 16; ++i) { const double br = b_re[(g * NST + p) * GRP + i], bi = b_im[(g * NST + p) * GRP + i]; bb[(p * 16 + i) * 2] = (float)(fre * br - fim * bi); bb[(p * 16 + i) * 2 + 1] = (float)(fre * bi + fim * br); }
        if (dq == 0) { A32[(g * NST + p) * 2] = ap[(p * 33 + 32) * 2]; A32[(g * NST + p) * 2 + 1] = ap[(p * 33 + 32) * 2 + 1];
            A32[4096 + (g * NST + p) * 2] = (float)abr; A32[4096 + (g * NST + p) * 2 + 1] = (float)abi;
            for (int i = 0; i < 16; ++i) { A32[8192 + ((g * NST + p) * 16 + i) * 2] = bb[(p * 16 + i) * 2]; A32[8192 + ((g * NST + p) * 16 + i) * 2 + 1] = bb[(p * 16 + i) * 2 + 1]; } }
    }
    for (int e = tid; e < 1024; e += 512) { const int i = e >> 6, p = e & 63; cc[e * 2] = c_re[(g * GRP + i) * NST + p]; cc[e * 2 + 1] = c_im[(g * GRP + i) * NST + p]; }
    LDS_WAIT(); __syncthreads();
    for (int e = tid; e < 1024; e += 512) { const int dd = e >> 8, i = (e >> 4) & 15, j = e & 15, d = 4 * dq + dd; float acc = 0.f;
        for (int p = 0; p < 64; ++p) { const float cr = cc[(i * 64 + p) * 2], ci = cc[(i * 64 + p) * 2 + 1], ar = ap[(p * 33 + d) * 2], ai = ap[(p * 33 + d) * 2 + 1], br = bb[(p * 16 + j) * 2], bi = bb[(p * 16 + j) * 2 + 1];
            const float tr = cr * ar - ci * ai, ti = cr * ai + ci * ar; acc += tr * br - ti * bi; }
        if (d == 0 && i == j) acc += d_skip[g * GRP + i];
        kj[e] = acc; }
    LDS_WAIT(); __syncthreads();
    for (int e = tid; e < 4 * 32 * 16; e += 512) { const int dd = e >> 9, t = (e >> 4) & 31, i = e & 15, d = 4 * dq + dd; bf16* rowp = TYT + ((size_t)g * 512 + t * 16 + i) * SKA;
        if (t >= d) { const LAS float* kp = kj + dd * 256 + i * 16; v4u w0, w1; w0.x = pk2(kp[0], kp[1]); w0.y = pk2(kp[2], kp[3]); w0.z = pk2(kp[4], kp[5]); w0.w = pk2(kp[6], kp[7]);
            w1.x = pk2(kp[8], kp[9]); w1.y = pk2(kp[10], kp[11]); w1.z = pk2(kp[12], kp[13]); w1.w = pk2(kp[14], kp[15]);
            *(GAS v4u*)(rowp + (t - d) * 16) = w0; *(GAS v4u*)(rowp + (t - d) * 16 + 8) = w1; }
        if (d >= 1 && t + d <= 31) { const v4u z = {0u, 0u, 0u, 0u}; *(GAS v4u*)(rowp + (t + d) * 16) = z; *(GAS v4u*)(rowp + (t + d) * 16 + 8) = z; } }
    for (int e = tid; e < 4 * 16 * 64; e += 512) { const int tt = e >> 10, i = (e >> 6) & 15, p = e & 63, t = 4 * dq + tt;
        const float cr = cc[(i * 64 + p) * 2], ci = cc[(i * 64 + p) * 2 + 1], ar = ap[(p * 33 + t + 1) * 2], ai = ap[(p * 33 + t + 1) * 2 + 1];
        bf16* rowp = TYT + ((size_t)g * 512 + t * 16 + i) * SKA; rowp[512 + p] = (bf16)f2bf(cr * ar - ci * ai); rowp[576 + p] = (bf16)f2bf(-(cr * ai + ci * ar)); }
    for (int e = tid; e < 64 * 4 * 16; e += 512) { const int p = e >> 6, tt = (e >> 4) & 3, i = e & 15, t = 4 * dq + tt;
        const float ar = ap[(p * 33 + 31 - t) * 2], ai = ap[(p * 33 + 31 - t) * 2 + 1], br = bb[(p * 16 + i) * 2], bi = bb[(p * 16 + i) * 2 + 1];
        MBT[((size_t)g * 256 + p) * SKU + t * 16 + i] = (bf16)f2bf(ar * br - ai * bi); MBT[((size_t)g * 256 + 64 + p) * SKU + t * 16 + i] = (bf16)f2bf(ar * bi + ai * br); }
    for (int e = tid; e < 128 * 8; e += 512) { const int r = e >> 3, c8 = e & 7; const v4u z = {0u, 0u, 0u, 0u}; *(GAS v4u*)(MBT + ((size_t)g * 256 + 128 + r) * SKU + 64 * dq + 8 * c8) = z; }
    LDS_WAIT(); __syncthreads();
}

__device__ __forceinline__ float reduce16(float (&v)[16], int lane) {
#pragma unroll
    for (int st = 0; st < 4; ++st) { const int half = 8 >> st, bit = 1 << st; const bool hi = (lane & bit) != 0;
#pragma unroll
        for (int j = 0; j < half; ++j) { const float send = hi ? v[j] : v[j + half], keep = hi ? v[j + half] : v[j]; v[j] = keep + __shfl_xor(send, bit); } }
    return rows_sum(v[0]);
}
__device__ __forceinline__ void ssm_sample(const void* const* in, const float* TAB, const bf16* Z, bf16* GY, float* out, int g, int b0, int bstride, LAS float* scr, int lane) {
    const float* c_re = (const float*)in[24]; const float* c_im = (const float*)in[25]; const float* d_skip = (const float*)in[26];
    const int p = lane;
    const float abr = TAB[4096 + (g * NST + p) * 2], abi = TAB[4096 + (g * NST + p) * 2 + 1];
    float bbr[16], bbi[16], cr[16], ci[16], dsk[16];
    { const GAS f32x4* bp = (const GAS f32x4*)(TAB + 8192 + (size_t)(g * NST + p) * 32);
#pragma unroll
      for (int i = 0; i < 8; ++i) { const f32x4 v = bp[i]; bbr[2 * i] = v[0]; bbi[2 * i] = v[1]; bbr[2 * i + 1] = v[2]; bbi[2 * i + 1] = v[3]; } }
#pragma unroll
    for (int i = 0; i < 16; ++i) { cr[i] = c_re[(g * GRP + i) * NST + p]; ci[i] = c_im[(g * GRP + i) * NST + p]; dsk[i] = (p == 0) ? d_skip[g * GRP + i] : 0.f; }
    for (int b = b0; b < DECB; b += bstride) {
    const int row0 = MP + b * DECT;
    float hr = ((const float*)in[7])[(b * NG + g) * NST + p], hi = ((const float*)in[8])[(b * NG + g) * NST + p];
    v4u uw[DECT][2];
#pragma unroll
    for (int t = 0; t < DECT; ++t) { const bf16* zr = Z + (size_t)(row0 + t) * NZ + ZC_U + GRP * g; uw[t][0] = *(const GAS v4u*)zr; uw[t][1] = *(const GAS v4u*)(zr + 8); }
#pragma unroll
    for (int t = 0; t < DECT; ++t) {
        float u[16]; { float a[8], b[8]; unpack8(uw[t][0], a); unpack8(uw[t][1], b);
#pragma unroll
            for (int i = 0; i < 8; ++i) { u[i] = a[i]; u[8 + i] = b[i]; } }
        float bur = 0.f, bui = 0.f;
#pragma unroll
        for (int i = 0; i < 16; ++i) { bur += bbr[i] * u[i]; bui += bbi[i] * u[i]; }
        const float nhr = abr * hr - abi * hi + bur, nhi = abr * hi + abi * hr + bui; hr = nhr; hi = nhi;
        float z[16];
#pragma unroll
        for (int i = 0; i < 16; ++i) z[i] = cr[i] * hr - ci[i] * hi + dsk[i] * u[i];
#pragma unroll
        for (int i = 0; i < 16; ++i) scr[lane * 17 + i] = z[i];
        LDS_WAIT(); asm volatile("" ::: "memory");
        float y = 0.f;
#pragma unroll
        for (int k = 0; k < 16; ++k) y += scr[((lane >> 4) * 16 + k) * 17 + (lane & 15)];
        y = rows_sum(y);
        LDS_WAIT(); asm volatile("" ::: "memory");
        if (lane < 16) GY[(size_t)(row0 + t) * SSMW + GRP * g + lane] = (bf16)f2bf(gelu_tanh(y));
    }
    out[O_SRES + (size_t)(b * NG + g) * NST + p] = hr; out[O_SIMS + (size_t)(b * NG + g) * NST + p] = hi;
    }
}
__device__ __forceinline__ void ssm_carry_item(const float* TAB, const float* SST, bf16* AY, float* out, int b, int g, int ph, LAS unsigned char* lds, int tid) {
    const int pl = tid & 31, sup = tid >> 5, p = 32 * ph + pl;
    const float ar = TAB[(g * NST + p) * 2], ai = TAB[(g * NST + p) * 2 + 1];
    float sr[16], si[16];
#pragma unroll
    for (int i = 0; i < 16; ++i) { const int ch = b * 256 + sup * 16 + i; const float* sp = SST + ((size_t)ch * NG + g) * 128; sr[i] = sp[p]; si[i] = sp[64 + p]; }
    float hr = 0.f, hi = 0.f;
#pragma unroll
    for (int i = 0; i < 16; ++i) { const float nr = ar * hr - ai * hi + sr[i], ni = ar * hi + ai * hr + si[i]; hr = nr; hi = ni; sr[i] = hr; si[i] = hi; }
    LAS float* tot = (LAS float*)lds;
    LAS float* car = tot + 1024;
    tot[(sup * 32 + pl) * 2] = hr; tot[(sup * 32 + pl) * 2 + 1] = hi;
    LDS_WAIT(); __syncthreads();
    if (sup == 0) { float br = ar, bi = ai;
#pragma unroll
        for (int k = 0; k < 4; ++k) { const float t = br * br - bi * bi; bi = 2.f * br * bi; br = t; }
        float cr = 0.f, ci = 0.f;
        for (int s2 = 0; s2 < 16; ++s2) { car[(s2 * 32 + pl) * 2] = cr; car[(s2 * 32 + pl) * 2 + 1] = ci; const float tr = tot[(s2 * 32 + pl) * 2], ti = tot[(s2 * 32 + pl) * 2 + 1];
            const float nr = br * cr - bi * ci + tr, ni = br * ci + bi * cr + ti; cr = nr; ci = ni; }
        out[O_SREP + (b * NG + g) * NST + p] = cr; out[O_SIMP + (b * NG + g) * NST + p] = ci; }
    LDS_WAIT(); __syncthreads();
    float er = car[(sup * 32 + pl) * 2], ei = car[(sup * 32 + pl) * 2 + 1], lr = 0.f, li = 0.f;
#pragma unroll
    for (int i = 0; i < 16; ++i) { const int ch = b * 256 + sup * 16 + i; bf16* ay = AY + ((size_t)g * SCH + ch) * SKA;
        ay[512 + p] = (bf16)f2bf(er + lr); ay[576 + p] = (bf16)f2bf(ei + li);
        const float nr = ar * er - ai * ei, ni = ar * ei + ai * er; er = nr; ei = ni; lr = sr[i]; li = si[i]; }
    LDS_WAIT(); __syncthreads();
}

#define TAIL_FILL(nbusy, NIT, ...) do { const int ntail_ = ((nbusy) < G) ? (nbusy) : 0; LAS float* scr = (LAS float*)(lds + RING_OFF + wave * 16384); \
        if (ntail_ == 0) { for (int r = gw; r < (NIT); r += NGW) { __VA_ARGS__; } } \
        else if (bx >= ntail_) { for (int r = (bx - ntail_) * NWAVES + wave; r < (NIT); r += (G - ntail_) * NWAVES) { __VA_ARGS__; } } } while (0)

__device__ __forceinline__ float softmax_ref(const float* g_q, const float* g_k, int lane) {
    float a = fmaxf(fabsf(g_q[lane]), fabsf(g_q[64 + (lane & 31)])), b = fmaxf(fabsf(g_k[lane]), fabsf(g_k[64 + (lane & 31)]));
#pragma unroll
    for (int o = 1; o < 64; o <<= 1) { a = fmaxf(a, __shfl_xor(a, o)); b = fmaxf(b, __shfl_xor(b, o)); }
    return QSCALE * 96.0f * a * b * 1.015f + 0.25f;
}

__device__ __forceinline__ void wait_panel(unsigned* cnt, int pm, unsigned target, unsigned* tmo) {
    if (threadIdx.x < 64) {
        unsigned sp = 0;
        while (__hip_atomic_load(cnt + 64 * pm, __ATOMIC_RELAXED, __HIP_MEMORY_SCOPE_AGENT) < target) {
            __builtin_amdgcn_s_sleep(2);
            if ((++sp & 1023u) == 0u && sp > (1u << 22)) { if (threadIdx.x == 0) __hip_atomic_store(tmo, 1u, __ATOMIC_RELAXED, __HIP_MEMORY_SCOPE_AGENT); break; }
        }
        __builtin_amdgcn_fence(__ATOMIC_ACQUIRE, "agent");
        asm volatile("s_waitcnt vmcnt(0)" ::: "memory");
    }
    __syncthreads();
}
#define GEMM_PS(g, nN_, base_p, base_s, E) do { \
      { pg8::Order S_; S_.init(MP / 256, (nN_), 1, G, bx, (base_p)); pg8::gemm_phase<decltype(E), true, true, false>(lds + RING_OFF, g, S_, E); } \
      { pg8::Order S_; S_.init(MS / 256, (nN_), 1, G, bx, (base_s), MP / 256, 4); pg8::gemm_phase<decltype(E), true, true, true>(lds + RING_OFF, g, S_, E); } } while (0)
#define GEMM_P(g, nN_, base_p, E) do { pg8::Order S_; S_.init(MP / 256, (nN_), 1, G, bx, (base_p)); pg8::gemm_phase<decltype(E), true, true, false>(lds + RING_OFF, g, S_, E); } while (0)
#define GEMM_S(g, nN_, base_s, E) do { pg8::Order S_; S_.init(MS / 256, (nN_), 1, G, bx, (base_s), MP / 256, 4); pg8::gemm_phase<decltype(E), true, true, true>(lds + RING_OFF, g, S_, E); } while (0)

__device__ __forceinline__ unsigned char* opqp(unsigned char* p) { asm volatile("" : "+s"(p)); return p; }
#define WIN ((bf16*)(ws + WS_WIN))
#define WUQ ((bf16*)(ws + WS_WUQ))
#define WKV ((bf16*)(ws + WS_WKV))
#define WGLU ((bf16*)(ws + WS_WGLU))
#define WOA ((bf16*)(ws + WS_WOA))
#define WOS ((bf16*)(ws + WS_WOS))
#define WOUT ((bf16*)(ws + WS_WOUT))
#define WPG ((bf16*)(ws + WS_WPG))
#define WPP ((bf16*)(ws + WS_WPP))
#define WUP ((bf16*)(ws + WS_WUP))
#define WDN ((bf16*)(ws + WS_WDN))
#define XN ((bf16*)(ws + WS_XN))
#define Z ((bf16*)(ws + WS_Z))
#define CQN ((bf16*)(ws + WS_CQN))
#define CKVN ((bf16*)(ws + WS_CKVN))
#define PB ((bf16*)(ws + WS_PB))
#define AY ((bf16*)(ws + WS_AY))
#define RT ((float*)(ws + WS_ROPE))
#define RB ((bf16*)(ws + WS_ROPEB))
#define QRAW ((bf16*)(ws + WS_QRAW))
#define KVRAW ((bf16*)(ws + WS_KVRAW))
#define PP ((bf16*)(ws + WS_PP))
#define Q ((bf16*)(ws + WS_Q))
#define K ((bf16*)(ws + WS_K))
#define ATT ((bf16*)(ws + WS_ATT))
#define GY ((bf16*)(ws + WS_GY))
#define YG ((bf16*)(ws + WS_YG))
#define T1 ((bf16*)(ws + WS_T1))
#define MIX ((bf16*)(ws + WS_MIX))
#define SS1 ((float*)(ws + WS_SS1))
#define SS2 ((float*)(ws + WS_SS2))
#define UPB ((bf16*)(ws + WS_UP))
#define HB ((bf16*)(ws + WS_H))
#define X2B ((bf16*)(ws + WS_X2))
#define CB ((bf16*)(ws + WS_CB))
#define KNC ((bf16*)(ws + WS_KNC))
#define ROPE ((float*)(ws + WS_ROPE))
#define SST ((float*)(ws + WS_SST))
__global__ void __launch_bounds__(NWAVES * 64, 2) mk_fwd(Args args) {
    extern __shared__ __attribute__((aligned(16))) unsigned char lds_raw[];
    LAS unsigned char* lds = (LAS unsigned char*)lds_raw;
    volatile LAS unsigned* MISC = (volatile LAS unsigned*)(lds + MISC_OFF);
    const int tid0 = threadIdx.x;
    const int G = gridDim.x, bx = blockIdx.x;
    const int vcu = (G % 8 == 0) ? (bx % 8) * (G / 8) + bx / 8 : bx;
    const int NGW = G * NWAVES;
    unsigned char* ws0 = args.ws;
    unsigned* ctl = (unsigned*)(ws0 + WS_CTL);
    float* out = args.out;
    for (int u = opq(tid0); u < (LDS_BYTES - LDSCTL_OFF) / 4; u += NWAVES * 64) ((LAS unsigned*)(lds + LDSCTL_OFF))[u] = 0u;
    __syncthreads();
    XcdBarrier bar; bar.bar = ctl + CW_BAR; bar.x = 0; bar.st = nullptr;
#if MK_ONE_LAUNCH
    bar = xcd_barrier_post(ctl + CW_BAR, MISC + 8);
#define GRID_BAR() xcd_barrier(bar)
#else
#define GRID_BAR() do {} while (0)
#endif
    const int lo = args.ph_lo, hi = args.ph_hi;
#ifndef PHMASK
#define PHMASK 0xFFFFFFFFu
#endif
#define IN(k) ((((PHMASK) >> (k)) & 1u) && lo <= (k) && (k) < hi)
#define BOTH(k) (IN(k) && IN((k) + 1))

    const float* x_prompt = (const float*)args.in[0]; const float* x_sample = (const float*)args.in[1];
    const float* p_prompt = (const float*)args.in[2]; const float* p_sample = (const float*)args.in[3];
    if (IN(0)) REPLOOP(0) { unsigned char* ws = opqp(ws0); const int tid = opq(tid0), lane = tid & 63, wave = __builtin_amdgcn_readfirstlane(tid >> 6), gw = vcu * NWAVES + wave; (void)lane; (void)gw;
        _Pragma("unroll") for (int rq_ = 0; rq_ < P0A; ++rq_)
        for (int it = bx; it < NG * 8; it += G) ssm_tables_item(args.in, it >> 3, it & 7, lds + RING_OFF, (bf16*)(ws + WS_MBT), (bf16*)(ws + WS_TYT), (float*)(ws + WS_SSMT), tid);
        LAS float* scr = (LAS float*)(lds + RING_OFF + wave * 16384);
        constexpr int I_WIN = 16 * (NZ / 32);
        _Pragma("unroll") for (int rq_ = 0; rq_ < P0B; ++rq_)
        for (int r = gw; r < I_WIN; r += NGW) { const int nblk = NZ / 32, kb = r / nblk, nb = r % nblk, nd = 32 * nb; int ns; bool pad = false;
                if (nd < 256) ns = 384 + nd; else if (nd < 640) ns = nd - 256; else if (nd < 672) ns = nd; else if (nd < 768) { ns = 0; pad = true; }
                else if (nd < 1280) ns = 672 + (nd - 768); else if (nd < 2304) ns = 1184 + (nd - 1280); else ns = 2208 + (nd - 2304);
                tr_item(pad ? nullptr : (const float*)args.in[11], 3232, 64 * kb, ns, WIN, 1024, nd, scr, lane); }
        const float* gmix = (const float*)args.in[10];
        f32x4 gm[4];
#pragma unroll
        for (int j = 0; j < 4; ++j) gm[j] = ((const GAS f32x4*)gmix)[lane + 64 * j];
        for (int m0 = gw; m0 < M; m0 += 2 * NGW) { const int m1 = m0 + NGW; const bool two = m1 < M;
            f32x4 v[2][4], pv[2];
#pragma unroll
            for (int r = 0; r < 2; ++r) { const int m = (r == 0 || two) ? (r == 0 ? m0 : m1) : m0;
                const float* xrow = (m < MP) ? x_prompt + (size_t)m * D : x_sample + (size_t)(m - MP) * D; const GAS f32x4* xr = (const GAS f32x4*)xrow + lane;
#pragma unroll
                for (int j = 0; j < 4; ++j) v[r][j] = xr[64 * j];
                const float* prow = (m < MP) ? p_prompt + (size_t)m * PLE : p_sample + (size_t)(m - MP) * PLE; pv[r] = ((const GAS f32x4*)prow)[lane]; }
#pragma unroll
            for (int r = 0; r < 2; ++r) { if (r == 1 && !two) break; const int m = r == 0 ? m0 : m1; float sq = 0.f;
#pragma unroll
                for (int j = 0; j < 4; ++j) sq += (v[r][j].x * v[r][j].x + v[r][j].y * v[r][j].y) + (v[r][j].z * v[r][j].z + v[r][j].w * v[r][j].w);
                const float rs = 1.0f / sqrtf(wave_sum(sq) * (1.f / D) + EPS);
                GAS v2u* o8 = (GAS v2u*)(XN + (size_t)m * D) + lane;
#pragma unroll
                for (int j = 0; j < 4; ++j) { v2u w; w.x = pk2(v[r][j].x * rs * gm[j].x, v[r][j].y * rs * gm[j].y); w.y = pk2(v[r][j].z * rs * gm[j].z, v[r][j].w * rs * gm[j].w); o8[64 * j] = w; }
                v2u w; w.x = pk2(pv[r].x, pv[r].y); w.y = pk2(pv[r].z, pv[r].w); ((GAS v2u*)(PB + (size_t)m * PLE))[lane] = w; }
        }
        if (BOTH(0)) GRID_BAR();
    }

    if (IN(1)) REPLOOP(1) { unsigned char* ws = opqp(ws0); const int tid = opq(tid0), lane = tid & 63, wave = __builtin_amdgcn_readfirstlane(tid >> 6), gw = vcu * NWAVES + wave; (void)lane; (void)gw;
        pg8::Gemm g{XN, WIN, D, D, D, 0, 0}; pg8::Order S; S.init(M / 256, NZ / 256, 1, G, bx, 0);
        EpiInproj E{Z, CQN, CKVN, AY, out, (const float*)args.in[13], lds + 131072};
        pg8::gemm_phase(lds + RING_OFF, g, S, E);
        { constexpr int I_WUQ = 6 * 24, I_WUK = 4 * 16, I_WUV = 4 * 16, I_WGLU = 8 * 32, I_WOA = 8 * 32, I_WOS = 8 * 32, I_WOUT = 16 * 32, I_WPP = 4 * 32;
          constexpr int NIT1 = I_WUQ + I_WUK + I_WUV + I_WGLU + I_WOA + I_WOS + I_WOUT + I_WPP;
          TAIL_FILL(((M / 256) * (NZ / 256)) % G, NIT1, { int q = r;
            if (q < I_WUQ) { tr_plain((const float*)args.in[14], 384, 768, WUQ, q, scr, lane, (const float*)args.in[12]); continue; } q -= I_WUQ;
            if (q < I_WUK) { tr_plain((const float*)args.in[15], 256, 512, WKV, q, scr, lane); continue; } q -= I_WUK;
            if (q < I_WUV) { tr_plain((const float*)args.in[16], 256, 512, WKV + 512 * 256, q, scr, lane); continue; } q -= I_WUV;
            if (q < I_WGLU) { const int kb = q / 32, nb = q % 32, nd = 32 * nb; const int pn = nd >> 8, bj = (nd >> 7) & 1, c = nd & 127; const int ns = bj * 512 + 128 * pn + c;
                tr_item((const float*)args.in[27], 1024, 64 * kb, ns, WGLU, 512, nd, scr, lane); continue; } q -= I_WGLU;
            if (q < I_WOA) { tr_plain((const float*)args.in[28], 512, 1024, WOA, q, scr, lane); continue; } q -= I_WOA;
            if (q < I_WOS) { tr_plain((const float*)args.in[29], 512, 1024, WOS, q, scr, lane); continue; } q -= I_WOS;
            if (q < I_WOUT) { tr_plain((const float*)args.in[30], 1024, 1024, WOUT, q, scr, lane); continue; } q -= I_WOUT;
            tr_plain((const float*)args.in[38], 256, 1024, WPP, q, scr, lane); });
          TAIL_FILL(((M / 256) * (NZ / 256)) % G, 16 * 176, { const int kb_ = r / 176, nd_ = 32 * (r % 176), ns_ = ((nd_ >> 7) & 1) * DFF + 128 * (nd_ >> 8) + (nd_ & 127);     \
            tr_item((const float*)args.in[32], UPW, 64 * kb_, ns_, WUP, 1024, nd_, scr, lane, (const float*)args.in[31]); });
          const int nb1 = ((M / 256) * (NZ / 256)) % G, b0_ = (nb1 && bx >= nb1) ? bx - nb1 : (nb1 ? -1 : bx), gs_ = nb1 ? G - nb1 : G;
          if (b0_ >= 0) {
        { for (int i = b0_ * 512 + tid; i < (SEQ + DECT) * 16; i += gs_ * 512) { const int pos = i >> 4, k = i & 15;
              const float inv = (float)exp(-(double)k * (1.0 / 16.0) * 9.210340371976184); const float ang = (float)pos * inv; const float c = cosf(ang), sn = sinf(ang);
              RT[pos * 32 + k] = c; RT[pos * 32 + 16 + k] = sn; RB[pos * 32 + k] = (bf16)f2bf(c); RB[pos * 32 + 16 + k] = (bf16)f2bf(sn); } }
        { unsigned* W8 = (unsigned*)(ws + WS_W8); const float* w_uk = (const float*)args.in[15];
          for (int i = b0_ * 512 + tid; i < 512 * 64; i += gs_ * 512) { const int row = i & 511, k4 = (i >> 9) * 4; int w = 0;
              w = __builtin_amdgcn_cvt_pk_fp8_f32(64.f * w_uk[(size_t)k4 * 512 + row], 64.f * w_uk[(size_t)(k4 + 1) * 512 + row], w, false);
              w = __builtin_amdgcn_cvt_pk_fp8_f32(64.f * w_uk[(size_t)(k4 + 2) * 512 + row], 64.f * w_uk[(size_t)(k4 + 3) * 512 + row], w, true);
              W8[row * 64 + (k4 >> 2)] = (unsigned)w; } }
          } }
        if (BOTH(1)) GRID_BAR();
    }

    constexpr int NMT = M / 256;

    if (IN(3)) REPLOOP(3) { unsigned char* ws = opqp(ws0); const int tid = opq(tid0), lane = tid & 63, wave = __builtin_amdgcn_readfirstlane(tid >> 6), gw = vcu * NWAVES + wave; (void)lane; (void)gw;
        {
          constexpr int NPR = MP / 256;
          pg8::Gemm gq{CQN, WUQ, QL, QL, QL, 0, 0}; auto fq_ = [=](const pg8::Unit& u, int row, int col, f32x4 a, f32x4 b) { *(GAS v4u*)(QRAW + (size_t)row * 768 + col) = pack8(a, b); }; pg8::EpiRow8<decltype(fq_)> Eq{fq_};
          pg8::Gemm gk{CKVN, WKV, KVL, KVL, KVL, 0, 0}; auto fk_ = [=](const pg8::Unit& u, int row, int col, f32x4 a, f32x4 b) { *(GAS v4u*)(KVRAW + (size_t)row * 1024 + col) = pack8(a, b); }; pg8::EpiRow8<decltype(fk_)> Ek{fk_};
          GEMM_P(gq, 3, 0, Eq); GEMM_P(gk, 4, NPR * 3, Ek);
          { pg8::Gemm g{AY, (const bf16*)(ws + WS_MBT), SKA, SKU, SKU, (size_t)SCH * SKA, (size_t)256 * SKU}; pg8::Order S; S.init(SCH / 256, 1, NG, G, bx, NPR * 7);
            auto f = [=](const pg8::Unit& u, int row, int col, f32x4 a, f32x4 b) { if (col < 128) { float* d = SST + ((size_t)row * NG + u.z) * 128 + col; *(GAS f32x4*)d = a; *(GAS f32x4*)(d + 4) = b; } };
            pg8::EpiRow8<decltype(f)> E{f}; pg8::gemm_phase(lds + RING_OFF, g, S, E); }
          constexpr int B2 = NPR * 7 + 64;
          GEMM_S(gq, 3, B2, Eq); GEMM_S(gk, 4, B2 + 24, Ek); }
        if (BOTH(3)) GRID_BAR();
    }

    if (IN(4)) REPLOOP(4) { unsigned char* ws = opqp(ws0); const int tid = opq(tid0), lane = tid & 63, wave = __builtin_amdgcn_readfirstlane(tid >> 6), gw = vcu * NWAVES + wave; (void)lane; (void)gw;
        _Pragma("unroll") for (int rpc_ = 0; rpc_ < P4C; ++rpc_)
        for (int it = bx; it < NBATCH * NG * 2; it += G) ssm_carry_item((const float*)(ws + WS_SSMT), (const float*)(ws + WS_SST), AY, out, it >> 6, (it >> 1) & 31, it & 1, lds + RING_OFF, tid);
        _Pragma("unroll") for (int rpd_ = 0; rpd_ < P4D; ++rpd_)
        for (int it = G - 1 - bx; it < NH * (MS / 64); it += G) qabs_item(args.in, QRAW, WKV, ROPE, (bf16*)(ws + WS_QABS), it & 7, it >> 3, lds + RING_OFF, tid);
        const float* g_q = (const float*)args.in[17]; const float* g_k = (const float*)args.in[18];
        const int h = lane >> 3, sub = lane & 7;
        float gq[12], gk[12];
#pragma unroll
        for (int i = 0; i < 8; ++i) { gq[i] = g_q[8 * sub + i]; gk[i] = g_k[8 * sub + i]; }
        gq[8] = g_q[64 + 2 * sub]; gq[9] = g_q[65 + 2 * sub]; gq[10] = g_q[80 + 2 * sub]; gq[11] = g_q[81 + 2 * sub];
        gk[8] = g_k[64 + 2 * sub]; gk[9] = g_k[65 + 2 * sub]; gk[10] = g_k[80 + 2 * sub]; gk[11] = g_k[81 + 2 * sub];
        _Pragma("unroll") for (int rpa_ = 0; rpa_ < P4A; ++rpa_)
        for (int m0 = gw; m0 < M; m0 += 2 * NGW) {
            const int m1 = m0 + NGW; const bool two = m1 < M;
            f32x2 cs[2], sn[2]; v4u qn8[2], kn8[2]; unsigned qa[2], qb[2]; f32x2 xa[2], xb[2];
#pragma unroll
            for (int j = 0; j < 2; ++j) { const int m = (j == 0 || two) ? (j == 0 ? m0 : m1) : m0;
                const int pos = (m < MP) ? (m & (SEQ - 1)) : SEQ + ((m - MP) & 3);
                const float* rp = ROPE + (size_t)pos * 32; cs[j] = *(const GAS f32x2*)(rp + 2 * sub); sn[j] = *(const GAS f32x2*)(rp + 16 + 2 * sub);
                const bf16* qr = QRAW + (size_t)m * 768 + h * QKH; qn8[j] = *(const GAS v4u*)(qr + 8 * sub); qa[j] = *(const GAS unsigned*)(qr + 64 + 2 * sub); qb[j] = *(const GAS unsigned*)(qr + 80 + 2 * sub);
                kn8[j] = *(const GAS v4u*)(KVRAW + (size_t)m * 1024 + h * QKN + 8 * sub);
                const float* krp = (m < MP) ? out + O_KRP + (size_t)m * QKR : out + O_KRS + (size_t)(m - MP) * QKR; xa[j] = *(const GAS f32x2*)(krp + 2 * sub); xb[j] = *(const GAS f32x2*)(krp + 16 + 2 * sub); }
#pragma unroll
            for (int j = 0; j < 2; ++j) { if (j == 1 && !two) break; const int m = j == 0 ? m0 : m1;
            { float n[8]; unpack8(qn8[j], n);
              float a0 = bflo(qa[j]), a1 = bfhi(qa[j]), b0 = bflo(qb[j]), b1 = bfhi(qb[j]);
              float ss = (a0 * a0 + a1 * a1) + (b0 * b0 + b1 * b1);
#pragma unroll
              for (int i = 0; i < 8; ++i) ss += n[i] * n[i];
              ss = sum8(ss);
              const float rs = QSCALE / sqrtf(ss * (1.f / QKH) + EPS);
#pragma unroll
              for (int i = 0; i < 8; ++i) n[i] *= rs * gq[i];
              a0 *= rs * gq[8]; a1 *= rs * gq[9]; b0 *= rs * gq[10]; b1 *= rs * gq[11];
              bf16* qo = Q + (size_t)m * 768 + h * QKH;
              v4u w; w.x = pk2(n[0], n[1]); w.y = pk2(n[2], n[3]); w.z = pk2(n[4], n[5]); w.w = pk2(n[6], n[7]); *(GAS v4u*)(qo + 8 * sub) = w;
              *(GAS unsigned*)(qo + 64 + 2 * sub) = pk2(a0 * cs[j].x - b0 * sn[j].x, a1 * cs[j].y - b1 * sn[j].y); *(GAS unsigned*)(qo + 80 + 2 * sub) = pk2(a0 * sn[j].x + b0 * cs[j].x, a1 * sn[j].y + b1 * cs[j].y); }
            { float n[8]; unpack8(kn8[j], n);
              float a0 = xa[j].x, a1 = xa[j].y, b0 = xb[j].x, b1 = xb[j].y;
              float ss = (a0 * a0 + a1 * a1) + (b0 * b0 + b1 * b1);
#pragma unroll
              for (int i = 0; i < 8; ++i) ss += n[i] * n[i];
              ss = sum8(ss);
              const float rs = 1.0f / sqrtf(ss * (1.f / QKH) + EPS);
#pragma unroll
              for (int i = 0; i < 8; ++i) n[i] *= rs * gk[i];
              a0 *= rs * gk[8]; a1 *= rs * gk[9]; b0 *= rs * gk[10]; b1 *= rs * gk[11];
              bf16* ko = K + (size_t)m * 768 + h * QKH;
              v4u w; w.x = pk2(n[0], n[1]); w.y = pk2(n[2], n[3]); w.z = pk2(n[4], n[5]); w.w = pk2(n[6], n[7]); *(GAS v4u*)(ko + 8 * sub) = w;
              *(GAS unsigned*)(ko + 64 + 2 * sub) = pk2(a0 * cs[j].x - b0 * sn[j].x, a1 * cs[j].y - b1 * sn[j].y);
              *(GAS unsigned*)(ko + 80 + 2 * sub) = pk2(a0 * sn[j].x + b0 * cs[j].x, a1 * sn[j].y + b1 * cs[j].y); } }
        }
        _Pragma("unroll") for (int rpb_ = 0; rpb_ < P4B; ++rpb_)
        if (NGW % NG == 0) ssm_sample(args.in, (const float*)(ws + WS_SSMT), Z, GY, out, gw % NG, gw / NG, NGW / NG, (LAS float*)(lds + RING_OFF + wave * 16384), lane);
        else for (int it = gw; it < DECB * NG; it += NGW) ssm_sample(args.in, (const float*)(ws + WS_SSMT), Z, GY, out, it % NG, it / NG, DECB, (LAS float*)(lds + RING_OFF + wave * 16384), lane);
        if (BOTH(4)) GRID_BAR();
    }

    if (IN(5)) REPLOOP(5) { unsigned char* ws = opqp(ws0); const int tid = opq(tid0), lane = tid & 63, wave = __builtin_amdgcn_readfirstlane(tid >> 6), gw = vcu * NWAVES + wave; (void)lane; (void)gw;
        const bool sa_first = SA_FIRST_ALL ? true : ((vcu & 1) != 0);
        const float sref = softmax_ref((const float*)args.in[17], (const float*)args.in[18], lane);
        if (sa_first)
            for (int it = bx; it < DECB * 2; it += G)
                sa::item<0>(args.in, (const bf16*)(ws + WS_QABS), (const unsigned char*)(ws + WS_W8), (const bf16*)(ws + WS_ROPEB), (float*)(ws + WS_PO), (float*)(ws + WS_PL), sref, it >> 1, it & 1, lds + RING_OFF, tid, wave, lane);
        for (int pi = vcu; pi < 256; pi += G) { const int bh = pi >> 4, s_ = pi & 15;
            pa::attn_unit(Q, K, KVRAW + 512, ATT, bh >> 3, bh & 7, s_, sref, lds + RING_OFF, wave, lane);
            pa::attn_unit(Q, K, KVRAW + 512, ATT, bh >> 3, bh & 7, 31 - s_, sref, lds + RING_OFF, wave, lane); }
        if (!sa_first)
            for (int it = bx; it < DECB * 2; it += G)
                sa::item<0>(args.in, (const bf16*)(ws + WS_QABS), (const unsigned char*)(ws + WS_W8), (const bf16*)(ws + WS_ROPEB), (float*)(ws + WS_PO), (float*)(ws + WS_PL), sref, it >> 1, it & 1, lds + RING_OFF, tid, wave, lane);
        if (BOTH(5)) GRID_BAR();
    }

    if (IN(6)) REPLOOP(6) { unsigned char* ws = opqp(ws0); const int tid = opq(tid0), lane = tid & 63, wave = __builtin_amdgcn_readfirstlane(tid >> 6), gw = vcu * NWAVES + wave; (void)lane; (void)gw;
        const float sref6 = softmax_ref((const float*)args.in[17], (const float*)args.in[18], lane);
        const int GH = G / 2;
        _Pragma("unroll") for (int rq_ = 0; rq_ < P6A; ++rq_)
        if (bx >= GH) for (int it = bx - GH; it < NH * (MS / 16); it += G - GH)
            sa::combine_item(args.in, Q, K, CKVN, (const float*)(ws + WS_PO), (const float*)(ws + WS_PL), sref6, ATT, it & 7, it >> 3, lds + RING_OFF, tid, wave, lane);
        { pg8::Gemm g{AY, (const bf16*)(ws + WS_TYT), SKA, SKA, SKA, (size_t)SCH * SKA, (size_t)512 * SKA}; pg8::Order S; S.init(SCH / 256, 2, NG, GH, bx, 0);
          auto f = [=](const pg8::Unit& u, int row, int col, f32x4 a, f32x4 b) {
#pragma unroll
              for (int i = 0; i < 4; ++i) { a[i] = gelu_tanh(a[i]); b[i] = gelu_tanh(b[i]); }
              *(GAS v4u*)(GY + ((size_t)row * SL + (col >> 4)) * SSMW + u.z * GRP + (col & 15)) = pack8(a, b); };
          pg8::EpiRow8<decltype(f)> E{f}; if (bx < GH) pg8::gemm_phase(lds + RING_OFF, g, S, E); }
        if (BOTH(6)) GRID_BAR();
    }

    if (IN(7)) REPLOOP(7) { unsigned char* ws = opqp(ws0); const int tid = opq(tid0), lane = tid & 63, wave = __builtin_amdgcn_readfirstlane(tid >> 6), gw = vcu * NWAVES + wave; (void)lane; (void)gw;
        { pg8::Gemm gg{GY, WGLU, SSMW, SSMW, SSMW, 0, 0};
          auto fg_ = [=](const pg8::Unit& u, int row, int cp, f32x4 a0, f32x4 a1, f32x4 b0, f32x4 b1) {
#pragma unroll
              for (int i = 0; i < 4; ++i) { a0[i] *= sigmoidf_(b0[i]); a1[i] *= sigmoidf_(b1[i]); }
              *(GAS v4u*)(YG + (size_t)row * SSMW + cp) = pack8(a0, a1); };
          pg8::EpiPair8<decltype(fg_)> Eg{fg_};
          pg8::Gemm ga_{ATT, WOA, ATTW, ATTW, ATTW, 0, 0};
          auto fa_ = [=](const pg8::Unit& u, int row, int col, f32x4 a, f32x4 b) { float gt[8]; unpack8(*(const GAS v4u*)(Z + (size_t)row * NZ + ZC_GA + col), gt);
#pragma unroll
              for (int i = 0; i < 4; ++i) { a[i] *= gt[i]; b[i] *= gt[4 + i]; }
              *(GAS v4u*)(T1 + (size_t)row * D + col) = pack8(a, b); };
          pg8::EpiRow8<decltype(fa_)> Ea{fa_};
          GEMM_P(gg, 4, 0, Eg); GEMM_P(ga_, 4, 256, Ea); GEMM_S(gg, 4, 512, Eg); GEMM_S(ga_, 4, 544, Ea); }
        if (BOTH(7)) GRID_BAR();
    }

    if (IN(8)) REPLOOP(8) { unsigned char* ws = opqp(ws0); const int tid = opq(tid0), lane = tid & 63, wave = __builtin_amdgcn_readfirstlane(tid >> 6), gw = vcu * NWAVES + wave; (void)lane; (void)gw;
        pg8::Gemm g{YG, WOS, SSMW, SSMW, SSMW, 0, 0};
        auto f = [=](const pg8::Unit& u, int row, int col, f32x4 a, f32x4 b) { float gt[8], t1[8]; unpack8(*(const GAS v4u*)(Z + (size_t)row * NZ + ZC_GS + col), gt); unpack8(*(const GAS v4u*)(T1 + (size_t)row * D + col), t1);
#pragma unroll
            for (int i = 0; i < 4; ++i) { a[i] = t1[i] + a[i] * gt[i]; b[i] = t1[4 + i] + b[i] * gt[4 + i]; }
            *(GAS v4u*)(MIX + (size_t)row * D + col) = pack8(a, b); };
        pg8::EpiRow8<decltype(f)> E{f}; GEMM_PS(g, 4, 0, 256, E);
        TAIL_FILL(32, 44 * 32, tr_plain((const float*)args.in[35], DFF, 1024, WDN, r, scr, lane));
        if (BOTH(8)) GRID_BAR();
    }

    if (IN(9)) REPLOOP(9) { unsigned char* ws = opqp(ws0); const int tid = opq(tid0), lane = tid & 63, wave = __builtin_amdgcn_readfirstlane(tid >> 6), gw = vcu * NWAVES + wave; (void)lane; (void)gw;
        pg8::Gemm g{MIX, WOUT, D, D, D, 0, 0};
        EpiResid<false> E{x_prompt, x_sample, nullptr, XN, SS1};
        GEMM_PS(g, 4, 0, 256, E);
        TAIL_FILL(32, 16 * 32, tr_plain((const float*)args.in[37], 1024, 1024, WPG, r, scr, lane, (const float*)args.in[36]));
        if (BOTH(9)) GRID_BAR();
    }

    if (IN(10)) REPLOOP(10) { unsigned char* ws = opqp(ws0); const int tid = opq(tid0), lane = tid & 63, wave = __builtin_amdgcn_readfirstlane(tid >> 6), gw = vcu * NWAVES + wave; (void)lane; (void)gw;
        pg8::Gemm g{XN, WUP, D, D, D, 0, 0};
        EpiUpConv E{SS1, HB, (bf16*)(ws + WS_UPF), (bf16*)(ws + WS_UPL), out, (const float*)args.in[33], (const float*)args.in[34], (const float*)args.in[9], lds + 131072, ctl + CW_PAN};
        constexpr int NUS = (MS / 256) * (UPW / 256), NUP = (MP / 256) * (UPW / 256);
        { pg8::Order Sa, Sb; Sa.init(MS / 256, UPW / 256, 1, G, bx, 0, MP / 256, 1); Sb.init(MP / 256, UPW / 256, 1, G, bx, NUS); pg8::OrderSeq S; S.init(Sa, Sb, NUS, G, bx);
          pg8::gemm_phase<EpiUpConv, true, true, false, pg8::OrderSeq>(lds + RING_OFF, g, S, E); }
        {
          pg8::Gemm gp{PB, WPP, PLE, PLE, PLE, 0, 0}; auto fp_ = [=](const pg8::Unit& u, int row, int col, f32x4 a, f32x4 b) { *(GAS v4u*)(PP + (size_t)row * 1024 + col) = pack8(a, b); }; pg8::EpiRow8<decltype(fp_)> Ep{fp_};
          const int nb_ = (NUS + NUP) % G; const int nidle = nb_ ? G - nb_ : G, ci = nb_ ? bx - nb_ : bx;
          const int nd_ = (nidle > 64) ? 32 : 0;
          if (ci >= 0 && ci < nd_) { pg8::Gemm gd{HB, WDN, DFF, DFF, DFF, 0, 0}; EpiResid<true> Ed{nullptr, nullptr, XN, X2B, SS2};
              pg8::Order Sd; Sd.init(MS / 256, 4, 1, nd_, ci, 0, MP / 256, 4); pg8::Unit uo;
              for (int i = 0; Sd.next(i, uo); ++i) wait_panel(ctl + CW_PAN, uo.pm, (unsigned)(UPW / 256) * 8u, ctl + CW_PTMO);
              pg8::gemm_phase<EpiResid<true>, true, true, true>(lds + RING_OFF, gd, Sd, Ed); }
          else if (ci >= nd_) { pg8::Order So; So.init(NMT, 4, 1, nidle - nd_, ci - nd_, 0); pg8::gemm_phase(lds + RING_OFF, gp, So, Ep); } }
        if (BOTH(10)) GRID_BAR();
    }


    if (IN(12)) REPLOOP(12) { unsigned char* ws = opqp(ws0); const int tid = opq(tid0), lane = tid & 63, wave = __builtin_amdgcn_readfirstlane(tid >> 6), gw = vcu * NWAVES + wave; (void)lane; (void)gw;
        { const float* conv_w = (const float*)args.in[33]; const float* conv_b = (const float*)args.in[34]; const bf16* UPF = (const bf16*)(ws + WS_UPF); const bf16* UPL = (const bf16*)(ws + WS_UPL);
          constexpr int NCG = DFF / 8; pg8::Order So; So.init(MP / 256, 4, 1, G, bx, 0); pg8::Unit uo;
          for (int ui = 0; So.next(ui, uo); ++ui) { const int pm = uo.pm;
          for (int it = tid; it < 2 * NCG; it += 512) {
            const int cg = it % NCG, rr = it / NCG, c0 = 8 * cg; const bool first = (pm & 31) == 0;
            float cur[16], p1[16], p2[16];
            unpack8(*(const GAS v4u*)(UPF + ((size_t)pm * 2 + rr) * UPW + c0), *(float(*)[8])&cur[0]); unpack8(*(const GAS v4u*)(UPF + ((size_t)pm * 2 + rr) * UPW + DFF + c0), *(float(*)[8])&cur[8]);
#pragma unroll
            for (int i = 0; i < 16; ++i) { p1[i] = 0.f; p2[i] = 0.f; }
            if (rr == 1) { unpack8(*(const GAS v4u*)(UPF + ((size_t)pm * 2) * UPW + c0), *(float(*)[8])&p1[0]); unpack8(*(const GAS v4u*)(UPF + ((size_t)pm * 2) * UPW + DFF + c0), *(float(*)[8])&p1[8]); }
            if (!first) {
                if (rr == 0) { unpack8(*(const GAS v4u*)(UPL + ((size_t)(pm - 1) * 2 + 1) * UPW + c0), *(float(*)[8])&p1[0]); unpack8(*(const GAS v4u*)(UPL + ((size_t)(pm - 1) * 2 + 1) * UPW + DFF + c0), *(float(*)[8])&p1[8]);
                               unpack8(*(const GAS v4u*)(UPL + ((size_t)(pm - 1) * 2) * UPW + c0), *(float(*)[8])&p2[0]); unpack8(*(const GAS v4u*)(UPL + ((size_t)(pm - 1) * 2) * UPW + DFF + c0), *(float(*)[8])&p2[8]); }
                else { unpack8(*(const GAS v4u*)(UPL + ((size_t)(pm - 1) * 2 + 1) * UPW + c0), *(float(*)[8])&p2[0]); unpack8(*(const GAS v4u*)(UPL + ((size_t)(pm - 1) * 2 + 1) * UPW + DFF + c0), *(float(*)[8])&p2[8]); }
            }
            float hh[8];
#pragma unroll
            for (int i = 0; i < 8; ++i) { const float ca = conv_b[c0 + i] + p2[i] * conv_w[c0 + i] + p1[i] * conv_w[UPW + c0 + i] + cur[i] * conv_w[2 * UPW + c0 + i];
                const float cv = conv_b[DFF + c0 + i] + p2[8 + i] * conv_w[DFF + c0 + i] + p1[8 + i] * conv_w[UPW + DFF + c0 + i] + cur[8 + i] * conv_w[2 * UPW + DFF + c0 + i]; hh[i] = gelu_tanh(ca) * cv; }
            v4u o; o.x = pk2(hh[0], hh[1]); o.y = pk2(hh[2], hh[3]); o.z = pk2(hh[4], hh[5]); o.w = pk2(hh[6], hh[7]);
            *(GAS v4u*)(HB + ((size_t)pm * 256 + rr) * DFF + c0) = o;
        }
          }
          asm volatile("s_waitcnt vmcnt(0)" ::: "memory"); __syncthreads(); }
        pg8::Gemm g{HB, WDN, DFF, DFF, DFF, 0, 0};
        EpiResid<true> E{nullptr, nullptr, XN, X2B, SS2};
        { constexpr int NU10 = (M / 256) * (UPW / 256); const int nb_ = NU10 % G, nidle = nb_ ? G - nb_ : G;
          if (nidle > 64) GEMM_P(g, 4, 0, E); else GEMM_PS(g, 4, 0, 256, E); }
        if (BOTH(12)) GRID_BAR();
    }

    if (IN(13)) REPLOOP(13) { unsigned char* ws = opqp(ws0); const int tid = opq(tid0), lane = tid & 63, wave = __builtin_amdgcn_readfirstlane(tid >> 6), gw = vcu * NWAVES + wave; (void)lane; (void)gw;
        pg8::Gemm g{X2B, WPG, D, D, D, 0, 0};
        EpiPle E{SS2, X2B, PP, out + O_Y};
        GEMM_PS(g, 4, 0, 256, E);
    }
#undef IN
#undef BOTH
}

#undef WIN
#undef WUQ
#undef WKV
#undef WGLU
#undef WOA
#undef WOS
#undef WOUT
#undef WPG
#undef WPP
#undef WUP
#undef WDN
#undef XN
#undef Z
#undef CQN
#undef CKVN
#undef PB
#undef AY
#undef RT
#undef RB
#undef QRAW
#undef KVRAW
#undef PP
#undef Q
#undef K
#undef ATT
#undef GY
#undef YG
#undef T1
#undef MIX
#undef SS1
#undef SS2
#undef UPB
#undef HB
#undef X2B
#undef CB
#undef KNC
#undef ROPE
#undef SST
constexpr int N_PHASES = 14;
extern "C" void kernel_launch(void* const* d_in, const int* in_sizes, int n_in, void* d_out, int out_size, void* d_ws, size_t ws_size, hipStream_t stream) {
    static int grid = 0;
    if (grid == 0) {
        if (n_in != 39 || (size_t)out_size != O_END || ws_size < WS_END) { fprintf(stderr, "kernel_launch: unexpected sizes n_in %d out %d ws %zu\n", n_in, out_size, ws_size); grid = -1; return; }
        int dev = 0, cus = 0, per_cu = 0;
        if (hipGetDevice(&dev) != hipSuccess || hipDeviceGetAttribute(&cus, hipDeviceAttributeMultiprocessorCount, dev) != hipSuccess) { grid = -1; return; }
        if (hipFuncSetAttribute((const void*)mk_fwd, hipFuncAttributeMaxDynamicSharedMemorySize, LDS_BYTES) != hipSuccess) { fprintf(stderr, "kernel_launch: hipFuncSetAttribute failed\n"); grid = -1; return; }
        if (hipOccupancyMaxActiveBlocksPerMultiprocessor(&per_cu, (const void*)mk_fwd, NWAVES * 64, LDS_BYTES) != hipSuccess || per_cu < 1)
            fprintf(stderr, "kernel_launch: occupancy query reports %d\n", per_cu);
        (void)hipGetLastError();
        grid = cus;
    }
    if (grid < 0) return;
    if (hipMemsetAsync((char*)d_ws + WS_CTL, 0, CTL_ZERO_BYTES, stream) != hipSuccess) return;
    Args a{};
    for (int i = 0; i < 39; ++i) a.in[i] = d_in[i];
    a.out = (float*)d_out; a.ws = (unsigned char*)d_ws;
#if MK_ONE_LAUNCH
    a.ph_lo = 0; a.ph_hi = N_PHASES;
    hipLaunchKernelGGL(mk_fwd, dim3(grid), dim3(NWAVES * 64), LDS_BYTES, stream, a);
#else
    for (int p = 0; p < N_PHASES; ++p) { a.ph_lo = p; a.ph_hi = p + 1;
        hipLaunchKernelGGL(mk_fwd, dim3(grid), dim3(NWAVES * 64), LDS_BYTES, stream, a); }
#endif
}
```
